# Optimizing an MI355X kernel written in HIP

```python
import math
import jax, jax.numpy as jnp
from jax import lax
import numpy as np

D_MODEL = 2048
BATCH = 2
SEQ = 4096
DEPTH = 1

ML_HEADS = 4
ML_DQK = 128
ML_DV = 256
ML_CHUNK = 64
ML_W = ML_HEADS * ML_DV
DA_HEADS = 8
DA_DQK = 64
DA_DV = 2 * DA_DQK
DA_W = DA_HEADS * DA_DV
Q_BLOCK = 128
ROPE_THETA = 10000.0
N_EXPERTS = 32
TOP_K = 4
D_EXPERT = D_MODEL
SWIGLU_LIMIT = 7.0
SWIGLU_ALPHA = 1.702
MOE_BLOCK = 128
EPS = 1e-6

IN_SPLITS = (
    ML_HEADS * ML_DQK,
    ML_HEADS * ML_DQK,
    ML_W,
    ML_W,
    4 * ML_HEADS,
    DA_HEADS * 2 * DA_DQK,
    DA_HEADS * 2 * DA_DQK,
    DA_W,
    D_MODEL,
    D_MODEL,
)
D_IN = sum(IN_SPLITS)

kernel_name = "hybrid_mlstm_diffattn_moe_encoder"


def rms_norm(x, g):
    xf = x.astype(jnp.float32)
    y = xf * lax.rsqrt(jnp.mean(xf * xf, axis=-1, keepdims=True) + EPS)
    return (y * g.astype(jnp.float32)).astype(x.dtype)


def split_columns(p):
    out = []
    off = 0
    for n in IN_SPLITS:
        out.append(p[..., off:off + n])
        off += n
    return out


def rope_tables(seq, dim):
    inv = ROPE_THETA ** (-jnp.arange(0, dim, 2, dtype=jnp.float32) / dim)
    ang = jnp.arange(seq, dtype=jnp.float32)[:, None] * inv[None, :]
    return jnp.cos(ang), jnp.sin(ang)


def apply_rope(x, cos, sin):
    half = x.shape[-1] // 2
    x1, x2 = x[..., :half], x[..., half:]
    return jnp.concatenate([x1 * cos - x2 * sin, x2 * cos + x1 * sin], axis=-1)


def mlstm_one_direction(q, k, v, ig, fg):
    B, H, S, dk = q.shape
    dv = v.shape[-1]
    L = ML_CHUNK
    NC = S // L
    q = q.reshape(B, H, NC, L, dk)
    k = k.reshape(B, H, NC, L, dk)
    v = v.reshape(B, H, NC, L, dv)
    ig = ig.reshape(B, H, NC, L)
    b = jnp.cumsum(jax.nn.log_sigmoid(fg).reshape(B, H, NC, L), axis=-1)
    g = b[..., -1]
    a = g[..., None] - b + ig

    def step(carry, inp):
        C, n, m = carry
        a_c, g_c, k_c, v_c = inp
        m_new = jnp.maximum(g_c + m, jnp.max(a_c, axis=-1))
        decay = jnp.exp(g_c + m - m_new)
        w = jnp.exp(a_c - m_new[..., None])
        C_new = decay[..., None, None] * C + jnp.einsum('bhsv,bhsk->bhvk', w[..., None] * v_c, k_c)
        n_new = decay[..., None] * n + jnp.einsum('bhs,bhsk->bhk', w, k_c)
        return (C_new, n_new, m_new), (C, n, m)

    init = (jnp.zeros((B, H, dv, dk), jnp.float32),
            jnp.zeros((B, H, dk), jnp.float32),
            jnp.zeros((B, H), jnp.float32))
    xs = (jnp.moveaxis(a, 2, 0), jnp.moveaxis(g, 2, 0),
          jnp.moveaxis(k, 2, 0), jnp.moveaxis(v, 2, 0))
    _, (C_prev, n_prev, m_prev) = lax.scan(step, init, xs)
    C_prev = jnp.moveaxis(C_prev, 0, 2)
    n_prev = jnp.moveaxis(n_prev, 0, 2)
    m_prev = jnp.moveaxis(m_prev, 0, 2)

    lower = jnp.tril(jnp.ones((L, L), dtype=bool))
    logD = b[..., :, None] - b[..., None, :] + ig[..., None, :]
    logD = jnp.where(lower, logD, -jnp.inf)
    inter = b + m_prev[..., None]
    m_t = jnp.maximum(inter, jnp.max(logD, axis=-1))
    s_inter = jnp.exp(inter - m_t)
    Dqk = jnp.exp(logD - m_t[..., None]) * jnp.einsum('bhctk,bhcsk->bhcts', q, k)
    num = (s_inter[..., None] * jnp.einsum('bhcvk,bhctk->bhctv', C_prev, q)
           + jnp.einsum('bhcts,bhcsv->bhctv', Dqk, v))
    den = s_inter * jnp.einsum('bhck,bhctk->bhct', n_prev, q) + jnp.sum(Dqk, axis=-1)
    den = jnp.maximum(jnp.abs(den), jnp.exp(-m_t))
    return (num / den[..., None]).reshape(B, H, S, dv)


def mlstm_branch(mq, mk, mv, mo, mg, gate_bias, norm_g, w_out):
    B, S, _ = mq.shape
    f32 = jnp.float32
    q = mq.astype(f32).reshape(B, S, ML_HEADS, ML_DQK).transpose(0, 2, 1, 3)
    k = mk.astype(f32).reshape(B, S, ML_HEADS, ML_DQK).transpose(0, 2, 1, 3) * (ML_DQK ** -0.5)
    v = mv.astype(f32).reshape(B, S, ML_HEADS, ML_DV).transpose(0, 2, 1, 3)
    gates = mg.astype(f32).reshape(B, S, 4, ML_HEADS) + gate_bias.astype(f32)
    i_f, f_f, i_b, f_b = gates.transpose(2, 0, 3, 1)
    rev = lambda t: jnp.flip(t, axis=2)
    h_f = mlstm_one_direction(q, k, v, i_f, f_f)
    h_b = rev(mlstm_one_direction(rev(q), rev(k), rev(v), rev(i_b), rev(f_b)))
    h = rms_norm((h_f + h_b).transpose(0, 2, 1, 3), norm_g).reshape(B, S, ML_W)
    h = h * jax.nn.sigmoid(mo.astype(f32))
    return h.astype(mq.dtype) @ w_out


def diff_attn_branch(dq, dk, dv, q_norm_g, k_norm_g, lam_params, norm_g, w_out, cos, sin, lam_init):
    B, S, _ = dq.shape
    d = DA_DQK
    cs, sn = cos[None, :, None, None, :], sin[None, :, None, None, :]
    q = apply_rope(rms_norm(dq.reshape(B, S, DA_HEADS, 2, d), q_norm_g), cs, sn)
    k = apply_rope(rms_norm(dk.reshape(B, S, DA_HEADS, 2, d), k_norm_g), cs, sn)
    q = q.transpose(0, 2, 3, 1, 4)
    k = k.transpose(0, 2, 3, 1, 4)
    v = dv.reshape(B, S, DA_HEADS, DA_DV).transpose(0, 2, 1, 3)
    lp = lam_params.astype(jnp.float32)
    lam = jnp.exp(jnp.sum(lp[0] * lp[1])) - jnp.exp(jnp.sum(lp[2] * lp[3])) + lam_init
    nq = S // Q_BLOCK
    qb = q.reshape(B, DA_HEADS, 2, nq, Q_BLOCK, d).transpose(3, 0, 1, 2, 4, 5)
    scale = d ** -0.5

    def attend(q_blk):
        s = jnp.einsum('bhmqd,bhmkd->bhmqk', q_blk, k).astype(jnp.float32) * scale
        p = jax.nn.softmax(s, axis=-1)
        amap = p[:, :, 0] - lam * p[:, :, 1]
        return jnp.einsum('bhqk,bhkv->bhqv', amap, v.astype(jnp.float32))

    o = lax.map(attend, qb)
    o = o.transpose(1, 0, 3, 2, 4).reshape(B, S, DA_HEADS, DA_DV)
    o = rms_norm(o, norm_g) * (1.0 - lam_init)
    return o.reshape(B, S, DA_W).astype(dq.dtype) @ w_out


def moe_ffn(h, w_r, b_r, w_gu, b_gu, w_dn, b_dn):
    T = h.shape[0]
    TK = T * TOP_K
    logits = (h @ w_r).astype(jnp.float32) + b_r.astype(jnp.float32)
    top_v, top_i = lax.top_k(logits, TOP_K)
    wts = jax.nn.softmax(top_v, axis=-1)
    flat_e = top_i.reshape(-1)
    order = jnp.argsort(flat_e)
    e_sorted = flat_e[order]
    tok_sorted = order // TOP_K
    counts = jnp.bincount(flat_e, length=N_EXPERTS)
    padded = (counts + MOE_BLOCK - 1) // MOE_BLOCK * MOE_BLOCK
    pad_end = jnp.cumsum(padded)
    pad_start = pad_end - padded
    start = jnp.cumsum(counts) - counts
    dest = pad_start[e_sorted] + (jnp.arange(TK) - start[e_sorted])
    n_rows = TK + N_EXPERTS * MOE_BLOCK
    n_blk = n_rows // MOE_BLOCK
    row_tok = jnp.zeros((n_rows,), jnp.int32).at[dest].set(tok_sorted.astype(jnp.int32))
    blk_exp = jnp.minimum(jnp.searchsorted(pad_end, jnp.arange(n_blk) * MOE_BLOCK, side='right'),
                          N_EXPERTS - 1)

    def expert_block(args):
        rows, e = args
        xb = h[rows]
        gu = xb @ w_gu[e] + b_gu[e]
        glu = jnp.minimum(gu[:, 0::2], SWIGLU_LIMIT)
        lin = jnp.clip(gu[:, 1::2], -SWIGLU_LIMIT, SWIGLU_LIMIT)
        act = glu * jax.nn.sigmoid(SWIGLU_ALPHA * glu) * (lin + 1.0)
        return act @ w_dn[e] + b_dn[e]

    y_rows = lax.map(expert_block, (row_tok.reshape(n_blk, MOE_BLOCK), blk_exp))
    y_rows = y_rows.reshape(n_rows, h.shape[-1])
    y_assign = y_rows[dest].astype(jnp.float32) * wts.reshape(-1)[order][:, None]
    return jax.ops.segment_sum(y_assign, tok_sorted, num_segments=T).astype(h.dtype)


def setup_inputs(seed: int = 0) -> dict:
    key = jax.random.key(seed)
    ks = jax.random.split(key, 20)
    nrm = lambda k, shape, s: jax.random.normal(k, shape, jnp.float32) * s
    gain = lambda k, shape: 1.0 + 0.02 * jax.random.normal(k, shape, jnp.float32)
    gate_off = jnp.array([0.0, 1.0, 0.0, 1.0], jnp.float32)[:, None] * jnp.linspace(3.0, 6.0, ML_HEADS)[None, :]
    return {
        "x": nrm(ks[0], (BATCH, SEQ, D_MODEL), 1.0),
        "norm1_g": gain(ks[1], (DEPTH, D_MODEL)),
        "w_in": nrm(ks[2], (DEPTH, D_MODEL, D_IN), D_MODEL ** -0.5),
        "ml_gate_bias": gate_off[None] + nrm(ks[3], (DEPTH, 4, ML_HEADS), 0.1),
        "ml_norm_g": gain(ks[4], (DEPTH, ML_DV)),
        "w_ml_out": nrm(ks[5], (DEPTH, ML_W, D_MODEL), ML_W ** -0.5),
        "da_q_norm_g": gain(ks[6], (DEPTH, DA_DQK)),
        "da_k_norm_g": gain(ks[7], (DEPTH, DA_DQK)),
        "da_lambda": nrm(ks[8], (DEPTH, 4, DA_DQK), 0.1),
        "da_norm_g": gain(ks[9], (DEPTH, DA_DV)),
        "w_da_out": nrm(ks[10], (DEPTH, DA_W, D_MODEL), DA_W ** -0.5),
        "w_o": nrm(ks[11], (DEPTH, D_MODEL, D_MODEL), D_MODEL ** -0.5),
        "norm2_g": gain(ks[12], (DEPTH, D_MODEL)),
        "w_router": nrm(ks[13], (DEPTH, D_MODEL, N_EXPERTS), D_MODEL ** -0.5),
        "b_router": nrm(ks[14], (DEPTH, N_EXPERTS), 0.01),
        "w_gate_up": nrm(ks[15], (DEPTH, N_EXPERTS, D_MODEL, 2 * D_EXPERT), D_MODEL ** -0.5),
        "b_gate_up": nrm(ks[16], (DEPTH, N_EXPERTS, 2 * D_EXPERT), 0.01),
        "w_down": nrm(ks[17], (DEPTH, N_EXPERTS, D_EXPERT, D_MODEL), D_EXPERT ** -0.5),
        "b_down": nrm(ks[18], (DEPTH, N_EXPERTS, D_MODEL), 0.01),
    }


def reference(x, norm1_g, w_in, ml_gate_bias, ml_norm_g, w_ml_out, da_q_norm_g, da_k_norm_g,
              da_lambda, da_norm_g, w_da_out, w_o, norm2_g, w_router, b_router,
              w_gate_up, b_gate_up, w_down, b_down):
    B, S, D = x.shape
    cos, sin = rope_tables(S, DA_DQK)
    for l in range(DEPTH):
        lam_init = 0.8 - 0.6 * math.exp(-0.3 * l)
        h = rms_norm(x, norm1_g[l])
        proj = h @ w_in[l]
        mq, mk, mv, mo, mg, dq, dk, dv, gm, gd = split_columns(proj)
        y_m = mlstm_branch(mq, mk, mv, mo, mg, ml_gate_bias[l], ml_norm_g[l], w_ml_out[l])
        y_d = diff_attn_branch(dq, dk, dv, da_q_norm_g[l], da_k_norm_g[l], da_lambda[l],
                               da_norm_g[l], w_da_out[l], cos, sin, lam_init)
        mix = (jax.nn.sigmoid(gm.astype(jnp.float32)) * y_m.astype(jnp.float32)
               + jax.nn.sigmoid(gd.astype(jnp.float32)) * y_d.astype(jnp.float32))
        x = x + (mix.astype(x.dtype) @ w_o[l]).astype(x.dtype)
        h2 = rms_norm(x, norm2_g[l]).reshape(B * S, D)
        y = moe_ffn(h2, w_router[l], b_router[l], w_gate_up[l], b_gate_up[l], w_down[l], b_down[l])
        x = x + y.reshape(B, S, D).astype(x.dtype)
    return x
```

```cpp
#include <hip/hip_runtime.h>
#include <cstdio>
#include <cstdint>
#include <math.h>

constexpr int D = 2048, NB = 2, S = 4096, T = NB * S;
constexpr int MLH = 4, MLDK = 128, MLDV = 256, MLW = 1024, NCH = 64;
constexpr int DAH = 8, DAD = 64, DADV = 128, DAW = 1024;
constexpr int NE = 32, TOPK = 4, DE = 2048;
constexpr int DIN = 10256, NPJ = 10240;
constexpr int G_OFF = 3072;
constexpr int P_MQ = 0, P_MK = 512, P_MV = 1024, P_MO = 2048, P_DQ = 3072, P_DK = 4096, P_DV = 5120, P_GM = 6144, P_GD = 8192;
constexpr float EPS = 1e-6f;
constexpr int PADM = 256;
constexpr int MAXROWS = T * TOPK + NE * PADM;
constexpr float LAM_INIT = 0.2f;
constexpr float QSCALE = 0.125f * 1.4426950408889634f;
constexpr float KSCALE = 0.08838834764831845f;

constexpr size_t MiB = 1ull << 20;
constexpr size_t WS_CTL = 0, CTL_ZERO_BYTES = 1 * MiB;
constexpr size_t WS_MSC = 1 * MiB;
constexpr size_t WS_RT = 2 * MiB;
constexpr size_t WS_ROPE = 3 * MiB;
constexpr size_t WS_MG = 4 * MiB;
constexpr size_t WS_NU = 5 * MiB;
constexpr size_t WS_NP = 6 * MiB;
constexpr size_t WS_WRH = 7 * MiB, WS_WRL = 7 * MiB + 256 * 1024;
constexpr size_t WS_WIN = 8 * MiB;
constexpr size_t WS_WIN8 = 32 * MiB;
constexpr size_t WS_WML = 48 * MiB;
constexpr size_t WS_WDA = 52 * MiB;
constexpr size_t WS_WO = 56 * MiB;
constexpr size_t WS_WGU = 64 * MiB;
constexpr size_t WS_WDN = 576 * MiB;
constexpr size_t WS_XN = 832 * MiB;
constexpr size_t WS_PROJ = 864 * MiB;
constexpr size_t WS_QN = 1024 * MiB;
constexpr size_t WS_KN = 1040 * MiB;
constexpr size_t WS_U = 1056 * MiB;
constexpr size_t WS_CP = 1184 * MiB;
constexpr size_t WS_HM = 1248 * MiB;
constexpr size_t WS_OD = 1264 * MiB;
constexpr size_t WS_XN8 = 1280 * MiB;
constexpr size_t WS_T1 = 1280 * MiB;
constexpr size_t WS_MIX = 1312 * MiB;
constexpr size_t WS_H2 = 1344 * MiB;
constexpr size_t WS_XG = 1376 * MiB;
constexpr size_t WS_ACT = 1536 * MiB;
constexpr size_t WS_Y = 1696 * MiB;
constexpr size_t WS_G8 = 1856 * MiB;
constexpr size_t WS_NAIVE = 1920 * MiB;
constexpr size_t WS_END = 2500 * MiB;
constexpr int CW_CNT = 64;
constexpr int CW_BAR = 4096;
constexpr int CW_WGCNT = 8192;

typedef unsigned short bf16;
typedef unsigned v4u __attribute__((ext_vector_type(4)));
typedef unsigned v2u __attribute__((ext_vector_type(2)));
typedef float f32x4 __attribute__((ext_vector_type(4)));
typedef float f32x2 __attribute__((ext_vector_type(2)));
typedef float f32x16 __attribute__((ext_vector_type(16)));
typedef short bf16x8 __attribute__((ext_vector_type(8)));
typedef short s16x4 __attribute__((ext_vector_type(4)));
typedef __bf16 bf16x2_t __attribute__((ext_vector_type(2)));
#define GAS __attribute__((address_space(1)))
#define LAS __attribute__((address_space(3)))

__device__ __forceinline__ float bf2f(unsigned v) { return __uint_as_float(v << 16); }
__device__ __forceinline__ float bflo(unsigned w) { return __uint_as_float(w << 16); }
__device__ __forceinline__ float bfhi(unsigned w) { return __uint_as_float(w & 0xffff0000u); }
__device__ __forceinline__ unsigned pk2(float lo, float hi) { f32x2 v = {lo, hi}; bf16x2_t b = __builtin_convertvector(v, bf16x2_t); return __builtin_bit_cast(unsigned, b); }
__device__ __forceinline__ bf16 f2bf(float f) { return (bf16)(pk2(f, 0.f) & 0xffffu); }
__device__ __forceinline__ float sigmoidf_(float x) { return 1.f / (1.f + __expf(-x)); }
__device__ __forceinline__ float logsigf_(float x) { return x >= 0.f ? -log1pf(__expf(-x)) : x - log1pf(__expf(x)); }
__device__ __forceinline__ float wave_sum(float v) {
#pragma unroll
    for (int o = 1; o < 64; o <<= 1) v += __shfl_xor(v, o);
    return v;
}
__device__ __forceinline__ float wave_max(float v) {
#pragma unroll
    for (int o = 1; o < 64; o <<= 1) v = fmaxf(v, __shfl_xor(v, o));
    return v;
}
namespace pg8 {
#define PG8_LAS __attribute__((address_space(3)))
typedef unsigned short bf16_t;
typedef short bf16x8 __attribute__((ext_vector_type(8)));
typedef float f32x4 __attribute__((ext_vector_type(4)));
typedef unsigned u32x4 __attribute__((ext_vector_type(4)));
constexpr int BM = 256, BK = 64, HALF = 128, HTB = HALF * BK * 2  , STAGE_BYTES = 8 * HTB, NXCD = 8, WGM = 8;

__host__ __device__ __forceinline__ int lds_byte(int r, int c) { const int st = (r >> 4) * 2 + (c >> 5), rr = r & 15, cc = c & 31, ob = rr * 64 + cc * 2; return st * 1024 + (ob ^ (((ob >> 9) & 1) << 5)); }
__host__ __device__ __forceinline__ void stage_rc(int b, int& R, int& C) { const int st = b / 1024, sb = b % 1024, swz = sb ^ (((sb >> 9) & 1) << 5); R = (st >> 1) * 16 + swz / 64; C = (st & 1) * 32 + (swz % 64) / 2; }
__host__ __device__ __forceinline__ int perm32(int rho) { const int n = rho >> 4, i = rho & 15; return 8 * (i >> 2) + 4 * n + (i & 3); }

struct Unit { int pm, pn, pb, half; };
struct Gemm { const bf16_t* A; const bf16_t* Bt; int M, N, K; };

struct StaticOrder {
    int nM, nN, nwg, G, c;
    __host__ __device__ void init(int M, int N, int G_, int c_) { nM = M / BM; nN = N / BM; nwg = nM * nN; G = G_; c = c_; }
    __host__ __device__ bool next(int i, Unit& u) const {
        const long L = (long)i * G + c; if (L >= nwg) return false;
        int wgid = (int)L; { const int q = nwg / NXCD, r = nwg % NXCD, xcd = wgid % NXCD, off = wgid / NXCD; wgid = (xcd < r ? xcd * (q + 1) : r * (q + 1) + (xcd - r) * q) + off; }
        const int nig = WGM * nN, gid = wgid / nig, fm = gid * WGM, gsz = (nM - fm) < WGM ? (nM - fm) : WGM;
        u.pm = fm + ((wgid % nig) % gsz); u.pn = (wgid % nig) / gsz; u.pb = u.pn; u.half = 0; return true;
    }
    __device__ __forceinline__ void a_ready(const Unit&) const {}
    __device__ __forceinline__ void done(const Unit&) const {}
    __device__ __forceinline__ int rot() const { return 0; }
};

__device__ __forceinline__ unsigned cvt_pk_bf16(float lo, float hi) { unsigned r; asm volatile("v_cvt_pk_bf16_f32 %0, %1, %2" : "=v"(r) : "v"(lo), "v"(hi)); return r; }
typedef float f32x2 __attribute__((ext_vector_type(2)));
typedef int v8i_t __attribute__((ext_vector_type(8)));
__device__ __forceinline__ const char* pg8_uni(const char* p) { const unsigned long long v = (unsigned long long)p; const unsigned lo = __builtin_amdgcn_readfirstlane((unsigned)v), hi = __builtin_amdgcn_readfirstlane((unsigned)(v >> 32)); return (const char*)(((unsigned long long)hi << 32) | lo); }
template <class Epi, class Sched, bool ALIGN_EPI = false, bool SP2 = false, bool FP8 = false, int BLK = 0>
__device__ __forceinline__ void gemm_phase(PG8_LAS unsigned char* lds, const Gemm g, const Sched& S, const Epi& E) {
    const int tid = threadIdx.x, wid = __builtin_amdgcn_readfirstlane(tid >> 6), lane = tid & 63, wr = wid >> 2, wc = wid & 3, fr = lane & 15, fq = lane >> 4;
    const int K = g.K, nt = K / BK;
    unsigned voffA[2], voffB[2];
#pragma unroll
    for (int i = 0; i < 2; ++i) { int R, C; stage_rc(tid * 16 + i * 8192, R, C); const int Rb = Epi::PERM ? ((R & ~31) + perm32(R & 31)) : R;
        voffA[i] = (unsigned)(R * ((BLK & 1) ? BK : K) + C) * 2u; voffB[i] = (unsigned)(Rb * ((BLK & 2) ? BK : K) + C) * 2u; }
    const size_t kstepA = (BLK & 1) ? (size_t)(2 * HTB) : (size_t)(BK * 2), kstepB = (BLK & 2) ? (size_t)(2 * HTB) : (size_t)(BK * 2);
    const size_t hstepA = (BLK & 1) ? (size_t)HTB : (size_t)HALF * K * 2, hstepB = (BLK & 2) ? (size_t)HTB : (size_t)HALF * K * 2;
    const size_t tstep = (size_t)2 * HALF * K * 2;
    const unsigned ldsb_ = (unsigned)(uintptr_t)lds;
    const unsigned ldsw = (unsigned)wid * 1024u;
    const int aoff = lds_byte(wr * 64 + fr, fq * 8), boff = lds_byte(wc * 32 + fr, fq * 8);
#define PG8_SA(b, h) (((b) * 2 + (h)) * HTB)
#define PG8_SB(b, h) ((4 + (b) * 2 + (h)) * HTB)
#define PG8_STAGE(bufoff, gbase, voff) do { _Pragma("unroll") for (int _i = 0; _i < 2; ++_i) { unsigned keep_; \
        asm volatile("s_mov_b32 %0, m0\n\ts_mov_b32 m0, %3\n\ts_nop 0\n\tglobal_load_lds_dwordx4 %1, %2\n\ts_mov_b32 m0, %0" : "=&s"(keep_) : "v"((voff)[_i]), "s"(pg8_uni((const char*)(gbase))), \
            "s"((unsigned)__builtin_amdgcn_readfirstlane((int)(ldsb_ + (unsigned)(bufoff) + ldsw + (unsigned)(_i * 8192)))) : "memory"); } } while (0)
#define PG8_CAT16(lo, hi) __builtin_bit_cast(v8i_t, __builtin_shufflevector(lo, hi, 0, 1, 2, 3, 4, 5, 6, 7, 8, 9, 10, 11, 12, 13, 14, 15))
#define PG8_LDA(dst, b, h) do { if constexpr (FP8) { _Pragma("unroll") for (int m = 0; m < 4; ++m) { const bf16x8 lo_ = *(const PG8_LAS bf16x8*)(lds + PG8_SA(b, h) + aoff + m * 2048), hi_ = *(const PG8_LAS bf16x8*)(lds + PG8_SA(b, h) + aoff + m * 2048 + 1024); dst##8[m] = PG8_CAT16(lo_, hi_); } } \
    else { _Pragma("unroll") for (int m = 0; m < 4; ++m) _Pragma("unroll") for (int k = 0; k < 2; ++k) dst[m][k] = *(const PG8_LAS bf16x8*)(lds + PG8_SA(b, h) + aoff + m * 2048 + k * 1024); } } while (0)
#define PG8_LDB(dst, b, h) do { if constexpr (FP8) { _Pragma("unroll") for (int n = 0; n < 2; ++n) { const bf16x8 lo_ = *(const PG8_LAS bf16x8*)(lds + PG8_SB(b, h) + boff + n * 2048), hi_ = *(const PG8_LAS bf16x8*)(lds + PG8_SB(b, h) + boff + n * 2048 + 1024); dst##8[n] = PG8_CAT16(lo_, hi_); } } \
    else { _Pragma("unroll") for (int n = 0; n < 2; ++n) _Pragma("unroll") for (int k = 0; k < 2; ++k) dst[n][k] = *(const PG8_LAS bf16x8*)(lds + PG8_SB(b, h) + boff + n * 2048 + k * 1024); } } while (0)
#define PG8_MMA(ai, bj, At, Bt) do { __builtin_amdgcn_s_setprio(1); \
    if constexpr (FP8) { _Pragma("unroll") for (int m = 0; m < 4; ++m) _Pragma("unroll") for (int n = 0; n < 2; ++n) \
        asm volatile("v_mfma_f32_16x16x128_f8f6f4 %0, %1, %2, %0" : "+v"(acc[ai][bj][m][n]) : "v"(Bt##8[n]), "v"(At##8[m])); } \
    else { _Pragma("unroll") for (int m = 0; m < 4; ++m) _Pragma("unroll") for (int n = 0; n < 2; ++n) _Pragma("unroll") for (int k = 0; k < 2; ++k) \
        acc[ai][bj][m][n] = __builtin_amdgcn_mfma_f32_16x16x32_bf16(Bt[n][k], At[m][k], acc[ai][bj][m][n], 0, 0, 0); } \
    __builtin_amdgcn_s_setprio(0); } while (0)
#define PG8_WAIT_V(n) asm volatile("s_waitcnt vmcnt(" #n ")" ::: "memory")
#define PG8_WAIT_L(n) asm volatile("s_waitcnt lgkmcnt(" #n ")" ::: "memory")
#define PG8_BAR __builtin_amdgcn_s_barrier()
#define PG8_SCHED __builtin_amdgcn_sched_barrier(0)
    Unit cur, nxt; int ui = 0;
    if (!S.next(0, cur)) return;
    f32x4 acc[2][2][4][2];
#pragma unroll
    for (int a = 0; a < 2; ++a)
#pragma unroll
        for (int b = 0; b < 2; ++b)
#pragma unroll
            for (int m = 0; m < 4; ++m)
#pragma unroll
                for (int n = 0; n < 2; ++n) acc[a][b][m][n] = (f32x4){0.f, 0.f, 0.f, 0.f};
    bf16x8 At[4][2], B0[2][2], B1[2][2]; v8i_t At8[4], B08[2], B18[2]; (void)At; (void)B0; (void)B1; (void)At8; (void)B08; (void)B18; int sc8_ = 0x7f7f7f7f; asm volatile("" : "+v"(sc8_)); (void)sc8_;
    const char* cA = (const char*)g.A + (size_t)cur.pm * tstep; const char* cB = (const char*)g.Bt + (size_t)cur.pb * tstep;
    const int rot = S.rot();
#define PG8_KIX(t) ((size_t)(((t) + rot) & (nt - 1)))
    const size_t k0A = PG8_KIX(0) * kstepA, k1A = PG8_KIX(1) * kstepA, k0B = PG8_KIX(0) * kstepB, k1B = PG8_KIX(1) * kstepB;
    S.a_ready(cur);
    if constexpr (SP2) {
        PG8_STAGE(PG8_SB(0, 0), cB + k0B, voffB); PG8_STAGE(PG8_SB(0, 1), cB + hstepB + k0B, voffB); PG8_STAGE(PG8_SA(0, 0), cA + k0A, voffA); PG8_STAGE(PG8_SA(0, 1), cA + hstepA + k0A, voffA);
        if (wr == 1) PG8_BAR;
        PG8_WAIT_V(2); PG8_BAR;
        PG8_STAGE(PG8_SB(1, 0), cB + k1B, voffB); PG8_STAGE(PG8_SA(1, 0), cA + k1A, voffA); PG8_STAGE(PG8_SB(1, 1), cB + hstepB + k1B, voffB);
        PG8_WAIT_V(6); PG8_BAR;
    } else {
        PG8_STAGE(PG8_SB(0, 0), cB + k0B, voffB); PG8_STAGE(PG8_SA(0, 0), cA + k0A, voffA); PG8_STAGE(PG8_SB(0, 1), cB + hstepB + k0B, voffB); PG8_STAGE(PG8_SA(0, 1), cA + hstepA + k0A, voffA);
        if (wr == 1) PG8_BAR;
        PG8_WAIT_V(4); PG8_BAR;
        PG8_STAGE(PG8_SB(1, 0), cB + k1B, voffB); PG8_STAGE(PG8_SA(1, 0), cA + k1A, voffA); PG8_STAGE(PG8_SB(1, 1), cB + hstepB + k1B, voffB);
        PG8_WAIT_V(6); PG8_BAR;
    }
    for (;;) {
        const bool has_next = S.next(ui + 1, nxt);
        const char* nA = has_next ? (const char*)g.A + (size_t)nxt.pm * tstep : cA; const char* nB = has_next ? (const char*)g.Bt + (size_t)nxt.pb * tstep : cB;
        for (int t = 0; t < nt; t += 2) {
            const bool last = (t == nt - 2);
            const char* a1 = cA + PG8_KIX(t + 1) * kstepA;
            const size_t i2 = PG8_KIX(t + 2), i3 = PG8_KIX(t + 3);
            const char* a2 = (last ? nA : cA) + i2 * kstepA; const char* b2 = (last ? nB : cB) + i2 * kstepB;
            const char* a3 = (last ? nA : cA) + i3 * kstepA; const char* b3 = (last ? nB : cB) + i3 * kstepB;
            if (last && has_next) S.a_ready(nxt);
            if constexpr (SP2) {
            PG8_LDB(B0, 0, 0); PG8_LDB(B1, 0, 1); PG8_SCHED; PG8_LDA(At, 0, 0); PG8_STAGE(PG8_SA(1, 1), a1 + hstepA, voffA);
            PG8_WAIT_V(8); PG8_WAIT_L(0); PG8_BAR; PG8_MMA(0, 0, At, B0); PG8_MMA(0, 1, At, B1); PG8_BAR; PG8_SCHED;
            PG8_LDA(At, 0, 1); PG8_STAGE(PG8_SB(0, 0), b2, voffB); PG8_STAGE(PG8_SB(0, 1), b2 + hstepB, voffB); PG8_STAGE(PG8_SA(0, 0), a2, voffA);
            PG8_WAIT_V(8); PG8_WAIT_L(0); PG8_BAR; if (!cur.half) { PG8_MMA(1, 0, At, B0); PG8_MMA(1, 1, At, B1); } PG8_BAR; PG8_SCHED;
            PG8_LDB(B0, 1, 0); PG8_LDB(B1, 1, 1); PG8_SCHED; PG8_LDA(At, 1, 0); PG8_STAGE(PG8_SA(0, 1), a2 + hstepA, voffA);
            PG8_WAIT_V(8); PG8_WAIT_L(0); PG8_BAR; PG8_MMA(0, 0, At, B0); PG8_MMA(0, 1, At, B1); PG8_BAR; PG8_SCHED;
            PG8_LDA(At, 1, 1); PG8_STAGE(PG8_SB(1, 0), b3, voffB); PG8_STAGE(PG8_SB(1, 1), b3 + hstepB, voffB); PG8_STAGE(PG8_SA(1, 0), a3, voffA);
            PG8_WAIT_V(8); PG8_WAIT_L(0); PG8_BAR; if (!cur.half) { PG8_MMA(1, 0, At, B0); PG8_MMA(1, 1, At, B1); } PG8_BAR; PG8_SCHED;
            } else {
            PG8_LDB(B0, 0, 0); PG8_SCHED; PG8_LDA(At, 0, 0); PG8_STAGE(PG8_SA(1, 1), a1 + hstepA, voffA);
            PG8_WAIT_L(8); PG8_BAR; PG8_WAIT_L(0); PG8_MMA(0, 0, At, B0); PG8_BAR; PG8_SCHED;
            PG8_LDB(B1, 0, 1); PG8_STAGE(PG8_SB(0, 0), b2, voffB);
            PG8_BAR; PG8_WAIT_L(0); PG8_MMA(0, 1, At, B1); PG8_BAR;
            PG8_LDA(At, 0, 1); PG8_STAGE(PG8_SA(0, 0), a2, voffA);
            PG8_BAR; PG8_WAIT_L(0); if (!cur.half) PG8_MMA(1, 0, At, B0); PG8_BAR; PG8_SCHED;
            PG8_STAGE(PG8_SB(0, 1), b2 + hstepB, voffB);
            PG8_WAIT_V(6); PG8_BAR; if (!cur.half) PG8_MMA(1, 1, At, B1); PG8_BAR;
            PG8_LDB(B0, 1, 0); PG8_SCHED; PG8_LDA(At, 1, 0); PG8_STAGE(PG8_SA(0, 1), a2 + hstepA, voffA);
            PG8_WAIT_L(8); PG8_BAR; PG8_WAIT_L(0); PG8_MMA(0, 0, At, B0); PG8_BAR; PG8_SCHED;
            PG8_LDB(B1, 1, 1); PG8_STAGE(PG8_SB(1, 0), b3, voffB);
            PG8_BAR; PG8_WAIT_L(0); PG8_MMA(0, 1, At, B1); PG8_BAR;
            PG8_LDA(At, 1, 1); PG8_STAGE(PG8_SA(1, 0), a3, voffA);
            PG8_BAR; PG8_WAIT_L(0); if (!cur.half) PG8_MMA(1, 0, At, B0); PG8_BAR; PG8_SCHED;
            PG8_STAGE(PG8_SB(1, 1), b3 + hstepB, voffB);
            PG8_WAIT_V(6); PG8_BAR; if (!cur.half) PG8_MMA(1, 1, At, B1); PG8_BAR;
            }
        }
        if constexpr (ALIGN_EPI) { if (wr == 0) PG8_BAR; }
        if constexpr (FP8) asm volatile("s_nop 15\n\ts_nop 15" ::: "memory");
        if constexpr (!Epi::AFTER_DRAIN) { E(acc, cur, wr, wc, fr, fq); S.done(cur); }
        if (!has_next) break;
#pragma unroll
        for (int a = 0; a < 2; ++a)
#pragma unroll
            for (int b = 0; b < 2; ++b)
#pragma unroll
                for (int m = 0; m < 4; ++m)
#pragma unroll
                    for (int n = 0; n < 2; ++n) acc[a][b][m][n] = (f32x4){0.f, 0.f, 0.f, 0.f};
        cur = nxt; cA = nA; cB = nB; ++ui;
        if constexpr (ALIGN_EPI) { if (wr == 1) PG8_BAR; }
    }
    PG8_WAIT_V(0);
    if constexpr (!ALIGN_EPI) { if (wr == 0) PG8_BAR; }
    PG8_BAR;
    if constexpr (Epi::AFTER_DRAIN) { E.fused(acc, cur, wr, wc, fr, fq, lds, wid, lane); S.done(cur); }
#undef PG8_KIX
#undef PG8_SA
#undef PG8_SB
#undef PG8_STAGE
#undef PG8_LDA
#undef PG8_LDB
#undef PG8_MMA
#undef PG8_WAIT_V
#undef PG8_WAIT_L
#undef PG8_BAR
#undef PG8_SCHED
}
}
constexpr int NWAVES = 8, NTHR = 512;
constexpr int LDS_BYTES = 147456;
constexpr int MISC_OFF = LDS_BYTES - 128;
typedef GAS unsigned gu32;
#define RLX_AGENT __ATOMIC_RELAXED, __HIP_MEMORY_SCOPE_AGENT
#define LDS_WAIT() asm volatile("s_waitcnt lgkmcnt(0)" ::: "memory")
#define VM_WAIT() asm volatile("s_waitcnt vmcnt(0)" ::: "memory")
#define XB_TMO      128
#define XB_XCNT(j)  (256  + 64 * (j))
#define XB_XSUB(j)  (1280 + 64 * (j))
#define XB_XGEN(j)  (2304 + 64 * (j))
#define XB_TOP      3328
#define XB_TOPGEN   3392
#define XCD_BAR_WORDS 3456
#define XB_SPIN_CAP (1u << 18)

__device__ __forceinline__ unsigned xb_ld(unsigned* p)              { return __hip_atomic_load(p, __ATOMIC_RELAXED, __HIP_MEMORY_SCOPE_AGENT); }
__device__ __forceinline__ unsigned xb_add(unsigned* p, unsigned v) { return __hip_atomic_fetch_add(p, v, __ATOMIC_RELAXED, __HIP_MEMORY_SCOPE_AGENT); }
__device__ __forceinline__ unsigned xb_xcc_id() { return (unsigned)__builtin_amdgcn_s_getreg((3 << 11) | 20) & 0xFu; }
#define XB_SPIN(cond, bar) do { unsigned _sp = 0; while (cond) { __builtin_amdgcn_s_sleep(1); \
    if ((++_sp & 255u) == 0u) { if (xb_ld(&(bar)[XB_TMO])) break; if (_sp > XB_SPIN_CAP) { atomicAdd(&(bar)[XB_TMO], 1u); break; } } } } while (0)

struct XcdBarrier {
    unsigned* bar; unsigned x;
    volatile LAS unsigned* st;
};

__device__ __forceinline__ XcdBarrier xcd_barrier_post(unsigned* bar, volatile LAS unsigned* st) {
    XcdBarrier b; b.bar = bar; b.x = xb_xcc_id(); b.st = st;
    if (threadIdx.x == 0) (void)xb_add(&bar[XB_XCNT(b.x)], 1u);
    return b;
}
__device__ __forceinline__ void xcd_barrier_complete(unsigned* bar, unsigned x, unsigned& nloc, unsigned& nx) {
    const unsigned G = gridDim.x * gridDim.y * gridDim.z;
    unsigned sum, cnt, mine, sp = 0u;
    for (;;) {
        sum = 0u; cnt = 0u; mine = 0u;
#pragma unroll
        for (unsigned j = 0; j < 16; ++j) { const unsigned c = xb_ld(&bar[XB_XCNT(j)]); sum += c; cnt += (c > 0u) ? 1u : 0u; mine = (j == x) ? c : mine; }
        if (sum == G) break;
        __builtin_amdgcn_s_sleep(1);
        if ((++sp & 255u) == 0u) { if (xb_ld(&bar[XB_TMO])) break; if (sp > XB_SPIN_CAP) { atomicAdd(&bar[XB_TMO], 1u); break; } }
    }
    nloc = mine > 0u ? mine : 1u; nx = cnt > 0u ? cnt : 1u;
}

__device__ __forceinline__ void xcd_barrier(const XcdBarrier& b) {
    asm volatile("s_waitcnt vmcnt(0)" ::: "memory");
    __syncthreads();
    if (threadIdx.x == 0) {
        unsigned* bar = b.bar;
        __builtin_amdgcn_s_waitcnt(0);
        unsigned nloc = b.st[0], nx = b.st[1];
        if (nloc == 0u) { xcd_barrier_complete(bar, b.x, nloc, nx); b.st[0] = nloc; b.st[1] = nx; }
        const unsigned old = xb_add(&bar[XB_XSUB(b.x)], 1u);
        const unsigned gen = old / nloc;
        if (old + 1u == (gen + 1u) * nloc) {
            __builtin_amdgcn_fence(__ATOMIC_RELEASE, "agent");
            asm volatile("s_waitcnt vmcnt(0)" ::: "memory");
            const unsigned og = xb_add(&bar[XB_TOP], 1u);
            const unsigned tg = og / nx;
            if (og + 1u == (tg + 1u) * nx) xb_add(&bar[XB_TOPGEN], 1u);
            else XB_SPIN(xb_ld(&bar[XB_TOPGEN]) == tg, bar);
            __builtin_amdgcn_fence(__ATOMIC_ACQUIRE, "agent");
            xb_add(&bar[XB_XGEN(b.x)], 1u);
            asm volatile("s_waitcnt vmcnt(0)" ::: "memory");
        } else {
            XB_SPIN(xb_ld(&bar[XB_XGEN(b.x)]) == gen, bar);
            __builtin_amdgcn_fence(__ATOMIC_ACQUIRE, "agent");
            asm volatile("s_waitcnt vmcnt(0)" ::: "memory");
        }
    }
    __syncthreads();
}
struct Ctx { LAS unsigned char* lds; int tid, lane, wave, vcu, G; };
struct Args { const float* in[19]; float* out; unsigned char* ws; int ph_lo, ph_hi; };

typedef short v4i16_t __attribute__((ext_vector_type(4)));
__device__ __forceinline__ s16x4 trr(LAS unsigned char* p) { return __builtin_bit_cast(s16x4, __builtin_amdgcn_ds_read_tr16_b64_v4i16((LAS v4i16_t*)p)); }
__device__ __forceinline__ bf16x8 cat8(s16x4 lo, s16x4 hi) { return (bf16x8){lo[0], lo[1], lo[2], lo[3], hi[0], hi[1], hi[2], hi[3]}; }
__device__ __forceinline__ float incl_sum_up(float v, int lane) {
#pragma unroll
    for (int o = 1; o < 64; o <<= 1) { const float t = __shfl_up(v, o); if (lane >= o) v += t; }
    return v;
}
__device__ __forceinline__ float incl_max_up(float v, int lane) {
#pragma unroll
    for (int o = 1; o < 64; o <<= 1) { const float t = __shfl_up(v, o); if (lane >= o) v = fmaxf(v, t); }
    return v;
}
__device__ __forceinline__ float incl_max_down(float v, int lane) {
#pragma unroll
    for (int o = 1; o < 64; o <<= 1) { const float t = __shfl_down(v, o); if (lane + o < 64) v = fmaxf(v, t); }
    return v;
}
__device__ __forceinline__ v4u scale8(v4u q, float s) {
    v4u o; o.x = pk2(bflo(q.x) * s, bfhi(q.x) * s); o.y = pk2(bflo(q.y) * s, bfhi(q.y) * s); o.z = pk2(bflo(q.z) * s, bfhi(q.z) * s); o.w = pk2(bflo(q.w) * s, bfhi(q.w) * s); return o;
}

__device__ __forceinline__ float sat8(float x) { return fminf(fmaxf(x, -448.f), 448.f); }
__device__ __forceinline__ void tr_item(const float* __restrict__ W, int ldw, int K, bf16* __restrict__ WT, int n_src0, int n_dst0, int k0, LAS unsigned char* scr, int lane) {
    const int nq = lane & 15, kg = lane >> 4;
    const float* src = W + (size_t)(k0 + 4 * kg) * ldw + n_src0 + 4 * nq;
#pragma unroll
    for (int j = 0; j < 4; ++j) {
        const float* s = src + (size_t)(16 * j) * ldw;
        const f32x4 r0 = *(const f32x4*)s, r1 = *(const f32x4*)(s + ldw), r2 = *(const f32x4*)(s + 2 * (size_t)ldw), r3 = *(const f32x4*)(s + 3 * (size_t)ldw);
#pragma unroll
        for (int c = 0; c < 4; ++c) { LAS unsigned* d = (LAS unsigned*)(scr + (4 * nq + c) * 132 + (16 * j + 4 * kg) * 2); d[0] = pk2(r0[c], r1[c]); d[1] = pk2(r2[c], r3[c]); }
    }
    const int row8 = lane >> 3, c8 = lane & 7;
#pragma unroll
    for (int jj = 0; jj < 8; ++jj) { const int row = row8 + 8 * jj; LAS unsigned char* rp = scr + row * 132 + 16 * c8;
        v4u o; o.x = *(LAS unsigned*)rp; o.y = *(LAS unsigned*)(rp + 4); o.z = *(LAS unsigned*)(rp + 8); o.w = *(LAS unsigned*)(rp + 12);
        *(v4u*)(WT + (size_t)(n_dst0 + row) * K + k0 + 8 * c8) = o; }
}
constexpr float W8SCALE = 64.f, W8INV = 1.f / 64.f;
__device__ __forceinline__ void tr8_item(const float* __restrict__ W, int ldw, int Kb, unsigned char* __restrict__ WT, int n0, int k0, LAS unsigned char* scr, int lane) {
    const int nq = lane & 15, kg = lane >> 4;
    const float* src = W + (size_t)(k0 + 4 * kg) * ldw + n0 + 4 * nq;
#pragma unroll 2
    for (int j = 0; j < 8; ++j) {
        const float* s = src + (size_t)(16 * j) * ldw;
        const f32x4 r0 = *(const f32x4*)s, r1 = *(const f32x4*)(s + ldw), r2 = *(const f32x4*)(s + 2 * (size_t)ldw), r3 = *(const f32x4*)(s + 3 * (size_t)ldw);
#pragma unroll
        for (int c = 0; c < 4; ++c) { int w = 0; w = __builtin_amdgcn_cvt_pk_fp8_f32(r0[c] * W8SCALE, r1[c] * W8SCALE, w, false); w = __builtin_amdgcn_cvt_pk_fp8_f32(r2[c] * W8SCALE, r3[c] * W8SCALE, w, true);
            *(LAS int*)(scr + (4 * nq + c) * 132 + 16 * j + 4 * kg) = w; }
    }
    const int row8 = lane >> 3, c8 = lane & 7;
#pragma unroll
    for (int jj = 0; jj < 8; ++jj) { const int row = row8 + 8 * jj; LAS unsigned char* rp = scr + row * 132 + 16 * c8;
        v4u o; o.x = *(LAS unsigned*)rp; o.y = *(LAS unsigned*)(rp + 4); o.z = *(LAS unsigned*)(rp + 8); o.w = *(LAS unsigned*)(rp + 12);
        *(v4u*)(WT + (size_t)(n0 + row) * Kb + k0 + 16 * c8) = o; }
}
__device__ __forceinline__ void p0_transposes(const Ctx& C, const Args& a) {
    const float* w_in = a.in[2]; const float* w_ml = a.in[5]; const float* w_da = a.in[10]; const float* w_o = a.in[11]; const float* w_gu = a.in[15]; const float* w_dn = a.in[17];
    bf16* WIN = (bf16*)(a.ws + WS_WIN); bf16* WML = (bf16*)(a.ws + WS_WML); bf16* WDA = (bf16*)(a.ws + WS_WDA); bf16* WO = (bf16*)(a.ws + WS_WO);
    const int gw = C.vcu * NWAVES + C.wave, NGW = C.G * NWAVES;
    constexpr int I_IN = 32 * 96, I_IN8 = 16 * 64;
    constexpr int NIT = I_IN + I_IN8;
    LAS unsigned char* scr = C.lds + C.wave * 8448;
    for (int it = gw; it < NIT; it += NGW) {
        int r = it;
        if (r < I_IN) { const int kb = r / 96, nb = r % 96, nd = nb * 64; tr_item(w_in, DIN, D, WIN, nd < G_OFF ? nd : nd + 16, nd, kb * 64, scr, C.lane); continue; } r -= I_IN;
        { const int kb = r / 64, nb = r % 64; tr8_item(w_in + (P_GM + 16), DIN, D, (unsigned char*)(a.ws + WS_WIN8), nb * 64, kb * 128, scr, C.lane); }
    }
    (void)w_ml; (void)w_da; (void)w_o; (void)WML; (void)WDA; (void)WO;
    __syncthreads();
}
__device__ __forceinline__ void p2_late_transposes(const Ctx& C, const Args& a) {
    const float* w_ml = a.in[5]; const float* w_da = a.in[10]; const float* w_o = a.in[11];
    bf16* WML = (bf16*)(a.ws + WS_WML); bf16* WDA = (bf16*)(a.ws + WS_WDA); bf16* WO = (bf16*)(a.ws + WS_WO);
    const int gw = C.vcu * NWAVES + C.wave, NGW = C.G * NWAVES;
    constexpr int I_ML = 16 * 32, I_O = 32 * 32, NIT = 2 * I_ML + I_O;
    LAS unsigned char* scr = C.lds + C.wave * 8448;
    for (int it = gw; it < NIT; it += NGW) {
        int r = it;
        if (r < I_ML) { const int kb = r / 32, nb = r % 32; tr_item(w_ml, D, MLW, WML, nb * 64, nb * 64, kb * 64, scr, C.lane); continue; } r -= I_ML;
        if (r < I_ML) { const int kb = r / 32, nb = r % 32; tr_item(w_da, D, DAW, WDA, nb * 64, nb * 64, kb * 64, scr, C.lane); continue; } r -= I_ML;
        { const int kb = r / 32, nb = r % 32; tr_item(w_o, D, D, WO, nb * 64, nb * 64, kb * 64, scr, C.lane); }
    }
    __syncthreads();
}
constexpr int CV_J_GU = 16 * 64, CV_J_DN = 16 * 32, CV_NJ = NE * (CV_J_GU + CV_J_DN);
struct ConvSet { f32x4 r[8]; };
struct Conv { int it, step; ConvSet s[2]; };
struct ConvItem { const float* src; unsigned char* dst; int ldw, Kb; };
__device__ __forceinline__ ConvItem conv_item(const Args& a, int it) {
    const float* w_gu = a.in[15]; const float* w_dn = a.in[17]; ConvItem ci;
    if (it < NE * CV_J_GU) { const int e = it / CV_J_GU, q = it % CV_J_GU, kb = q / 64, nb = q % 64; ci.ldw = 2 * DE; ci.Kb = 128;
        ci.src = w_gu + (size_t)e * D * 2 * DE + (size_t)(kb * 128) * (2 * DE) + nb * 64;
        ci.dst = a.ws + WS_WGU + ((size_t)((e * 16 + (nb >> 2)) * 16 + kb)) * 32768 + (size_t)((nb & 3) * 64) * 128; }
    else { const int r = it - NE * CV_J_GU, e = r / CV_J_DN, q = r % CV_J_DN, kb = q / 32, nb = q % 32; ci.ldw = D; ci.Kb = 128;
        ci.src = w_dn + (size_t)e * DE * D + (size_t)(kb * 128) * D + nb * 64;
        ci.dst = a.ws + WS_WDN + ((size_t)((e * 8 + (nb >> 2)) * 16 + kb)) * 32768 + (size_t)((nb & 3) * 64) * 128; }
    return ci;
}
__device__ __forceinline__ const char* uni_ptr(const void* p) { const unsigned long long v = (unsigned long long)p; const unsigned lo = __builtin_amdgcn_readfirstlane((unsigned)v), hi = __builtin_amdgcn_readfirstlane((unsigned)(v >> 32)); return (const char*)(((unsigned long long)hi << 32) | lo); }
struct ConvSrc { const float* src; int ldw; };
__device__ __forceinline__ ConvSrc conv_src(const Args& a, int it) { const int itc = it < CV_NJ ? it : CV_NJ - 1; const ConvItem ci = conv_item(a, __builtin_amdgcn_readfirstlane(itc)); ConvSrc s; s.src = ci.src; s.ldw = ci.ldw; return s; }
__device__ __forceinline__ unsigned conv_loff(const ConvSrc& cs, int lane) { return ((unsigned)(4 * (lane >> 4)) * (unsigned)cs.ldw + 4u * (lane & 15)) * 4u; }
__device__ __forceinline__ void conv_issue_one(ConvSet& S, const ConvSrc& cs, unsigned loff, int st, int q) {
    const char* sb = (const char*)(cs.src + (size_t)(16 * (2 * st + (q >> 2)) + (q & 3)) * cs.ldw);
    asm volatile("global_load_dwordx4 %0, %1, %2 nt" : "=v"(S.r[q]) : "v"(loff), "s"(sb) : "memory");
}
__device__ __forceinline__ void conv_issue(ConvSet& S, const Args& a, int it, int st, int lane) {
    const ConvSrc cs = conv_src(a, it); const unsigned loff = conv_loff(cs, lane);
#pragma unroll
    for (int q = 0; q < 8; ++q) conv_issue_one(S, cs, loff, st, q);
}
__device__ __forceinline__ void conv_next(int& it, int& st, int NGW) { if (st == 3) { st = 0; it += NGW; } else ++st; }
__device__ __forceinline__ void conv_begin(Conv& cv, const Args& a, int gw, int NGW, int lane) { cv.it = gw; cv.step = 0; conv_issue(cv.s[0], a, cv.it, cv.step, lane); }
__device__ __forceinline__ void conv_issue_next(Conv& cv, ConvSet& S, const Args& a, int NGW, int lane) { int it1 = cv.it, st1 = cv.step; conv_next(it1, st1, NGW); conv_issue(S, a, it1, st1, lane); }
template <int NW> __device__ __forceinline__ bool conv_consume(Conv& cv, ConvSet& S, const Args& a, LAS unsigned char* scr, int NGW, int lane) {
    if constexpr (NW == 12) asm volatile("s_waitcnt vmcnt(12)" : "+v"(S.r[0]), "+v"(S.r[1]), "+v"(S.r[2]), "+v"(S.r[3]), "+v"(S.r[4]), "+v"(S.r[5]), "+v"(S.r[6]), "+v"(S.r[7]) :: "memory");
    else if constexpr (NW == 8) asm volatile("s_waitcnt vmcnt(8)" : "+v"(S.r[0]), "+v"(S.r[1]), "+v"(S.r[2]), "+v"(S.r[3]), "+v"(S.r[4]), "+v"(S.r[5]), "+v"(S.r[6]), "+v"(S.r[7]) :: "memory");
    else asm volatile("s_waitcnt vmcnt(0)" : "+v"(S.r[0]), "+v"(S.r[1]), "+v"(S.r[2]), "+v"(S.r[3]), "+v"(S.r[4]), "+v"(S.r[5]), "+v"(S.r[6]), "+v"(S.r[7]) :: "memory");
    const int nq = lane & 15, kg = lane >> 4; const bool st = (cv.it < CV_NJ) && cv.step == 3;
#pragma unroll
    for (int jj = 0; jj < 2; ++jj) { const int j = 2 * cv.step + jj;
#pragma unroll
        for (int c = 0; c < 4; ++c) { int w = 0; w = __builtin_amdgcn_cvt_pk_fp8_f32(S.r[4 * jj + 0][c] * W8SCALE, S.r[4 * jj + 1][c] * W8SCALE, w, false);
            w = __builtin_amdgcn_cvt_pk_fp8_f32(S.r[4 * jj + 2][c] * W8SCALE, S.r[4 * jj + 3][c] * W8SCALE, w, true);
            *(LAS int*)(scr + (4 * nq + c) * 132 + 16 * j + 4 * kg) = w; } }
    if (st) {
        const ConvItem ci = conv_item(a, __builtin_amdgcn_readfirstlane(cv.it));
        const int row8 = lane >> 3, c8 = lane & 7;
#pragma unroll 2
        for (int jj = 0; jj < 8; ++jj) { const int row = row8 + 8 * jj; LAS unsigned char* rp = scr + row * 132 + 16 * c8;
            v4u o; o.x = *(LAS unsigned*)rp; o.y = *(LAS unsigned*)(rp + 4); o.z = *(LAS unsigned*)(rp + 8); o.w = *(LAS unsigned*)(rp + 12);
            *(v4u*)(ci.dst + (size_t)row * ci.Kb + 16 * c8) = o; }
    }
    conv_next(cv.it, cv.step, NGW);
    return st;
}
__device__ __forceinline__ void p0_xn_gates(const Ctx& C, const Args& a) {
    const float* x = a.in[0]; const float* g1 = a.in[1]; const float* w_in = a.in[2]; const float* gbias = a.in[3];
    bf16* XN = (bf16*)(a.ws + WS_XN); float* MG = (float*)(a.ws + WS_MG);
    for (int idx = C.tid; idx < D * 4; idx += NTHR) {
        const int k = idx >> 2, c = idx & 3; const f32x4 w = *(const f32x4*)(w_in + (size_t)k * DIN + G_OFF + 4 * c);
        const int r = (k & 3) * 512 + (k >> 2);
        *(LAS f32x4*)(C.lds + r * 64 + ((c ^ ((r >> 2) & 3)) * 16)) = w;
    }
    __syncthreads();
    const int gw = C.vcu * NWAVES + C.wave, NGW = C.G * NWAVES, lane = C.lane;
    for (int m = gw; m < T; m += NGW) {
        const f32x4* xr = (const f32x4*)(x + (size_t)m * D) + lane; f32x4 v[8]; float ss = 0.f;
#pragma unroll
        for (int j = 0; j < 8; ++j) { v[j] = xr[64 * j]; ss += (v[j].x * v[j].x + v[j].y * v[j].y) + (v[j].z * v[j].z + v[j].w * v[j].w); }
        const float rstd = rsqrtf(wave_sum(ss) * (1.f / D) + EPS);
        float acc[16];
#pragma unroll
        for (int i = 0; i < 16; ++i) acc[i] = 0.f;
        int lb = lane * 64; asm volatile("" : "+v"(lb));
        int lbase[4];
#pragma unroll
        for (int c = 0; c < 4; ++c) lbase[c] = lb + ((c ^ ((lane >> 2) & 3)) << 4);
#pragma unroll
        for (int j = 0; j < 8; ++j) {
            const f32x4 g = *((const f32x4*)g1 + lane + 64 * j);
            v[j].x *= rstd * g.x; v[j].y *= rstd * g.y; v[j].z *= rstd * g.z; v[j].w *= rstd * g.w;
            v2u o; o.x = pk2(v[j].x, v[j].y); o.y = pk2(v[j].z, v[j].w);
            *((v2u*)(XN + (size_t)m * D) + lane + 64 * j) = o;
            { int o8 = 0; o8 = __builtin_amdgcn_cvt_pk_fp8_f32(v[j].x, v[j].y, o8, false); o8 = __builtin_amdgcn_cvt_pk_fp8_f32(v[j].z, v[j].w, o8, true); *((int*)(a.ws + WS_XN8 + (size_t)m * D) + lane + 64 * j) = o8; }
#pragma unroll
            for (int i = 0; i < 4; ++i) {
                const float hv = v[j][i];
#pragma unroll
                for (int c = 0; c < 4; ++c) { const f32x4 w = *(const LAS f32x4*)(C.lds + lbase[c] + (i * 512 + 64 * j) * 64);
                    acc[4 * c + 0] += hv * w.x; acc[4 * c + 1] += hv * w.y; acc[4 * c + 2] += hv * w.z; acc[4 * c + 3] += hv * w.w; }
            }
        }
        float mine = 0.f;
#pragma unroll
        for (int i = 0; i < 16; ++i) { const float s = wave_sum(acc[i]); if (lane == i) mine = s; }
        if (lane < 16) MG[(size_t)m * 16 + lane] = mine + gbias[lane];
    }
}
__device__ __forceinline__ void p0_router_w(const Ctx& C, const Args& a) {
    const float* wr = a.in[13]; bf16* WRH = (bf16*)(a.ws + WS_WRH); bf16* WRL = (bf16*)(a.ws + WS_WRL);
    for (int g = C.vcu * NTHR + C.tid; g < D * NE; g += C.G * NTHR) { const int k = g >> 5, e = g & 31; const float w = wr[g];
        const bf16 hi = f2bf(w); const bf16 lo = f2bf(w - bf2f(hi)); WRH[e * D + k] = hi; WRL[e * D + k] = lo; }
}
__device__ __forceinline__ void p0_rope(const Ctx& C, const Args& a) {
    float* ROPE = (float*)(a.ws + WS_ROPE);
    for (int g = C.vcu * NTHR + C.tid; g < S * 32; g += C.G * NTHR) {
        const int pos = g >> 5, i = g & 31;
        const double inv = exp2(-(double)i * (13.287712379549449 / 32.0));
        const double rev = (double)pos * inv * 0.15915494309189535;
        const double fr = rev - floor(rev + 0.5);
        const float ang = (float)(fr * 6.283185307179586);
        f32x2 cs; cs.x = cosf(ang); cs.y = sinf(ang);
        *(f32x2*)(ROPE + 2 * g) = cs;
    }
}

template <bool GATES8> struct EpiProj {
    static constexpr bool PERM = true, AFTER_DRAIN = false;
    bf16* O; unsigned char* G8;
    __device__ __forceinline__ void operator()(const pg8::f32x4 (&acc)[2][2][4][2], const pg8::Unit& u, int wr, int wc, int fr, int fq) const {
        const int pn = GATES8 ? u.pn + 24 : u.pn;
        const int row0 = u.pm * 256 + wr * 64 + fr, col0 = pn * 256 + wc * 32 + 8 * fq;
        const int mode = (pn == 2 || pn == 3) ? 1 : (((pn >= 8 && pn < 12) || pn >= 24) ? 2 : 0);
#pragma unroll
        for (int ai = 0; ai < 2; ++ai)
#pragma unroll
            for (int m = 0; m < 4; ++m) { bf16* rowp = O + (size_t)(row0 + ai * 128 + m * 16) * NPJ + col0;
#pragma unroll
                for (int bj = 0; bj < 2; ++bj) { pg8::f32x4 v0 = acc[ai][bj][m][0], v1 = acc[ai][bj][m][1];
                    if (GATES8) { v0 = v0 * W8INV; v1 = v1 * W8INV; }
                    if (mode == 1) { v0 = v0 * KSCALE; v1 = v1 * KSCALE; }
                    if (mode == 2) {
#pragma unroll
                        for (int i = 0; i < 4; ++i) { v0[i] = sigmoidf_(v0[i]); v1[i] = sigmoidf_(v1[i]); } }
                    if (GATES8) {
                        const unsigned q[8] = {(unsigned)__builtin_rintf(v0[0] * 255.f), (unsigned)__builtin_rintf(v0[1] * 255.f), (unsigned)__builtin_rintf(v0[2] * 255.f), (unsigned)__builtin_rintf(v0[3] * 255.f),
                                               (unsigned)__builtin_rintf(v1[0] * 255.f), (unsigned)__builtin_rintf(v1[1] * 255.f), (unsigned)__builtin_rintf(v1[2] * 255.f), (unsigned)__builtin_rintf(v1[3] * 255.f)};
                        v2u w; w.x = q[0] | (q[1] << 8) | (q[2] << 16) | (q[3] << 24); w.y = q[4] | (q[5] << 8) | (q[6] << 16) | (q[7] << 24);
                        *(v2u*)(G8 + (size_t)(row0 + ai * 128 + m * 16) * 4096 + u.pn * 256 + wc * 32 + 8 * fq + bj * 128) = w;
                    } else {
                    v4u w; w.x = pk2(v0[0], v0[1]); w.y = pk2(v0[2], v0[3]); w.z = pk2(v1[0], v1[1]); w.w = pk2(v1[2], v1[3]);
                    *(v4u*)(rowp + bj * 128) = w; } } }
    }
};
__device__ __forceinline__ void gate8(const unsigned char* G8, size_t row, int gcol, float (&g)[8]) {
    const v2u w = *(const v2u*)(G8 + row * 4096 + gcol); const float s = 1.f / 255.f;
    g[0] = (float)(w.x & 0xff) * s; g[1] = (float)((w.x >> 8) & 0xff) * s; g[2] = (float)((w.x >> 16) & 0xff) * s; g[3] = (float)(w.x >> 24) * s;
    g[4] = (float)(w.y & 0xff) * s; g[5] = (float)((w.y >> 8) & 0xff) * s; g[6] = (float)((w.y >> 16) & 0xff) * s; g[7] = (float)(w.y >> 24) * s;
}
template <int MODE> struct EpiGate {
    static constexpr bool PERM = true, AFTER_DRAIN = false;
    const bf16* PROJ; const bf16* T1in; bf16* O;
    __device__ __forceinline__ void operator()(const pg8::f32x4 (&acc)[2][2][4][2], const pg8::Unit& u, int wr, int wc, int fr, int fq) const {
        const int row0 = u.pm * 256 + wr * 64 + fr, col0 = u.pn * 256 + wc * 32 + 8 * fq;
#pragma unroll
        for (int ai = 0; ai < 2; ++ai)
#pragma unroll
            for (int m = 0; m < 4; ++m) { const size_t row = (size_t)(row0 + ai * 128 + m * 16);
#pragma unroll
                for (int bj = 0; bj < 2; ++bj) { const int col = col0 + bj * 128; const pg8::f32x4 v0 = acc[ai][bj][m][0], v1 = acc[ai][bj][m][1];
                    float g[8]; gate8((const unsigned char*)PROJ, row, (MODE ? 2048 : 0) + col, g);
                    float o[8] = {g[0] * v0[0], g[1] * v0[1], g[2] * v0[2], g[3] * v0[3], g[4] * v1[0], g[5] * v1[1], g[6] * v1[2], g[7] * v1[3]};
                    if (MODE == 1) { const v4u t = *(const v4u*)(T1in + row * D + col);
                        o[0] += bflo(t.x); o[1] += bfhi(t.x); o[2] += bflo(t.y); o[3] += bfhi(t.y); o[4] += bflo(t.z); o[5] += bfhi(t.z); o[6] += bflo(t.w); o[7] += bfhi(t.w); }
                    v4u w; w.x = pk2(o[0], o[1]); w.y = pk2(o[2], o[3]); w.z = pk2(o[4], o[5]); w.w = pk2(o[6], o[7]);
                    *(v4u*)(O + row * D + col) = w; } }
    }
};
struct EpiGatePair {
    static constexpr bool PERM = true, AFTER_DRAIN = false;
    const bf16* PROJ; bf16* T1; bf16* MIX;
    __device__ __forceinline__ void operator()(const pg8::f32x4 (&acc)[2][2][4][2], const pg8::Unit& u, int wr, int wc, int fr, int fq) const {
        const bool second = u.pm >= T / 256; const int pmr = second ? u.pm - T / 256 : u.pm;
        const int row0 = pmr * 256 + wr * 64 + fr, col0 = u.pn * 256 + wc * 32 + 8 * fq; const int gcol = second ? 2048 : 0; bf16* O = second ? MIX : T1;
#pragma unroll
        for (int ai = 0; ai < 2; ++ai)
#pragma unroll
            for (int m = 0; m < 4; ++m) { const size_t row = (size_t)(row0 + ai * 128 + m * 16);
#pragma unroll
                for (int bj = 0; bj < 2; ++bj) { const int col = col0 + bj * 128; const pg8::f32x4 v0 = acc[ai][bj][m][0], v1 = acc[ai][bj][m][1];
                    float g[8]; gate8((const unsigned char*)PROJ, row, gcol + col, g);
                    float o[8] = {g[0] * v0[0], g[1] * v0[1], g[2] * v0[2], g[3] * v0[3], g[4] * v1[0], g[5] * v1[1], g[6] * v1[2], g[7] * v1[3]};
                    if (second) { const v4u t = *(const v4u*)(T1 + row * D + col);
                        o[0] += bflo(t.x); o[1] += bfhi(t.x); o[2] += bflo(t.y); o[3] += bfhi(t.y); o[4] += bflo(t.z); o[5] += bfhi(t.z); o[6] += bflo(t.w); o[7] += bfhi(t.w); }
                    v4u w; w.x = pk2(o[0], o[1]); w.y = pk2(o[2], o[3]); w.z = pk2(o[4], o[5]); w.w = pk2(o[6], o[7]);
                    *(v4u*)(O + row * D + col) = w; } }
    }
};
struct PairOrder {
    pg8::StaticOrder so;
    __device__ __forceinline__ bool next(int i, pg8::Unit& u) const {
        const int per = so.nwg / so.G;
        if (i >= 2 * per) return false;
        const bool second = i >= per; if (!so.next(second ? i - per : i, u)) return false;
        if (second) { u.pm += T / 256; u.pb += D / 256; }
        return true;
    }
    __device__ __forceinline__ void a_ready(const pg8::Unit&) const {}
    __device__ __forceinline__ void done(const pg8::Unit&) const {}
    __device__ __forceinline__ int rot() const { return 0; }
};
struct EpiRes {
    static constexpr bool PERM = false, AFTER_DRAIN = false;
    const float* X; float* O;
    __device__ __forceinline__ void operator()(const pg8::f32x4 (&acc)[2][2][4][2], const pg8::Unit& u, int wr, int wc, int fr, int fq) const {
        const int row0 = u.pm * 256 + wr * 64 + fr, col0 = u.pn * 256 + wc * 32 + 4 * fq;
#pragma unroll
        for (int ai = 0; ai < 2; ++ai)
#pragma unroll
            for (int m = 0; m < 4; ++m) { const size_t off = (size_t)(row0 + ai * 128 + m * 16) * D + col0;
#pragma unroll
                for (int bj = 0; bj < 2; ++bj)
#pragma unroll
                    for (int n = 0; n < 2; ++n) { const pg8::f32x4 xv = *(const pg8::f32x4*)(X + off + bj * 128 + n * 16); *(pg8::f32x4*)(O + off + bj * 128 + n * 16) = xv + acc[ai][bj][m][n]; } }
    }
};
struct EpiAct {
    static constexpr bool PERM = true, AFTER_DRAIN = false;
    const float* bias; unsigned char* O;
    __device__ __forceinline__ void operator()(const pg8::f32x4 (&acc)[2][2][4][2], const pg8::Unit& u, int wr, int wc, int fr, int fq) const {
        const int row0 = u.pm * 256 + wr * 64 + fr, col0 = u.pn * 256 + wc * 32 + 8 * fq, e = u.pb >> 4;
        pg8::f32x4 bv[2][2];
#pragma unroll
        for (int bj = 0; bj < 2; ++bj)
#pragma unroll
            for (int n = 0; n < 2; ++n) bv[bj][n] = *(const pg8::f32x4*)(bias + (size_t)e * 2 * DE + col0 + bj * 128 + 4 * n);
#pragma unroll
        for (int ai = 0; ai < 2; ++ai)
#pragma unroll
            for (int m = 0; m < 4; ++m) { const size_t row = (size_t)(row0 + ai * 128 + m * 16);
#pragma unroll
                for (int bj = 0; bj < 2; ++bj) { const pg8::f32x4 v0 = acc[ai][bj][m][0] * W8INV + bv[bj][0], v1 = acc[ai][bj][m][1] * W8INV + bv[bj][1];
                    const float gu[8] = {v0[0], v0[1], v0[2], v0[3], v1[0], v1[1], v1[2], v1[3]}; float o[4];
#pragma unroll
                    for (int p = 0; p < 4; ++p) { const float glu = fminf(gu[2 * p], 7.f), lin = fminf(fmaxf(gu[2 * p + 1], -7.f), 7.f); o[p] = glu * sigmoidf_(1.702f * glu) * (lin + 1.f); }
                    int w = 0; w = __builtin_amdgcn_cvt_pk_fp8_f32(o[0], o[1], w, false); w = __builtin_amdgcn_cvt_pk_fp8_f32(o[2], o[3], w, true);
                    *(int*)(O + (size_t)u.pm * (256 * DE) + (size_t)u.pn * 32768 + (row & 255) * 128 + (((col0 & 255) + bj * 128) >> 1)) = w; } }
    }
};
struct EpiY {
    static constexpr bool PERM = true, AFTER_DRAIN = false;
    const float* bias; bf16* O;
    __device__ __forceinline__ void operator()(const pg8::f32x4 (&acc)[2][2][4][2], const pg8::Unit& u, int wr, int wc, int fr, int fq) const {
        const int row0 = u.pm * 256 + wr * 64 + fr, col0 = u.pn * 256 + wc * 32 + 8 * fq, e = u.pb >> 3;
        pg8::f32x4 bv[2][2];
#pragma unroll
        for (int bj = 0; bj < 2; ++bj)
#pragma unroll
            for (int n = 0; n < 2; ++n) bv[bj][n] = *(const pg8::f32x4*)(bias + (size_t)e * D + col0 + bj * 128 + 4 * n);
#pragma unroll
        for (int ai = 0; ai < 2; ++ai)
#pragma unroll
            for (int m = 0; m < 4; ++m) { const size_t row = (size_t)(row0 + ai * 128 + m * 16);
#pragma unroll
                for (int bj = 0; bj < 2; ++bj) { const pg8::f32x4 v0 = acc[ai][bj][m][0] * W8INV + bv[bj][0], v1 = acc[ai][bj][m][1] * W8INV + bv[bj][1];
                    int a0 = 0, a1 = 0; a0 = __builtin_amdgcn_cvt_pk_fp8_f32(sat8(v0[0]), sat8(v0[1]), a0, false); a0 = __builtin_amdgcn_cvt_pk_fp8_f32(sat8(v0[2]), sat8(v0[3]), a0, true);
                    a1 = __builtin_amdgcn_cvt_pk_fp8_f32(sat8(v1[0]), sat8(v1[1]), a1, false); a1 = __builtin_amdgcn_cvt_pk_fp8_f32(sat8(v1[2]), sat8(v1[3]), a1, true);
                    v2u w; w.x = (unsigned)a0; w.y = (unsigned)a1;
                    *(v2u*)((unsigned char*)O + row * D + col0 + bj * 128) = w; } }
    }
};
struct MoeSched {
    int tsl, fin, hin, fl, F, total, NT, G, c;
    __device__ __forceinline__ void init(const int* cnt, int NT_, int G_, int c_, int lane) {
        const int cn = lane < NE ? cnt[lane] : 0, f = cn / PADM, r = cn - f * PADM;
        const int full = f + (r > PADM / 2 ? 1 : 0), half = (r > 0 && r <= PADM / 2) ? 1 : 0, tiles = full + half;
        int it = tiles, iff = full, ih = half;
#pragma unroll
        for (int o = 1; o < 32; o <<= 1) { const int t0 = __shfl_up(it, o), t1 = __shfl_up(iff, o), t2 = __shfl_up(ih, o); if (lane >= o) { it += t0; iff += t1; ih += t2; } }
        F = __shfl(iff, 31); total = F + __shfl(ih, 31);
        tsl = it - tiles; fl = full; fin = lane < NE ? iff : 0x7fffffff; hin = lane < NE ? ih : 0x7fffffff; NT = NT_; G = G_; c = c_;
    }
    __device__ __forceinline__ bool next(int i, pg8::Unit& u) const {
        int mo, pn;
        if (G == 256) { const int x = c & 7, jj = c >> 3, NPB = NT >> 3, RPM = (8 / NPB) * 4;
            mo = i * RPM + (x / NPB) * 4 + (jj & 3); pn = (x % NPB) * 8 + (jj >> 2); }
        else { const long L = (long)i * G + c; mo = (int)(L / NT); pn = (int)(L % NT); }
        if (mo >= total) return false;
        int e, mt, hf;
        if (mo < F) { e = __popcll(__ballot(fin <= mo)); mt = __shfl(tsl, e) + (mo - (__shfl(fin, e) - __shfl(fl, e))); hf = 0; }
        else { e = __popcll(__ballot(hin <= mo - F)); mt = __shfl(tsl, e) + __shfl(fl, e); hf = 1; }
        u.pm = mt; u.pn = pn; u.pb = e * NT + pn; u.half = __builtin_amdgcn_readfirstlane(hf); return true;
    }
    __device__ __forceinline__ void a_ready(const pg8::Unit&) const {}
    __device__ __forceinline__ void done(const pg8::Unit&) const {}
    __device__ __forceinline__ int rot() const { const int jj = c >> 3; return G == 256 ? ((jj >> 2) + (jj & 3)) & 15 : 0; }
};

__device__ __forceinline__ void p2_mstats(const Ctx& C, const Args& a) {
    const float* MG = (const float*)(a.ws + WS_MG); float* GA = (float*)(a.ws + WS_MSC);
    const int gw = C.vcu * NWAVES + C.wave, NGW = C.G * NWAVES, lane = C.lane;
    for (int q = gw; q < 16 * 64; q += NGW) {
        const int chain = q >> 6, c = q & 63, dir = chain & 1, hh = (chain >> 1) & 3, b = chain >> 3;
        const int p = b * S + 64 * c + (dir ? 63 - lane : lane);
        const float lf = logsigf_(MG[(size_t)p * 16 + (dir ? 12 : 4) + hh]), ig = MG[(size_t)p * 16 + (dir ? 8 : 0) + hh];
        const float bs = incl_sum_up(lf, lane), g = __shfl(bs, 63), amax = g + wave_max(ig - bs);
        if (lane == 0) { f32x2 o; o.x = g; o.y = amax; *(f32x2*)(GA + (size_t)q * 2) = o; }
    }
}
struct MScan { float mprev, mnew, dec; };
__device__ __forceinline__ float rdlane(float v, int l) { return __int_as_float(__builtin_amdgcn_readlane(__float_as_int(v), l)); }
__device__ __forceinline__ MScan mscan(const float* GA, int chain, int lane) {
    const f32x2 ga = *(const f32x2*)(GA + (size_t)(chain * 64 + lane) * 2); const int dir = chain & 1;
    MScan r; r.mprev = 0.f; r.mnew = 0.f; r.dec = 0.f; float m = 0.f;
    for (int ci = 0; ci < 64; ++ci) { const int cc = dir ? 63 - ci : ci;
        const float gc = rdlane(ga.x, cc), ac = rdlane(ga.y, cc), mnew = fmaxf(gc + m, ac);
        if (lane == cc) { r.mprev = m; r.mnew = mnew; r.dec = __expf(gc + m - mnew); }
        m = mnew; }
    return r;
}
__device__ __forceinline__ void p2_qkprep(const Ctx& C, const Args& a) {
    const bf16* PROJ = (const bf16*)(a.ws + WS_PROJ); const float* ROPE = (const float*)(a.ws + WS_ROPE);
    const float* qg = a.in[6]; const float* kg = a.in[7];
    bf16* QN = (bf16*)(a.ws + WS_QN); bf16* KN = (bf16*)(a.ws + WS_KN);
    const int gw = C.vcu * NWAVES + C.wave, NGW = C.G * NWAVES, lane = C.lane, g = lane >> 2, sub = lane & 3;
    for (int m = gw; m < T; m += NGW) {
        const int pos = m & (S - 1);
        float cs[8], sn[8];
#pragma unroll
        for (int i = 0; i < 4; ++i) { const f32x4 t = *(const f32x4*)(ROPE + ((size_t)pos * 32 + sub * 8 + 2 * i) * 2); cs[2 * i] = t.x; sn[2 * i] = t.y; cs[2 * i + 1] = t.z; sn[2 * i + 1] = t.w; }
#pragma unroll
        for (int which = 0; which < 2; ++which) {
            const bf16* src = PROJ + (size_t)m * NPJ + (which ? P_DK : P_DQ) + g * 64 + sub * 8;
            const v4u a1 = *(const v4u*)src, a2 = *(const v4u*)(src + 32);
            float x1[8] = {bflo(a1.x), bfhi(a1.x), bflo(a1.y), bfhi(a1.y), bflo(a1.z), bfhi(a1.z), bflo(a1.w), bfhi(a1.w)};
            float x2[8] = {bflo(a2.x), bfhi(a2.x), bflo(a2.y), bfhi(a2.y), bflo(a2.z), bfhi(a2.z), bflo(a2.w), bfhi(a2.w)};
            float ss = 0.f;
#pragma unroll
            for (int i = 0; i < 8; ++i) ss += x1[i] * x1[i] + x2[i] * x2[i];
            ss += __shfl_xor(ss, 1); ss += __shfl_xor(ss, 2);
            const float r = rsqrtf(ss * (1.f / 64.f) + EPS) * (which ? 1.f : QSCALE);
            const float* gn = which ? kg : qg; float o1[8], o2[8];
#pragma unroll
            for (int i = 0; i < 8; ++i) { const float u1 = x1[i] * r * gn[sub * 8 + i], u2 = x2[i] * r * gn[32 + sub * 8 + i]; o1[i] = u1 * cs[i] - u2 * sn[i]; o2[i] = u2 * cs[i] + u1 * sn[i]; }
            bf16* dst = (which ? KN : QN) + (size_t)m * 1024 + g * 64 + sub * 8;
            v4u w1, w2; w1.x = pk2(o1[0], o1[1]); w1.y = pk2(o1[2], o1[3]); w1.z = pk2(o1[4], o1[5]); w1.w = pk2(o1[6], o1[7]);
            w2.x = pk2(o2[0], o2[1]); w2.y = pk2(o2[2], o2[3]); w2.z = pk2(o2[4], o2[5]); w2.w = pk2(o2[6], o2[7]);
            *(v4u*)dst = w1; *(v4u*)(dst + 32) = w2;
        }
    }
}

__device__ __forceinline__ void mlA_unit(const Ctx& C, int u, const Args& a) {
    const bf16* PROJ = (const bf16*)(a.ws + WS_PROJ); const float* MG = (const float*)(a.ws + WS_MG); const float* MSC = (const float*)(a.ws + WS_MSC);
    bf16* U = (bf16*)(a.ws + WS_U); float* NU = (float*)(a.ws + WS_NU);
    const int b = u >> 8, hh = (u >> 6) & 3, j = u & 63, chain0 = (b * 4 + hh) * 2;
    const size_t row0 = (size_t)b * S + j * 64;
    const int tid = C.tid, lane = C.lane, w = C.wave;
    LAS unsigned char* lds = C.lds;
    constexpr int KI = 0, VI = 20480, WKF = 57344, WKB = 77824, WF = 98304;
    __syncthreads();
#pragma unroll
    for (int i = 0; i < 2; ++i) { const int p = tid + 512 * i, row = p >> 4, c = p & 15;
        *(LAS v4u*)(lds + KI + row * 320 + c * 16) = *(const v4u*)(PROJ + (row0 + row) * NPJ + P_MK + hh * 128 + c * 8); }
#pragma unroll
    for (int i = 0; i < 4; ++i) { const int p = tid + 512 * i, row = p >> 5, c = p & 31;
        *(LAS v4u*)(lds + VI + row * 576 + c * 16) = *(const v4u*)(PROJ + (row0 + row) * NPJ + P_MV + hh * 256 + c * 8); }
    if (w < 2) {
        const int dir = w, t = lane;
        const float fgv = MG[(row0 + t) * 16 + (dir ? 12 : 4) + hh], igv = MG[(row0 + t) * 16 + (dir ? 8 : 0) + hh];
        const float lf = logsigf_(fgv), P = incl_sum_up(lf, lane), Gt = __shfl(P, 63);
        const float bcur = dir ? (Gt - P + lf) : P;
        const MScan ms = mscan(MSC, chain0 + dir, lane);
        const float av = Gt - bcur + igv, mnew = rdlane(ms.mnew, j);
        ((LAS float*)(lds + WF + dir * 256))[t] = __expf(av - mnew);
    }
    __syncthreads();
#pragma unroll
    for (int i = 0; i < 2; ++i) { const int p = tid + 512 * i, row = p >> 4, c = p & 15;
        const v4u kv = *(LAS v4u*)(lds + KI + row * 320 + c * 16);
        const float wf = ((LAS float*)(lds + WF))[row], wb = ((LAS float*)(lds + WF + 256))[row];
        *(LAS v4u*)(lds + WKF + row * 320 + c * 16) = scale8(kv, wf);
        *(LAS v4u*)(lds + WKB + row * 320 + c * 16) = scale8(kv, wb); }
    if (tid < 256) { const int dir = tid >> 7, k = tid & 127; float s = 0.f;
        for (int t = 0; t < 64; ++t) s += ((LAS float*)(lds + WF + dir * 256))[t] * bf2f(*(LAS bf16*)(lds + KI + t * 320 + k * 2));
        NU[(size_t)((chain0 + dir) * 64 + j) * 128 + k] = s; }
    __syncthreads();
    const int G_ = (lane >> 4) & 1, i16 = lane & 15, q_ = i16 >> 2, p_ = i16 & 3, h = lane >> 5, r32 = lane & 31;
    f32x16 acc[2][4];
#pragma unroll
    for (int d = 0; d < 2; ++d)
#pragma unroll
        for (int n = 0; n < 4; ++n) acc[d][n] = f32x16{};
#pragma unroll
    for (int s = 0; s < 4; ++s) {
        LAS unsigned char* va = lds + VI + (16 * s + 8 * h + q_) * 576 + (32 * w + 16 * G_ + 4 * p_) * 2;
        const bf16x8 af = cat8(trr(va), trr(va + 4 * 576));
#pragma unroll
        for (int d = 0; d < 2; ++d)
#pragma unroll
            for (int n = 0; n < 4; ++n) {
                LAS unsigned char* ba = lds + (d ? WKB : WKF) + (16 * s + 8 * h + q_) * 320 + (32 * n + 16 * G_ + 4 * p_) * 2;
                const bf16x8 bfr = cat8(trr(ba), trr(ba + 4 * 320));
                acc[d][n] = __builtin_amdgcn_mfma_f32_32x32x16_bf16(bfr, af, acc[d][n], 0, 0, 0);
            }
    }
    __syncthreads();
    LAS unsigned char* ut = lds + w * 4096;
#pragma unroll
    for (int d = 0; d < 2; ++d) {
#pragma unroll
        for (int n = 0; n < 4; ++n)
#pragma unroll
            for (int g4 = 0; g4 < 4; ++g4) { int o = 0; o = __builtin_amdgcn_cvt_pk_fp8_f32(sat8(acc[d][n][4 * g4 + 0]), sat8(acc[d][n][4 * g4 + 1]), o, false); o = __builtin_amdgcn_cvt_pk_fp8_f32(sat8(acc[d][n][4 * g4 + 2]), sat8(acc[d][n][4 * g4 + 3]), o, true);
                *(LAS int*)(ut + r32 * 128 + ((32 * n + 8 * g4 + 4 * h) ^ ((r32 & 7) << 4))) = o; }
        unsigned char* ub = (unsigned char*)U + ((size_t)((chain0 + d) * 64 + j) * 256 + 32 * w) * 128;
#pragma unroll
        for (int i = 0; i < 4; ++i) { const int row = 8 * i + (lane >> 3), ch = lane & 7;
            const v4u v = *(LAS v4u*)(ut + row * 128 + ((ch ^ (row & 7)) << 4));
            *(v4u*)(ub + (size_t)row * 128 + ch * 16) = v; }
    }
}
__device__ __forceinline__ void mlB_scan(const Ctx& C, const Args& a) {
    const bf16* __restrict__ U = (const bf16*)(a.ws + WS_U); bf16* __restrict__ CP = (bf16*)(a.ws + WS_CP); const float* MSC = (const float*)(a.ws + WS_MSC);
    const float* __restrict__ NU = (const float*)(a.ws + WS_NU); float* __restrict__ NP = (float*)(a.ws + WS_NP);
    for (int g = C.vcu * NTHR + C.tid; g < 16 * 8192; g += C.G * NTHR) {
        const int chain = __builtin_amdgcn_readfirstlane(g >> 13), e4 = g & 8191, dir = chain & 1;
        const MScan ms = mscan(MSC, chain, C.lane);
        const unsigned char* ub = (const unsigned char*)U + (size_t)chain * 64 * 32768 + 4 * e4; unsigned char* cb = (unsigned char*)CP + (size_t)chain * 64 * 32768 + 4 * e4;
        f32x4 st = {0.f, 0.f, 0.f, 0.f};
#pragma unroll 8
        for (int ci = 0; ci < 64; ++ci) { const int c = dir ? 63 - ci : ci; const float dec = rdlane(ms.dec, c);
            { int o = 0; o = __builtin_amdgcn_cvt_pk_fp8_f32(sat8(st.x), sat8(st.y), o, false); o = __builtin_amdgcn_cvt_pk_fp8_f32(sat8(st.z), sat8(st.w), o, true); *(int*)(cb + (size_t)c * 32768) = o; }
            const int ur = *(const int*)(ub + (size_t)c * 32768); const f32x4 uv = {__builtin_amdgcn_cvt_f32_fp8(ur, 0), __builtin_amdgcn_cvt_f32_fp8(ur, 1), __builtin_amdgcn_cvt_f32_fp8(ur, 2), __builtin_amdgcn_cvt_f32_fp8(ur, 3)}; st = st * dec + uv; }
    }
    const int g = C.vcu * NTHR + C.tid;
    if (g < 512) { const int chain = g >> 5, k4 = g & 31, dir = chain & 1; f32x4 st = {0.f, 0.f, 0.f, 0.f};
        const int chA = __builtin_amdgcn_readfirstlane(chain); const MScan m0 = mscan(MSC, chA, C.lane), m1 = mscan(MSC, chA + 1, C.lane);
        for (int ci = 0; ci < 64; ++ci) { const int c = dir ? 63 - ci : ci; const float d0 = __shfl(m0.dec, c), d1 = __shfl(m1.dec, c); const float dec = (chain == chA) ? d0 : d1;
            *(f32x4*)(NP + (size_t)(chain * 64 + c) * 128 + 4 * k4) = st;
            const f32x4 uv = *(const f32x4*)(NU + (size_t)(chain * 64 + c) * 128 + 4 * k4); st = st * dec + uv; } }
}
__device__ __forceinline__ void mlC_unit(const Ctx& C, int u, const Args& a) {
    const bf16* PROJ = (const bf16*)(a.ws + WS_PROJ); const float* MG = (const float*)(a.ws + WS_MG); const float* MSC = (const float*)(a.ws + WS_MSC);
    const bf16* CP = (const bf16*)(a.ws + WS_CP); const float* NP = (const float*)(a.ws + WS_NP); const float* mlg = a.in[4]; bf16* HM = (bf16*)(a.ws + WS_HM);
    const int b = u >> 8, hh = (u >> 6) & 3, j = u & 63, chain0 = (b * 4 + hh) * 2;
    const size_t row0 = (size_t)b * S + j * 64;
    const int tid = C.tid, lane = C.lane, w = C.wave;
    LAS unsigned char* lds = C.lds;
    constexpr int QI = 0, KI = 17408, VI = 34816, SI = 71680, PI = 89088, SC = 98304;
    constexpr int NQ = SC + 2048, NPL = SC + 6144, SSO = SC + 7168, RS = SC + 9216;
    __syncthreads();
#pragma unroll
    for (int i = 0; i < 2; ++i) { const int p = tid + 512 * i, row = p >> 4, c = p & 15;
        *(LAS v4u*)(lds + QI + row * 272 + c * 16) = *(const v4u*)(PROJ + (row0 + row) * NPJ + P_MQ + hh * 128 + c * 8);
        *(LAS v4u*)(lds + KI + row * 272 + c * 16) = *(const v4u*)(PROJ + (row0 + row) * NPJ + P_MK + hh * 128 + c * 8); }
#pragma unroll
    for (int i = 0; i < 4; ++i) { const int p = tid + 512 * i, row = p >> 5, c = p & 31;
        *(LAS v4u*)(lds + VI + row * 576 + c * 16) = *(const v4u*)(PROJ + (row0 + row) * NPJ + P_MV + hh * 256 + c * 8); }
    if (tid < 256) ((LAS float*)(lds + NPL))[tid] = NP[(size_t)((chain0 + (tid >> 7)) * 64 + j) * 128 + (tid & 127)];
    v2u cpr[2][8];
#pragma unroll
    for (int d = 0; d < 2; ++d) { const unsigned char* cp = (const unsigned char*)CP + ((size_t)((chain0 + d) * 64 + j) * 256 + 32 * w + (lane & 31)) * 128 + 8 * (lane >> 5);
#pragma unroll
        for (int ks = 0; ks < 8; ++ks) cpr[d][ks] = *(const v2u*)(cp + 16 * ks); }
    if (w < 2) {
        const int dir = w, t = lane;
        const float fgv = MG[(row0 + t) * 16 + (dir ? 12 : 4) + hh], igv = MG[(row0 + t) * 16 + (dir ? 8 : 0) + hh];
        const float lf = logsigf_(fgv), P = incl_sum_up(lf, lane), Gt = __shfl(P, 63);
        const float bcur = dir ? (Gt - P + lf) : P, cv = igv - bcur;
        const float pm = dir ? incl_max_down(cv, lane) : incl_max_up(cv, lane);
        const MScan ms = mscan(MSC, chain0 + dir, lane); const float mprev = rdlane(ms.mprev, j);
        const float mt = bcur + fmaxf(mprev, pm), si = __expf(bcur + mprev - mt);
        LAS float* sc = (LAS float*)(lds + SC + dir * 1024);
        sc[t] = bcur; sc[64 + t] = cv; sc[128 + t] = mt; sc[192 + t] = si;
    }
    __syncthreads();
    {
        const int fr = lane & 15, fq = lane >> 4;
#pragma unroll
        for (int tt = 0; tt < 2; ++tt) { const int tile = 2 * w + tt, ti = tile >> 2, si_ = tile & 3; f32x4 acc4 = {0.f, 0.f, 0.f, 0.f};
#pragma unroll
            for (int ks = 0; ks < 4; ++ks) {
                const bf16x8 aq = *(LAS bf16x8*)(lds + QI + (16 * ti + fr) * 272 + (32 * ks + 8 * fq) * 2);
                const bf16x8 bk = *(LAS bf16x8*)(lds + KI + (16 * si_ + fr) * 272 + (32 * ks + 8 * fq) * 2);
                acc4 = __builtin_amdgcn_mfma_f32_16x16x32_bf16(aq, bk, acc4, 0, 0, 0); }
#pragma unroll
            for (int i = 0; i < 4; ++i) ((LAS float*)(lds + SI))[(16 * ti + 4 * fq + i) * 68 + 16 * si_ + fr] = acc4[i]; }
        const int t = tid & 63, part = tid >> 6;
        const v4u q0 = *(LAS v4u*)(lds + QI + t * 272 + part * 32), q1 = *(LAS v4u*)(lds + QI + t * 272 + part * 32 + 16);
        const float qv[16] = {bflo(q0.x), bfhi(q0.x), bflo(q0.y), bfhi(q0.y), bflo(q0.z), bfhi(q0.z), bflo(q0.w), bfhi(q0.w), bflo(q1.x), bfhi(q1.x), bflo(q1.y), bfhi(q1.y), bflo(q1.z), bfhi(q1.z), bflo(q1.w), bfhi(q1.w)};
#pragma unroll
        for (int d = 0; d < 2; ++d) { float s = 0.f;
#pragma unroll
            for (int k = 0; k < 16; ++k) s += ((LAS float*)(lds + NPL))[d * 128 + part * 16 + k] * qv[k];
            ((LAS float*)(lds + NQ))[(d * 8 + part) * 64 + t] = s; }
    }
    __syncthreads();
    {
        const int t = tid >> 3, sg = tid & 7, s0 = 8 * sg;
        const f32x4 sa = *(LAS f32x4*)(lds + SI + (t * 68 + s0) * 4), sb = *(LAS f32x4*)(lds + SI + (t * 68 + s0 + 4) * 4);
        const float sv[8] = {sa.x, sa.y, sa.z, sa.w, sb.x, sb.y, sb.z, sb.w};
        float p[2][8], inv[2];
#pragma unroll
        for (int d = 0; d < 2; ++d) { LAS float* sc = (LAS float*)(lds + SC + d * 1024);
            const float Bt = sc[t], MTt = sc[128 + t], SIt = sc[192 + t]; float rs = 0.f;
#pragma unroll
            for (int e = 0; e < 8; ++e) { const int s = s0 + e; const bool ok = d ? (s >= t) : (s <= t);
                const float dv = ok ? __expf(Bt + sc[64 + s] - MTt) : 0.f; p[d][e] = dv * sv[e]; rs += p[d][e]; }
            float nq = ((LAS float*)(lds + NQ))[(d * 8 + sg) * 64 + t];
            rs += __shfl_xor(rs, 1); rs += __shfl_xor(rs, 2); rs += __shfl_xor(rs, 4);
            nq += __shfl_xor(nq, 1); nq += __shfl_xor(nq, 2); nq += __shfl_xor(nq, 4);
            const float den = fmaxf(fabsf(SIt * nq + rs), __expf(-MTt)); inv[d] = 1.f / den;
            if (sg == 0) ((LAS float*)(lds + RS))[d * 64 + t] = SIt * inv[d]; }
        float o[8];
#pragma unroll
        for (int e = 0; e < 8; ++e) o[e] = p[0][e] * inv[0] + p[1][e] * inv[1];
        v4u wv; wv.x = pk2(o[0], o[1]); wv.y = pk2(o[2], o[3]); wv.z = pk2(o[4], o[5]); wv.w = pk2(o[6], o[7]);
        *(LAS v4u*)(lds + PI + t * 144 + s0 * 2) = wv;
    }
    __syncthreads();
#pragma unroll
    for (int i = 0; i < 2; ++i) { const int p = tid + 512 * i, row = p >> 4, c = p & 15;
        const v4u qv = *(LAS v4u*)(lds + QI + row * 272 + c * 16);
        const float rf = ((LAS float*)(lds + RS))[row], rb = ((LAS float*)(lds + RS))[64 + row];
        *(LAS v4u*)(lds + QI + row * 272 + c * 16) = scale8(qv, rf);
        *(LAS v4u*)(lds + KI + row * 272 + c * 16) = scale8(qv, rb); }
    __syncthreads();
    const int G_ = (lane >> 4) & 1, i16 = lane & 15, q_ = i16 >> 2, p_ = i16 & 3, h = lane >> 5, r32 = lane & 31;
    f32x16 acc[2]; acc[0] = f32x16{}; acc[1] = f32x16{};
#pragma unroll
    for (int d = 0; d < 2; ++d) {
#pragma unroll
        for (int ks = 0; ks < 8; ++ks) { const v2u cr = cpr[d][ks]; v4u a4;
            a4.x = pk2(__builtin_amdgcn_cvt_f32_fp8((int)cr.x, 0), __builtin_amdgcn_cvt_f32_fp8((int)cr.x, 1)); a4.y = pk2(__builtin_amdgcn_cvt_f32_fp8((int)cr.x, 2), __builtin_amdgcn_cvt_f32_fp8((int)cr.x, 3));
            a4.z = pk2(__builtin_amdgcn_cvt_f32_fp8((int)cr.y, 0), __builtin_amdgcn_cvt_f32_fp8((int)cr.y, 1)); a4.w = pk2(__builtin_amdgcn_cvt_f32_fp8((int)cr.y, 2), __builtin_amdgcn_cvt_f32_fp8((int)cr.y, 3));
            const bf16x8 af = __builtin_bit_cast(bf16x8, a4);
#pragma unroll
            for (int th = 0; th < 2; ++th) { const bf16x8 bq = *(LAS bf16x8*)(lds + (d ? KI : QI) + (32 * th + r32) * 272 + (16 * ks + 8 * h) * 2);
                acc[th] = __builtin_amdgcn_mfma_f32_32x32x16_bf16(af, bq, acc[th], 0, 0, 0); } } }
#pragma unroll
    for (int ks = 0; ks < 4; ++ks) { LAS unsigned char* va = lds + VI + (16 * ks + 8 * h + q_) * 576 + (32 * w + 16 * G_ + 4 * p_) * 2;
        const bf16x8 af = cat8(trr(va), trr(va + 4 * 576));
#pragma unroll
        for (int th = 0; th < 2; ++th) { const bf16x8 bp = *(LAS bf16x8*)(lds + PI + (32 * th + r32) * 144 + (16 * ks + 8 * h) * 2);
            acc[th] = __builtin_amdgcn_mfma_f32_32x32x16_bf16(af, bp, acc[th], 0, 0, 0); } }
#pragma unroll
    for (int th = 0; th < 2; ++th) { float ss = 0.f;
#pragma unroll
        for (int r = 0; r < 16; ++r) ss += acc[th][r] * acc[th][r];
        ss += __shfl_xor(ss, 32);
        if (h == 0) ((LAS float*)(lds + SSO))[w * 64 + 32 * th + r32] = ss; }
    __syncthreads();
#pragma unroll
    for (int th = 0; th < 2; ++th) { float tot = 0.f;
#pragma unroll
        for (int ww = 0; ww < 8; ++ww) tot += ((LAS float*)(lds + SSO))[ww * 64 + 32 * th + r32];
        const float rr = rsqrtf(tot * (1.f / 256.f) + EPS); const size_t tok = row0 + 32 * th + r32;
#pragma unroll
        for (int g4 = 0; g4 < 4; ++g4) { const int v0 = 32 * w + 8 * g4 + 4 * h;
            const f32x4 gn = *(const f32x4*)(mlg + v0); const v2u sm = *(const v2u*)(PROJ + tok * NPJ + P_MO + hh * 256 + v0);
            v2u o; o.x = pk2(acc[th][4 * g4 + 0] * rr * gn.x * bflo(sm.x), acc[th][4 * g4 + 1] * rr * gn.y * bfhi(sm.x));
            o.y = pk2(acc[th][4 * g4 + 2] * rr * gn.z * bflo(sm.y), acc[th][4 * g4 + 3] * rr * gn.w * bfhi(sm.y));
            *(v2u*)(HM + tok * 1024 + hh * 256 + v0) = o; } }
}

constexpr int AT_BUF = 32768, AT_K2 = 8192, AT_V = 16384, AT_CV = 65536, AT_DUMMY = AT_CV + 8 * 8448;
__device__ __forceinline__ void at_dma(unsigned off, const char* base, unsigned ldsaddr) { unsigned keep;
    asm volatile("s_mov_b32 %0, m0\n\ts_mov_b32 m0, %3\n\ts_nop 0\n\tglobal_load_lds_dwordx4 %1, %2\n\ts_mov_b32 m0, %0" : "=&s"(keep) : "v"(off), "s"(base), "s"(ldsaddr) : "memory"); }
__device__ __forceinline__ void attn_unit(const Ctx& C, int u, int uidx, const Args& a, int lam_s, Conv& cv) {
    const bf16* QN = (const bf16*)(a.ws + WS_QN); const bf16* KN = (const bf16*)(a.ws + WS_KN); const bf16* PROJ = (const bf16*)(a.ws + WS_PROJ);
    const int b = u >> 8, hh = (u >> 5) & 7, qb = u & 31;
    const int lane = C.lane, w = C.wave, rg = w >> 1, mp = w & 1, r32 = lane & 31, h = lane >> 5;
    LAS unsigned char* lds = C.lds; const unsigned ldsb = (unsigned)(uintptr_t)lds;
    const size_t rowbase = (size_t)b * S; const int NGW = C.G * NWAVES;
    unsigned ko, vo0;
    { const int row = 8 * w + (lane >> 3), c = (lane & 7) ^ ((row >> 1) & 7); ko = (unsigned)((row * 1024 + c * 8) * 2); }
    { const int row = 8 * w + (lane >> 4), ch = (lane & 15) ^ ((row & 3) << 2); vo0 = (unsigned)((row * NPJ + ch * 8) * 2); }
    const char* kbase = (const char*)(KN + rowbase * 1024 + hh * 128); const char* vbase = (const char*)(PROJ + rowbase * NPJ + P_DV + hh * 128);
#define AT_TILE_DMA(t_, bufoff_) do { const char* kb__ = uni_ptr(kbase + (size_t)(t_) * 64 * 1024 * 2); const char* vb__ = uni_ptr(vbase + (size_t)(t_) * 64 * NPJ * 2); \
        const unsigned d__ = (unsigned)__builtin_amdgcn_readfirstlane((int)(ldsb + (bufoff_))); \
        at_dma(ko, kb__, d__ + w * 1024); at_dma(ko, kb__ + 128, d__ + AT_K2 + w * 1024); at_dma(vo0, vb__, d__ + AT_V + w * 2048); at_dma(vo0, vb__ + 4 * NPJ * 2, d__ + AT_V + w * 2048 + 1024); } while (0)
    bf16x8 qf[4];
    { const bf16* qsrc = QN + (rowbase + qb * 128 + rg * 32 + r32) * 1024 + hh * 128 + mp * 64 + h * 8;
#pragma unroll
      for (int d0 = 0; d0 < 4; ++d0) qf[d0] = *(const bf16x8*)(qsrc + 16 * d0); }
    f32x16 O[4];
#pragma unroll
    for (int d0 = 0; d0 < 4; ++d0) O[d0] = f32x16{};
    float lsum = 0.f;
    const int G_ = (lane >> 4) & 1, i16 = lane & 15, q_ = i16 >> 2, p_ = i16 & 3;
    const int kofb = mp * AT_K2 + r32 * 128 + ((h ^ ((r32 >> 1) & 1)) << 4) + (((r32 >> 2) & 3) << 5);
    const int vofb = AT_V + (4 * h + q_) * 256 + (q_ << 6) + 32 * G_ + 8 * p_;
#define kof(d0) (kofb ^ ((d0) << 5))
#define vof(d0) (vofb ^ ((d0) << 6))
    asm volatile("s_waitcnt lgkmcnt(0)" ::: "memory"); __builtin_amdgcn_s_barrier(); asm volatile("" ::: "memory");
    AT_TILE_DMA(0, 0);
    asm volatile("s_waitcnt vmcnt(0)" ::: "memory"); __builtin_amdgcn_s_barrier(); asm volatile("" ::: "memory");
#define AT_ITER(t_, SET_, TICK_) do { \
        LAS unsigned char* cur = lds + ((t_) & 1) * AT_BUF; \
        if ((t_) + 1 < S / 64) AT_TILE_DMA((t_) + 1, (((t_) + 1) & 1) * AT_BUF); \
        else { const unsigned d__ = (unsigned)__builtin_amdgcn_readfirstlane((int)(ldsb + AT_DUMMY)); const char* kb__ = uni_ptr(kbase); at_dma(ko, kb__, d__); at_dma(ko, kb__, d__); at_dma(ko, kb__, d__); at_dma(ko, kb__, d__); } \
        int cit_ = cv.it, cst_ = cv.step; conv_next(cit_, cst_, NGW); const ConvSrc csrc_ = conv_src(a, cit_); const unsigned cloff_ = conv_loff(csrc_, lane); (void)cst_; (void)cloff_; \
        _Pragma("unroll") for (int hv = 0; hv < 2; ++hv) { f32x16 pp = f32x16{}; \
            _Pragma("unroll") for (int d0 = 0; d0 < 4; ++d0) { const bf16x8 ka = *(LAS bf16x8*)(cur + kof(d0) + hv * 32 * 128); pp = __builtin_amdgcn_mfma_f32_32x32x16_bf16(ka, qf[d0], pp, 0, 0, 0); } \
            if (TICK_) conv_issue_one(cv.s[(SET_) ^ 1], csrc_, cloff_, cst_, 4 * hv + 0); \
            _Pragma("unroll") for (int r = 0; r < 16; ++r) { pp[r] = __builtin_amdgcn_exp2f(pp[r]); lsum += pp[r]; } \
            if (TICK_) conv_issue_one(cv.s[(SET_) ^ 1], csrc_, cloff_, cst_, 4 * hv + 1); \
            _Pragma("unroll") for (int k2 = 0; k2 < 2; ++k2) { const int o = 8 * k2; \
                v4u t4; t4.x = pk2(pp[o + 0], pp[o + 1]); t4.y = pk2(pp[o + 2], pp[o + 3]); t4.z = pk2(pp[o + 4], pp[o + 5]); t4.w = pk2(pp[o + 6], pp[o + 7]); \
                const bf16x8 pa = __builtin_bit_cast(bf16x8, t4); \
                _Pragma("unroll") for (int d0 = 0; d0 < 4; ++d0) { LAS unsigned char* va = cur + vof(d0) + (32 * hv + 16 * k2) * 256; \
                    const bf16x8 vf = cat8(trr(va), trr(va + 8 * 256)); \
                    O[d0] = __builtin_amdgcn_mfma_f32_32x32x16_bf16(vf, pa, O[d0], 0, 0, 0); } \
                if (TICK_) conv_issue_one(cv.s[(SET_) ^ 1], csrc_, cloff_, cst_, 4 * hv + 2 + k2); } } \
        if (TICK_) { if (conv_consume<12>(cv, cv.s[SET_], a, lds + AT_CV + w * 8448, NGW, lane)) asm volatile("s_waitcnt vmcnt(16) lgkmcnt(0)" ::: "memory"); \
            else asm volatile("s_waitcnt vmcnt(8) lgkmcnt(0)" ::: "memory"); } \
        else asm volatile("s_waitcnt vmcnt(0) lgkmcnt(0)" ::: "memory"); \
        __builtin_amdgcn_s_barrier(); asm volatile("" ::: "memory"); \
    } while (0)
    { const int slot = C.vcu & 3; int pa = 64, pb = 64;
      if ((slot >> 1) == uidx) { pa = 32 * (slot & 1); pb = pa + 32; }
      int t = 0;
      for (; t < pa; t += 2) { AT_ITER(t, 0, true); AT_ITER(t + 1, 1, true); }
      for (; t < pb; t += 2) { AT_ITER(t, 0, false); AT_ITER(t + 1, 1, false); }
      for (; t < S / 64; t += 2) { AT_ITER(t, 0, true); AT_ITER(t + 1, 1, true); } }
#undef AT_ITER
#undef AT_TILE_DMA
#undef kof
#undef vof
    lsum += __shfl_xor(lsum, 32);
    const float inv = 1.f / lsum;
    int le = C.tid & 63; asm volatile("" : "+v"(le));
    LAS float* ex = (LAS float*)lds + rg * 4096;
    if (mp == 1) {
#pragma unroll
        for (int d0 = 0; d0 < 4; ++d0)
#pragma unroll
            for (int r = 0; r < 16; ++r) ex[(d0 * 16 + r) * 64 + le] = O[d0][r] * inv; }
    asm volatile("s_waitcnt lgkmcnt(0)" ::: "memory"); __builtin_amdgcn_s_barrier(); asm volatile("" ::: "memory");
    if (mp == 0) {
        float ss = 0.f; int lb_ = lam_s; asm volatile("" : "+s"(lb_)); const float lamv = __int_as_float(lb_);
#pragma unroll
        for (int d0 = 0; d0 < 4; ++d0)
#pragma unroll
            for (int r = 0; r < 16; ++r) { const float o = O[d0][r] * inv - lamv * ex[(d0 * 16 + r) * 64 + le]; O[d0][r] = o; ss += o * o; }
        ss += __shfl_xor(ss, 32);
        const float rr = rsqrtf(ss * (1.f / 128.f) + EPS) * (1.f - LAM_INIT);
        const size_t tok = (size_t)b * S + qb * 128 + rg * 32 + (le & 31); const int he = le >> 5;
        bf16* odp = (bf16*)(a.ws + WS_OD) + tok * 1024 + hh * 128 + 4 * he;
#pragma unroll
        for (int d0 = 0; d0 < 4; ++d0)
#pragma unroll
            for (int g4 = 0; g4 < 4; ++g4) { const int dv0 = 32 * d0 + 8 * g4; const f32x4 gn = *(const f32x4*)(a.in[9] + dv0 + 4 * he);
                v2u o; o.x = pk2(O[d0][4 * g4 + 0] * rr * gn.x, O[d0][4 * g4 + 1] * rr * gn.y); o.y = pk2(O[d0][4 * g4 + 2] * rr * gn.z, O[d0][4 * g4 + 3] * rr * gn.w);
                *(v2u*)(odp + dv0) = o; }
    }
}

__device__ __forceinline__ void p8_router(const Ctx& C, const Args& a) {
    const float* x1 = a.out; const float* g2 = a.in[12]; const float* br = a.in[14];
    const bf16* WRH = (const bf16*)(a.ws + WS_WRH); const bf16* WRL = (const bf16*)(a.ws + WS_WRL);
    unsigned char* H2 = a.ws + WS_H2; int* cnt = (int*)(a.ws + WS_CTL) + CW_WGCNT;
    int* TOPE = (int*)(a.ws + WS_RT); int* SLOT = TOPE + T * 4; float* WTS = (float*)(SLOT + T * 4);
    const int lane = C.lane, w = C.wave, r32 = lane & 31, h = lane >> 5;
    LAS float* PLG = (LAS float*)C.lds;
    LAS float* SSQ = (LAS float*)(C.lds + 32768);
    LAS float* LG = (LAS float*)(C.lds + 32768 + 1024);
    LAS float* RSTD = (LAS float*)(C.lds + 32768 + 1024 + 32 * 33 * 4);
    LAS int* lcnt = (LAS int*)(C.lds + 65536);
    if (C.tid < NE) lcnt[C.tid] = 0;
    for (int m0 = C.vcu * 32; m0 < T; m0 += C.G * 32) {
        __syncthreads();
        f32x16 acc = f32x16{}; float ssq = 0.f;
        const float* xrow = x1 + (size_t)(m0 + r32) * D + 256 * w + 8 * h;
        const float* grow = g2 + 256 * w + 8 * h;
        const bf16* whp = WRH + (size_t)r32 * D + 256 * w + 8 * h; const bf16* wlp = WRL + (size_t)r32 * D + 256 * w + 8 * h;
#pragma unroll 4
        for (int s = 0; s < 16; ++s) {
            const f32x4 xa = *(const f32x4*)(xrow + 16 * s), xb = *(const f32x4*)(xrow + 16 * s + 4);
            const f32x4 ga = *(const f32x4*)(grow + 16 * s), gb = *(const f32x4*)(grow + 16 * s + 4);
            const bf16x8 wh = *(const bf16x8*)(whp + 16 * s), wl = *(const bf16x8*)(wlp + 16 * s);
            ssq += (xa.x * xa.x + xa.y * xa.y) + (xa.z * xa.z + xa.w * xa.w) + (xb.x * xb.x + xb.y * xb.y) + (xb.z * xb.z + xb.w * xb.w);
            const float hv[8] = {xa.x * ga.x, xa.y * ga.y, xa.z * ga.z, xa.w * ga.w, xb.x * gb.x, xb.y * gb.y, xb.z * gb.z, xb.w * gb.w};
            v4u hi4, lo4;
#pragma unroll
            for (int i = 0; i < 4; ++i) { const unsigned hp = pk2(hv[2 * i], hv[2 * i + 1]); ((unsigned*)&hi4)[i] = hp; ((unsigned*)&lo4)[i] = pk2(hv[2 * i] - bflo(hp), hv[2 * i + 1] - bfhi(hp)); }
            const bf16x8 hh = __builtin_bit_cast(bf16x8, hi4), hl = __builtin_bit_cast(bf16x8, lo4);
            acc = __builtin_amdgcn_mfma_f32_32x32x16_bf16(wh, hh, acc, 0, 0, 0);
            acc = __builtin_amdgcn_mfma_f32_32x32x16_bf16(wh, hl, acc, 0, 0, 0);
            acc = __builtin_amdgcn_mfma_f32_32x32x16_bf16(wl, hh, acc, 0, 0, 0);
        }
        ssq += __shfl_xor(ssq, 32);
#pragma unroll
        for (int r = 0; r < 16; ++r) PLG[(w * 16 + r) * 64 + lane] = acc[r];
        if (h == 0) SSQ[w * 32 + r32] = ssq;
        __syncthreads();
        if (C.tid < 32) { float s = 0.f;
#pragma unroll
            for (int ww = 0; ww < 8; ++ww) s += SSQ[ww * 32 + C.tid];
            RSTD[C.tid] = rsqrtf(s * (1.f / D) + EPS); }
        __syncthreads();
#pragma unroll
        for (int q = 0; q < 2; ++q) { const int idx = C.tid + 512 * q, r = idx >> 6, l = idx & 63; float s = 0.f;
#pragma unroll
            for (int ww = 0; ww < 8; ++ww) s += PLG[(ww * 16 + r) * 64 + l];
            const int e = (r & 3) + 8 * (r >> 2) + 4 * (l >> 5), t = l & 31;
            LG[t * 33 + e] = s * RSTD[t] + br[e]; }
        __syncthreads();
        if (C.tid < 32) { const int t = C.tid, m = m0 + t; float v[32];
#pragma unroll
            for (int e = 0; e < 32; ++e) v[e] = LG[t * 33 + e];
            float tv[4]; int ti[4];
#pragma unroll
            for (int k = 0; k < 4; ++k) { float best = -INFINITY; int bi = 0;
#pragma unroll
                for (int e = 0; e < 32; ++e) { const bool tk = v[e] > best; best = tk ? v[e] : best; bi = tk ? e : bi; }
                tv[k] = best; ti[k] = bi;
#pragma unroll
                for (int e = 0; e < 32; ++e) v[e] = (e == bi) ? -INFINITY : v[e]; }
            const float e1 = __expf(tv[1] - tv[0]), e2 = __expf(tv[2] - tv[0]), e3 = __expf(tv[3] - tv[0]); const float inv = 1.f / (1.f + e1 + e2 + e3);
            const float wv[4] = {inv, e1 * inv, e2 * inv, e3 * inv};
#pragma unroll
            for (int k = 0; k < 4; ++k) { TOPE[m * 4 + k] = ti[k]; SLOT[m * 4 + k] = __hip_atomic_fetch_add(lcnt + ti[k], 1, __ATOMIC_RELAXED, __HIP_MEMORY_SCOPE_WORKGROUP); WTS[m * 4 + k] = wv[k]; } }
#pragma unroll
        for (int it = 0; it < 4; ++it) { const int t = 4 * w + it, m = m0 + t; const float rs = RSTD[t];
            const f32x4* xr = (const f32x4*)(x1 + (size_t)m * D) + lane;
#pragma unroll
            for (int j = 0; j < 8; ++j) { const f32x4 v = xr[64 * j]; const f32x4 g = *((const f32x4*)g2 + lane + 64 * j);
                int o = 0; o = __builtin_amdgcn_cvt_pk_fp8_f32(v.x * rs * g.x, v.y * rs * g.y, o, false); o = __builtin_amdgcn_cvt_pk_fp8_f32(v.z * rs * g.z, v.w * rs * g.w, o, true);
                *((int*)(H2 + (size_t)m * D) + lane + 64 * j) = o; } }
    }
    __syncthreads();
    if (C.tid < NE) cnt[C.vcu * NE + C.tid] = lcnt[C.tid];
}
__device__ __forceinline__ size_t xg_off(int row, int lane) { return (size_t)(row >> 8) * (256 * D) + (size_t)(lane >> 3) * 32768 + (size_t)(row & 255) * 128 + (size_t)(lane & 7) * 16; }
__device__ __forceinline__ void p9_gather(const Ctx& C, const Args& a) {
    const unsigned char* H2 = a.ws + WS_H2; const int* wgcnt = (const int*)(a.ws + WS_CTL) + CW_WGCNT; int* cnt = (int*)(a.ws + WS_CTL) + CW_CNT;
    const int* TOPE = (const int*)(a.ws + WS_RT); const int* SLOT = TOPE + T * 4; int* DEST = (int*)(a.ws + WS_RT) + 3 * T * 4; unsigned char* XG = a.ws + WS_XG;
    const int gw = C.vcu * NWAVES + C.wave, NGW = C.G * NWAVES, lane = C.lane;
    int mycnt = 0, mybase = 0;
#pragma unroll 8
    for (int w = 0; w < C.G; ++w) { const int v = wgcnt[w * NE + (lane & 31)]; mycnt += v; mybase += (w < C.vcu) ? v : 0; }
    if (lane >= NE) { mycnt = 0; mybase = 0; }
    int tiles = (mycnt + PADM - 1) / PADM, inc = tiles;
#pragma unroll
    for (int o = 1; o < 32; o <<= 1) { const int t = __shfl_up(inc, o); if (lane >= o) inc += t; }
    const int startrow = (inc - tiles) * PADM;
    if (gw == 0 && lane < NE) cnt[lane] = mycnt;
    for (int m0 = C.vcu * 32; m0 < T; m0 += C.G * 32) for (int it = 0; it < 4; ++it) { const int t = m0 + 4 * C.wave + it;
#pragma unroll
        for (int k = 0; k < 4; ++k) { const int q = t * 4 + k, e = TOPE[q]; const int row = __shfl(startrow, e) + __shfl(mybase, e) + SLOT[q];
            if (lane == 0) DEST[q] = row;
            const v4u* src = (const v4u*)(H2 + (size_t)t * D) + lane; unsigned char* dst = XG + xg_off(row, lane);
            *(v4u*)dst = src[0]; *(v4u*)(dst + 8 * 32768) = src[64]; } }
    for (int p = gw; p < NE * PADM; p += NGW) { const int e = p / PADM, qq = p % PADM; const int c = __shfl(mycnt, e), st = __shfl(startrow, e), tl = __shfl(tiles, e);
        if (c + qq < tl * PADM) { unsigned char* dst = XG + xg_off(st + c + qq, lane); const v4u z = {0u, 0u, 0u, 0u}; *(v4u*)dst = z; *(v4u*)(dst + 8 * 32768) = z; } }
}
__device__ __forceinline__ void p12_combine(const Ctx& C, const Args& a) {
    const bf16* Y = (const bf16*)(a.ws + WS_Y); const float* WTS = (const float*)(a.ws + WS_RT) + 2 * T * 4; const int* DEST = (const int*)(a.ws + WS_RT) + 3 * T * 4; float* out = a.out;
    const int gw = C.vcu * NWAVES + C.wave, NGW = C.G * NWAVES, lane = C.lane;
    for (int m = gw; m < T; m += NGW) { int d[4]; float wv[4];
#pragma unroll
        for (int k = 0; k < 4; ++k) { d[k] = DEST[m * 4 + k]; wv[k] = WTS[m * 4 + k]; }
#pragma unroll
        for (int j = 0; j < 8; ++j) { f32x4 o = *((const f32x4*)(out + (size_t)m * D) + lane + 64 * j);
#pragma unroll
            for (int k = 0; k < 4; ++k) { const int y = *((const int*)((const unsigned char*)Y + (size_t)d[k] * D) + lane + 64 * j);
                o.x += wv[k] * __builtin_amdgcn_cvt_f32_fp8(y, 0); o.y += wv[k] * __builtin_amdgcn_cvt_f32_fp8(y, 1); o.z += wv[k] * __builtin_amdgcn_cvt_f32_fp8(y, 2); o.w += wv[k] * __builtin_amdgcn_cvt_f32_fp8(y, 3); }
            *((f32x4*)(out + (size_t)m * D) + lane + 64 * j) = o; } }
}

constexpr int N_PHASES = 14;
__global__ void __launch_bounds__(NTHR, 2) mega_fwd(Args args) {
    extern __shared__ __attribute__((aligned(16))) unsigned char lds_raw[];
    Ctx C; C.lds = (LAS unsigned char*)lds_raw; C.tid = threadIdx.x; C.lane = C.tid & 63; C.wave = __builtin_amdgcn_readfirstlane(C.tid >> 6);
    C.G = gridDim.x; { const int bx = blockIdx.x; C.vcu = (C.G % 8 == 0) ? (bx % 8) * (C.G / 8) + bx / 8 : bx; }
    volatile LAS unsigned* MISC = (volatile LAS unsigned*)(C.lds + MISC_OFF);
    if (C.tid < 32) MISC[C.tid] = 0u;
    __syncthreads();
    unsigned* ctl = (unsigned*)(args.ws + WS_CTL);
    XcdBarrier bar = xcd_barrier_post(ctl + CW_BAR, MISC + 8);
    const int lo = args.ph_lo, hi = args.ph_hi;
#ifndef ONLY_MASK
#define ONLY_MASK 0xFFFF
#endif
#define IN(k) (((ONLY_MASK >> (k)) & 1) && lo <= (k) && (k) < hi)
#ifndef DBL_MASK
#define DBL_MASK 0
#endif
#define REP(k) for (int rep_ = 0; rep_ < (((DBL_MASK >> (k)) & 1) ? 2 : 1); ++rep_, (((DBL_MASK >> (k)) & 1) && rep_ == 1 ? xcd_barrier(bar) : (void)0))
#define SEAM(k) do { if (IN(k) && IN((k) + 1)) xcd_barrier(bar); } while (0)
    if (IN(0)) REP(0) { p0_transposes(C, args); p0_rope(C, args); p0_router_w(C, args); p0_xn_gates(C, args); }
    SEAM(0);
    if (IN(1)) REP(1) { p2_mstats(C, args);
        { pg8::Gemm g{(const bf16*)(args.ws + WS_XN), (const bf16*)(args.ws + WS_WIN), T, 6144, D}; pg8::StaticOrder So; So.init(T, 6144, C.G, (int)blockIdx.x);
          EpiProj<false> E{(bf16*)(args.ws + WS_PROJ), nullptr}; pg8::gemm_phase<EpiProj<false>, pg8::StaticOrder, true, true>(C.lds, g, So, E); }
        __syncthreads();
        { pg8::Gemm g{(const bf16*)(args.ws + WS_XN8), (const bf16*)(args.ws + WS_WIN8), T, 4096, D / 2}; pg8::StaticOrder So; So.init(T, 4096, C.G, (int)blockIdx.x);
          EpiProj<true> E{(bf16*)(args.ws + WS_PROJ), args.ws + WS_G8}; pg8::gemm_phase<EpiProj<true>, pg8::StaticOrder, true, true, true>(C.lds, g, So, E); } }
    SEAM(1);
    if (IN(2)) REP(2) { p2_late_transposes(C, args); p2_qkprep(C, args); }
    if (!(IN(2) && IN(3))) SEAM(2);
    if (IN(3)) REP(3) { for (int u = C.vcu; u < 512; u += C.G) mlA_unit(C, u, args); }
    SEAM(3);
    if (IN(4)) REP(4) { mlB_scan(C, args); }
    SEAM(4);
    if (IN(5)) REP(5) { for (int u = C.vcu; u < 512; u += C.G) mlC_unit(C, u, args); }
    if (IN(6)) REP(6) {
        const float* lp = args.in[8]; const float sa = wave_sum(lp[C.lane] * lp[64 + C.lane]), sb = wave_sum(lp[128 + C.lane] * lp[192 + C.lane]);
        const float lam = __expf(sa) - __expf(sb) + LAM_INIT;
        Conv cv; conv_begin(cv, args, C.vcu * NWAVES + C.wave, C.G * NWAVES, C.lane);
        int lam_s = __builtin_amdgcn_readfirstlane(__float_as_int(lam)); asm volatile("" : "+s"(lam_s));
        { int uidx = 0; for (int u = C.vcu; u < 512; u += C.G, ++uidx) attn_unit(C, u, uidx, args, lam_s, cv); }
        asm volatile("s_waitcnt lgkmcnt(0)" ::: "memory"); __builtin_amdgcn_s_barrier(); asm volatile("" ::: "memory");
        int ln2 = (int)__builtin_amdgcn_mbcnt_hi(~0u, __builtin_amdgcn_mbcnt_lo(~0u, 0u)); asm volatile("" : "+v"(ln2));
        while (cv.it < CV_NJ) { conv_issue_next(cv, cv.s[1], args, C.G * NWAVES, ln2); (void)conv_consume<8>(cv, cv.s[0], args, C.lds + AT_CV + C.wave * 8448, C.G * NWAVES, ln2);
            conv_issue_next(cv, cv.s[0], args, C.G * NWAVES, ln2); (void)conv_consume<8>(cv, cv.s[1], args, C.lds + AT_CV + C.wave * 8448, C.G * NWAVES, ln2); }
        asm volatile("s_waitcnt vmcnt(0)" ::: "memory");
    }
    SEAM(6);
    if (IN(7)) REP(7) { __syncthreads();
        pg8::StaticOrder So; So.init(T, D, C.G, (int)blockIdx.x);
        if (So.nwg % C.G == 0) {
            static_assert(WS_OD - WS_HM == (size_t)T * MLW * 2 && WS_WDA - WS_WML == (size_t)D * MLW * 2 && MLW == DAW, "pair stream: operands of the two products must be adjacent");
            pg8::Gemm g{(const bf16*)(args.ws + WS_HM), (const bf16*)(args.ws + WS_WML), 2 * T, D, MLW}; PairOrder Po{So};
            EpiGatePair E{(const bf16*)(args.ws + WS_G8), (bf16*)(args.ws + WS_T1), (bf16*)(args.ws + WS_MIX)}; pg8::gemm_phase<EpiGatePair, PairOrder, true, true>(C.lds, g, Po, E);
        } else {
        { pg8::Gemm g{(const bf16*)(args.ws + WS_HM), (const bf16*)(args.ws + WS_WML), T, D, MLW};
          EpiGate<0> E{(const bf16*)(args.ws + WS_G8), nullptr, (bf16*)(args.ws + WS_T1)}; pg8::gemm_phase<EpiGate<0>, pg8::StaticOrder, true, true>(C.lds, g, So, E); }
        __syncthreads();
        { pg8::Gemm g{(const bf16*)(args.ws + WS_OD), (const bf16*)(args.ws + WS_WDA), T, D, DAW};
          EpiGate<1> E{(const bf16*)(args.ws + WS_G8), (const bf16*)(args.ws + WS_T1), (bf16*)(args.ws + WS_MIX)}; pg8::gemm_phase<EpiGate<1>, pg8::StaticOrder, true, true>(C.lds, g, So, E); }
        }
    }
    SEAM(7);
    if (IN(8)) REP(8) { pg8::Gemm g{(const bf16*)(args.ws + WS_MIX), (const bf16*)(args.ws + WS_WO), T, D, D}; pg8::StaticOrder So; So.init(T, D, C.G, (int)blockIdx.x);
        EpiRes E{args.in[0], args.out}; pg8::gemm_phase<EpiRes, pg8::StaticOrder, true, true>(C.lds, g, So, E); }
    SEAM(8);
    if (IN(9)) REP(9) { p8_router(C, args); }
    SEAM(9);
    if (IN(10)) REP(10) { p9_gather(C, args); }
    SEAM(10);
    if (IN(11)) REP(11) { MoeSched Ms; Ms.init((const int*)(args.ws + WS_CTL) + CW_CNT, 16, C.G, (int)blockIdx.x, C.lane);
        pg8::Gemm g{(const bf16*)(args.ws + WS_XG), (const bf16*)(args.ws + WS_WGU), MAXROWS, 2 * DE, D / 2};
        EpiAct E{args.in[16], args.ws + WS_ACT}; pg8::gemm_phase<EpiAct, MoeSched, true, true, true, 3>(C.lds, g, Ms, E); }
    SEAM(11);
    if (IN(12)) REP(12) { MoeSched Ms; Ms.init((const int*)(args.ws + WS_CTL) + CW_CNT, 8, C.G, (int)blockIdx.x, C.lane);
        pg8::Gemm g{(const bf16*)(args.ws + WS_ACT), (const bf16*)(args.ws + WS_WDN), MAXROWS, D, DE / 2};
        EpiY E{args.in[18], (bf16*)(args.ws + WS_Y)}; pg8::gemm_phase<EpiY, MoeSched, true, true, true, 3>(C.lds, g, Ms, E); }
    SEAM(12);
    if (IN(13)) REP(13) { p12_combine(C, args); }
#undef IN
#undef SEAM
}
#ifdef DEV_NAIVE
constexpr size_t NV_XN32 = WS_NAIVE, NV_PROJ32 = NV_XN32 + 64 * MiB, NV_F = NV_PROJ32 + 322 * MiB, NV_HF = NV_F + 1 * MiB, NV_OD32 = NV_HF + 64 * MiB, NV_MIX32 = NV_OD32 + 32 * MiB, NV_END = NV_MIX32 + 64 * MiB;
__device__ __forceinline__ float ldf(const float* p) { return *p; }
__device__ __forceinline__ float ldf(const bf16* p) { return bf2f(*p); }
__global__ __launch_bounds__(256) void k_rmsnorm(const float* __restrict__ x, const float* __restrict__ g, float* __restrict__ y) {
    const int row = blockIdx.x * 4 + (threadIdx.x >> 6), lane = threadIdx.x & 63;
    const float* xr = x + (size_t)row * D; float v[32]; float s = 0.f;
#pragma unroll
    for (int j = 0; j < 32; ++j) { v[j] = xr[lane + 64 * j]; s += v[j] * v[j]; }
    s = wave_sum(s); const float r = rsqrtf(s * (1.f / D) + EPS);
#pragma unroll
    for (int j = 0; j < 32; ++j) y[(size_t)row * D + lane + 64 * j] = v[j] * r * g[lane + 64 * j];
}
struct GArgs { const void* A; const float* B; void* C; int M, N, K, lda, ldb, ldc; const void* aux0; const void* aux1; const int* cnt; };
template <int EPI, typename TA> __global__ __launch_bounds__(256) void k_gemm(GArgs g) {
    __shared__ float As[16][64 + 4], Bs[16][64 + 4];
    const int tx = threadIdx.x & 15, ty = threadIdx.x >> 4;
    int m0 = blockIdx.y * 64, n0 = blockIdx.x * 64;
    const TA* A = (const TA*)g.A; const float* Bp = g.B; int M = g.M; int rowbase = 0; int e = 0;
    if (EPI == 4 || EPI == 5) {
        e = blockIdx.z; int start = 0;
        for (int i = 0; i < e; ++i) start += (g.cnt[i] + PADM - 1) / PADM * PADM;
        const int c = g.cnt[e]; if (m0 >= c) return;
        M = (c + PADM - 1) / PADM * PADM; rowbase = start;
        A = (const TA*)g.A + (size_t)rowbase * g.lda; Bp = g.B + (size_t)e * g.K * g.ldb;
    }
    float acc[4][4] = {};
    for (int k0 = 0; k0 < g.K; k0 += 16) {
        for (int i = threadIdx.x; i < 64 * 16; i += 256) { const int mm = i >> 4, kk = i & 15; const int m = m0 + mm; As[kk][mm] = (m < M) ? ldf(A + (size_t)m * g.lda + k0 + kk) : 0.f; }
        for (int i = threadIdx.x; i < 16 * 64; i += 256) { const int kk = i >> 6, nn = i & 63; const int n = n0 + nn; Bs[kk][nn] = (n < g.N) ? Bp[(size_t)(k0 + kk) * g.ldb + n] : 0.f; }
        __syncthreads();
#pragma unroll
        for (int kk = 0; kk < 16; ++kk) {
            float a[4], b[4];
#pragma unroll
            for (int i = 0; i < 4; ++i) { a[i] = As[kk][ty * 4 + i]; b[i] = Bs[kk][tx * 4 + i]; }
#pragma unroll
            for (int i = 0; i < 4; ++i)
#pragma unroll
                for (int j = 0; j < 4; ++j) acc[i][j] += a[i] * b[j];
        }
        __syncthreads();
    }
#pragma unroll
    for (int i = 0; i < 4; ++i) {
        const int m = m0 + ty * 4 + i; if (m >= M) continue;
        if (EPI == 4) {
            const float* bias = (const float*)g.aux0 + (size_t)e * g.N;
#pragma unroll
            for (int j = 0; j < 4; j += 2) {
                const int n = n0 + tx * 4 + j;
                float glu = acc[i][j] + bias[n], lin = acc[i][j + 1] + bias[n + 1];
                glu = fminf(glu, 7.f); lin = fminf(fmaxf(lin, -7.f), 7.f);
                ((bf16*)g.C)[(size_t)(rowbase + m) * g.ldc + (n >> 1)] = f2bf(glu * sigmoidf_(1.702f * glu) * (lin + 1.f));
            }
        } else {
#pragma unroll
            for (int j = 0; j < 4; ++j) {
                const int n = n0 + tx * 4 + j; if (n >= g.N) continue;
                const float v = acc[i][j];
                if (EPI == 0) ((float*)g.C)[(size_t)m * g.ldc + n] = v;
                if (EPI == 1) ((float*)g.C)[(size_t)m * g.ldc + n] = bf2f(((const bf16*)g.aux0)[(size_t)m * NPJ + P_GM + n]) * v;
                if (EPI == 2) ((float*)g.C)[(size_t)m * g.ldc + n] += bf2f(((const bf16*)g.aux0)[(size_t)m * NPJ + P_GD + n]) * v;
                if (EPI == 3) ((float*)g.C)[(size_t)m * g.ldc + n] = ((const float*)g.aux0)[(size_t)m * g.ldc + n] + v;
                if (EPI == 5) ((bf16*)g.C)[(size_t)(rowbase + m) * g.ldc + n] = f2bf(v + ((const float*)g.aux0)[(size_t)e * g.N + n]);
            }
        }
    }
}
__global__ __launch_bounds__(256) void k_pack(const float* __restrict__ P32, const float* __restrict__ gbias, bf16* __restrict__ PROJ, float* __restrict__ MG) {
    const int t = blockIdx.x;
    for (int c = threadIdx.x; c < NPJ; c += 256) { const int src = c < G_OFF ? c : c + 16; float v = P32[(size_t)t * DIN + src];
        if (c >= P_MK && c < P_MV) v *= KSCALE;
        if ((c >= P_MO && c < P_DQ) || c >= P_GM) v = sigmoidf_(v);
        PROJ[(size_t)t * NPJ + c] = f2bf(v); }
    if (threadIdx.x < 16) MG[(size_t)t * 16 + threadIdx.x] = P32[(size_t)t * DIN + G_OFF + threadIdx.x] + gbias[threadIdx.x];
}
__global__ __launch_bounds__(256) void k_rope(float* __restrict__ ROPE) {
    const int g = blockIdx.x * 256 + threadIdx.x; const int pos = g >> 5, i = g & 31;
    const double inv = exp2(-(double)i * (13.287712379549449 / 32.0));
    const float ang = (float)pos * (float)inv;
    ROPE[2 * g] = cosf(ang); ROPE[2 * g + 1] = sinf(ang);
}
__global__ __launch_bounds__(256) void k_qkprep(const bf16* __restrict__ PROJ, const float* __restrict__ ROPE, const float* __restrict__ qg, const float* __restrict__ kg, bf16* __restrict__ QN, bf16* __restrict__ KN) {
    const int t = blockIdx.x * 4 + (threadIdx.x >> 6), lane = threadIdx.x & 63;
    const int pos = t % S, g = lane >> 2, sub = lane & 3;
    for (int which = 0; which < 2; ++which) {
        const bf16* src = PROJ + (size_t)t * NPJ + (which ? P_DK : P_DQ) + g * 64;
        const float* gn = which ? kg : qg; bf16* dst = (which ? KN : QN) + (size_t)t * 1024 + g * 64;
        float x1[8], x2[8]; float ss = 0.f;
#pragma unroll
        for (int i = 0; i < 8; ++i) { x1[i] = bf2f(src[sub * 8 + i]); x2[i] = bf2f(src[32 + sub * 8 + i]); ss += x1[i] * x1[i] + x2[i] * x2[i]; }
        ss += __shfl_xor(ss, 1); ss += __shfl_xor(ss, 2);
        const float r = rsqrtf(ss * (1.f / 64.f) + EPS) * (which ? 1.f : QSCALE);
#pragma unroll
        for (int i = 0; i < 8; ++i) {
            const int fi = sub * 8 + i; const float c = ROPE[((size_t)pos * 32 + fi) * 2], s = ROPE[((size_t)pos * 32 + fi) * 2 + 1];
            const float a = x1[i] * r * gn[fi], b = x2[i] * r * gn[32 + fi];
            dst[fi] = f2bf(a * c - b * s); dst[32 + fi] = f2bf(b * c + a * s);
        }
    }
}
__global__ void k_mlF(const float* __restrict__ MG, float* __restrict__ F) {
    const int chain = threadIdx.x; if (chain >= 16) return;
    const int dir = chain & 1, h = (chain >> 1) & 3, b = chain >> 3;
    const int col = (dir ? 12 : 4) + h; float acc = 0.f;
    if (!dir) { for (int p = 0; p < S; ++p) { acc += logsigf_(MG[(size_t)(b * S + p) * 16 + col]); F[chain * S + p] = acc; } }
    else      { for (int p = S - 1; p >= 0; --p) { acc += logsigf_(MG[(size_t)(b * S + p) * 16 + col]); F[chain * S + p] = acc; } }
}
__global__ __launch_bounds__(256) void k_mlquad(const bf16* __restrict__ PROJ, const float* __restrict__ MG, const float* __restrict__ F, float* __restrict__ HF) {
    __shared__ float qs[16][128 + 1], ks[64][128 + 1], sc[16][64 + 1], rs[16];
    const int chain = blockIdx.y, dir = chain & 1, h = (chain >> 1) & 3, b = chain >> 3;
    const int t0 = blockIdx.x * 16, tid = threadIdx.x; const int icol = (dir ? 8 : 0) + h;
    for (int i = tid; i < 16 * 128; i += 256) { const int tt = i >> 7, kk = i & 127; qs[tt][kk] = bf2f(PROJ[(size_t)(b * S + t0 + tt) * NPJ + P_MQ + h * 128 + kk]); }
    float acc[16];
#pragma unroll
    for (int i = 0; i < 16; ++i) acc[i] = 0.f;
    if (tid < 16) rs[tid] = 0.f;
    const int sbeg = dir ? (t0 / 64) * 64 : 0, send = dir ? S : (t0 + 16 + 63) / 64 * 64;
    for (int s0 = sbeg; s0 < send; s0 += 64) {
        __syncthreads();
        for (int i = tid; i < 64 * 128; i += 256) { const int ss = i >> 7, kk = i & 127; ks[ss][kk] = bf2f(PROJ[(size_t)(b * S + s0 + ss) * NPJ + P_MK + h * 128 + kk]); }
        __syncthreads();
        for (int i = tid; i < 1024; i += 256) {
            const int tt = i >> 6, ss = i & 63; const int t = t0 + tt, s = s0 + ss; float v = 0.f;
            const bool ok = dir ? (s >= t) : (s <= t);
            if (ok) { float d = 0.f; for (int kk = 0; kk < 128; ++kk) d += qs[tt][kk] * ks[ss][kk];
                v = d * __expf(F[chain * S + t] - F[chain * S + s] + MG[(size_t)(b * S + s) * 16 + icol]); }
            sc[tt][ss] = v;
        }
        __syncthreads();
        if (tid < 16) { float r = 0.f; for (int ss = 0; ss < 64; ++ss) r += sc[tid][ss]; rs[tid] += r; }
        for (int ss = 0; ss < 64; ++ss) { const float vv = bf2f(PROJ[(size_t)(b * S + s0 + ss) * NPJ + P_MV + h * 256 + tid]);
#pragma unroll
            for (int tt = 0; tt < 16; ++tt) acc[tt] += sc[tt][ss] * vv; }
    }
    __syncthreads();
#pragma unroll
    for (int tt = 0; tt < 16; ++tt) HF[((size_t)dir * T + (b * S + t0 + tt)) * 1024 + h * 256 + tid] = acc[tt] / fmaxf(fabsf(rs[tt]), 1.f);
}
__global__ __launch_bounds__(256) void k_mlpost(const float* __restrict__ HF, const bf16* __restrict__ PROJ, const float* __restrict__ g, bf16* __restrict__ HM) {
    const int w = blockIdx.x * 4 + (threadIdx.x >> 6), lane = threadIdx.x & 63; const int t = w >> 2, h = w & 3;
    float v[4]; float ss = 0.f;
#pragma unroll
    for (int j = 0; j < 4; ++j) { const int c = h * 256 + lane + 64 * j; v[j] = HF[(size_t)t * 1024 + c] + HF[((size_t)T + t) * 1024 + c]; ss += v[j] * v[j]; }
    ss = wave_sum(ss); const float r = rsqrtf(ss * (1.f / 256.f) + EPS);
#pragma unroll
    for (int j = 0; j < 4; ++j) { const int c = h * 256 + lane + 64 * j; HM[(size_t)t * 1024 + c] = f2bf(v[j] * r * g[lane + 64 * j] * bf2f(PROJ[(size_t)t * NPJ + P_MO + c])); }
}
__global__ __launch_bounds__(256) void k_attn(const bf16* __restrict__ QN, const bf16* __restrict__ KN, const bf16* __restrict__ PROJ, const float* __restrict__ lamp, float* __restrict__ OD32) {
    __shared__ float qs[2][16][64 + 1], ks[2][64][64 + 1], sc[2][16][64 + 1], ls[2][16];
    const int bh = blockIdx.y, b = bh >> 3, h = bh & 7, t0 = blockIdx.x * 16, tid = threadIdx.x;
    const int v = tid & 127, mp = tid >> 7;
    for (int i = tid; i < 2 * 16 * 64; i += 256) { const int m = i >> 10, tt = (i >> 6) & 15, dd = i & 63; qs[m][tt][dd] = bf2f(QN[(size_t)(b * S + t0 + tt) * 1024 + h * 128 + m * 64 + dd]); }
    if (tid < 32) ls[tid >> 4][tid & 15] = 0.f;
    float acc[16];
#pragma unroll
    for (int i = 0; i < 16; ++i) acc[i] = 0.f;
    for (int s0 = 0; s0 < S; s0 += 64) {
        __syncthreads();
        for (int i = tid; i < 2 * 64 * 64; i += 256) { const int m = i >> 12, ss = (i >> 6) & 63, dd = i & 63; ks[m][ss][dd] = bf2f(KN[(size_t)(b * S + s0 + ss) * 1024 + h * 128 + m * 64 + dd]); }
        __syncthreads();
        for (int i = tid; i < 2 * 16 * 64; i += 256) { const int m = i >> 10, tt = (i >> 6) & 15, ss = i & 63; float d = 0.f;
            for (int dd = 0; dd < 64; ++dd) d += qs[m][tt][dd] * ks[m][ss][dd];
            sc[m][tt][ss] = exp2f(d); }
        __syncthreads();
        if (tid < 32) { const int m = tid >> 4, tt = tid & 15; float r = 0.f; for (int ss = 0; ss < 64; ++ss) r += sc[m][tt][ss]; ls[m][tt] += r; }
        for (int ss = 0; ss < 64; ++ss) { const float vv = bf2f(PROJ[(size_t)(b * S + s0 + ss) * NPJ + P_DV + h * 128 + v]);
#pragma unroll
            for (int tt = 0; tt < 16; ++tt) acc[tt] += sc[mp][tt][ss] * vv; }
    }
    __syncthreads();
    float s01 = 0.f, s23 = 0.f;
    for (int i = 0; i < 64; ++i) { s01 += lamp[i] * lamp[64 + i]; s23 += lamp[128 + i] * lamp[192 + i]; }
    const float lam = __expf(s01) - __expf(s23) + LAM_INIT;
    float* ob = &ks[0][0][0];
    if (mp == 1) { for (int tt = 0; tt < 16; ++tt) ob[tt * 128 + v] = acc[tt] / ls[1][tt]; }
    __syncthreads();
    if (mp == 0) { for (int tt = 0; tt < 16; ++tt) OD32[(size_t)(b * S + t0 + tt) * 1024 + h * 128 + v] = acc[tt] / ls[0][tt] - lam * ob[tt * 128 + v]; }
}
__global__ __launch_bounds__(256) void k_dapost(const float* __restrict__ OD32, const float* __restrict__ g, bf16* __restrict__ OD) {
    const int w = blockIdx.x * 4 + (threadIdx.x >> 6), lane = threadIdx.x & 63; const int t = w >> 3, h = w & 7;
    float v[2]; float ss = 0.f;
#pragma unroll
    for (int j = 0; j < 2; ++j) { v[j] = OD32[(size_t)t * 1024 + h * 128 + lane + 64 * j]; ss += v[j] * v[j]; }
    ss = wave_sum(ss); const float r = rsqrtf(ss * (1.f / 128.f) + EPS);
#pragma unroll
    for (int j = 0; j < 2; ++j) OD[(size_t)t * 1024 + h * 128 + lane + 64 * j] = f2bf(v[j] * r * g[lane + 64 * j] * (1.f - LAM_INIT));
}
__global__ __launch_bounds__(256) void k_route1(const float* __restrict__ x1, const float* __restrict__ g2, const float* __restrict__ wr, const float* __restrict__ br,
                                                bf16* __restrict__ H2, int* __restrict__ cnt, int* __restrict__ TOPE, int* __restrict__ SLOT, float* __restrict__ WTS) {
    const int t = blockIdx.x * 4 + (threadIdx.x >> 6), lane = threadIdx.x & 63;
    const float* xr = x1 + (size_t)t * D; float v[32]; float s = 0.f;
#pragma unroll
    for (int j = 0; j < 32; ++j) { v[j] = xr[lane + 64 * j]; s += v[j] * v[j]; }
    s = wave_sum(s); const float r = rsqrtf(s * (1.f / D) + EPS);
#pragma unroll
    for (int j = 0; j < 32; ++j) { v[j] = v[j] * r * g2[lane + 64 * j]; H2[(size_t)t * D + lane + 64 * j] = f2bf(v[j]); }
    float mylogit = -INFINITY;
    for (int e = 0; e < NE; ++e) { float p = 0.f;
#pragma unroll
        for (int j = 0; j < 32; ++j) p += v[j] * wr[(size_t)(lane + 64 * j) * NE + e];
        p = wave_sum(p) + br[e]; if (lane == e) mylogit = p; }
    float tv[4]; int ti[4]; float cur = mylogit;
#pragma unroll
    for (int k = 0; k < 4; ++k) { const float m = wave_max(cur); const unsigned long long bal = __ballot(cur == m && lane < NE); const int idx = __ffsll((long long)bal) - 1; tv[k] = m; ti[k] = idx; if (lane == idx) cur = -INFINITY; }
    if (lane == 0) { const float e1 = __expf(tv[1] - tv[0]), e2 = __expf(tv[2] - tv[0]), e3 = __expf(tv[3] - tv[0]); const float inv = 1.f / (1.f + e1 + e2 + e3);
        const float w[4] = {inv, e1 * inv, e2 * inv, e3 * inv};
#pragma unroll
        for (int k = 0; k < 4; ++k) { TOPE[t * 4 + k] = ti[k]; SLOT[t * 4 + k] = atomicAdd(&cnt[ti[k]], 1); WTS[t * 4 + k] = w[k]; } }
}
__global__ __launch_bounds__(256) void k_route2(const bf16* __restrict__ H2, const int* __restrict__ cnt, const int* __restrict__ TOPE, const int* __restrict__ SLOT, int* __restrict__ DEST, bf16* __restrict__ XG) {
    const int a = blockIdx.x * 4 + (threadIdx.x >> 6), lane = threadIdx.x & 63;
    if (a < T * TOPK) { const int t = a >> 2, e = TOPE[a]; int start = 0;
        for (int i = 0; i < e; ++i) start += (cnt[i] + PADM - 1) / PADM * PADM;
        const int row = start + SLOT[a]; if (lane == 0) DEST[a] = row;
        for (int j = 0; j < 32; ++j) XG[(size_t)row * D + lane + 64 * j] = H2[(size_t)t * D + lane + 64 * j];
    } else { const int p = a - T * TOPK; if (p >= NE * PADM) return;
        const int e = p / PADM, q = p % PADM; int start = 0;
        for (int i = 0; i < e; ++i) start += (cnt[i] + PADM - 1) / PADM * PADM;
        const int c = cnt[e], padded = (c + PADM - 1) / PADM * PADM;
        if (c + q < padded) { const int row = start + c + q; for (int j = 0; j < 32; ++j) XG[(size_t)row * D + lane + 64 * j] = 0; } }
}
__global__ __launch_bounds__(256) void k_combine(float* __restrict__ out, const bf16* __restrict__ Y, const int* __restrict__ DEST, const float* __restrict__ WTS) {
    const int t = blockIdx.x * 4 + (threadIdx.x >> 6), lane = threadIdx.x & 63; int d[4]; float w[4];
#pragma unroll
    for (int k = 0; k < 4; ++k) { d[k] = DEST[t * 4 + k]; w[k] = WTS[t * 4 + k]; }
    for (int j = 0; j < 32; ++j) { const int c = lane + 64 * j; float a = out[(size_t)t * D + c];
#pragma unroll
        for (int k = 0; k < 4; ++k) a += w[k] * bf2f(Y[(size_t)d[k] * D + c]);
        out[(size_t)t * D + c] = a; }
}
#endif
#ifndef MEGA_MASK
#define MEGA_MASK 0xFF
#endif
static int g_grid = 0;
static void launch_mega(Args a, int lo, int hi, hipStream_t stream) {
    (void)hipMemsetAsync(a.ws + WS_CTL + CW_BAR * 4, 0, XCD_BAR_WORDS * 4, stream);
    a.ph_lo = lo; a.ph_hi = hi;
    hipLaunchKernelGGL(mega_fwd, dim3(g_grid), dim3(NTHR), LDS_BYTES, stream, a);
}
extern "C" void kernel_launch(void* const* d_in, const int* in_sizes, int n_in, void* d_out, int out_size, void* d_ws, size_t ws_size, hipStream_t stream) {
    if (g_grid == 0) {
        int dev = 0, cus = 0;
        if (n_in != 19 || out_size != T * D || hipGetDevice(&dev) != hipSuccess || hipDeviceGetAttribute(&cus, hipDeviceAttributeMultiprocessorCount, dev) != hipSuccess) { g_grid = -1; return; }
        if (hipFuncSetAttribute((const void*)mega_fwd, hipFuncAttributeMaxDynamicSharedMemorySize, LDS_BYTES) != hipSuccess) { g_grid = -1; return; }
        int per_cu = 0; (void)hipOccupancyMaxActiveBlocksPerMultiprocessor(&per_cu, (const void*)mega_fwd, NTHR, LDS_BYTES); (void)hipGetLastError();
        g_grid = cus;
    }
    if (g_grid < 0) return;
    Args a{};
    for (int i = 0; i < 19; ++i) a.in[i] = (const float*)d_in[i];
    a.out = (float*)d_out; a.ws = (unsigned char*)d_ws;
    (void)hipMemsetAsync(a.ws + WS_CTL, 0, 4096 * 4, stream);
#ifdef DEV_NAIVE
    unsigned char* ws = a.ws; const int mask = MEGA_MASK;
    bf16* PROJ = (bf16*)(ws + WS_PROJ); float* MG = (float*)(ws + WS_MG); float* ROPE = (float*)(ws + WS_ROPE);
    bf16* QN = (bf16*)(ws + WS_QN); bf16* KN = (bf16*)(ws + WS_KN); bf16* HM = (bf16*)(ws + WS_HM); bf16* OD = (bf16*)(ws + WS_OD);
    bf16* H2 = (bf16*)(ws + WS_H2); bf16* XG = (bf16*)(ws + WS_XG); bf16* ACT = (bf16*)(ws + WS_ACT); bf16* Y = (bf16*)(ws + WS_Y);
    int* cnt = (int*)(ws + WS_CTL) + CW_CNT; int* TOPE = (int*)(ws + WS_RT); int* SLOT = TOPE + T * 4; float* WTS = (float*)(SLOT + T * 4); int* DEST = (int*)(WTS + T * 4);
    float* XN32 = (float*)(ws + NV_XN32); float* PROJ32 = (float*)(ws + NV_PROJ32); float* F = (float*)(ws + NV_F); float* HF = (float*)(ws + NV_HF); float* OD32 = (float*)(ws + NV_OD32); float* MIX32 = (float*)(ws + NV_MIX32);
    const float* x = a.in[0]; float* out = a.out;
    static const int ranges[8][2] = {{0, 2}, {2, 3}, {3, 6}, {6, 7}, {7, 9}, {9, 11}, {11, 13}, {13, 14}};
    for (int s = 0; s < 8; ++s) {
        if (mask & (1 << s)) { int e = s; while (e + 1 < 8 && (mask & (1 << (e + 1)))) ++e; launch_mega(a, ranges[s][0], ranges[e][1], stream); s = e; continue; }
        switch (s) {
        case 0: { k_rmsnorm<<<T / 4, 256, 0, stream>>>(x, a.in[1], XN32);
            GArgs g{}; g.A = XN32; g.B = a.in[2]; g.C = PROJ32; g.M = T; g.N = DIN; g.K = D; g.lda = D; g.ldb = DIN; g.ldc = DIN;
            k_gemm<0, float><<<dim3((DIN + 63) / 64, T / 64), 256, 0, stream>>>(g);
            k_pack<<<T, 256, 0, stream>>>(PROJ32, a.in[3], PROJ, MG); k_rope<<<S * 32 / 256, 256, 0, stream>>>(ROPE); } break;
        case 1: k_qkprep<<<T / 4, 256, 0, stream>>>(PROJ, ROPE, a.in[6], a.in[7], QN, KN); break;
        case 2: k_mlF<<<1, 64, 0, stream>>>(MG, F); k_mlquad<<<dim3(S / 16, 16), 256, 0, stream>>>(PROJ, MG, F, HF); k_mlpost<<<T, 256, 0, stream>>>(HF, PROJ, a.in[4], HM); break;
        case 3: k_attn<<<dim3(S / 16, 16), 256, 0, stream>>>(QN, KN, PROJ, a.in[8], OD32); k_dapost<<<T * 2, 256, 0, stream>>>(OD32, a.in[9], OD); break;
        case 4: { GArgs g{}; g.A = HM; g.B = a.in[5]; g.C = MIX32; g.M = T; g.N = D; g.K = MLW; g.lda = MLW; g.ldb = D; g.ldc = D; g.aux0 = PROJ;
            k_gemm<1, bf16><<<dim3(D / 64, T / 64), 256, 0, stream>>>(g);
            g.A = OD; g.B = a.in[10]; g.K = DAW; g.lda = DAW; k_gemm<2, bf16><<<dim3(D / 64, T / 64), 256, 0, stream>>>(g);
            GArgs h{}; h.A = MIX32; h.B = a.in[11]; h.C = out; h.M = T; h.N = D; h.K = D; h.lda = D; h.ldb = D; h.ldc = D; h.aux0 = x;
            k_gemm<3, float><<<dim3(D / 64, T / 64), 256, 0, stream>>>(h); } break;
        case 5: k_route1<<<T / 4, 256, 0, stream>>>(out, a.in[12], a.in[13], a.in[14], H2, cnt, TOPE, SLOT, WTS);
            k_route2<<<(T * TOPK + NE * PADM) / 4, 256, 0, stream>>>(H2, cnt, TOPE, SLOT, DEST, XG); break;
        case 6: { GArgs g{}; g.A = XG; g.B = a.in[15]; g.C = ACT; g.N = 2 * DE; g.K = D; g.lda = D; g.ldb = 2 * DE; g.ldc = DE; g.aux0 = a.in[16]; g.cnt = cnt;
            k_gemm<4, bf16><<<dim3(2 * DE / 64, T / 64, NE), 256, 0, stream>>>(g);
            GArgs h{}; h.A = ACT; h.B = a.in[17]; h.C = Y; h.N = D; h.K = DE; h.lda = DE; h.ldb = D; h.ldc = D; h.aux0 = a.in[18]; h.cnt = cnt;
            k_gemm<5, bf16><<<dim3(D / 64, T / 64, NE), 256, 0, stream>>>(h); } break;
        case 7: k_combine<<<T / 4, 256, 0, stream>>>(out, Y, DEST, WTS); break;
        }
    }
#else
    launch_mega(a, 0, N_PHASES, stream);
#endif
}
```

```cpp
#include <hip/hip_runtime.h>
#include <cstdio>
#include <cstdint>
#include <math.h>

constexpr int D = 2048, NB = 2, S = 4096, T = NB * S;
constexpr int MLH = 4, MLDK = 128, MLDV = 256, MLW = 1024, NCH = 64;
constexpr int DAH = 8, DAD = 64, DADV = 128, DAW = 1024;
constexpr int NE = 32, TOPK = 4, DE = 2048;
constexpr int DIN = 10256, NPJ = 10240;
constexpr int G_OFF = 3072;
constexpr int P_MQ = 0, P_MK = 512, P_MV = 1024, P_MO = 2048, P_DQ = 3072, P_DK = 4096, P_DV = 5120, P_GM = 6144, P_GD = 8192;
constexpr float EPS = 1e-6f;
constexpr int PADM = 256;
constexpr int MAXROWS = T * TOPK + NE * PADM;
constexpr float LAM_INIT = 0.2f;
constexpr float QSCALE = 0.125f * 1.4426950408889634f;
constexpr float KSCALE = 0.08838834764831845f;

constexpr size_t MiB = 1ull << 20;
constexpr size_t WS_CTL = 0, CTL_ZERO_BYTES = 1 * MiB;
constexpr size_t WS_MSC = 1 * MiB;
constexpr size_t WS_RT = 2 * MiB;
constexpr size_t WS_ROPE = 3 * MiB;
constexpr size_t WS_MG = 4 * MiB;
constexpr size_t WS_NU = 5 * MiB;
constexpr size_t WS_NP = 6 * MiB;
constexpr size_t WS_WRH = 7 * MiB, WS_WRL = 7 * MiB + 256 * 1024;
constexpr size_t WS_WIN = 8 * MiB;
constexpr size_t WS_WIN8 = 32 * MiB;
constexpr size_t WS_WML = 48 * MiB;
constexpr size_t WS_WDA = 52 * MiB;
constexpr size_t WS_WO = 56 * MiB;
constexpr size_t WS_WGU = 64 * MiB;
constexpr size_t WS_WDN = 576 * MiB;
constexpr size_t WS_XN = 832 * MiB;
constexpr size_t WS_PROJ = 864 * MiB;
constexpr size_t WS_QN = 1024 * MiB;
constexpr size_t WS_KN = 1040 * MiB;
constexpr size_t WS_U = 1056 * MiB;
constexpr size_t WS_CP = 1184 * MiB;
constexpr size_t WS_HM = 1248 * MiB;
constexpr size_t WS_OD = 1264 * MiB;
constexpr size_t WS_XN8 = 1280 * MiB;
constexpr size_t WS_T1 = 1280 * MiB;
constexpr size_t WS_MIX = 1312 * MiB;
constexpr size_t WS_H2 = 1344 * MiB;
constexpr size_t WS_XG = 1376 * MiB;
constexpr size_t WS_ACT = 1536 * MiB;
constexpr size_t WS_Y = 1696 * MiB;
constexpr size_t WS_G8 = 1856 * MiB;
constexpr size_t WS_NAIVE = 1920 * MiB;
constexpr size_t WS_END = 2500 * MiB;
constexpr int CW_CNT = 64;
constexpr int CW_BAR = 4096;
constexpr int CW_WGCNT = 8192;

typedef unsigned short bf16;
typedef unsigned v4u __attribute__((ext_vector_type(4)));
typedef unsigned v2u __attribute__((ext_vector_type(2)));
typedef float f32x4 __attribute__((ext_vector_type(4)));
typedef float f32x2 __attribute__((ext_vector_type(2)));
typedef float f32x16 __attribute__((ext_vector_type(16)));
typedef short bf16x8 __attribute__((ext_vector_type(8)));
typedef short s16x4 __attribute__((ext_vector_type(4)));
typedef __bf16 bf16x2_t __attribute__((ext_vector_type(2)));
#define GAS __attribute__((address_space(1)))
#define LAS __attribute__((address_space(3)))

__device__ __forceinline__ float bf2f(unsigned v) { return __uint_as_float(v << 16); }
__device__ __forceinline__ float bflo(unsigned w) { return __uint_as_float(w << 16); }
__device__ __forceinline__ float bfhi(unsigned w) { return __uint_as_float(w & 0xffff0000u); }
__device__ __forceinline__ unsigned pk2(float lo, float hi) { f32x2 v = {lo, hi}; bf16x2_t b = __builtin_convertvector(v, bf16x2_t); return __builtin_bit_cast(unsigned, b); }
__device__ __forceinline__ bf16 f2bf(float f) { return (bf16)(pk2(f, 0.f) & 0xffffu); }
__device__ __forceinline__ float sigmoidf_(float x) { return 1.f / (1.f + __expf(-x)); }
__device__ __forceinline__ float logsigf_(float x) { return x >= 0.f ? -log1pf(__expf(-x)) : x - log1pf(__expf(x)); }
__device__ __forceinline__ float wave_sum(float v) {
#pragma unroll
    for (int o = 1; o < 64; o <<= 1) v += __shfl_xor(v, o);
    return v;
}
__device__ __forceinline__ float wave_max(float v) {
#pragma unroll
    for (int o = 1; o < 64; o <<= 1) v = fmaxf(v, __shfl_xor(v, o));
    return v;
}
namespace pg8 {
#define PG8_LAS __attribute__((address_space(3)))
typedef unsigned short bf16_t;
typedef short bf16x8 __attribute__((ext_vector_type(8)));
typedef float f32x4 __attribute__((ext_vector_type(4)));
typedef unsigned u32x4 __attribute__((ext_vector_type(4)));
constexpr int BM = 256, BK = 64, HALF = 128, HTB = HALF * BK * 2  , STAGE_BYTES = 8 * HTB, NXCD = 8, WGM = 8;

__host__ __device__ __forceinline__ int lds_byte(int r, int c) { const int st = (r >> 4) * 2 + (c >> 5), rr = r & 15, cc = c & 31, ob = rr * 64 + cc * 2; return st * 1024 + (ob ^ (((ob >> 9) & 1) << 5)); }
__host__ __device__ __forceinline__ void stage_rc(int b, int& R, int& C) { const int st = b / 1024, sb = b % 1024, swz = sb ^ (((sb >> 9) & 1) << 5); R = (st >> 1) * 16 + swz / 64; C = (st & 1) * 32 + (swz % 64) / 2; }
__host__ __device__ __forceinline__ int perm32(int rho) { const int n = rho >> 4, i = rho & 15; return 8 * (i >> 2) + 4 * n + (i & 3); }

struct Unit { int pm, pn, pb, half; };
struct Gemm { const bf16_t* A; const bf16_t* Bt; int M, N, K; };

struct StaticOrder {
    int nM, nN, nwg, G, c;
    __host__ __device__ void init(int M, int N, int G_, int c_) { nM = M / BM; nN = N / BM; nwg = nM * nN; G = G_; c = c_; }
    __host__ __device__ bool next(int i, Unit& u) const {
        const long L = (long)i * G + c; if (L >= nwg) return false;
        int wgid = (int)L; { const int q = nwg / NXCD, r = nwg % NXCD, xcd = wgid % NXCD, off = wgid / NXCD; wgid = (xcd < r ? xcd * (q + 1) : r * (q + 1) + (xcd - r) * q) + off; }
        const int nig = WGM * nN, gid = wgid / nig, fm = gid * WGM, gsz = (nM - fm) < WGM ? (nM - fm) : WGM;
        u.pm = fm + ((wgid % nig) % gsz); u.pn = (wgid % nig) / gsz; u.pb = u.pn; u.half = 0; return true;
    }
    __device__ __forceinline__ void a_ready(const Unit&) const {}
    __device__ __forceinline__ void done(const Unit&) const {}
    __device__ __forceinline__ int rot() const { return 0; }
};

__device__ __forceinline__ unsigned cvt_pk_bf16(float lo, float hi) { unsigned r; asm volatile("v_cvt_pk_bf16_f32 %0, %1, %2" : "=v"(r) : "v"(lo), "v"(hi)); return r; }
typedef float f32x2 __attribute__((ext_vector_type(2)));
typedef int v8i_t __attribute__((ext_vector_type(8)));
__device__ __forceinline__ const char* pg8_uni(const char* p) { const unsigned long long v = (unsigned long long)p; const unsigned lo = __builtin_amdgcn_readfirstlane((unsigned)v), hi = __builtin_amdgcn_readfirstlane((unsigned)(v >> 32)); return (const char*)(((unsigned long long)hi << 32) | lo); }
template <class Epi, class Sched, bool ALIGN_EPI = false, bool SP2 = false, bool FP8 = false, int BLK = 0>
__device__ __forceinline__ void gemm_phase(PG8_LAS unsigned char* lds, const Gemm g, const Sched& S, const Epi& E) {
    const int tid = threadIdx.x, wid = __builtin_amdgcn_readfirstlane(tid >> 6), lane = tid & 63, wr = wid >> 2, wc = wid & 3, fr = lane & 15, fq = lane >> 4;
    const int K = g.K, nt = K / BK;
    unsigned voffA[2], voffB[2];
#pragma unroll
    for (int i = 0; i < 2; ++i) { int R, C; stage_rc(tid * 16 + i * 8192, R, C); const int Rb = Epi::PERM ? ((R & ~31) + perm32(R & 31)) : R;
        voffA[i] = (unsigned)(R * ((BLK & 1) ? BK : K) + C) * 2u; voffB[i] = (unsigned)(Rb * ((BLK & 2) ? BK : K) + C) * 2u; }
    const size_t kstepA = (BLK & 1) ? (size_t)(2 * HTB) : (size_t)(BK * 2), kstepB = (BLK & 2) ? (size_t)(2 * HTB) : (size_t)(BK * 2);
    const size_t hstepA = (BLK & 1) ? (size_t)HTB : (size_t)HALF * K * 2, hstepB = (BLK & 2) ? (size_t)HTB : (size_t)HALF * K * 2;
    const size_t tstep = (size_t)2 * HALF * K * 2;
    const unsigned ldsb_ = (unsigned)(uintptr_t)lds;
    const unsigned ldsw = (unsigned)wid * 1024u;
    const int aoff = lds_byte(wr * 64 + fr, fq * 8), boff = lds_byte(wc * 32 + fr, fq * 8);
#define PG8_SA(b, h) (((b) * 2 + (h)) * HTB)
#define PG8_SB(b, h) ((4 + (b) * 2 + (h)) * HTB)
#define PG8_STAGE(bufoff, gbase, voff) do { _Pragma("unroll") for (int _i = 0; _i < 2; ++_i) { unsigned keep_; \
        asm volatile("s_mov_b32 %0, m0\n\ts_mov_b32 m0, %3\n\ts_nop 0\n\tglobal_load_lds_dwordx4 %1, %2\n\ts_mov_b32 m0, %0" : "=&s"(keep_) : "v"((voff)[_i]), "s"(pg8_uni((const char*)(gbase))), \
            "s"((unsigned)__builtin_amdgcn_readfirstlane((int)(ldsb_ + (unsigned)(bufoff) + ldsw + (unsigned)(_i * 8192)))) : "memory"); } } while (0)
#define PG8_CAT16(lo, hi) __builtin_bit_cast(v8i_t, __builtin_shufflevector(lo, hi, 0, 1, 2, 3, 4, 5, 6, 7, 8, 9, 10, 11, 12, 13, 14, 15))
#define PG8_LDA(dst, b, h) do { if constexpr (FP8) { _Pragma("unroll") for (int m = 0; m < 4; ++m) { const bf16x8 lo_ = *(const PG8_LAS bf16x8*)(lds + PG8_SA(b, h) + aoff + m * 2048), hi_ = *(const PG8_LAS bf16x8*)(lds + PG8_SA(b, h) + aoff + m * 2048 + 1024); dst##8[m] = PG8_CAT16(lo_, hi_); } } \
    else { _Pragma("unroll") for (int m = 0; m < 4; ++m) _Pragma("unroll") for (int k = 0; k < 2; ++k) dst[m][k] = *(const PG8_LAS bf16x8*)(lds + PG8_SA(b, h) + aoff + m * 2048 + k * 1024); } } while (0)
#define PG8_LDB(dst, b, h) do { if constexpr (FP8) { _Pragma("unroll") for (int n = 0; n < 2; ++n) { const bf16x8 lo_ = *(const PG8_LAS bf16x8*)(lds + PG8_SB(b, h) + boff + n * 2048), hi_ = *(const PG8_LAS bf16x8*)(lds + PG8_SB(b, h) + boff + n * 2048 + 1024); dst##8[n] = PG8_CAT16(lo_, hi_); } } \
    else { _Pragma("unroll") for (int n = 0; n < 2; ++n) _Pragma("unroll") for (int k = 0; k < 2; ++k) dst[n][k] = *(const PG8_LAS bf16x8*)(lds + PG8_SB(b, h) + boff + n * 2048 + k * 1024); } } while (0)
#define PG8_MMA(ai, bj, At, Bt) do { __builtin_amdgcn_s_setprio(1); \
    if constexpr (FP8) { _Pragma("unroll") for (int m = 0; m < 4; ++m) _Pragma("unroll") for (int n = 0; n < 2; ++n) \
        asm volatile("v_mfma_f32_16x16x128_f8f6f4 %0, %1, %2, %0" : "+v"(acc[ai][bj][m][n]) : "v"(Bt##8[n]), "v"(At##8[m])); } \
    else { _Pragma("unroll") for (int m = 0; m < 4; ++m) _Pragma("unroll") for (int n = 0; n < 2; ++n) _Pragma("unroll") for (int k = 0; k < 2; ++k) \
        acc[ai][bj][m][n] = __builtin_amdgcn_mfma_f32_16x16x32_bf16(Bt[n][k], At[m][k], acc[ai][bj][m][n], 0, 0, 0); } \
    __builtin_amdgcn_s_setprio(0); } while (0)
#define PG8_WAIT_V(n) asm volatile("s_waitcnt vmcnt(" #n ")" ::: "memory")
#define PG8_WAIT_L(n) asm volatile("s_waitcnt lgkmcnt(" #n ")" ::: "memory")
#define PG8_BAR __builtin_amdgcn_s_barrier()
#define PG8_SCHED __builtin_amdgcn_sched_barrier(0)
    Unit cur, nxt; int ui = 0;
    if (!S.next(0, cur)) return;
    f32x4 acc[2][2][4][2];
#pragma unroll
    for (int a = 0; a < 2; ++a)
#pragma unroll
        for (int b = 0; b < 2; ++b)
#pragma unroll
            for (int m = 0; m < 4; ++m)
#pragma unroll
                for (int n = 0; n < 2; ++n) acc[a][b][m][n] = (f32x4){0.f, 0.f, 0.f, 0.f};
    bf16x8 At[4][2], B0[2][2], B1[2][2]; v8i_t At8[4], B08[2], B18[2]; (void)At; (void)B0; (void)B1; (void)At8; (void)B08; (void)B18; int sc8_ = 0x7f7f7f7f; asm volatile("" : "+v"(sc8_)); (void)sc8_;
    const char* cA = (const char*)g.A + (size_t)cur.pm * tstep; const char* cB = (const char*)g.Bt + (size_t)cur.pb * tstep;
    const int rot = S.rot();
#define PG8_KIX(t) ((size_t)(((t) + rot) & (nt - 1)))
    const size_t k0A = PG8_KIX(0) * kstepA, k1A = PG8_KIX(1) * kstepA, k0B = PG8_KIX(0) * kstepB, k1B = PG8_KIX(1) * kstepB;
    S.a_ready(cur);
    if constexpr (SP2) {
        PG8_STAGE(PG8_SB(0, 0), cB + k0B, voffB); PG8_STAGE(PG8_SB(0, 1), cB + hstepB + k0B, voffB); PG8_STAGE(PG8_SA(0, 0), cA + k0A, voffA); PG8_STAGE(PG8_SA(0, 1), cA + hstepA + k0A, voffA);
        if (wr == 1) PG8_BAR;
        PG8_WAIT_V(2); PG8_BAR;
        PG8_STAGE(PG8_SB(1, 0), cB + k1B, voffB); PG8_STAGE(PG8_SA(1, 0), cA + k1A, voffA); PG8_STAGE(PG8_SB(1, 1), cB + hstepB + k1B, voffB);
        PG8_WAIT_V(6); PG8_BAR;
    } else {
        PG8_STAGE(PG8_SB(0, 0), cB + k0B, voffB); PG8_STAGE(PG8_SA(0, 0), cA + k0A, voffA); PG8_STAGE(PG8_SB(0, 1), cB + hstepB + k0B, voffB); PG8_STAGE(PG8_SA(0, 1), cA + hstepA + k0A, voffA);
        if (wr == 1) PG8_BAR;
        PG8_WAIT_V(4); PG8_BAR;
        PG8_STAGE(PG8_SB(1, 0), cB + k1B, voffB); PG8_STAGE(PG8_SA(1, 0), cA + k1A, voffA); PG8_STAGE(PG8_SB(1, 1), cB + hstepB + k1B, voffB);
        PG8_WAIT_V(6); PG8_BAR;
    }
    for (;;) {
        const bool has_next = S.next(ui + 1, nxt);
        const char* nA = has_next ? (const char*)g.A + (size_t)nxt.pm * tstep : cA; const char* nB = has_next ? (const char*)g.Bt + (size_t)nxt.pb * tstep : cB;
        for (int t = 0; t < nt; t += 2) {
            const bool last = (t == nt - 2);
            const char* a1 = cA + PG8_KIX(t + 1) * kstepA;
            const size_t i2 = PG8_KIX(t + 2), i3 = PG8_KIX(t + 3);
            const char* a2 = (last ? nA : cA) + i2 * kstepA; const char* b2 = (last ? nB : cB) + i2 * kstepB;
            const char* a3 = (last ? nA : cA) + i3 * kstepA; const char* b3 = (last ? nB : cB) + i3 * kstepB;
            if (last && has_next) S.a_ready(nxt);
            if constexpr (SP2) {
            PG8_LDB(B0, 0, 0); PG8_LDB(B1, 0, 1); PG8_SCHED; PG8_LDA(At, 0, 0); PG8_STAGE(PG8_SA(1, 1), a1 + hstepA, voffA);
            PG8_WAIT_V(8); PG8_WAIT_L(0); PG8_BAR; PG8_MMA(0, 0, At, B0); PG8_MMA(0, 1, At, B1); PG8_BAR; PG8_SCHED;
            PG8_LDA(At, 0, 1); PG8_STAGE(PG8_SB(0, 0), b2, voffB); PG8_STAGE(PG8_SB(0, 1), b2 + hstepB, voffB); PG8_STAGE(PG8_SA(0, 0), a2, voffA);
            PG8_WAIT_V(8); PG8_WAIT_L(0); PG8_BAR; if (!cur.half) { PG8_MMA(1, 0, At, B0); PG8_MMA(1, 1, At, B1); } PG8_BAR; PG8_SCHED;
            PG8_LDB(B0, 1, 0); PG8_LDB(B1, 1, 1); PG8_SCHED; PG8_LDA(At, 1, 0); PG8_STAGE(PG8_SA(0, 1), a2 + hstepA, voffA);
            PG8_WAIT_V(8); PG8_WAIT_L(0); PG8_BAR; PG8_MMA(0, 0, At, B0); PG8_MMA(0, 1, At, B1); PG8_BAR; PG8_SCHED;
            PG8_LDA(At, 1, 1); PG8_STAGE(PG8_SB(1, 0), b3, voffB); PG8_STAGE(PG8_SB(1, 1), b3 + hstepB, voffB); PG8_STAGE(PG8_SA(1, 0), a3, voffA);
            PG8_WAIT_V(8); PG8_WAIT_L(0); PG8_BAR; if (!cur.half) { PG8_MMA(1, 0, At, B0); PG8_MMA(1, 1, At, B1); } PG8_BAR; PG8_SCHED;
            } else {
            PG8_LDB(B0, 0, 0); PG8_SCHED; PG8_LDA(At, 0, 0); PG8_STAGE(PG8_SA(1, 1), a1 + hstepA, voffA);
            PG8_WAIT_L(8); PG8_BAR; PG8_WAIT_L(0); PG8_MMA(0, 0, At, B0); PG8_BAR; PG8_SCHED;
            PG8_LDB(B1, 0, 1); PG8_STAGE(PG8_SB(0, 0), b2, voffB);
            PG8_BAR; PG8_WAIT_L(0); PG8_MMA(0, 1, At, B1); PG8_BAR;
            PG8_LDA(At, 0, 1); PG8_STAGE(PG8_SA(0, 0), a2, voffA);
            PG8_BAR; PG8_WAIT_L(0); if (!cur.half) PG8_MMA(1, 0, At, B0); PG8_BAR; PG8_SCHED;
            PG8_STAGE(PG8_SB(0, 1), b2 + hstepB, voffB);
            PG8_WAIT_V(6); PG8_BAR; if (!cur.half) PG8_MMA(1, 1, At, B1); PG8_BAR;
            PG8_LDB(B0, 1, 0); PG8_SCHED; PG8_LDA(At, 1, 0); PG8_STAGE(PG8_SA(0, 1), a2 + hstepA, voffA);
            PG8_WAIT_L(8); PG8_BAR; PG8_WAIT_L(0); PG8_MMA(0, 0, At, B0); PG8_BAR; PG8_SCHED;
            PG8_LDB(B1, 1, 1); PG8_STAGE(PG8_SB(1, 0), b3, voffB);
            PG8_BAR; PG8_WAIT_L(0); PG8_MMA(0, 1, At, B1); PG8_BAR;
            PG8_LDA(At, 1, 1); PG8_STAGE(PG8_SA(1, 0), a3, voffA);
            PG8_BAR; PG8_WAIT_L(0); if (!cur.half) PG8_MMA(1, 0, At, B0); PG8_BAR; PG8_SCHED;
            PG8_STAGE(PG8_SB(1, 1), b3 + hstepB, voffB);
            PG8_WAIT_V(6); PG8_BAR; if (!cur.half) PG8_MMA(1, 1, At, B1); PG8_BAR;
            }
        }
        if constexpr (ALIGN_EPI) { if (wr == 0) PG8_BAR; }
        if constexpr (FP8) asm volatile("s_nop 15\n\ts_nop 15" ::: "memory");
        if constexpr (!Epi::AFTER_DRAIN) { E(acc, cur, wr, wc, fr, fq); S.done(cur); }
        if (!has_next) break;
#pragma unroll
        for (int a = 0; a < 2; ++a)
#pragma unroll
            for (int b = 0; b < 2; ++b)
#pragma unroll
                for (int m = 0; m < 4; ++m)
#pragma unroll
                    for (int n = 0; n < 2; ++n) acc[a][b][m][n] = (f32x4){0.f, 0.f, 0.f, 0.f};
        cur = nxt; cA = nA; cB = nB; ++ui;
        if constexpr (ALIGN_EPI) { if (wr == 1) PG8_BAR; }
    }
    PG8_WAIT_V(0);
    if constexpr (!ALIGN_EPI) { if (wr == 0) PG8_BAR; }
    PG8_BAR;
    if constexpr (Epi::AFTER_DRAIN) { E.fused(acc, cur, wr, wc, fr, fq, lds, wid, lane); S.done(cur); }
#undef PG8_KIX
#undef PG8_SA
#undef PG8_SB
#undef PG8_STAGE
#undef PG8_LDA
#undef PG8_LDB
#undef PG8_MMA
#undef PG8_WAIT_V
#undef PG8_WAIT_L
#undef PG8_BAR
#undef PG8_SCHED
}
}
constexpr int NWAVES = 8, NTHR = 512;
constexpr int LDS_BYTES = 147456;
constexpr int MISC_OFF = LDS_BYTES - 128;
typedef GAS unsigned gu32;
#define RLX_AGENT __ATOMIC_RELAXED, __HIP_MEMORY_SCOPE_AGENT
#define LDS_WAIT() asm volatile("s_waitcnt lgkmcnt(0)" ::: "memory")
#define VM_WAIT() asm volatile("s_waitcnt vmcnt(0)" ::: "memory")
#define XB_TMO      128
#define XB_XCNT(j)  (256  + 64 * (j))
#define XB_XSUB(j)  (1280 + 64 * (j))
#define XB_XGEN(j)  (2304 + 64 * (j))
#define XB_TOP      3328
#define XB_TOPGEN   3392
#define XCD_BAR_WORDS 3456
#define XB_SPIN_CAP (1u << 18)

__device__ __forceinline__ unsigned xb_ld(unsigned* p)              { return __hip_atomic_load(p, __ATOMIC_RELAXED, __HIP_MEMORY_SCOPE_AGENT); }
__device__ __forceinline__ unsigned xb_add(unsigned* p, unsigned v) { return __hip_atomic_fetch_add(p, v, __ATOMIC_RELAXED, __HIP_MEMORY_SCOPE_AGENT); }
__device__ __forceinline__ unsigned xb_xcc_id() { return (unsigned)__builtin_amdgcn_s_getreg((3 << 11) | 20) & 0xFu; }
#define XB_SPIN(cond, bar) do { unsigned _sp = 0; while (cond) { __builtin_amdgcn_s_sleep(1); \
    if ((++_sp & 255u) == 0u) { if (xb_ld(&(bar)[XB_TMO])) break; if (_sp > XB_SPIN_CAP) { atomicAdd(&(bar)[XB_TMO], 1u); break; } } } } while (0)

struct XcdBarrier {
    unsigned* bar; unsigned x;
    volatile LAS unsigned* st;
};

__device__ __forceinline__ XcdBarrier xcd_barrier_post(unsigned* bar, volatile LAS unsigned* st) {
    XcdBarrier b; b.bar = bar; b.x = xb_xcc_id(); b.st = st;
    if (threadIdx.x == 0) (void)xb_add(&bar[XB_XCNT(b.x)], 1u);
    return b;
}
__device__ __forceinline__ void xcd_barrier_complete(unsigned* bar, unsigned x, unsigned& nloc, unsigned& nx) {
    const unsigned G = gridDim.x * gridDim.y * gridDim.z;
    unsigned sum, cnt, mine, sp = 0u;
    for (;;) {
        sum = 0u; cnt = 0u; mine = 0u;
#pragma unroll
        for (unsigned j = 0; j < 16; ++j) { const unsigned c = xb_ld(&bar[XB_XCNT(j)]); sum += c; cnt += (c > 0u) ? 1u : 0u; mine = (j == x) ? c : mine; }
        if (sum == G) break;
        __builtin_amdgcn_s_sleep(1);
        if ((++sp & 255u) == 0u) { if (xb_ld(&bar[XB_TMO])) break; if (sp > XB_SPIN_CAP) { atomicAdd(&bar[XB_TMO], 1u); break; } }
    }
    nloc = mine > 0u ? mine : 1u; nx = cnt > 0u ? cnt : 1u;
}

__device__ __forceinline__ void xcd_barrier(const XcdBarrier& b) {
    asm volatile("s_waitcnt vmcnt(0)" ::: "memory");
    __syncthreads();
    if (threadIdx.x == 0) {
        unsigned* bar = b.bar;
        __builtin_amdgcn_s_waitcnt(0);
        unsigned nloc = b.st[0], nx = b.st[1];
        if (nloc == 0u) { xcd_barrier_complete(bar, b.x, nloc, nx); b.st[0] = nloc; b.st[1] = nx; }
        const unsigned old = xb_add(&bar[XB_XSUB(b.x)], 1u);
        const unsigned gen = old / nloc;
        if (old + 1u == (gen + 1u) * nloc) {
            __builtin_amdgcn_fence(__ATOMIC_RELEASE, "agent");
            asm volatile("s_waitcnt vmcnt(0)" ::: "memory");
            const unsigned og = xb_add(&bar[XB_TOP], 1u);
            const unsigned tg = og / nx;
            if (og + 1u == (tg + 1u) * nx) xb_add(&bar[XB_TOPGEN], 1u);
            else XB_SPIN(xb_ld(&bar[XB_TOPGEN]) == tg, bar);
            __builtin_amdgcn_fence(__ATOMIC_ACQUIRE, "agent");
            xb_add(&bar[XB_XGEN(b.x)], 1u);
            asm volatile("s_waitcnt vmcnt(0)" ::: "memory");
        } else {
            XB_SPIN(xb_ld(&bar[XB_XGEN(b.x)]) == gen, bar);
            __builtin_amdgcn_fence(__ATOMIC_ACQUIRE, "agent");
            asm volatile("s_waitcnt vmcnt(0)" ::: "memory");
        }
    }
    __syncthreads();
}
struct Ctx { LAS unsigned char* lds; int tid, lane, wave, vcu, G; };
struct Args { const float* in[19]; float* out; unsigned char* ws; int ph_lo, ph_hi; };

typedef short v4i16_t __attribute__((ext_vector_type(4)));
__device__ __forceinline__ s16x4 trr(LAS unsigned char* p) { return __builtin_bit_cast(s16x4, __builtin_amdgcn_ds_read_tr16_b64_v4i16((LAS v4i16_t*)p)); }
__device__ __forceinline__ bf16x8 cat8(s16x4 lo, s16x4 hi) { return (bf16x8){lo[0], lo[1], lo[2], lo[3], hi[0], hi[1], hi[2], hi[3]}; }
__device__ __forceinline__ float incl_sum_up(float v, int lane) {
#pragma unroll
    for (int o = 1; o < 64; o <<= 1) { const float t = __shfl_up(v, o); if (lane >= o) v += t; }
    return v;
}
__device__ __forceinline__ float incl_max_up(float v, int lane) {
#pragma unroll
    for (int o = 1; o < 64; o <<= 1) { const float t = __shfl_up(v, o); if (lane >= o) v = fmaxf(v, t); }
    return v;
}
__device__ __forceinline__ float incl_max_down(float v, int lane) {
#pragma unroll
    for (int o = 1; o < 64; o <<= 1) { const float t = __shfl_down(v, o); if (lane + o < 64) v = fmaxf(v, t); }
    return v;
}
__device__ __forceinline__ v4u scale8(v4u q, float s) {
    v4u o; o.x = pk2(bflo(q.x) * s, bfhi(q.x) * s); o.y = pk2(bflo(q.y) * s, bfhi(q.y) * s); o.z = pk2(bflo(q.z) * s, bfhi(q.z) * s); o.w = pk2(bflo(q.w) * s, bfhi(q.w) * s); return o;
}

__device__ __forceinline__ float sat8(float x) { return fminf(fmaxf(x, -448.f), 448.f); }
__device__ __forceinline__ void tr_item(const float* __restrict__ W, int ldw, int K, bf16* __restrict__ WT, int n_src0, int n_dst0, int k0, LAS unsigned char* scr, int lane) {
    const int nq = lane & 15, kg = lane >> 4;
    const float* src = W + (size_t)(k0 + 4 * kg) * ldw + n_src0 + 4 * nq;
#pragma unroll
    for (int j = 0; j < 4; ++j) {
        const float* s = src + (size_t)(16 * j) * ldw;
        const f32x4 r0 = *(const f32x4*)s, r1 = *(const f32x4*)(s + ldw), r2 = *(const f32x4*)(s + 2 * (size_t)ldw), r3 = *(const f32x4*)(s + 3 * (size_t)ldw);
#pragma unroll
        for (int c = 0; c < 4; ++c) { LAS unsigned* d = (LAS unsigned*)(scr + (4 * nq + c) * 132 + (16 * j + 4 * kg) * 2); d[0] = pk2(r0[c], r1[c]); d[1] = pk2(r2[c], r3[c]); }
    }
    const int row8 = lane >> 3, c8 = lane & 7;
#pragma unroll
    for (int jj = 0; jj < 8; ++jj) { const int row = row8 + 8 * jj; LAS unsigned char* rp = scr + row * 132 + 16 * c8;
        v4u o; o.x = *(LAS unsigned*)rp; o.y = *(LAS unsigned*)(rp + 4); o.z = *(LAS unsigned*)(rp + 8); o.w = *(LAS unsigned*)(rp + 12);
        *(v4u*)(WT + (size_t)(n_dst0 + row) * K + k0 + 8 * c8) = o; }
}
constexpr float W8SCALE = 64.f, W8INV = 1.f / 64.f;
__device__ __forceinline__ void tr8_item(const float* __restrict__ W, int ldw, int Kb, unsigned char* __restrict__ WT, int n0, int k0, LAS unsigned char* scr, int lane) {
    const int nq = lane & 15, kg = lane >> 4;
    const float* src = W + (size_t)(k0 + 4 * kg) * ldw + n0 + 4 * nq;
#pragma unroll 2
    for (int j = 0; j < 8; ++j) {
        const float* s = src + (size_t)(16 * j) * ldw;
        const f32x4 r0 = *(const f32x4*)s, r1 = *(const f32x4*)(s + ldw), r2 = *(const f32x4*)(s + 2 * (size_t)ldw), r3 = *(const f32x4*)(s + 3 * (size_t)ldw);
#pragma unroll
        for (int c = 0; c < 4; ++c) { int w = 0; w = __builtin_amdgcn_cvt_pk_fp8_f32(r0[c] * W8SCALE, r1[c] * W8SCALE, w, false); w = __builtin_amdgcn_cvt_pk_fp8_f32(r2[c] * W8SCALE, r3[c] * W8SCALE, w, true);
            *(LAS int*)(scr + (4 * nq + c) * 132 + 16 * j + 4 * kg) = w; }
    }
    const int row8 = lane >> 3, c8 = lane & 7;
#pragma unroll
    for (int jj = 0; jj < 8; ++jj) { const int row = row8 + 8 * jj; LAS unsigned char* rp = scr + row * 132 + 16 * c8;
        v4u o; o.x = *(LAS unsigned*)rp; o.y = *(LAS unsigned*)(rp + 4); o.z = *(LAS unsigned*)(rp + 8); o.w = *(LAS unsigned*)(rp + 12);
        *(v4u*)(WT + (size_t)(n0 + row) * Kb + k0 + 16 * c8) = o; }
}
__device__ __forceinline__ void p0_transposes(const Ctx& C, const Args& a) {
    const float* w_in = a.in[2]; const float* w_ml = a.in[5]; const float* w_da = a.in[10]; const float* w_o = a.in[11]; const float* w_gu = a.in[15]; const float* w_dn = a.in[17];
    bf16* WIN = (bf16*)(a.ws + WS_WIN); bf16* WML = (bf16*)(a.ws + WS_WML); bf16* WDA = (bf16*)(a.ws + WS_WDA); bf16* WO = (bf16*)(a.ws + WS_WO);
    const int gw = C.vcu * NWAVES + C.wave, NGW = C.G * NWAVES;
    constexpr int I_IN = 32 * 96, I_IN8 = 16 * 64;
    constexpr int NIT = I_IN + I_IN8;
    LAS unsigned char* scr = C.lds + C.wave * 8448;
    for (int it = gw; it < NIT; it += NGW) {
        int r = it;
        if (r < I_IN) { const int kb = r / 96, nb = r % 96, nd = nb * 64; tr_item(w_in, DIN, D, WIN, nd < G_OFF ? nd : nd + 16, nd, kb * 64, scr, C.lane); continue; } r -= I_IN;
        { const int kb = r / 64, nb = r % 64; tr8_item(w_in + (P_GM + 16), DIN, D, (unsigned char*)(a.ws + WS_WIN8), nb * 64, kb * 128, scr, C.lane); }
    }
    (void)w_ml; (void)w_da; (void)w_o; (void)WML; (void)WDA; (void)WO;
    __syncthreads();
}
__device__ __forceinline__ void p2_late_transposes(const Ctx& C, const Args& a) {
    const float* w_ml = a.in[5]; const float* w_da = a.in[10]; const float* w_o = a.in[11];
    bf16* WML = (bf16*)(a.ws + WS_WML); bf16* WDA = (bf16*)(a.ws + WS_WDA); bf16* WO = (bf16*)(a.ws + WS_WO);
    const int gw = C.vcu * NWAVES + C.wave, NGW = C.G * NWAVES;
    constexpr int I_ML = 16 * 32, I_O = 32 * 32, NIT = 2 * I_ML + I_O;
    LAS unsigned char* scr = C.lds + C.wave * 8448;
    for (int it = gw; it < NIT; it += NGW) {
        int r = it;
        if (r < I_ML) { const int kb = r / 32, nb = r % 32; tr_item(w_ml, D, MLW, WML, nb * 64, nb * 64, kb * 64, scr, C.lane); continue; } r -= I_ML;
        if (r < I_ML) { const int kb = r / 32, nb = r % 32; tr_item(w_da, D, DAW, WDA, nb * 64, nb * 64, kb * 64, scr, C.lane); continue; } r -= I_ML;
        { const int kb = r / 32, nb = r % 32; tr_item(w_o, D, D, WO, nb * 64, nb * 64, kb * 64, scr, C.lane); }
    }
    __syncthreads();
}
constexpr int CV_J_GU = 16 * 64, CV_J_DN = 16 * 32, CV_NJ = NE * (CV_J_GU + CV_J_DN);
struct ConvSet { f32x4 r[8]; };
struct Conv { int it, step; ConvSet s[2]; };
struct ConvItem { const float* src; unsigned char* dst; int ldw, Kb; };
__device__ __forceinline__ ConvItem conv_item(const Args& a, int it) {
    const float* w_gu = a.in[15]; const float* w_dn = a.in[17]; ConvItem ci;
    if (it < NE * CV_J_GU) { const int e = it / CV_J_GU, q = it % CV_J_GU, kb = q / 64, nb = q % 64; ci.ldw = 2 * DE; ci.Kb = D;
        ci.src = w_gu + (size_t)e * D * 2 * DE + (size_t)(kb * 128) * (2 * DE) + nb * 64;
        ci.dst = a.ws + WS_WGU + (size_t)e * 2 * DE * D + (size_t)(nb * 64) * D + kb * 128; }
    else { const int r = it - NE * CV_J_GU, e = r / CV_J_DN, q = r % CV_J_DN, kb = q / 32, nb = q % 32; ci.ldw = D; ci.Kb = DE;
        ci.src = w_dn + (size_t)e * DE * D + (size_t)(kb * 128) * D + nb * 64;
        ci.dst = a.ws + WS_WDN + (size_t)e * D * DE + (size_t)(nb * 64) * DE + kb * 128; }
    return ci;
}
__device__ __forceinline__ const char* uni_ptr(const void* p) { const unsigned long long v = (unsigned long long)p; const unsigned lo = __builtin_amdgcn_readfirstlane((unsigned)v), hi = __builtin_amdgcn_readfirstlane((unsigned)(v >> 32)); return (const char*)(((unsigned long long)hi << 32) | lo); }
struct ConvSrc { const float* src; int ldw; };
__device__ __forceinline__ ConvSrc conv_src(const Args& a, int it) { const int itc = it < CV_NJ ? it : CV_NJ - 1; const ConvItem ci = conv_item(a, __builtin_amdgcn_readfirstlane(itc)); ConvSrc s; s.src = ci.src; s.ldw = ci.ldw; return s; }
__device__ __forceinline__ unsigned conv_loff(const ConvSrc& cs, int lane) { return ((unsigned)(4 * (lane >> 4)) * (unsigned)cs.ldw + 4u * (lane & 15)) * 4u; }
__device__ __forceinline__ void conv_issue_one(ConvSet& S, const ConvSrc& cs, unsigned loff, int st, int q) {
    const char* sb = (const char*)(cs.src + (size_t)(16 * (2 * st + (q >> 2)) + (q & 3)) * cs.ldw);
    asm volatile("global_load_dwordx4 %0, %1, %2 nt" : "=v"(S.r[q]) : "v"(loff), "s"(sb) : "memory");
}
__device__ __forceinline__ void conv_issue(ConvSet& S, const Args& a, int it, int st, int lane) {
    const ConvSrc cs = conv_src(a, it); const unsigned loff = conv_loff(cs, lane);
#pragma unroll
    for (int q = 0; q < 8; ++q) conv_issue_one(S, cs, loff, st, q);
}
__device__ __forceinline__ void conv_next(int& it, int& st, int NGW) { if (st == 3) { st = 0; it += NGW; } else ++st; }
__device__ __forceinline__ void conv_begin(Conv& cv, const Args& a, int gw, int NGW, int lane) { cv.it = gw; cv.step = 0; conv_issue(cv.s[0], a, cv.it, cv.step, lane); }
__device__ __forceinline__ void conv_issue_next(Conv& cv, ConvSet& S, const Args& a, int NGW, int lane) { int it1 = cv.it, st1 = cv.step; conv_next(it1, st1, NGW); conv_issue(S, a, it1, st1, lane); }
template <int NW> __device__ __forceinline__ bool conv_consume(Conv& cv, ConvSet& S, const Args& a, LAS unsigned char* scr, int NGW, int lane) {
    if constexpr (NW == 12) asm volatile("s_waitcnt vmcnt(12)" : "+v"(S.r[0]), "+v"(S.r[1]), "+v"(S.r[2]), "+v"(S.r[3]), "+v"(S.r[4]), "+v"(S.r[5]), "+v"(S.r[6]), "+v"(S.r[7]) :: "memory");
    else if constexpr (NW == 8) asm volatile("s_waitcnt vmcnt(8)" : "+v"(S.r[0]), "+v"(S.r[1]), "+v"(S.r[2]), "+v"(S.r[3]), "+v"(S.r[4]), "+v"(S.r[5]), "+v"(S.r[6]), "+v"(S.r[7]) :: "memory");
    else asm volatile("s_waitcnt vmcnt(0)" : "+v"(S.r[0]), "+v"(S.r[1]), "+v"(S.r[2]), "+v"(S.r[3]), "+v"(S.r[4]), "+v"(S.r[5]), "+v"(S.r[6]), "+v"(S.r[7]) :: "memory");
    const int nq = lane & 15, kg = lane >> 4; const bool st = (cv.it < CV_NJ) && cv.step == 3;
#pragma unroll
    for (int jj = 0; jj < 2; ++jj) { const int j = 2 * cv.step + jj;
#pragma unroll
        for (int c = 0; c < 4; ++c) { int w = 0; w = __builtin_amdgcn_cvt_pk_fp8_f32(S.r[4 * jj + 0][c] * W8SCALE, S.r[4 * jj + 1][c] * W8SCALE, w, false);
            w = __builtin_amdgcn_cvt_pk_fp8_f32(S.r[4 * jj + 2][c] * W8SCALE, S.r[4 * jj + 3][c] * W8SCALE, w, true);
            *(LAS int*)(scr + (4 * nq + c) * 132 + 16 * j + 4 * kg) = w; } }
    if (st) {
        const ConvItem ci = conv_item(a, __builtin_amdgcn_readfirstlane(cv.it));
        const int row8 = lane >> 3, c8 = lane & 7;
#pragma unroll 2
        for (int jj = 0; jj < 8; ++jj) { const int row = row8 + 8 * jj; LAS unsigned char* rp = scr + row * 132 + 16 * c8;
            v4u o; o.x = *(LAS unsigned*)rp; o.y = *(LAS unsigned*)(rp + 4); o.z = *(LAS unsigned*)(rp + 8); o.w = *(LAS unsigned*)(rp + 12);
            *(v4u*)(ci.dst + (size_t)row * ci.Kb + 16 * c8) = o; }
    }
    conv_next(cv.it, cv.step, NGW);
    return st;
}
__device__ __forceinline__ void p0_xn_gates(const Ctx& C, const Args& a) {
    const float* x = a.in[0]; const float* g1 = a.in[1]; const float* w_in = a.in[2]; const float* gbias = a.in[3];
    bf16* XN = (bf16*)(a.ws + WS_XN); float* MG = (float*)(a.ws + WS_MG);
    for (int idx = C.tid; idx < D * 4; idx += NTHR) {
        const int k = idx >> 2, c = idx & 3; const f32x4 w = *(const f32x4*)(w_in + (size_t)k * DIN + G_OFF + 4 * c);
        const int r = (k & 3) * 512 + (k >> 2);
        *(LAS f32x4*)(C.lds + r * 64 + ((c ^ ((r >> 2) & 3)) * 16)) = w;
    }
    __syncthreads();
    const int gw = C.vcu * NWAVES + C.wave, NGW = C.G * NWAVES, lane = C.lane;
    for (int m = gw; m < T; m += NGW) {
        const f32x4* xr = (const f32x4*)(x + (size_t)m * D) + lane; f32x4 v[8]; float ss = 0.f;
#pragma unroll
        for (int j = 0; j < 8; ++j) { v[j] = xr[64 * j]; ss += (v[j].x * v[j].x + v[j].y * v[j].y) + (v[j].z * v[j].z + v[j].w * v[j].w); }
        const float rstd = rsqrtf(wave_sum(ss) * (1.f / D) + EPS);
        float acc[16];
#pragma unroll
        for (int i = 0; i < 16; ++i) acc[i] = 0.f;
        int lb = lane * 64; asm volatile("" : "+v"(lb));
        int lbase[4];
#pragma unroll
        for (int c = 0; c < 4; ++c) lbase[c] = lb + ((c ^ ((lane >> 2) & 3)) << 4);
#pragma unroll
        for (int j = 0; j < 8; ++j) {
            const f32x4 g = *((const f32x4*)g1 + lane + 64 * j);
            v[j].x *= rstd * g.x; v[j].y *= rstd * g.y; v[j].z *= rstd * g.z; v[j].w *= rstd * g.w;
            v2u o; o.x = pk2(v[j].x, v[j].y); o.y = pk2(v[j].z, v[j].w);
            *((v2u*)(XN + (size_t)m * D) + lane + 64 * j) = o;
            { int o8 = 0; o8 = __builtin_amdgcn_cvt_pk_fp8_f32(v[j].x, v[j].y, o8, false); o8 = __builtin_amdgcn_cvt_pk_fp8_f32(v[j].z, v[j].w, o8, true); *((int*)(a.ws + WS_XN8 + (size_t)m * D) + lane + 64 * j) = o8; }
#pragma unroll
            for (int i = 0; i < 4; ++i) {
                const float hv = v[j][i];
#pragma unroll
                for (int c = 0; c < 4; ++c) { const f32x4 w = *(const LAS f32x4*)(C.lds + lbase[c] + (i * 512 + 64 * j) * 64);
                    acc[4 * c + 0] += hv * w.x; acc[4 * c + 1] += hv * w.y; acc[4 * c + 2] += hv * w.z; acc[4 * c + 3] += hv * w.w; }
            }
        }
        float mine = 0.f;
#pragma unroll
        for (int i = 0; i < 16; ++i) { const float s = wave_sum(acc[i]); if (lane == i) mine = s; }
        if (lane < 16) MG[(size_t)m * 16 + lane] = mine + gbias[lane];
    }
}
__device__ __forceinline__ void p0_router_w(const Ctx& C, const Args& a) {
    const float* wr = a.in[13]; bf16* WRH = (bf16*)(a.ws + WS_WRH); bf16* WRL = (bf16*)(a.ws + WS_WRL);
    for (int g = C.vcu * NTHR + C.tid; g < D * NE; g += C.G * NTHR) { const int k = g >> 5, e = g & 31; const float w = wr[g];
        const int kp = (k & ~12) | ((k & 4) << 1) | ((k & 8) >> 1);
        const bf16 hi = f2bf(w); const bf16 lo = f2bf(w - bf2f(hi)); WRH[e * D + kp] = hi; WRL[e * D + kp] = lo; }
}
__device__ __forceinline__ void p0_rope(const Ctx& C, const Args& a) {
    float* ROPE = (float*)(a.ws + WS_ROPE);
    for (int g = C.vcu * NTHR + C.tid; g < S * 32; g += C.G * NTHR) {
        const int pos = g >> 5, i = g & 31;
        const double inv = exp2(-(double)i * (13.287712379549449 / 32.0));
        const double rev = (double)pos * inv * 0.15915494309189535;
        const double fr = rev - floor(rev + 0.5);
        const float ang = (float)(fr * 6.283185307179586);
        f32x2 cs; cs.x = cosf(ang); cs.y = sinf(ang);
        *(f32x2*)(ROPE + 2 * g) = cs;
    }
}

template <bool GATES8> struct EpiProj {
    static constexpr bool PERM = true, AFTER_DRAIN = false;
    bf16* O; unsigned char* G8;
    __device__ __forceinline__ void operator()(const pg8::f32x4 (&acc)[2][2][4][2], const pg8::Unit& u, int wr, int wc, int fr, int fq) const {
        const int pn = GATES8 ? u.pn + 24 : u.pn;
        const int row0 = u.pm * 256 + wr * 64 + fr, col0 = pn * 256 + wc * 32 + 8 * fq;
        const int mode = (pn == 2 || pn == 3) ? 1 : (((pn >= 8 && pn < 12) || pn >= 24) ? 2 : 0);
#pragma unroll
        for (int ai = 0; ai < 2; ++ai)
#pragma unroll
            for (int m = 0; m < 4; ++m) { bf16* rowp = O + (size_t)(row0 + ai * 128 + m * 16) * NPJ + col0;
#pragma unroll
                for (int bj = 0; bj < 2; ++bj) { pg8::f32x4 v0 = acc[ai][bj][m][0], v1 = acc[ai][bj][m][1];
                    if (GATES8) { v0 = v0 * W8INV; v1 = v1 * W8INV; }
                    if (mode == 1) { v0 = v0 * KSCALE; v1 = v1 * KSCALE; }
                    if (mode == 2) {
#pragma unroll
                        for (int i = 0; i < 4; ++i) { v0[i] = sigmoidf_(v0[i]); v1[i] = sigmoidf_(v1[i]); } }
                    if (GATES8) {
                        const unsigned q[8] = {(unsigned)__builtin_rintf(v0[0] * 255.f), (unsigned)__builtin_rintf(v0[1] * 255.f), (unsigned)__builtin_rintf(v0[2] * 255.f), (unsigned)__builtin_rintf(v0[3] * 255.f),
                                               (unsigned)__builtin_rintf(v1[0] * 255.f), (unsigned)__builtin_rintf(v1[1] * 255.f), (unsigned)__builtin_rintf(v1[2] * 255.f), (unsigned)__builtin_rintf(v1[3] * 255.f)};
                        v2u w; w.x = q[0] | (q[1] << 8) | (q[2] << 16) | (q[3] << 24); w.y = q[4] | (q[5] << 8) | (q[6] << 16) | (q[7] << 24);
                        *(v2u*)(G8 + (size_t)(row0 + ai * 128 + m * 16) * 4096 + u.pn * 256 + wc * 32 + 8 * fq + bj * 128) = w;
                    } else {
                    v4u w; w.x = pk2(v0[0], v0[1]); w.y = pk2(v0[2], v0[3]); w.z = pk2(v1[0], v1[1]); w.w = pk2(v1[2], v1[3]);
                    *(v4u*)(rowp + bj * 128) = w; } } }
    }
};
__device__ __forceinline__ void gate8(const unsigned char* G8, size_t row, int gcol, float (&g)[8]) {
    const v2u w = *(const v2u*)(G8 + row * 4096 + gcol); const float s = 1.f / 255.f;
    g[0] = (float)(w.x & 0xff) * s; g[1] = (float)((w.x >> 8) & 0xff) * s; g[2] = (float)((w.x >> 16) & 0xff) * s; g[3] = (float)(w.x >> 24) * s;
    g[4] = (float)(w.y & 0xff) * s; g[5] = (float)((w.y >> 8) & 0xff) * s; g[6] = (float)((w.y >> 16) & 0xff) * s; g[7] = (float)(w.y >> 24) * s;
}
template <int MODE> struct EpiGate {
    static constexpr bool PERM = true, AFTER_DRAIN = false;
    const bf16* PROJ; const bf16* T1in; bf16* O;
    __device__ __forceinline__ void operator()(const pg8::f32x4 (&acc)[2][2][4][2], const pg8::Unit& u, int wr, int wc, int fr, int fq) const {
        const int row0 = u.pm * 256 + wr * 64 + fr, col0 = u.pn * 256 + wc * 32 + 8 * fq;
#pragma unroll
        for (int ai = 0; ai < 2; ++ai)
#pragma unroll
            for (int m = 0; m < 4; ++m) { const size_t row = (size_t)(row0 + ai * 128 + m * 16);
#pragma unroll
                for (int bj = 0; bj < 2; ++bj) { const int col = col0 + bj * 128; const pg8::f32x4 v0 = acc[ai][bj][m][0], v1 = acc[ai][bj][m][1];
                    float g[8]; gate8((const unsigned char*)PROJ, row, (MODE ? 2048 : 0) + col, g);
                    float o[8] = {g[0] * v0[0], g[1] * v0[1], g[2] * v0[2], g[3] * v0[3], g[4] * v1[0], g[5] * v1[1], g[6] * v1[2], g[7] * v1[3]};
                    if (MODE == 1) { const v4u t = *(const v4u*)(T1in + row * D + col);
                        o[0] += bflo(t.x); o[1] += bfhi(t.x); o[2] += bflo(t.y); o[3] += bfhi(t.y); o[4] += bflo(t.z); o[5] += bfhi(t.z); o[6] += bflo(t.w); o[7] += bfhi(t.w); }
                    v4u w; w.x = pk2(o[0], o[1]); w.y = pk2(o[2], o[3]); w.z = pk2(o[4], o[5]); w.w = pk2(o[6], o[7]);
                    *(v4u*)(O + row * D + col) = w; } }
    }
};
struct EpiGatePair {
    static constexpr bool PERM = true, AFTER_DRAIN = false;
    const bf16* PROJ; bf16* T1; bf16* MIX;
    __device__ __forceinline__ void operator()(const pg8::f32x4 (&acc)[2][2][4][2], const pg8::Unit& u, int wr, int wc, int fr, int fq) const {
        const bool second = u.pm >= T / 256; const int pmr = second ? u.pm - T / 256 : u.pm;
        const int row0 = pmr * 256 + wr * 64 + fr, col0 = u.pn * 256 + wc * 32 + 8 * fq; const int gcol = second ? 2048 : 0; bf16* O = second ? MIX : T1;
#pragma unroll
        for (int ai = 0; ai < 2; ++ai)
#pragma unroll
            for (int m = 0; m < 4; ++m) { const size_t row = (size_t)(row0 + ai * 128 + m * 16);
#pragma unroll
                for (int bj = 0; bj < 2; ++bj) { const int col = col0 + bj * 128; const pg8::f32x4 v0 = acc[ai][bj][m][0], v1 = acc[ai][bj][m][1];
                    float g[8]; gate8((const unsigned char*)PROJ, row, gcol + col, g);
                    float o[8] = {g[0] * v0[0], g[1] * v0[1], g[2] * v0[2], g[3] * v0[3], g[4] * v1[0], g[5] * v1[1], g[6] * v1[2], g[7] * v1[3]};
                    if (second) { const v4u t = *(const v4u*)(T1 + row * D + col);
                        o[0] += bflo(t.x); o[1] += bfhi(t.x); o[2] += bflo(t.y); o[3] += bfhi(t.y); o[4] += bflo(t.z); o[5] += bfhi(t.z); o[6] += bflo(t.w); o[7] += bfhi(t.w); }
                    v4u w; w.x = pk2(o[0], o[1]); w.y = pk2(o[2], o[3]); w.z = pk2(o[4], o[5]); w.w = pk2(o[6], o[7]);
                    *(v4u*)(O + row * D + col) = w; } }
    }
};
struct PairOrder {
    pg8::StaticOrder so;
    __device__ __forceinline__ bool next(int i, pg8::Unit& u) const {
        const int per = so.nwg / so.G;
        if (i >= 2 * per) return false;
        const bool second = i >= per; if (!so.next(second ? i - per : i, u)) return false;
        if (second) { u.pm += T / 256; u.pb += D / 256; }
        return true;
    }
    __device__ __forceinline__ void a_ready(const pg8::Unit&) const {}
    __device__ __forceinline__ void done(const pg8::Unit&) const {}
    __device__ __forceinline__ int rot() const { return 0; }
};
struct EpiRes {
    static constexpr bool PERM = false, AFTER_DRAIN = false;
    const float* X; float* O;
    __device__ __forceinline__ void operator()(const pg8::f32x4 (&acc)[2][2][4][2], const pg8::Unit& u, int wr, int wc, int fr, int fq) const {
        const int row0 = u.pm * 256 + wr * 64 + fr, col0 = u.pn * 256 + wc * 32 + 4 * fq;
#pragma unroll
        for (int ai = 0; ai < 2; ++ai)
#pragma unroll
            for (int m = 0; m < 4; ++m) { const size_t off = (size_t)(row0 + ai * 128 + m * 16) * D + col0;
#pragma unroll
                for (int bj = 0; bj < 2; ++bj)
#pragma unroll
                    for (int n = 0; n < 2; ++n) { const pg8::f32x4 xv = *(const pg8::f32x4*)(X + off + bj * 128 + n * 16); *(pg8::f32x4*)(O + off + bj * 128 + n * 16) = xv + acc[ai][bj][m][n]; } }
    }
};
struct EpiAct {
    static constexpr bool PERM = true, AFTER_DRAIN = false;
    const float* bias; unsigned char* O;
    __device__ __forceinline__ void operator()(const pg8::f32x4 (&acc)[2][2][4][2], const pg8::Unit& u, int wr, int wc, int fr, int fq) const {
        const int row0 = u.pm * 256 + wr * 64 + fr, col0 = u.pn * 256 + wc * 32 + 8 * fq, e = u.pb >> 4;
        pg8::f32x4 bv[2][2];
#pragma unroll
        for (int bj = 0; bj < 2; ++bj)
#pragma unroll
            for (int n = 0; n < 2; ++n) bv[bj][n] = *(const pg8::f32x4*)(bias + (size_t)e * 2 * DE + col0 + bj * 128 + 4 * n);
#pragma unroll
        for (int ai = 0; ai < 2; ++ai)
#pragma unroll
            for (int m = 0; m < 4; ++m) { const size_t row = (size_t)(row0 + ai * 128 + m * 16);
#pragma unroll
                for (int bj = 0; bj < 2; ++bj) { const pg8::f32x4 v0 = acc[ai][bj][m][0] * W8INV + bv[bj][0], v1 = acc[ai][bj][m][1] * W8INV + bv[bj][1];
                    const float gu[8] = {v0[0], v0[1], v0[2], v0[3], v1[0], v1[1], v1[2], v1[3]}; float o[4];
#pragma unroll
                    for (int p = 0; p < 4; ++p) { const float glu = fminf(gu[2 * p], 7.f), lin = fminf(fmaxf(gu[2 * p + 1], -7.f), 7.f); o[p] = glu * sigmoidf_(1.702f * glu) * (lin + 1.f); }
                    int w = 0; w = __builtin_amdgcn_cvt_pk_fp8_f32(o[0], o[1], w, false); w = __builtin_amdgcn_cvt_pk_fp8_f32(o[2], o[3], w, true);
                    *(int*)(O + row * DE + ((col0 + bj * 128) >> 1)) = w; } }
    }
};
struct EpiY {
    static constexpr bool PERM = true, AFTER_DRAIN = false;
    const float* bias; bf16* O;
    __device__ __forceinline__ void operator()(const pg8::f32x4 (&acc)[2][2][4][2], const pg8::Unit& u, int wr, int wc, int fr, int fq) const {
        const int row0 = u.pm * 256 + wr * 64 + fr, col0 = u.pn * 256 + wc * 32 + 8 * fq, e = u.pb >> 3;
        pg8::f32x4 bv[2][2];
#pragma unroll
        for (int bj = 0; bj < 2; ++bj)
#pragma unroll
            for (int n = 0; n < 2; ++n) bv[bj][n] = *(const pg8::f32x4*)(bias + (size_t)e * D + col0 + bj * 128 + 4 * n);
#pragma unroll
        for (int ai = 0; ai < 2; ++ai)
#pragma unroll
            for (int m = 0; m < 4; ++m) { const size_t row = (size_t)(row0 + ai * 128 + m * 16);
#pragma unroll
                for (int bj = 0; bj < 2; ++bj) { const pg8::f32x4 v0 = acc[ai][bj][m][0] * W8INV + bv[bj][0], v1 = acc[ai][bj][m][1] * W8INV + bv[bj][1];
                    int a0 = 0, a1 = 0; a0 = __builtin_amdgcn_cvt_pk_fp8_f32(sat8(v0[0]), sat8(v0[1]), a0, false); a0 = __builtin_amdgcn_cvt_pk_fp8_f32(sat8(v0[2]), sat8(v0[3]), a0, true);
                    a1 = __builtin_amdgcn_cvt_pk_fp8_f32(sat8(v1[0]), sat8(v1[1]), a1, false); a1 = __builtin_amdgcn_cvt_pk_fp8_f32(sat8(v1[2]), sat8(v1[3]), a1, true);
                    v2u w; w.x = (unsigned)a0; w.y = (unsigned)a1;
                    *(v2u*)((unsigned char*)O + row * D + col0 + bj * 128) = w; } }
    }
};
struct MoeSched {
    int tsl, fin, hin, fl, F, total, NT, G, c;
    __device__ __forceinline__ void init(const int* cnt, int NT_, int G_, int c_, int lane) {
        const int cn = lane < NE ? cnt[lane] : 0, f = cn / PADM, r = cn - f * PADM;
        const int full = f + (r > PADM / 2 ? 1 : 0), half = (r > 0 && r <= PADM / 2) ? 1 : 0, tiles = full + half;
        int it = tiles, iff = full, ih = half;
#pragma unroll
        for (int o = 1; o < 32; o <<= 1) { const int t0 = __shfl_up(it, o), t1 = __shfl_up(iff, o), t2 = __shfl_up(ih, o); if (lane >= o) { it += t0; iff += t1; ih += t2; } }
        F = __shfl(iff, 31); total = F + __shfl(ih, 31);
        tsl = it - tiles; fl = full; fin = lane < NE ? iff : 0x7fffffff; hin = lane < NE ? ih : 0x7fffffff; NT = NT_; G = G_; c = c_;
    }
    __device__ __forceinline__ bool next(int i, pg8::Unit& u) const {
        int mo, pn;
        if (G == 256) { const int x = c & 7, jj = c >> 3, NPB = NT >> 3, RPM = (8 / NPB) * 4;
            mo = i * RPM + (x / NPB) * 4 + (jj & 3); pn = (x % NPB) * 8 + (jj >> 2); }
        else { const long L = (long)i * G + c; mo = (int)(L / NT); pn = (int)(L % NT); }
        if (mo >= total) return false;
        int e, mt, hf;
        if (mo < F) { e = __popcll(__ballot(fin <= mo)); mt = __shfl(tsl, e) + (mo - (__shfl(fin, e) - __shfl(fl, e))); hf = 0; }
        else { e = __popcll(__ballot(hin <= mo - F)); mt = __shfl(tsl, e) + __shfl(fl, e); hf = 1; }
        u.pm = mt; u.pn = pn; u.pb = e * NT + pn; u.half = __builtin_amdgcn_readfirstlane(hf); return true;
    }
    __device__ __forceinline__ void a_ready(const pg8::Unit&) const {}
    __device__ __forceinline__ void done(const pg8::Unit&) const {}
    __device__ __forceinline__ int rot() const { const int jj = c >> 3; return G == 256 ? ((jj >> 2) + (jj & 3)) & 15 : 0; }
};

__device__ __forceinline__ void p2_mstats(const Ctx& C, const Args& a) {
    const float* MG = (const float*)(a.ws + WS_MG); float* GA = (float*)(a.ws + WS_MSC);
    const int gw = C.vcu * NWAVES + C.wave, NGW = C.G * NWAVES, lane = C.lane;
    for (int q = gw; q < 16 * 64; q += NGW) {
        const int chain = q >> 6, c = q & 63, dir = chain & 1, hh = (chain >> 1) & 3, b = chain >> 3;
        const int p = b * S + 64 * c + (dir ? 63 - lane : lane);
        const float lf = logsigf_(MG[(size_t)p * 16 + (dir ? 12 : 4) + hh]), ig = MG[(size_t)p * 16 + (dir ? 8 : 0) + hh];
        const float bs = incl_sum_up(lf, lane), g = __shfl(bs, 63), amax = g + wave_max(ig - bs);
        if (lane == 0) { f32x2 o; o.x = g; o.y = amax; *(f32x2*)(GA + (size_t)q * 2) = o; }
    }
}
struct MScan { float mprev, mnew, dec; };
__device__ __forceinline__ float rdlane(float v, int l) { return __int_as_float(__builtin_amdgcn_readlane(__float_as_int(v), l)); }
__device__ __forceinline__ MScan mscan(const float* GA, int chain, int lane) {
    const f32x2 ga = *(const f32x2*)(GA + (size_t)(chain * 64 + lane) * 2); const int dir = chain & 1;
    MScan r; r.mprev = 0.f; r.mnew = 0.f; r.dec = 0.f; float m = 0.f;
    for (int ci = 0; ci < 64; ++ci) { const int cc = dir ? 63 - ci : ci;
        const float gc = rdlane(ga.x, cc), ac = rdlane(ga.y, cc), mnew = fmaxf(gc + m, ac);
        if (lane == cc) { r.mprev = m; r.mnew = mnew; r.dec = __expf(gc + m - mnew); }
        m = mnew; }
    return r;
}
__device__ __forceinline__ void p2_qkprep(const Ctx& C, const Args& a) {
    const bf16* PROJ = (const bf16*)(a.ws + WS_PROJ); const float* ROPE = (const float*)(a.ws + WS_ROPE);
    const float* qg = a.in[6]; const float* kg = a.in[7];
    bf16* QN = (bf16*)(a.ws + WS_QN); bf16* KN = (bf16*)(a.ws + WS_KN);
    const int gw = C.vcu * NWAVES + C.wave, NGW = C.G * NWAVES, lane = C.lane, g = lane >> 2, sub = lane & 3;
    for (int m = gw; m < T; m += NGW) {
        const int pos = m & (S - 1);
        float cs[8], sn[8];
#pragma unroll
        for (int i = 0; i < 4; ++i) { const f32x4 t = *(const f32x4*)(ROPE + ((size_t)pos * 32 + sub * 8 + 2 * i) * 2); cs[2 * i] = t.x; sn[2 * i] = t.y; cs[2 * i + 1] = t.z; sn[2 * i + 1] = t.w; }
#pragma unroll
        for (int which = 0; which < 2; ++which) {
            const bf16* src = PROJ + (size_t)m * NPJ + (which ? P_DK : P_DQ) + g * 64 + sub * 8;
            const v4u a1 = *(const v4u*)src, a2 = *(const v4u*)(src + 32);
            float x1[8] = {bflo(a1.x), bfhi(a1.x), bflo(a1.y), bfhi(a1.y), bflo(a1.z), bfhi(a1.z), bflo(a1.w), bfhi(a1.w)};
            float x2[8] = {bflo(a2.x), bfhi(a2.x), bflo(a2.y), bfhi(a2.y), bflo(a2.z), bfhi(a2.z), bflo(a2.w), bfhi(a2.w)};
            float ss = 0.f;
#pragma unroll
            for (int i = 0; i < 8; ++i) ss += x1[i] * x1[i] + x2[i] * x2[i];
            ss += __shfl_xor(ss, 1); ss += __shfl_xor(ss, 2);
            const float r = rsqrtf(ss * (1.f / 64.f) + EPS) * (which ? 1.f : QSCALE);
            const float* gn = which ? kg : qg; float o1[8], o2[8];
#pragma unroll
            for (int i = 0; i < 8; ++i) { const float u1 = x1[i] * r * gn[sub * 8 + i], u2 = x2[i] * r * gn[32 + sub * 8 + i]; o1[i] = u1 * cs[i] - u2 * sn[i]; o2[i] = u2 * cs[i] + u1 * sn[i]; }
            bf16* dst = (which ? KN : QN) + (size_t)m * 1024 + g * 64 + sub * 8;
            v4u w1, w2; w1.x = pk2(o1[0], o1[1]); w1.y = pk2(o1[2], o1[3]); w1.z = pk2(o1[4], o1[5]); w1.w = pk2(o1[6], o1[7]);
            w2.x = pk2(o2[0], o2[1]); w2.y = pk2(o2[2], o2[3]); w2.z = pk2(o2[4], o2[5]); w2.w = pk2(o2[6], o2[7]);
            *(v4u*)dst = w1; *(v4u*)(dst + 32) = w2;
        }
    }
}

__device__ __forceinline__ void mlA_unit(const Ctx& C, int u, const Args& a) {
    const bf16* PROJ = (const bf16*)(a.ws + WS_PROJ); const float* MG = (const float*)(a.ws + WS_MG); const float* MSC = (const float*)(a.ws + WS_MSC);
    bf16* U = (bf16*)(a.ws + WS_U); float* NU = (float*)(a.ws + WS_NU);
    const int b = u >> 8, hh = (u >> 6) & 3, j = u & 63, chain0 = (b * 4 + hh) * 2;
    const size_t row0 = (size_t)b * S + j * 64;
    const int tid = C.tid, lane = C.lane, w = C.wave;
    LAS unsigned char* lds = C.lds;
    constexpr int KI = 0, VI = 20480, WKF = 57344, WKB = 77824, WF = 98304;
    __syncthreads();
#pragma unroll
    for (int i = 0; i < 2; ++i) { const int p = tid + 512 * i, row = p >> 4, c = p & 15;
        *(LAS v4u*)(lds + KI + row * 320 + c * 16) = *(const v4u*)(PROJ + (row0 + row) * NPJ + P_MK + hh * 128 + c * 8); }
#pragma unroll
    for (int i = 0; i < 4; ++i) { const int p = tid + 512 * i, row = p >> 5, c = p & 31;
        *(LAS v4u*)(lds + VI + row * 576 + c * 16) = *(const v4u*)(PROJ + (row0 + row) * NPJ + P_MV + hh * 256 + c * 8); }
    if (w < 2) {
        const int dir = w, t = lane;
        const float fgv = MG[(row0 + t) * 16 + (dir ? 12 : 4) + hh], igv = MG[(row0 + t) * 16 + (dir ? 8 : 0) + hh];
        const float lf = logsigf_(fgv), P = incl_sum_up(lf, lane), Gt = __shfl(P, 63);
        const float bcur = dir ? (Gt - P + lf) : P;
        const MScan ms = mscan(MSC, chain0 + dir, lane);
        const float av = Gt - bcur + igv, mnew = rdlane(ms.mnew, j);
        ((LAS float*)(lds + WF + dir * 256))[t] = __expf(av - mnew);
    }
    __syncthreads();
#pragma unroll
    for (int i = 0; i < 2; ++i) { const int p = tid + 512 * i, row = p >> 4, c = p & 15;
        const v4u kv = *(LAS v4u*)(lds + KI + row * 320 + c * 16);
        const float wf = ((LAS float*)(lds + WF))[row], wb = ((LAS float*)(lds + WF + 256))[row];
        *(LAS v4u*)(lds + WKF + row * 320 + c * 16) = scale8(kv, wf);
        *(LAS v4u*)(lds + WKB + row * 320 + c * 16) = scale8(kv, wb); }
    if (tid < 256) { const int dir = tid >> 7, k = tid & 127; float s = 0.f;
        for (int t = 0; t < 64; ++t) s += ((LAS float*)(lds + WF + dir * 256))[t] * bf2f(*(LAS bf16*)(lds + KI + t * 320 + k * 2));
        NU[(size_t)((chain0 + dir) * 64 + j) * 128 + k] = s; }
    __syncthreads();
    const int G_ = (lane >> 4) & 1, i16 = lane & 15, q_ = i16 >> 2, p_ = i16 & 3, h = lane >> 5, r32 = lane & 31;
    f32x16 acc[2][4];
#pragma unroll
    for (int d = 0; d < 2; ++d)
#pragma unroll
        for (int n = 0; n < 4; ++n) acc[d][n] = f32x16{};
#pragma unroll
    for (int s = 0; s < 4; ++s) {
        LAS unsigned char* va = lds + VI + (16 * s + 8 * h + q_) * 576 + (32 * w + 16 * G_ + 4 * p_) * 2;
        const bf16x8 af = cat8(trr(va), trr(va + 4 * 576));
#pragma unroll
        for (int d = 0; d < 2; ++d)
#pragma unroll
            for (int n = 0; n < 4; ++n) {
                LAS unsigned char* ba = lds + (d ? WKB : WKF) + (16 * s + 8 * h + q_) * 320 + (32 * n + 16 * G_ + 4 * p_) * 2;
                const bf16x8 bfr = cat8(trr(ba), trr(ba + 4 * 320));
                acc[d][n] = __builtin_amdgcn_mfma_f32_32x32x16_bf16(bfr, af, acc[d][n], 0, 0, 0);
            }
    }
    __syncthreads();
    LAS unsigned char* ut = lds + w * 4096;
#pragma unroll
    for (int d = 0; d < 2; ++d) {
#pragma unroll
        for (int n = 0; n < 4; ++n)
#pragma unroll
            for (int g4 = 0; g4 < 4; ++g4) { int o = 0; o = __builtin_amdgcn_cvt_pk_fp8_f32(sat8(acc[d][n][4 * g4 + 0]), sat8(acc[d][n][4 * g4 + 1]), o, false); o = __builtin_amdgcn_cvt_pk_fp8_f32(sat8(acc[d][n][4 * g4 + 2]), sat8(acc[d][n][4 * g4 + 3]), o, true);
                *(LAS int*)(ut + r32 * 128 + ((32 * n + 8 * g4 + 4 * h) ^ ((r32 & 7) << 4))) = o; }
        unsigned char* ub = (unsigned char*)U + ((size_t)((chain0 + d) * 64 + j) * 256 + 32 * w) * 128;
#pragma unroll
        for (int i = 0; i < 4; ++i) { const int row = 8 * i + (lane >> 3), ch = lane & 7;
            const v4u v = *(LAS v4u*)(ut + row * 128 + ((ch ^ (row & 7)) << 4));
            *(v4u*)(ub + (size_t)row * 128 + ch * 16) = v; }
    }
}
__device__ __forceinline__ void mlB_scan(const Ctx& C, const Args& a) {
    const bf16* __restrict__ U = (const bf16*)(a.ws + WS_U); bf16* __restrict__ CP = (bf16*)(a.ws + WS_CP); const float* MSC = (const float*)(a.ws + WS_MSC);
    const float* __restrict__ NU = (const float*)(a.ws + WS_NU); float* __restrict__ NP = (float*)(a.ws + WS_NP);
    for (int g = C.vcu * NTHR + C.tid; g < 16 * 8192; g += C.G * NTHR) {
        const int chain = __builtin_amdgcn_readfirstlane(g >> 13), e4 = g & 8191, dir = chain & 1;
        const MScan ms = mscan(MSC, chain, C.lane);
        const unsigned char* ub = (const unsigned char*)U + (size_t)chain * 64 * 32768 + 4 * e4; unsigned char* cb = (unsigned char*)CP + (size_t)chain * 64 * 32768 + 4 * e4;
        f32x4 st = {0.f, 0.f, 0.f, 0.f};
#pragma unroll 8
        for (int ci = 0; ci < 64; ++ci) { const int c = dir ? 63 - ci : ci; const float dec = rdlane(ms.dec, c);
            { int o = 0; o = __builtin_amdgcn_cvt_pk_fp8_f32(sat8(st.x), sat8(st.y), o, false); o = __builtin_amdgcn_cvt_pk_fp8_f32(sat8(st.z), sat8(st.w), o, true); *(int*)(cb + (size_t)c * 32768) = o; }
            const int ur = *(const int*)(ub + (size_t)c * 32768); const f32x4 uv = {__builtin_amdgcn_cvt_f32_fp8(ur, 0), __builtin_amdgcn_cvt_f32_fp8(ur, 1), __builtin_amdgcn_cvt_f32_fp8(ur, 2), __builtin_amdgcn_cvt_f32_fp8(ur, 3)}; st = st * dec + uv; }
    }
    const int g = C.vcu * NTHR + C.tid;
    if (g < 512) { const int chain = g >> 5, k4 = g & 31, dir = chain & 1; f32x4 st = {0.f, 0.f, 0.f, 0.f};
        const int chA = __builtin_amdgcn_readfirstlane(chain); const MScan m0 = mscan(MSC, chA, C.lane), m1 = mscan(MSC, chA + 1, C.lane);
        for (int ci = 0; ci < 64; ++ci) { const int c = dir ? 63 - ci : ci; const float d0 = __shfl(m0.dec, c), d1 = __shfl(m1.dec, c); const float dec = (chain == chA) ? d0 : d1;
            *(f32x4*)(NP + (size_t)(chain * 64 + c) * 128 + 4 * k4) = st;
            const f32x4 uv = *(const f32x4*)(NU + (size_t)(chain * 64 + c) * 128 + 4 * k4); st = st * dec + uv; } }
}
__device__ __forceinline__ void mlC_unit(const Ctx& C, int u, const Args& a) {
    const bf16* PROJ = (const bf16*)(a.ws + WS_PROJ); const float* MG = (const float*)(a.ws + WS_MG); const float* MSC = (const float*)(a.ws + WS_MSC);
    const bf16* CP = (const bf16*)(a.ws + WS_CP); const float* NP = (const float*)(a.ws + WS_NP); const float* mlg = a.in[4]; bf16* HM = (bf16*)(a.ws + WS_HM);
    const int b = u >> 8, hh = (u >> 6) & 3, j = u & 63, chain0 = (b * 4 + hh) * 2;
    const size_t row0 = (size_t)b * S + j * 64;
    const int tid = C.tid, lane = C.lane, w = C.wave;
    LAS unsigned char* lds = C.lds;
    constexpr int QI = 0, KI = 17408, VI = 34816, SI = 71680, PI = 89088, SC = 98304;
    constexpr int NQ = SC + 2048, NPL = SC + 6144, SSO = SC + 7168, RS = SC + 9216;
    __syncthreads();
#pragma unroll
    for (int i = 0; i < 2; ++i) { const int p = tid + 512 * i, row = p >> 4, c = p & 15;
        *(LAS v4u*)(lds + QI + row * 272 + c * 16) = *(const v4u*)(PROJ + (row0 + row) * NPJ + P_MQ + hh * 128 + c * 8);
        *(LAS v4u*)(lds + KI + row * 272 + c * 16) = *(const v4u*)(PROJ + (row0 + row) * NPJ + P_MK + hh * 128 + c * 8); }
#pragma unroll
    for (int i = 0; i < 4; ++i) { const int p = tid + 512 * i, row = p >> 5, c = p & 31;
        *(LAS v4u*)(lds + VI + row * 576 + c * 16) = *(const v4u*)(PROJ + (row0 + row) * NPJ + P_MV + hh * 256 + c * 8); }
    if (tid < 256) ((LAS float*)(lds + NPL))[tid] = NP[(size_t)((chain0 + (tid >> 7)) * 64 + j) * 128 + (tid & 127)];
    v2u cpr[2][8];
#pragma unroll
    for (int d = 0; d < 2; ++d) { const unsigned char* cp = (const unsigned char*)CP + ((size_t)((chain0 + d) * 64 + j) * 256 + 32 * w + (lane & 31)) * 128 + 8 * (lane >> 5);
#pragma unroll
        for (int ks = 0; ks < 8; ++ks) cpr[d][ks] = *(const v2u*)(cp + 16 * ks); }
    if (w < 2) {
        const int dir = w, t = lane;
        const float fgv = MG[(row0 + t) * 16 + (dir ? 12 : 4) + hh], igv = MG[(row0 + t) * 16 + (dir ? 8 : 0) + hh];
        const float lf = logsigf_(fgv), P = incl_sum_up(lf, lane), Gt = __shfl(P, 63);
        const float bcur = dir ? (Gt - P + lf) : P, cv = igv - bcur;
        const float pm = dir ? incl_max_down(cv, lane) : incl_max_up(cv, lane);
        const MScan ms = mscan(MSC, chain0 + dir, lane); const float mprev = rdlane(ms.mprev, j);
        const float mt = bcur + fmaxf(mprev, pm), si = __expf(bcur + mprev - mt);
        LAS float* sc = (LAS float*)(lds + SC + dir * 1024);
        sc[t] = bcur; sc[64 + t] = cv; sc[128 + t] = mt; sc[192 + t] = si;
    }
    __syncthreads();
    {
        const int fr = lane & 15, fq = lane >> 4;
#pragma unroll
        for (int tt = 0; tt < 2; ++tt) { const int tile = 2 * w + tt, ti = tile >> 2, si_ = tile & 3; f32x4 acc4 = {0.f, 0.f, 0.f, 0.f};
#pragma unroll
            for (int ks = 0; ks < 4; ++ks) {
                const bf16x8 aq = *(LAS bf16x8*)(lds + QI + (16 * ti + fr) * 272 + (32 * ks + 8 * fq) * 2);
                const bf16x8 bk = *(LAS bf16x8*)(lds + KI + (16 * si_ + fr) * 272 + (32 * ks + 8 * fq) * 2);
                acc4 = __builtin_amdgcn_mfma_f32_16x16x32_bf16(aq, bk, acc4, 0, 0, 0); }
#pragma unroll
            for (int i = 0; i < 4; ++i) ((LAS float*)(lds + SI))[(16 * ti + 4 * fq + i) * 68 + 16 * si_ + fr] = acc4[i]; }
        const int t = tid & 63, part = tid >> 6;
        const v4u q0 = *(LAS v4u*)(lds + QI + t * 272 + part * 32), q1 = *(LAS v4u*)(lds + QI + t * 272 + part * 32 + 16);
        const float qv[16] = {bflo(q0.x), bfhi(q0.x), bflo(q0.y), bfhi(q0.y), bflo(q0.z), bfhi(q0.z), bflo(q0.w), bfhi(q0.w), bflo(q1.x), bfhi(q1.x), bflo(q1.y), bfhi(q1.y), bflo(q1.z), bfhi(q1.z), bflo(q1.w), bfhi(q1.w)};
#pragma unroll
        for (int d = 0; d < 2; ++d) { float s = 0.f;
#pragma unroll
            for (int k = 0; k < 16; ++k) s += ((LAS float*)(lds + NPL))[d * 128 + part * 16 + k] * qv[k];
            ((LAS float*)(lds + NQ))[(d * 8 + part) * 64 + t] = s; }
    }
    __syncthreads();
    {
        const int t = tid >> 3, sg = tid & 7, s0 = 8 * sg;
        const f32x4 sa = *(LAS f32x4*)(lds + SI + (t * 68 + s0) * 4), sb = *(LAS f32x4*)(lds + SI + (t * 68 + s0 + 4) * 4);
        const float sv[8] = {sa.x, sa.y, sa.z, sa.w, sb.x, sb.y, sb.z, sb.w};
        float p[2][8], inv[2];
#pragma unroll
        for (int d = 0; d < 2; ++d) { LAS float* sc = (LAS float*)(lds + SC + d * 1024);
            const float Bt = sc[t], MTt = sc[128 + t], SIt = sc[192 + t]; float rs = 0.f;
#pragma unroll
            for (int e = 0; e < 8; ++e) { const int s = s0 + e; const bool ok = d ? (s >= t) : (s <= t);
                const float dv = ok ? __expf(Bt + sc[64 + s] - MTt) : 0.f; p[d][e] = dv * sv[e]; rs += p[d][e]; }
            float nq = ((LAS float*)(lds + NQ))[(d * 8 + sg) * 64 + t];
            rs += __shfl_xor(rs, 1); rs += __shfl_xor(rs, 2); rs += __shfl_xor(rs, 4);
            nq += __shfl_xor(nq, 1); nq += __shfl_xor(nq, 2); nq += __shfl_xor(nq, 4);
            const float den = fmaxf(fabsf(SIt * nq + rs), __expf(-MTt)); inv[d] = 1.f / den;
            if (sg == 0) ((LAS float*)(lds + RS))[d * 64 + t] = SIt * inv[d]; }
        float o[8];
#pragma unroll
        for (int e = 0; e < 8; ++e) o[e] = p[0][e] * inv[0] + p[1][e] * inv[1];
        v4u wv; wv.x = pk2(o[0], o[1]); wv.y = pk2(o[2], o[3]); wv.z = pk2(o[4], o[5]); wv.w = pk2(o[6], o[7]);
        *(LAS v4u*)(lds + PI + t * 144 + s0 * 2) = wv;
    }
    __syncthreads();
#pragma unroll
    for (int i = 0; i < 2; ++i) { const int p = tid + 512 * i, row = p >> 4, c = p & 15;
        const v4u qv = *(LAS v4u*)(lds + QI + row * 272 + c * 16);
        const float rf = ((LAS float*)(lds + RS))[row], rb = ((LAS float*)(lds + RS))[64 + row];
        *(LAS v4u*)(lds + QI + row * 272 + c * 16) = scale8(qv, rf);
        *(LAS v4u*)(lds + KI + row * 272 + c * 16) = scale8(qv, rb); }
    __syncthreads();
    const int G_ = (lane >> 4) & 1, i16 = lane & 15, q_ = i16 >> 2, p_ = i16 & 3, h = lane >> 5, r32 = lane & 31;
    f32x16 acc[2]; acc[0] = f32x16{}; acc[1] = f32x16{};
#pragma unroll
    for (int d = 0; d < 2; ++d) {
#pragma unroll
        for (int ks = 0; ks < 8; ++ks) { const v2u cr = cpr[d][ks]; v4u a4;
            a4.x = pk2(__builtin_amdgcn_cvt_f32_fp8((int)cr.x, 0), __builtin_amdgcn_cvt_f32_fp8((int)cr.x, 1)); a4.y = pk2(__builtin_amdgcn_cvt_f32_fp8((int)cr.x, 2), __builtin_amdgcn_cvt_f32_fp8((int)cr.x, 3));
            a4.z = pk2(__builtin_amdgcn_cvt_f32_fp8((int)cr.y, 0), __builtin_amdgcn_cvt_f32_fp8((int)cr.y, 1)); a4.w = pk2(__builtin_amdgcn_cvt_f32_fp8((int)cr.y, 2), __builtin_amdgcn_cvt_f32_fp8((int)cr.y, 3));
            const bf16x8 af = __builtin_bit_cast(bf16x8, a4);
#pragma unroll
            for (int th = 0; th < 2; ++th) { const bf16x8 bq = *(LAS bf16x8*)(lds + (d ? KI : QI) + (32 * th + r32) * 272 + (16 * ks + 8 * h) * 2);
                acc[th] = __builtin_amdgcn_mfma_f32_32x32x16_bf16(af, bq, acc[th], 0, 0, 0); } } }
#pragma unroll
    for (int ks = 0; ks < 4; ++ks) { LAS unsigned char* va = lds + VI + (16 * ks + 8 * h + q_) * 576 + (32 * w + 16 * G_ + 4 * p_) * 2;
        const bf16x8 af = cat8(trr(va), trr(va + 4 * 576));
#pragma unroll
        for (int th = 0; th < 2; ++th) { const bf16x8 bp = *(LAS bf16x8*)(lds + PI + (32 * th + r32) * 144 + (16 * ks + 8 * h) * 2);
            acc[th] = __builtin_amdgcn_mfma_f32_32x32x16_bf16(af, bp, acc[th], 0, 0, 0); } }
#pragma unroll
    for (int th = 0; th < 2; ++th) { float ss = 0.f;
#pragma unroll
        for (int r = 0; r < 16; ++r) ss += acc[th][r] * acc[th][r];
        ss += __shfl_xor(ss, 32);
        if (h == 0) ((LAS float*)(lds + SSO))[w * 64 + 32 * th + r32] = ss; }
    __syncthreads();
#pragma unroll
    for (int th = 0; th < 2; ++th) { float tot = 0.f;
#pragma unroll
        for (int ww = 0; ww < 8; ++ww) tot += ((LAS float*)(lds + SSO))[ww * 64 + 32 * th + r32];
        const float rr = rsqrtf(tot * (1.f / 256.f) + EPS); const size_t tok = row0 + 32 * th + r32;
#pragma unroll
        for (int g4 = 0; g4 < 4; ++g4) { const int v0 = 32 * w + 8 * g4 + 4 * h;
            const f32x4 gn = *(const f32x4*)(mlg + v0); const v2u sm = *(const v2u*)(PROJ + tok * NPJ + P_MO + hh * 256 + v0);
            v2u o; o.x = pk2(acc[th][4 * g4 + 0] * rr * gn.x * bflo(sm.x), acc[th][4 * g4 + 1] * rr * gn.y * bfhi(sm.x));
            o.y = pk2(acc[th][4 * g4 + 2] * rr * gn.z * bflo(sm.y), acc[th][4 * g4 + 3] * rr * gn.w * bfhi(sm.y));
            *(v2u*)(HM + tok * 1024 + hh * 256 + v0) = o; } }
}

constexpr int AT_BUF = 32768, AT_K2 = 8192, AT_V = 16384, AT_CV = 65536, AT_DUMMY = AT_CV + 8 * 8448;
__device__ __forceinline__ void at_dma(unsigned off, const char* base, unsigned ldsaddr) { unsigned keep;
    asm volatile("s_mov_b32 %0, m0\n\ts_mov_b32 m0, %3\n\ts_nop 0\n\tglobal_load_lds_dwordx4 %1, %2\n\ts_mov_b32 m0, %0" : "=&s"(keep) : "v"(off), "s"(base), "s"(ldsaddr) : "memory"); }
__device__ __forceinline__ void attn_unit(const Ctx& C, int u, int uidx, const Args& a, int lam_s, Conv& cv) {
    const bf16* QN = (const bf16*)(a.ws + WS_QN); const bf16* KN = (const bf16*)(a.ws + WS_KN); const bf16* PROJ = (const bf16*)(a.ws + WS_PROJ);
    const int b = u >> 8, hh = (u >> 5) & 7, qb = u & 31;
    const int lane = C.lane, w = C.wave, rg = w >> 1, mp = w & 1, r32 = lane & 31, h = lane >> 5;
    LAS unsigned char* lds = C.lds; const unsigned ldsb = (unsigned)(uintptr_t)lds;
    const size_t rowbase = (size_t)b * S; const int NGW = C.G * NWAVES;
    unsigned ko, vo0;
    { const int row = 8 * w + (lane >> 3), c = (lane & 7) ^ ((row >> 1) & 7); ko = (unsigned)((row * 1024 + c * 8) * 2); }
    { const int row = 8 * w + (lane >> 4), ch = (lane & 15) ^ ((row & 3) << 2); vo0 = (unsigned)((row * NPJ + ch * 8) * 2); }
    const char* kbase = (const char*)(KN + rowbase * 1024 + hh * 128); const char* vbase = (const char*)(PROJ + rowbase * NPJ + P_DV + hh * 128);
#define AT_TILE_DMA(t_, bufoff_) do { const char* kb__ = uni_ptr(kbase + (size_t)(t_) * 64 * 1024 * 2); const char* vb__ = uni_ptr(vbase + (size_t)(t_) * 64 * NPJ * 2); \
        const unsigned d__ = (unsigned)__builtin_amdgcn_readfirstlane((int)(ldsb + (bufoff_))); \
        at_dma(ko, kb__, d__ + w * 1024); at_dma(ko, kb__ + 128, d__ + AT_K2 + w * 1024); at_dma(vo0, vb__, d__ + AT_V + w * 2048); at_dma(vo0, vb__ + 4 * NPJ * 2, d__ + AT_V + w * 2048 + 1024); } while (0)
    bf16x8 qf[4];
    { const bf16* qsrc = QN + (rowbase + qb * 128 + rg * 32 + r32) * 1024 + hh * 128 + mp * 64 + h * 8;
#pragma unroll
      for (int d0 = 0; d0 < 4; ++d0) qf[d0] = *(const bf16x8*)(qsrc + 16 * d0); }
    f32x16 O[4];
#pragma unroll
    for (int d0 = 0; d0 < 4; ++d0) O[d0] = f32x16{};
    float lsum = 0.f;
    const int G_ = (lane >> 4) & 1, i16 = lane & 15, q_ = i16 >> 2, p_ = i16 & 3;
    const int kofb = mp * AT_K2 + r32 * 128 + ((h ^ ((r32 >> 1) & 1)) << 4) + (((r32 >> 2) & 3) << 5);
    const int vofb = AT_V + (4 * h + q_) * 256 + (q_ << 6) + 32 * G_ + 8 * p_;
#define kof(d0) (kofb ^ ((d0) << 5))
#define vof(d0) (vofb ^ ((d0) << 6))
    asm volatile("s_waitcnt lgkmcnt(0)" ::: "memory"); __builtin_amdgcn_s_barrier(); asm volatile("" ::: "memory");
    AT_TILE_DMA(0, 0);
    asm volatile("s_waitcnt vmcnt(0)" ::: "memory"); __builtin_amdgcn_s_barrier(); asm volatile("" ::: "memory");
#define AT_ITER(t_, SET_, TICK_) do { \
        LAS unsigned char* cur = lds + ((t_) & 1) * AT_BUF; \
        if ((t_) + 1 < S / 64) AT_TILE_DMA((t_) + 1, (((t_) + 1) & 1) * AT_BUF); \
        else { const unsigned d__ = (unsigned)__builtin_amdgcn_readfirstlane((int)(ldsb + AT_DUMMY)); const char* kb__ = uni_ptr(kbase); at_dma(ko, kb__, d__); at_dma(ko, kb__, d__); at_dma(ko, kb__, d__); at_dma(ko, kb__, d__); } \
        int cit_ = cv.it, cst_ = cv.step; conv_next(cit_, cst_, NGW); const ConvSrc csrc_ = conv_src(a, cit_); const unsigned cloff_ = conv_loff(csrc_, lane); (void)cst_; (void)cloff_; \
        _Pragma("unroll") for (int hv = 0; hv < 2; ++hv) { f32x16 pp = f32x16{}; \
            _Pragma("unroll") for (int d0 = 0; d0 < 4; ++d0) { const bf16x8 ka = *(LAS bf16x8*)(cur + kof(d0) + hv * 32 * 128); pp = __builtin_amdgcn_mfma_f32_32x32x16_bf16(ka, qf[d0], pp, 0, 0, 0); } \
            if (TICK_) conv_issue_one(cv.s[(SET_) ^ 1], csrc_, cloff_, cst_, 4 * hv + 0); \
            _Pragma("unroll") for (int r = 0; r < 16; ++r) { pp[r] = __builtin_amdgcn_exp2f(pp[r]); lsum += pp[r]; } \
            if (TICK_) conv_issue_one(cv.s[(SET_) ^ 1], csrc_, cloff_, cst_, 4 * hv + 1); \
            _Pragma("unroll") for (int k2 = 0; k2 < 2; ++k2) { const int o = 8 * k2; \
                v4u t4; t4.x = pk2(pp[o + 0], pp[o + 1]); t4.y = pk2(pp[o + 2], pp[o + 3]); t4.z = pk2(pp[o + 4], pp[o + 5]); t4.w = pk2(pp[o + 6], pp[o + 7]); \
                const bf16x8 pa = __builtin_bit_cast(bf16x8, t4); \
                _Pragma("unroll") for (int d0 = 0; d0 < 4; ++d0) { LAS unsigned char* va = cur + vof(d0) + (32 * hv + 16 * k2) * 256; \
                    const bf16x8 vf = cat8(trr(va), trr(va + 8 * 256)); \
                    O[d0] = __builtin_amdgcn_mfma_f32_32x32x16_bf16(vf, pa, O[d0], 0, 0, 0); } \
                if (TICK_) conv_issue_one(cv.s[(SET_) ^ 1], csrc_, cloff_, cst_, 4 * hv + 2 + k2); } } \
        if (TICK_) { if (conv_consume<12>(cv, cv.s[SET_], a, lds + AT_CV + w * 8448, NGW, lane)) asm volatile("s_waitcnt vmcnt(16) lgkmcnt(0)" ::: "memory"); \
            else asm volatile("s_waitcnt vmcnt(8) lgkmcnt(0)" ::: "memory"); } \
        else asm volatile("s_waitcnt vmcnt(0) lgkmcnt(0)" ::: "memory"); \
        __builtin_amdgcn_s_barrier(); asm volatile("" ::: "memory"); \
    } while (0)
    { const int slot = C.vcu & 3; int pa = 64, pb = 64;
      if ((slot >> 1) == uidx) { pa = 32 * (slot & 1); pb = pa + 32; }
      int t = 0;
      for (; t < pa; t += 2) { AT_ITER(t, 0, true); AT_ITER(t + 1, 1, true); }
      for (; t < pb; t += 2) { AT_ITER(t, 0, false); AT_ITER(t + 1, 1, false); }
      for (; t < S / 64; t += 2) { AT_ITER(t, 0, true); AT_ITER(t + 1, 1, true); } }
#undef AT_ITER
#undef AT_TILE_DMA
#undef kof
#undef vof
    lsum += __shfl_xor(lsum, 32);
    const float inv = 1.f / lsum;
    int le = C.tid & 63; asm volatile("" : "+v"(le));
    LAS float* ex = (LAS float*)lds + rg * 4096;
    if (mp == 1) {
#pragma unroll
        for (int d0 = 0; d0 < 4; ++d0)
#pragma unroll
            for (int r = 0; r < 16; ++r) ex[(d0 * 16 + r) * 64 + le] = O[d0][r] * inv; }
    asm volatile("s_waitcnt lgkmcnt(0)" ::: "memory"); __builtin_amdgcn_s_barrier(); asm volatile("" ::: "memory");
    if (mp == 0) {
        float ss = 0.f; int lb_ = lam_s; asm volatile("" : "+s"(lb_)); const float lamv = __int_as_float(lb_);
#pragma unroll
        for (int d0 = 0; d0 < 4; ++d0)
#pragma unroll
            for (int r = 0; r < 16; ++r) { const float o = O[d0][r] * inv - lamv * ex[(d0 * 16 + r) * 64 + le]; O[d0][r] = o; ss += o * o; }
        ss += __shfl_xor(ss, 32);
        const float rr = rsqrtf(ss * (1.f / 128.f) + EPS) * (1.f - LAM_INIT);
        const size_t tok = (size_t)b * S + qb * 128 + rg * 32 + (le & 31); const int he = le >> 5;
        bf16* odp = (bf16*)(a.ws + WS_OD) + tok * 1024 + hh * 128 + 4 * he;
#pragma unroll
        for (int d0 = 0; d0 < 4; ++d0)
#pragma unroll
            for (int g4 = 0; g4 < 4; ++g4) { const int dv0 = 32 * d0 + 8 * g4; const f32x4 gn = *(const f32x4*)(a.in[9] + dv0 + 4 * he);
                v2u o; o.x = pk2(O[d0][4 * g4 + 0] * rr * gn.x, O[d0][4 * g4 + 1] * rr * gn.y); o.y = pk2(O[d0][4 * g4 + 2] * rr * gn.z, O[d0][4 * g4 + 3] * rr * gn.w);
                *(v2u*)(odp + dv0) = o; }
    }
}

__device__ __forceinline__ void p8_router(const Ctx& C, const Args& a) {
    const float* x1 = a.out; const float* g2 = a.in[12]; const float* br = a.in[14];
    const bf16* WRH = (const bf16*)(a.ws + WS_WRH); const bf16* WRL = (const bf16*)(a.ws + WS_WRL);
    unsigned char* H2 = a.ws + WS_H2; int* cnt = (int*)(a.ws + WS_CTL) + CW_WGCNT;
    int* TOPE = (int*)(a.ws + WS_RT); int* SLOT = TOPE + T * 4; float* WTS = (float*)(SLOT + T * 4);
    const int lane = C.lane, w = C.wave, r32 = lane & 31, h = lane >> 5;
    constexpr int XP = 4112, XT_BYTES = 32 * XP;
    LAS unsigned char* XT = C.lds;
    LAS float* PLG = (LAS float*)C.lds;
    LAS float* SSQ = (LAS float*)(C.lds + XT_BYTES);
    LAS float* LG = (LAS float*)(C.lds + XT_BYTES + 1024);
    LAS float* RSTD = (LAS float*)(C.lds + XT_BYTES + 1024 + 32 * 33 * 4);
    LAS int* lcnt = (LAS int*)(C.lds + XT_BYTES + 1024 + 32 * 33 * 4 + 128);
    static_assert(XT_BYTES + 1024 + 32 * 33 * 4 + 256 <= MISC_OFF, "router LDS");
    if (C.tid < NE) lcnt[C.tid] = 0;
    for (int m0 = C.vcu * 32; m0 < T; m0 += C.G * 32) {
        __syncthreads();
        f32x16 acc = f32x16{}; float ssq = 0.f;
        const float* xrow = x1 + (size_t)(m0 + r32) * D + 256 * w + 4 * h;
        const float* grow = g2 + 256 * w + 4 * h;
        const bf16* whp = WRH + (size_t)r32 * D + 256 * w + 8 * h; const bf16* wlp = WRL + (size_t)r32 * D + 256 * w + 8 * h;
        LAS unsigned char* xt = XT + r32 * XP + (256 * w + 4 * h) * 2;
#pragma unroll 4
        for (int s = 0; s < 16; ++s) {
            const f32x4 xa = *(const f32x4*)(xrow + 16 * s), xb = *(const f32x4*)(xrow + 16 * s + 8);
            const f32x4 ga = *(const f32x4*)(grow + 16 * s), gb = *(const f32x4*)(grow + 16 * s + 8);
            const bf16x8 wh = *(const bf16x8*)(whp + 16 * s), wl = *(const bf16x8*)(wlp + 16 * s);
            ssq += (xa.x * xa.x + xa.y * xa.y) + (xa.z * xa.z + xa.w * xa.w) + (xb.x * xb.x + xb.y * xb.y) + (xb.z * xb.z + xb.w * xb.w);
            const float hv[8] = {xa.x * ga.x, xa.y * ga.y, xa.z * ga.z, xa.w * ga.w, xb.x * gb.x, xb.y * gb.y, xb.z * gb.z, xb.w * gb.w};
            v4u hi4, lo4;
#pragma unroll
            for (int i = 0; i < 4; ++i) { const unsigned hp = pk2(hv[2 * i], hv[2 * i + 1]); ((unsigned*)&hi4)[i] = hp; ((unsigned*)&lo4)[i] = pk2(hv[2 * i] - bflo(hp), hv[2 * i + 1] - bfhi(hp)); }
            { v2u t0; t0.x = hi4.x; t0.y = hi4.y; v2u t1; t1.x = hi4.z; t1.y = hi4.w; *(LAS v2u*)(xt + 32 * s) = t0; *(LAS v2u*)(xt + 32 * s + 16) = t1; }
            const bf16x8 hh = __builtin_bit_cast(bf16x8, hi4), hl = __builtin_bit_cast(bf16x8, lo4);
            acc = __builtin_amdgcn_mfma_f32_32x32x16_bf16(wh, hh, acc, 0, 0, 0);
            acc = __builtin_amdgcn_mfma_f32_32x32x16_bf16(wh, hl, acc, 0, 0, 0);
            acc = __builtin_amdgcn_mfma_f32_32x32x16_bf16(wl, hh, acc, 0, 0, 0);
        }
        ssq += __shfl_xor(ssq, 32);
        if (h == 0) SSQ[w * 32 + r32] = ssq;
        __syncthreads();
        if (C.tid < 32) { float s = 0.f;
#pragma unroll
            for (int ww = 0; ww < 8; ++ww) s += SSQ[ww * 32 + C.tid];
            RSTD[C.tid] = rsqrtf(s * (1.f / D) + EPS); }
        __syncthreads();
#pragma unroll
        for (int it = 0; it < 4; ++it) { const int t = 4 * w + it, m = m0 + t; const float rs = RSTD[t];
#pragma unroll
            for (int j = 0; j < 8; ++j) { const v2u q = *(const LAS v2u*)(XT + t * XP + (lane + 64 * j) * 8);
                int o = 0; o = __builtin_amdgcn_cvt_pk_fp8_f32(bflo(q.x) * rs, bfhi(q.x) * rs, o, false); o = __builtin_amdgcn_cvt_pk_fp8_f32(bflo(q.y) * rs, bfhi(q.y) * rs, o, true);
                *((int*)(H2 + (size_t)m * D) + lane + 64 * j) = o; } }
        __syncthreads();
#pragma unroll
        for (int r = 0; r < 16; ++r) PLG[(w * 16 + r) * 64 + lane] = acc[r];
        __syncthreads();
#pragma unroll
        for (int q = 0; q < 2; ++q) { const int idx = C.tid + 512 * q, r = idx >> 6, l = idx & 63; float s = 0.f;
#pragma unroll
            for (int ww = 0; ww < 8; ++ww) s += PLG[(ww * 16 + r) * 64 + l];
            const int e = (r & 3) + 8 * (r >> 2) + 4 * (l >> 5), t = l & 31;
            LG[t * 33 + e] = s * RSTD[t] + br[e]; }
        __syncthreads();
#pragma unroll
        for (int ps = 0; ps < 2; ++ps) { const int t = 4 * w + 2 * ps + h, m = m0 + t; float v = LG[t * 33 + r32]; float tv[4]; int ti[4];
#pragma unroll
            for (int k = 0; k < 4; ++k) { float best = v;
#pragma unroll
                for (int o = 1; o < 32; o <<= 1) best = fmaxf(best, __shfl_xor(best, o));
                const unsigned long long bm = __ballot(v == best); const unsigned hm = h ? (unsigned)(bm >> 32) : (unsigned)bm; const int bi = __builtin_ctz(hm);
                tv[k] = best; ti[k] = bi; v = (r32 == bi) ? -INFINITY : v; }
            const float e1 = __expf(tv[1] - tv[0]), e2 = __expf(tv[2] - tv[0]), e3 = __expf(tv[3] - tv[0]); const float inv = 1.f / (1.f + e1 + e2 + e3);
            if (r32 < 4) { const int k = r32; const int tk = k == 0 ? ti[0] : k == 1 ? ti[1] : k == 2 ? ti[2] : ti[3]; const float wk = (k == 0 ? 1.f : k == 1 ? e1 : k == 2 ? e2 : e3) * inv;
                TOPE[m * 4 + k] = tk; SLOT[m * 4 + k] = __hip_atomic_fetch_add(lcnt + tk, 1, __ATOMIC_RELAXED, __HIP_MEMORY_SCOPE_WORKGROUP); WTS[m * 4 + k] = wk; } }
    }
    __syncthreads();
    if (C.tid < NE) cnt[C.vcu * NE + C.tid] = lcnt[C.tid];
}
__device__ __forceinline__ void p9_gather(const Ctx& C, const Args& a) {
    const unsigned char* H2 = a.ws + WS_H2; const int* wgcnt = (const int*)(a.ws + WS_CTL) + CW_WGCNT; int* cnt = (int*)(a.ws + WS_CTL) + CW_CNT;
    const int* TOPE = (const int*)(a.ws + WS_RT); const int* SLOT = TOPE + T * 4; int* DEST = (int*)(a.ws + WS_RT) + 3 * T * 4; unsigned char* XG = a.ws + WS_XG;
    const int gw = C.vcu * NWAVES + C.wave, NGW = C.G * NWAVES, lane = C.lane;
    int mycnt = 0, mybase = 0;
#pragma unroll 8
    for (int w = 0; w < C.G; ++w) { const int v = wgcnt[w * NE + (lane & 31)]; mycnt += v; mybase += (w < C.vcu) ? v : 0; }
    if (lane >= NE) { mycnt = 0; mybase = 0; }
    int tiles = (mycnt + PADM - 1) / PADM, inc = tiles;
#pragma unroll
    for (int o = 1; o < 32; o <<= 1) { const int t = __shfl_up(inc, o); if (lane >= o) inc += t; }
    const int startrow = (inc - tiles) * PADM;
    if (gw == 0 && lane < NE) cnt[lane] = mycnt;
    for (int m0 = C.vcu * 32; m0 < T; m0 += C.G * 32) for (int it = 0; it < 4; ++it) { const int t = m0 + 4 * C.wave + it;
#pragma unroll
        for (int k = 0; k < 4; ++k) { const int q = t * 4 + k, e = TOPE[q]; const int row = __shfl(startrow, e) + __shfl(mybase, e) + SLOT[q];
            if (lane == 0) DEST[q] = row;
            const v4u* src = (const v4u*)(H2 + (size_t)t * D) + lane; v4u* dst = (v4u*)(XG + (size_t)row * D) + lane;
            dst[0] = src[0]; dst[64] = src[64]; } }
    for (int p = gw; p < NE * PADM; p += NGW) { const int e = p / PADM, qq = p % PADM; const int c = __shfl(mycnt, e), st = __shfl(startrow, e), tl = __shfl(tiles, e);
        if (c + qq < tl * PADM) { v4u* dst = (v4u*)(XG + (size_t)(st + c + qq) * D) + lane; const v4u z = {0u, 0u, 0u, 0u}; dst[0] = z; dst[64] = z; } }
}
__device__ __forceinline__ void p12_combine(const Ctx& C, const Args& a) {
    const bf16* Y = (const bf16*)(a.ws + WS_Y); const float* WTS = (const float*)(a.ws + WS_RT) + 2 * T * 4; const int* DEST = (const int*)(a.ws + WS_RT) + 3 * T * 4; float* out = a.out;
    const int gw = C.vcu * NWAVES + C.wave, NGW = C.G * NWAVES, lane = C.lane;
    for (int m = gw; m < T; m += NGW) { int d[4]; float wv[4];
#pragma unroll
        for (int k = 0; k < 4; ++k) { d[k] = DEST[m * 4 + k]; wv[k] = WTS[m * 4 + k]; }
#pragma unroll
        for (int j = 0; j < 8; ++j) { f32x4 o = *((const f32x4*)(out + (size_t)m * D) + lane + 64 * j);
#pragma unroll
            for (int k = 0; k < 4; ++k) { const int y = *((const int*)((const unsigned char*)Y + (size_t)d[k] * D) + lane + 64 * j);
                o.x += wv[k] * __builtin_amdgcn_cvt_f32_fp8(y, 0); o.y += wv[k] * __builtin_amdgcn_cvt_f32_fp8(y, 1); o.z += wv[k] * __builtin_amdgcn_cvt_f32_fp8(y, 2); o.w += wv[k] * __builtin_amdgcn_cvt_f32_fp8(y, 3); }
            *((f32x4*)(out + (size_t)m * D) + lane + 64 * j) = o; } }
}

constexpr int N_PHASES = 14;
__global__ void __launch_bounds__(NTHR, 2) mega_fwd(Args args) {
    extern __shared__ __attribute__((aligned(16))) unsigned char lds_raw[];
    Ctx C; C.lds = (LAS unsigned char*)lds_raw; C.tid = threadIdx.x; C.lane = C.tid & 63; C.wave = __builtin_amdgcn_readfirstlane(C.tid >> 6);
    C.G = gridDim.x; { const int bx = blockIdx.x; C.vcu = (C.G % 8 == 0) ? (bx % 8) * (C.G / 8) + bx / 8 : bx; }
    volatile LAS unsigned* MISC = (volatile LAS unsigned*)(C.lds + MISC_OFF);
    if (C.tid < 32) MISC[C.tid] = 0u;
    __syncthreads();
    unsigned* ctl = (unsigned*)(args.ws + WS_CTL);
    XcdBarrier bar = xcd_barrier_post(ctl + CW_BAR, MISC + 8);
    const int lo = args.ph_lo, hi = args.ph_hi;
#ifndef ONLY_MASK
#define ONLY_MASK 0xFFFF
#endif
#define IN(k) (((ONLY_MASK >> (k)) & 1) && lo <= (k) && (k) < hi)
#ifndef DBL_MASK
#define DBL_MASK 0
#endif
#define REP(k) for (int rep_ = 0; rep_ < (((DBL_MASK >> (k)) & 1) ? 2 : 1); ++rep_, (((DBL_MASK >> (k)) & 1) && rep_ == 1 ? xcd_barrier(bar) : (void)0))
#define SEAM(k) do { if (IN(k) && IN((k) + 1)) xcd_barrier(bar); } while (0)
    if (IN(0)) REP(0) { p0_transposes(C, args); p0_rope(C, args); p0_router_w(C, args); p0_xn_gates(C, args); }
    SEAM(0);
    if (IN(1)) REP(1) { p2_mstats(C, args);
        { pg8::Gemm g{(const bf16*)(args.ws + WS_XN), (const bf16*)(args.ws + WS_WIN), T, 6144, D}; pg8::StaticOrder So; So.init(T, 6144, C.G, (int)blockIdx.x);
          EpiProj<false> E{(bf16*)(args.ws + WS_PROJ), nullptr}; pg8::gemm_phase<EpiProj<false>, pg8::StaticOrder, true, true>(C.lds, g, So, E); }
        __syncthreads();
        { pg8::Gemm g{(const bf16*)(args.ws + WS_XN8), (const bf16*)(args.ws + WS_WIN8), T, 4096, D / 2}; pg8::StaticOrder So; So.init(T, 4096, C.G, (int)blockIdx.x);
          EpiProj<true> E{(bf16*)(args.ws + WS_PROJ), args.ws + WS_G8}; pg8::gemm_phase<EpiProj<true>, pg8::StaticOrder, true, true, true>(C.lds, g, So, E); } }
    SEAM(1);
    if (IN(2)) REP(2) { p2_late_transposes(C, args); p2_qkprep(C, args); }
    if (!(IN(2) && IN(3))) SEAM(2);
    if (IN(3)) REP(3) { for (int u = C.vcu; u < 512; u += C.G) mlA_unit(C, u, args); }
    SEAM(3);
    if (IN(4)) REP(4) { mlB_scan(C, args); }
    SEAM(4);
    if (IN(5)) REP(5) { for (int u = C.vcu; u < 512; u += C.G) mlC_unit(C, u, args); }
    if (IN(6)) REP(6) {
        const float* lp = args.in[8]; const float sa = wave_sum(lp[C.lane] * lp[64 + C.lane]), sb = wave_sum(lp[128 + C.lane] * lp[192 + C.lane]);
        const float lam = __expf(sa) - __expf(sb) + LAM_INIT;
        Conv cv; conv_begin(cv, args, C.vcu * NWAVES + C.wave, C.G * NWAVES, C.lane);
        int lam_s = __builtin_amdgcn_readfirstlane(__float_as_int(lam)); asm volatile("" : "+s"(lam_s));
        { int uidx = 0; for (int u = C.vcu; u < 512; u += C.G, ++uidx) attn_unit(C, u, uidx, args, lam_s, cv); }
        asm volatile("s_waitcnt lgkmcnt(0)" ::: "memory"); __builtin_amdgcn_s_barrier(); asm volatile("" ::: "memory");
        while (cv.it < CV_NJ) { conv_issue_next(cv, cv.s[1], args, C.G * NWAVES, C.lane); (void)conv_consume<8>(cv, cv.s[0], args, C.lds + AT_CV + C.wave * 8448, C.G * NWAVES, C.lane);
            conv_issue_next(cv, cv.s[0], args, C.G * NWAVES, C.lane); (void)conv_consume<8>(cv, cv.s[1], args, C.lds + AT_CV + C.wave * 8448, C.G * NWAVES, C.lane); }
        asm volatile("s_waitcnt vmcnt(0)" ::: "memory");
    }
    SEAM(6);
    if (IN(7)) REP(7) { __syncthreads();
        pg8::StaticOrder So; So.init(T, D, C.G, (int)blockIdx.x);
        if (So.nwg % C.G == 0) {
            static_assert(WS_OD - WS_HM == (size_t)T * MLW * 2 && WS_WDA - WS_WML == (size_t)D * MLW * 2 && MLW == DAW, "pair stream: operands of the two products must be adjacent");
            pg8::Gemm g{(const bf16*)(args.ws + WS_HM), (const bf16*)(args.ws + WS_WML), 2 * T, D, MLW}; PairOrder Po{So};
            EpiGatePair E{(const bf16*)(args.ws + WS_G8), (bf16*)(args.ws + WS_T1), (bf16*)(args.ws + WS_MIX)}; pg8::gemm_phase<EpiGatePair, PairOrder, true, true>(C.lds, g, Po, E);
        } else {
        { pg8::Gemm g{(const bf16*)(args.ws + WS_HM), (const bf16*)(args.ws + WS_WML), T, D, MLW};
          EpiGate<0> E{(const bf16*)(args.ws + WS_G8), nullptr, (bf16*)(args.ws + WS_T1)}; pg8::gemm_phase<EpiGate<0>, pg8::StaticOrder, true, true>(C.lds, g, So, E); }
        __syncthreads();
        { pg8::Gemm g{(const bf16*)(args.ws + WS_OD), (const bf16*)(args.ws + WS_WDA), T, D, DAW};
          EpiGate<1> E{(const bf16*)(args.ws + WS_G8), (const bf16*)(args.ws + WS_T1), (bf16*)(args.ws + WS_MIX)}; pg8::gemm_phase<EpiGate<1>, pg8::StaticOrder, true, true>(C.lds, g, So, E); }
        }
    }
    SEAM(7);
    if (IN(8)) REP(8) { pg8::Gemm g{(const bf16*)(args.ws + WS_MIX), (const bf16*)(args.ws + WS_WO), T, D, D}; pg8::StaticOrder So; So.init(T, D, C.G, (int)blockIdx.x);
        EpiRes E{args.in[0], args.out}; pg8::gemm_phase<EpiRes, pg8::StaticOrder, true, true>(C.lds, g, So, E); }
    SEAM(8);
    if (IN(9)) REP(9) { p8_router(C, args); }
    SEAM(9);
    if (IN(10)) REP(10) { p9_gather(C, args); }
    SEAM(10);
    if (IN(11)) REP(11) { MoeSched Ms; Ms.init((const int*)(args.ws + WS_CTL) + CW_CNT, 16, C.G, (int)blockIdx.x, C.lane);
        pg8::Gemm g{(const bf16*)(args.ws + WS_XG), (const bf16*)(args.ws + WS_WGU), MAXROWS, 2 * DE, D / 2};
        EpiAct E{args.in[16], args.ws + WS_ACT}; pg8::gemm_phase<EpiAct, MoeSched, true, true, true>(C.lds, g, Ms, E); }
    SEAM(11);
    if (IN(12)) REP(12) { MoeSched Ms; Ms.init((const int*)(args.ws + WS_CTL) + CW_CNT, 8, C.G, (int)blockIdx.x, C.lane);
        pg8::Gemm g{(const bf16*)(args.ws + WS_ACT), (const bf16*)(args.ws + WS_WDN), MAXROWS, D, DE / 2};
        EpiY E{args.in[18], (bf16*)(args.ws + WS_Y)}; pg8::gemm_phase<EpiY, MoeSched, true, true, true>(C.lds, g, Ms, E); }
    SEAM(12);
    if (IN(13)) REP(13) { p12_combine(C, args); }
#undef IN
#undef SEAM
}
#ifdef DEV_NAIVE
constexpr size_t NV_XN32 = WS_NAIVE, NV_PROJ32 = NV_XN32 + 64 * MiB, NV_F = NV_PROJ32 + 322 * MiB, NV_HF = NV_F + 1 * MiB, NV_OD32 = NV_HF + 64 * MiB, NV_MIX32 = NV_OD32 + 32 * MiB, NV_END = NV_MIX32 + 64 * MiB;
__device__ __forceinline__ float ldf(const float* p) { return *p; }
__device__ __forceinline__ float ldf(const bf16* p) { return bf2f(*p); }
__global__ __launch_bounds__(256) void k_rmsnorm(const float* __restrict__ x, const float* __restrict__ g, float* __restrict__ y) {
    const int row = blockIdx.x * 4 + (threadIdx.x >> 6), lane = threadIdx.x & 63;
    const float* xr = x + (size_t)row * D; float v[32]; float s = 0.f;
#pragma unroll
    for (int j = 0; j < 32; ++j) { v[j] = xr[lane + 64 * j]; s += v[j] * v[j]; }
    s = wave_sum(s); const float r = rsqrtf(s * (1.f / D) + EPS);
#pragma unroll
    for (int j = 0; j < 32; ++j) y[(size_t)row * D + lane + 64 * j] = v[j] * r * g[lane + 64 * j];
}
struct GArgs { const void* A; const float* B; void* C; int M, N, K, lda, ldb, ldc; const void* aux0; const void* aux1; const int* cnt; };
template <int EPI, typename TA> __global__ __launch_bounds__(256) void k_gemm(GArgs g) {
    __shared__ float As[16][64 + 4], Bs[16][64 + 4];
    const int tx = threadIdx.x & 15, ty = threadIdx.x >> 4;
    int m0 = blockIdx.y * 64, n0 = blockIdx.x * 64;
    const TA* A = (const TA*)g.A; const float* Bp = g.B; int M = g.M; int rowbase = 0; int e = 0;
    if (EPI == 4 || EPI == 5) {
        e = blockIdx.z; int start = 0;
        for (int i = 0; i < e; ++i) start += (g.cnt[i] + PADM - 1) / PADM * PADM;
        const int c = g.cnt[e]; if (m0 >= c) return;
        M = (c + PADM - 1) / PADM * PADM; rowbase = start;
        A = (const TA*)g.A + (size_t)rowbase * g.lda; Bp = g.B + (size_t)e * g.K * g.ldb;
    }
    float acc[4][4] = {};
    for (int k0 = 0; k0 < g.K; k0 += 16) {
        for (int i = threadIdx.x; i < 64 * 16; i += 256) { const int mm = i >> 4, kk = i & 15; const int m = m0 + mm; As[kk][mm] = (m < M) ? ldf(A + (size_t)m * g.lda + k0 + kk) : 0.f; }
        for (int i = threadIdx.x; i < 16 * 64; i += 256) { const int kk = i >> 6, nn = i & 63; const int n = n0 + nn; Bs[kk][nn] = (n < g.N) ? Bp[(size_t)(k0 + kk) * g.ldb + n] : 0.f; }
        __syncthreads();
#pragma unroll
        for (int kk = 0; kk < 16; ++kk) {
            float a[4], b[4];
#pragma unroll
            for (int i = 0; i < 4; ++i) { a[i] = As[kk][ty * 4 + i]; b[i] = Bs[kk][tx * 4 + i]; }
#pragma unroll
            for (int i = 0; i < 4; ++i)
#pragma unroll
                for (int j = 0; j < 4; ++j) acc[i][j] += a[i] * b[j];
        }
        __syncthreads();
    }
#pragma unroll
    for (int i = 0; i < 4; ++i) {
        const int m = m0 + ty * 4 + i; if (m >= M) continue;
        if (EPI == 4) {
            const float* bias = (const float*)g.aux0 + (size_t)e * g.N;
#pragma unroll
            for (int j = 0; j < 4; j += 2) {
                const int n = n0 + tx * 4 + j;
                float glu = acc[i][j] + bias[n], lin = acc[i][j + 1] + bias[n + 1];
                glu = fminf(glu, 7.f); lin = fminf(fmaxf(lin, -7.f), 7.f);
                ((bf16*)g.C)[(size_t)(rowbase + m) * g.ldc + (n >> 1)] = f2bf(glu * sigmoidf_(1.702f * glu) * (lin + 1.f));
            }
        } else {
#pragma unroll
            for (int j = 0; j < 4; ++j) {
                const int n = n0 + tx * 4 + j; if (n >= g.N) continue;
                const float v = acc[i][j];
                if (EPI == 0) ((float*)g.C)[(size_t)m * g.ldc + n] = v;
                if (EPI == 1) ((float*)g.C)[(size_t)m * g.ldc + n] = bf2f(((const bf16*)g.aux0)[(size_t)m * NPJ + P_GM + n]) * v;
                if (EPI == 2) ((float*)g.C)[(size_t)m * g.ldc + n] += bf2f(((const bf16*)g.aux0)[(size_t)m * NPJ + P_GD + n]) * v;
                if (EPI == 3) ((float*)g.C)[(size_t)m * g.ldc + n] = ((const float*)g.aux0)[(size_t)m * g.ldc + n] + v;
                if (EPI == 5) ((bf16*)g.C)[(size_t)(rowbase + m) * g.ldc + n] = f2bf(v + ((const float*)g.aux0)[(size_t)e * g.N + n]);
            }
        }
    }
}
__global__ __launch_bounds__(256) void k_pack(const float* __restrict__ P32, const float* __restrict__ gbias, bf16* __restrict__ PROJ, float* __restrict__ MG) {
    const int t = blockIdx.x;
    for (int c = threadIdx.x; c < NPJ; c += 256) { const int src = c < G_OFF ? c : c + 16; float v = P32[(size_t)t * DIN + src];
        if (c >= P_MK && c < P_MV) v *= KSCALE;
        if ((c >= P_MO && c < P_DQ) || c >= P_GM) v = sigmoidf_(v);
        PROJ[(size_t)t * NPJ + c] = f2bf(v); }
    if (threadIdx.x < 16) MG[(size_t)t * 16 + threadIdx.x] = P32[(size_t)t * DIN + G_OFF + threadIdx.x] + gbias[threadIdx.x];
}
__global__ __launch_bounds__(256) void k_rope(float* __restrict__ ROPE) {
    const int g = blockIdx.x * 256 + threadIdx.x; const int pos = g >> 5, i = g & 31;
    const double inv = exp2(-(double)i * (13.287712379549449 / 32.0));
    const float ang = (float)pos * (float)inv;
    ROPE[2 * g] = cosf(ang); ROPE[2 * g + 1] = sinf(ang);
}
__global__ __launch_bounds__(256) void k_qkprep(const bf16* __restrict__ PROJ, const float* __restrict__ ROPE, const float* __restrict__ qg, const float* __restrict__ kg, bf16* __restrict__ QN, bf16* __restrict__ KN) {
    const int t = blockIdx.x * 4 + (threadIdx.x >> 6), lane = threadIdx.x & 63;
    const int pos = t % S, g = lane >> 2, sub = lane & 3;
    for (int which = 0; which < 2; ++which) {
        const bf16* src = PROJ + (size_t)t * NPJ + (which ? P_DK : P_DQ) + g * 64;
        const float* gn = which ? kg : qg; bf16* dst = (which ? KN : QN) + (size_t)t * 1024 + g * 64;
        float x1[8], x2[8]; float ss = 0.f;
#pragma unroll
        for (int i = 0; i < 8; ++i) { x1[i] = bf2f(src[sub * 8 + i]); x2[i] = bf2f(src[32 + sub * 8 + i]); ss += x1[i] * x1[i] + x2[i] * x2[i]; }
        ss += __shfl_xor(ss, 1); ss += __shfl_xor(ss, 2);
        const float r = rsqrtf(ss * (1.f / 64.f) + EPS) * (which ? 1.f : QSCALE);
#pragma unroll
        for (int i = 0; i < 8; ++i) {
            const int fi = sub * 8 + i; const float c = ROPE[((size_t)pos * 32 + fi) * 2], s = ROPE[((size_t)pos * 32 + fi) * 2 + 1];
            const float a = x1[i] * r * gn[fi], b = x2[i] * r * gn[32 + fi];
            dst[fi] = f2bf(a * c - b * s); dst[32 + fi] = f2bf(b * c + a * s);
        }
    }
}
__global__ void k_mlF(const float* __restrict__ MG, float* __restrict__ F) {
    const int chain = threadIdx.x; if (chain >= 16) return;
    const int dir = chain & 1, h = (chain >> 1) & 3, b = chain >> 3;
    const int col = (dir ? 12 : 4) + h; float acc = 0.f;
    if (!dir) { for (int p = 0; p < S; ++p) { acc += logsigf_(MG[(size_t)(b * S + p) * 16 + col]); F[chain * S + p] = acc; } }
    else      { for (int p = S - 1; p >= 0; --p) { acc += logsigf_(MG[(size_t)(b * S + p) * 16 + col]); F[chain * S + p] = acc; } }
}
__global__ __launch_bounds__(256) void k_mlquad(const bf16* __restrict__ PROJ, const float* __restrict__ MG, const float* __restrict__ F, float* __restrict__ HF) {
    __shared__ float qs[16][128 + 1], ks[64][128 + 1], sc[16][64 + 1], rs[16];
    const int chain = blockIdx.y, dir = chain & 1, h = (chain >> 1) & 3, b = chain >> 3;
    const int t0 = blockIdx.x * 16, tid = threadIdx.x; const int icol = (dir ? 8 : 0) + h;
    for (int i = tid; i < 16 * 128; i += 256) { const int tt = i >> 7, kk = i & 127; qs[tt][kk] = bf2f(PROJ[(size_t)(b * S + t0 + tt) * NPJ + P_MQ + h * 128 + kk]); }
    float acc[16];
#pragma unroll
    for (int i = 0; i < 16; ++i) acc[i] = 0.f;
    if (tid < 16) rs[tid] = 0.f;
    const int sbeg = dir ? (t0 / 64) * 64 : 0, send = dir ? S : (t0 + 16 + 63) / 64 * 64;
    for (int s0 = sbeg; s0 < send; s0 += 64) {
        __syncthreads();
        for (int i = tid; i < 64 * 128; i += 256) { const int ss = i >> 7, kk = i & 127; ks[ss][kk] = bf2f(PROJ[(size_t)(b * S + s0 + ss) * NPJ + P_MK + h * 128 + kk]); }
        __syncthreads();
        for (int i = tid; i < 1024; i += 256) {
            const int tt = i >> 6, ss = i & 63; const int t = t0 + tt, s = s0 + ss; float v = 0.f;
            const bool ok = dir ? (s >= t) : (s <= t);
            if (ok) { float d = 0.f; for (int kk = 0; kk < 128; ++kk) d += qs[tt][kk] * ks[ss][kk];
                v = d * __expf(F[chain * S + t] - F[chain * S + s] + MG[(size_t)(b * S + s) * 16 + icol]); }
            sc[tt][ss] = v;
        }
        __syncthreads();
        if (tid < 16) { float r = 0.f; for (int ss = 0; ss < 64; ++ss) r += sc[tid][ss]; rs[tid] += r; }
        for (int ss = 0; ss < 64; ++ss) { const float vv = bf2f(PROJ[(size_t)(b * S + s0 + ss) * NPJ + P_MV + h * 256 + tid]);
#pragma unroll
            for (int tt = 0; tt < 16; ++tt) acc[tt] += sc[tt][ss] * vv; }
    }
    __syncthreads();
#pragma unroll
    for (int tt = 0; tt < 16; ++tt) HF[((size_t)dir * T + (b * S + t0 + tt)) * 1024 + h * 256 + tid] = acc[tt] / fmaxf(fabsf(rs[tt]), 1.f);
}
__global__ __launch_bounds__(256) void k_mlpost(const float* __restrict__ HF, const bf16* __restrict__ PROJ, const float* __restrict__ g, bf16* __restrict__ HM) {
    const int w = blockIdx.x * 4 + (threadIdx.x >> 6), lane = threadIdx.x & 63; const int t = w >> 2, h = w & 3;
    float v[4]; float ss = 0.f;
#pragma unroll
    for (int j = 0; j < 4; ++j) { const int c = h * 256 + lane + 64 * j; v[j] = HF[(size_t)t * 1024 + c] + HF[((size_t)T + t) * 1024 + c]; ss += v[j] * v[j]; }
    ss = wave_sum(ss); const float r = rsqrtf(ss * (1.f / 256.f) + EPS);
#pragma unroll
    for (int j = 0; j < 4; ++j) { const int c = h * 256 + lane + 64 * j; HM[(size_t)t * 1024 + c] = f2bf(v[j] * r * g[lane + 64 * j] * bf2f(PROJ[(size_t)t * NPJ + P_MO + c])); }
}
__global__ __launch_bounds__(256) void k_attn(const bf16* __restrict__ QN, const bf16* __restrict__ KN, const bf16* __restrict__ PROJ, const float* __restrict__ lamp, float* __restrict__ OD32) {
    __shared__ float qs[2][16][64 + 1], ks[2][64][64 + 1], sc[2][16][64 + 1], ls[2][16];
    const int bh = blockIdx.y, b = bh >> 3, h = bh & 7, t0 = blockIdx.x * 16, tid = threadIdx.x;
    const int v = tid & 127, mp = tid >> 7;
    for (int i = tid; i < 2 * 16 * 64; i += 256) { const int m = i >> 10, tt = (i >> 6) & 15, dd = i & 63; qs[m][tt][dd] = bf2f(QN[(size_t)(b * S + t0 + tt) * 1024 + h * 128 + m * 64 + dd]); }
    if (tid < 32) ls[tid >> 4][tid & 15] = 0.f;
    float acc[16];
#pragma unroll
    for (int i = 0; i < 16; ++i) acc[i] = 0.f;
    for (int s0 = 0; s0 < S; s0 += 64) {
        __syncthreads();
        for (int i = tid; i < 2 * 64 * 64; i += 256) { const int m = i >> 12, ss = (i >> 6) & 63, dd = i & 63; ks[m][ss][dd] = bf2f(KN[(size_t)(b * S + s0 + ss) * 1024 + h * 128 + m * 64 + dd]); }
        __syncthreads();
        for (int i = tid; i < 2 * 16 * 64; i += 256) { const int m = i >> 10, tt = (i >> 6) & 15, ss = i & 63; float d = 0.f;
            for (int dd = 0; dd < 64; ++dd) d += qs[m][tt][dd] * ks[m][ss][dd];
            sc[m][tt][ss] = exp2f(d); }
        __syncthreads();
        if (tid < 32) { const int m = tid >> 4, tt = tid & 15; float r = 0.f; for (int ss = 0; ss < 64; ++ss) r += sc[m][tt][ss]; ls[m][tt] += r; }
        for (int ss = 0; ss < 64; ++ss) { const float vv = bf2f(PROJ[(size_t)(b * S + s0 + ss) * NPJ + P_DV + h * 128 + v]);
#pragma unroll
            for (int tt = 0; tt < 16; ++tt) acc[tt] += sc[mp][tt][ss] * vv; }
    }
    __syncthreads();
    float s01 = 0.f, s23 = 0.f;
    for (int i = 0; i < 64; ++i) { s01 += lamp[i] * lamp[64 + i]; s23 += lamp[128 + i] * lamp[192 + i]; }
    const float lam = __expf(s01) - __expf(s23) + LAM_INIT;
    float* ob = &ks[0][0][0];
    if (mp == 1) { for (int tt = 0; tt < 16; ++tt) ob[tt * 128 + v] = acc[tt] / ls[1][tt]; }
    __syncthreads();
    if (mp == 0) { for (int tt = 0; tt < 16; ++tt) OD32[(size_t)(b * S + t0 + tt) * 1024 + h * 128 + v] = acc[tt] / ls[0][tt] - lam * ob[tt * 128 + v]; }
}
__global__ __launch_bounds__(256) void k_dapost(const float* __restrict__ OD32, const float* __restrict__ g, bf16* __restrict__ OD) {
    const int w = blockIdx.x * 4 + (threadIdx.x >> 6), lane = threadIdx.x & 63; const int t = w >> 3, h = w & 7;
    float v[2]; float ss = 0.f;
#pragma unroll
    for (int j = 0; j < 2; ++j) { v[j] = OD32[(size_t)t * 1024 + h * 128 + lane + 64 * j]; ss += v[j] * v[j]; }
    ss = wave_sum(ss); const float r = rsqrtf(ss * (1.f / 128.f) + EPS);
#pragma unroll
    for (int j = 0; j < 2; ++j) OD[(size_t)t * 1024 + h * 128 + lane + 64 * j] = f2bf(v[j] * r * g[lane + 64 * j] * (1.f - LAM_INIT));
}
__global__ __launch_bounds__(256) void k_route1(const float* __restrict__ x1, const float* __restrict__ g2, const float* __restrict__ wr, const float* __restrict__ br,
                                                bf16* __restrict__ H2, int* __restrict__ cnt, int* __restrict__ TOPE, int* __restrict__ SLOT, float* __restrict__ WTS) {
    const int t = blockIdx.x * 4 + (threadIdx.x >> 6), lane = threadIdx.x & 63;
    const float* xr = x1 + (size_t)t * D; float v[32]; float s = 0.f;
#pragma unroll
    for (int j = 0; j < 32; ++j) { v[j] = xr[lane + 64 * j]; s += v[j] * v[j]; }
    s = wave_sum(s); const float r = rsqrtf(s * (1.f / D) + EPS);
#pragma unroll
    for (int j = 0; j < 32; ++j) { v[j] = v[j] * r * g2[lane + 64 * j]; H2[(size_t)t * D + lane + 64 * j] = f2bf(v[j]); }
    float mylogit = -INFINITY;
    for (int e = 0; e < NE; ++e) { float p = 0.f;
#pragma unroll
        for (int j = 0; j < 32; ++j) p += v[j] * wr[(size_t)(lane + 64 * j) * NE + e];
        p = wave_sum(p) + br[e]; if (lane == e) mylogit = p; }
    float tv[4]; int ti[4]; float cur = mylogit;
#pragma unroll
    for (int k = 0; k < 4; ++k) { const float m = wave_max(cur); const unsigned long long bal = __ballot(cur == m && lane < NE); const int idx = __ffsll((long long)bal) - 1; tv[k] = m; ti[k] = idx; if (lane == idx) cur = -INFINITY; }
    if (lane == 0) { const float e1 = __expf(tv[1] - tv[0]), e2 = __expf(tv[2] - tv[0]), e3 = __expf(tv[3] - tv[0]); const float inv = 1.f / (1.f + e1 + e2 + e3);
        const float w[4] = {inv, e1 * inv, e2 * inv, e3 * inv};
#pragma unroll
        for (int k = 0; k < 4; ++k) { TOPE[t * 4 + k] = ti[k]; SLOT[t * 4 + k] = atomicAdd(&cnt[ti[k]], 1); WTS[t * 4 + k] = w[k]; } }
}
__global__ __launch_bounds__(256) void k_route2(const bf16* __restrict__ H2, const int* __restrict__ cnt, const int* __restrict__ TOPE, const int* __restrict__ SLOT, int* __restrict__ DEST, bf16* __restrict__ XG) {
    const int a = blockIdx.x * 4 + (threadIdx.x >> 6), lane = threadIdx.x & 63;
    if (a < T * TOPK) { const int t = a >> 2, e = TOPE[a]; int start = 0;
        for (int i = 0; i < e; ++i) start += (cnt[i] + PADM - 1) / PADM * PADM;
        const int row = start + SLOT[a]; if (lane == 0) DEST[a] = row;
        for (int j = 0; j < 32; ++j) XG[(size_t)row * D + lane + 64 * j] = H2[(size_t)t * D + lane + 64 * j];
    } else { const int p = a - T * TOPK; if (p >= NE * PADM) return;
        const int e = p / PADM, q = p % PADM; int start = 0;
        for (int i = 0; i < e; ++i) start += (cnt[i] + PADM - 1) / PADM * PADM;
        const int c = cnt[e], padded = (c + PADM - 1) / PADM * PADM;
        if (c + q < padded) { const int row = start + c + q; for (int j = 0; j < 32; ++j) XG[(size_t)row * D + lane + 64 * j] = 0; } }
}
__global__ __launch_bounds__(256) void k_combine(float* __restrict__ out, const bf16* __restrict__ Y, const int* __restrict__ DEST, const float* __restrict__ WTS) {
    const int t = blockIdx.x * 4 + (threadIdx.x >> 6), lane = threadIdx.x & 63; int d[4]; float w[4];
#pragma unroll
    for (int k = 0; k < 4; ++k) { d[k] = DEST[t * 4 + k]; w[k] = WTS[t * 4 + k]; }
    for (int j = 0; j < 32; ++j) { const int c = lane + 64 * j; float a = out[(size_t)t * D + c];
#pragma unroll
        for (int k = 0; k < 4; ++k) a += w[k] * bf2f(Y[(size_t)d[k] * D + c]);
        out[(size_t)t * D + c] = a; }
}
#endif
#ifndef MEGA_MASK
#define MEGA_MASK 0xFF
#endif
static int g_grid = 0;
static void launch_mega(Args a, int lo, int hi, hipStream_t stream) {
    (void)hipMemsetAsync(a.ws + WS_CTL + CW_BAR * 4, 0, XCD_BAR_WORDS * 4, stream);
    a.ph_lo = lo; a.ph_hi = hi;
    hipLaunchKernelGGL(mega_fwd, dim3(g_grid), dim3(NTHR), LDS_BYTES, stream, a);
}
extern "C" void kernel_launch(void* const* d_in, const int* in_sizes, int n_in, void* d_out, int out_size, void* d_ws, size_t ws_size, hipStream_t stream) {
    if (g_grid == 0) {
        int dev = 0, cus = 0;
        if (n_in != 19 || out_size != T * D || hipGetDevice(&dev) != hipSuccess || hipDeviceGetAttribute(&cus, hipDeviceAttributeMultiprocessorCount, dev) != hipSuccess) { g_grid = -1; return; }
        if (hipFuncSetAttribute((const void*)mega_fwd, hipFuncAttributeMaxDynamicSharedMemorySize, LDS_BYTES) != hipSuccess) { g_grid = -1; return; }
        int per_cu = 0; (void)hipOccupancyMaxActiveBlocksPerMultiprocessor(&per_cu, (const void*)mega_fwd, NTHR, LDS_BYTES); (void)hipGetLastError();
        g_grid = cus;
    }
    if (g_grid < 0) return;
    Args a{};
    for (int i = 0; i < 19; ++i) a.in[i] = (const float*)d_in[i];
    a.out = (float*)d_out; a.ws = (unsigned char*)d_ws;
    (void)hipMemsetAsync(a.ws + WS_CTL, 0, 4096 * 4, stream);
#ifdef DEV_NAIVE
    unsigned char* ws = a.ws; const int mask = MEGA_MASK;
    bf16* PROJ = (bf16*)(ws + WS_PROJ); float* MG = (float*)(ws + WS_MG); float* ROPE = (float*)(ws + WS_ROPE);
    bf16* QN = (bf16*)(ws + WS_QN); bf16* KN = (bf16*)(ws + WS_KN); bf16* HM = (bf16*)(ws + WS_HM); bf16* OD = (bf16*)(ws + WS_OD);
    bf16* H2 = (bf16*)(ws + WS_H2); bf16* XG = (bf16*)(ws + WS_XG); bf16* ACT = (bf16*)(ws + WS_ACT); bf16* Y = (bf16*)(ws + WS_Y);
    int* cnt = (int*)(ws + WS_CTL) + CW_CNT; int* TOPE = (int*)(ws + WS_RT); int* SLOT = TOPE + T * 4; float* WTS = (float*)(SLOT + T * 4); int* DEST = (int*)(WTS + T * 4);
    float* XN32 = (float*)(ws + NV_XN32); float* PROJ32 = (float*)(ws + NV_PROJ32); float* F = (float*)(ws + NV_F); float* HF = (float*)(ws + NV_HF); float* OD32 = (float*)(ws + NV_OD32); float* MIX32 = (float*)(ws + NV_MIX32);
    const float* x = a.in[0]; float* out = a.out;
    static const int ranges[8][2] = {{0, 2}, {2, 3}, {3, 6}, {6, 7}, {7, 9}, {9, 11}, {11, 13}, {13, 14}};
    for (int s = 0; s < 8; ++s) {
        if (mask & (1 << s)) { int e = s; while (e + 1 < 8 && (mask & (1 << (e + 1)))) ++e; launch_mega(a, ranges[s][0], ranges[e][1], stream); s = e; continue; }
        switch (s) {
        case 0: { k_rmsnorm<<<T / 4, 256, 0, stream>>>(x, a.in[1], XN32);
            GArgs g{}; g.A = XN32; g.B = a.in[2]; g.C = PROJ32; g.M = T; g.N = DIN; g.K = D; g.lda = D; g.ldb = DIN; g.ldc = DIN;
            k_gemm<0, float><<<dim3((DIN + 63) / 64, T / 64), 256, 0, stream>>>(g);
            k_pack<<<T, 256, 0, stream>>>(PROJ32, a.in[3], PROJ, MG); k_rope<<<S * 32 / 256, 256, 0, stream>>>(ROPE); } break;
        case 1: k_qkprep<<<T / 4, 256, 0, stream>>>(PROJ, ROPE, a.in[6], a.in[7], QN, KN); break;
        case 2: k_mlF<<<1, 64, 0, stream>>>(MG, F); k_mlquad<<<dim3(S / 16, 16), 256, 0, stream>>>(PROJ, MG, F, HF); k_mlpost<<<T, 256, 0, stream>>>(HF, PROJ, a.in[4], HM); break;
        case 3: k_attn<<<dim3(S / 16, 16), 256, 0, stream>>>(QN, KN, PROJ, a.in[8], OD32); k_dapost<<<T * 2, 256, 0, stream>>>(OD32, a.in[9], OD); break;
        case 4: { GArgs g{}; g.A = HM; g.B = a.in[5]; g.C = MIX32; g.M = T; g.N = D; g.K = MLW; g.lda = MLW; g.ldb = D; g.ldc = D; g.aux0 = PROJ;
            k_gemm<1, bf16><<<dim3(D / 64, T / 64), 256, 0, stream>>>(g);
            g.A = OD; g.B = a.in[10]; g.K = DAW; g.lda = DAW; k_gemm<2, bf16><<<dim3(D / 64, T / 64), 256, 0, stream>>>(g);
            GArgs h{}; h.A = MIX32; h.B = a.in[11]; h.C = out; h.M = T; h.N = D; h.K = D; h.lda = D; h.ldb = D; h.ldc = D; h.aux0 = x;
            k_gemm<3, float><<<dim3(D / 64, T / 64), 256, 0, stream>>>(h); } break;
        case 5: k_route1<<<T / 4, 256, 0, stream>>>(out, a.in[12], a.in[13], a.in[14], H2, cnt, TOPE, SLOT, WTS);
            k_route2<<<(T * TOPK + NE * PADM) / 4, 256, 0, stream>>>(H2, cnt, TOPE, SLOT, DEST, XG); break;
        case 6: { GArgs g{}; g.A = XG; g.B = a.in[15]; g.C = ACT; g.N = 2 * DE; g.K = D; g.lda = D; g.ldb = 2 * DE; g.ldc = DE; g.aux0 = a.in[16]; g.cnt = cnt;
            k_gemm<4, bf16><<<dim3(2 * DE / 64, T / 64, NE), 256, 0, stream>>>(g);
            GArgs h{}; h.A = ACT; h.B = a.in[17]; h.C = Y; h.N = D; h.K = DE; h.lda = DE; h.ldb = D; h.ldc = D; h.aux0 = a.in[18]; h.cnt = cnt;
            k_gemm<5, bf16><<<dim3(D / 64, T / 64, NE), 256, 0, stream>>>(h); } break;
        case 7: k_combine<<<T / 4, 256, 0, stream>>>(out, Y, DEST, WTS); break;
        }
    }
#else
    launch_mega(a, 0, N_PHASES, stream);
#endif
}
```

```cpp
#include <hip/hip_runtime.h>
#include <cstdio>
#include <cstdint>
#include <math.h>

constexpr int D = 2048, NB = 2, S = 4096, T = NB * S;
constexpr int MLH = 4, MLDK = 128, MLDV = 256, MLW = 1024, NCH = 64;
constexpr int DAH = 8, DAD = 64, DADV = 128, DAW = 1024;
constexpr int NE = 32, TOPK = 4, DE = 2048;
constexpr int DIN = 10256, NPJ = 10240;
constexpr int G_OFF = 3072;
constexpr int P_MQ = 0, P_MK = 512, P_MV = 1024, P_MO = 2048, P_DQ = 3072, P_DK = 4096, P_DV = 5120, P_GM = 6144, P_GD = 8192;
constexpr float EPS = 1e-6f;
constexpr int PADM = 256;
constexpr int MAXROWS = T * TOPK + NE * PADM;
constexpr float LAM_INIT = 0.2f;
constexpr float QSCALE = 0.125f * 1.4426950408889634f;
constexpr float KSCALE = 0.08838834764831845f;

constexpr size_t MiB = 1ull << 20;
constexpr size_t WS_CTL = 0, CTL_ZERO_BYTES = 1 * MiB;
constexpr size_t WS_MSC = 1 * MiB;
constexpr size_t WS_RT = 2 * MiB;
constexpr size_t WS_ROPE = 3 * MiB;
constexpr size_t WS_MG = 4 * MiB;
constexpr size_t WS_NU = 5 * MiB;
constexpr size_t WS_NP = 6 * MiB;
constexpr size_t WS_WRH = 7 * MiB, WS_WRL = 7 * MiB + 256 * 1024;
constexpr size_t WS_WIN = 8 * MiB;
constexpr size_t WS_WIN8 = 32 * MiB;
constexpr size_t WS_WML = 48 * MiB;
constexpr size_t WS_WDA = 52 * MiB;
constexpr size_t WS_WO = 56 * MiB;
constexpr size_t WS_WGU = 64 * MiB;
constexpr size_t WS_WDN = 576 * MiB;
constexpr size_t WS_XN = 832 * MiB;
constexpr size_t WS_PROJ = 864 * MiB;
constexpr size_t WS_QN = 1024 * MiB;
constexpr size_t WS_KN = 1040 * MiB;
constexpr size_t WS_U = 1056 * MiB;
constexpr size_t WS_CP = 1184 * MiB;
constexpr size_t WS_HM = 1248 * MiB;
constexpr size_t WS_OD = 1264 * MiB;
constexpr size_t WS_XN8 = 1280 * MiB;
constexpr size_t WS_T1 = 1280 * MiB;
constexpr size_t WS_MIX = 1312 * MiB;
constexpr size_t WS_H2 = 1344 * MiB;
constexpr size_t WS_XG = 1376 * MiB;
constexpr size_t WS_ACT = 1536 * MiB;
constexpr size_t WS_Y = 1696 * MiB;
constexpr size_t WS_G8 = 1856 * MiB;
constexpr size_t WS_NAIVE = 1920 * MiB;
constexpr size_t WS_END = 2500 * MiB;
constexpr int CW_CNT = 64;
constexpr int CW_BAR = 4096;
constexpr int CW_WGCNT = 8192;

typedef unsigned short bf16;
typedef unsigned v4u __attribute__((ext_vector_type(4)));
typedef unsigned v2u __attribute__((ext_vector_type(2)));
typedef float f32x4 __attribute__((ext_vector_type(4)));
typedef float f32x2 __attribute__((ext_vector_type(2)));
typedef float f32x16 __attribute__((ext_vector_type(16)));
typedef short bf16x8 __attribute__((ext_vector_type(8)));
typedef short s16x4 __attribute__((ext_vector_type(4)));
typedef __bf16 bf16x2_t __attribute__((ext_vector_type(2)));
#define GAS __attribute__((address_space(1)))
#define LAS __attribute__((address_space(3)))

__device__ __forceinline__ float bf2f(unsigned v) { return __uint_as_float(v << 16); }
__device__ __forceinline__ float bflo(unsigned w) { return __uint_as_float(w << 16); }
__device__ __forceinline__ float bfhi(unsigned w) { return __uint_as_float(w & 0xffff0000u); }
__device__ __forceinline__ unsigned pk2(float lo, float hi) { f32x2 v = {lo, hi}; bf16x2_t b = __builtin_convertvector(v, bf16x2_t); return __builtin_bit_cast(unsigned, b); }
__device__ __forceinline__ bf16 f2bf(float f) { return (bf16)(pk2(f, 0.f) & 0xffffu); }
__device__ __forceinline__ float sigmoidf_(float x) { return 1.f / (1.f + __expf(-x)); }
__device__ __forceinline__ float logsigf_(float x) { return x >= 0.f ? -log1pf(__expf(-x)) : x - log1pf(__expf(x)); }
__device__ __forceinline__ float wave_sum(float v) {
#pragma unroll
    for (int o = 1; o < 64; o <<= 1) v += __shfl_xor(v, o);
    return v;
}
__device__ __forceinline__ float wave_max(float v) {
#pragma unroll
    for (int o = 1; o < 64; o <<= 1) v = fmaxf(v, __shfl_xor(v, o));
    return v;
}
namespace pg8 {
#define PG8_LAS __attribute__((address_space(3)))
typedef unsigned short bf16_t;
typedef short bf16x8 __attribute__((ext_vector_type(8)));
typedef float f32x4 __attribute__((ext_vector_type(4)));
typedef unsigned u32x4 __attribute__((ext_vector_type(4)));
constexpr int BM = 256, BK = 64, HALF = 128, HTB = HALF * BK * 2  , STAGE_BYTES = 8 * HTB, NXCD = 8, WGM = 8;

__host__ __device__ __forceinline__ int lds_byte(int r, int c) { const int st = (r >> 4) * 2 + (c >> 5), rr = r & 15, cc = c & 31, ob = rr * 64 + cc * 2; return st * 1024 + (ob ^ (((ob >> 9) & 1) << 5)); }
__host__ __device__ __forceinline__ void stage_rc(int b, int& R, int& C) { const int st = b / 1024, sb = b % 1024, swz = sb ^ (((sb >> 9) & 1) << 5); R = (st >> 1) * 16 + swz / 64; C = (st & 1) * 32 + (swz % 64) / 2; }
__host__ __device__ __forceinline__ int perm32(int rho) { const int n = rho >> 4, i = rho & 15; return 8 * (i >> 2) + 4 * n + (i & 3); }

struct Unit { int pm, pn, pb, half; };
struct Gemm { const bf16_t* A; const bf16_t* Bt; int M, N, K; };

struct StaticOrder {
    int nM, nN, nwg, G, c;
    __host__ __device__ void init(int M, int N, int G_, int c_) { nM = M / BM; nN = N / BM; nwg = nM * nN; G = G_; c = c_; }
    __host__ __device__ bool next(int i, Unit& u) const {
        const long L = (long)i * G + c; if (L >= nwg) return false;
        int wgid = (int)L; { const int q = nwg / NXCD, r = nwg % NXCD, xcd = wgid % NXCD, off = wgid / NXCD; wgid = (xcd < r ? xcd * (q + 1) : r * (q + 1) + (xcd - r) * q) + off; }
        const int nig = WGM * nN, gid = wgid / nig, fm = gid * WGM, gsz = (nM - fm) < WGM ? (nM - fm) : WGM;
        u.pm = fm + ((wgid % nig) % gsz); u.pn = (wgid % nig) / gsz; u.pb = u.pn; u.half = 0; return true;
    }
    __device__ __forceinline__ void a_ready(const Unit&) const {}
    __device__ __forceinline__ void done(const Unit&) const {}
    __device__ __forceinline__ int rot() const { return 0; }
};

__device__ __forceinline__ unsigned cvt_pk_bf16(float lo, float hi) { unsigned r; asm volatile("v_cvt_pk_bf16_f32 %0, %1, %2" : "=v"(r) : "v"(lo), "v"(hi)); return r; }
typedef float f32x2 __attribute__((ext_vector_type(2)));
typedef int v8i_t __attribute__((ext_vector_type(8)));
__device__ __forceinline__ const char* pg8_uni(const char* p) { const unsigned long long v = (unsigned long long)p; const unsigned lo = __builtin_amdgcn_readfirstlane((unsigned)v), hi = __builtin_amdgcn_readfirstlane((unsigned)(v >> 32)); return (const char*)(((unsigned long long)hi << 32) | lo); }
template <class Epi, class Sched, bool ALIGN_EPI = false, bool SP2 = false, bool FP8 = false, int BLK = 0>
__device__ __forceinline__ void gemm_phase(PG8_LAS unsigned char* lds, const Gemm g, const Sched& S, const Epi& E) {
    const int tid = threadIdx.x, wid = __builtin_amdgcn_readfirstlane(tid >> 6), lane = tid & 63, wr = wid >> 2, wc = wid & 3, fr = lane & 15, fq = lane >> 4;
    const int K = g.K, nt = K / BK;
    unsigned voffA[2], voffB[2];
#pragma unroll
    for (int i = 0; i < 2; ++i) { int R, C; stage_rc(tid * 16 + i * 8192, R, C); const int Rb = Epi::PERM ? ((R & ~31) + perm32(R & 31)) : R;
        voffA[i] = (unsigned)(R * ((BLK & 1) ? BK : K) + C) * 2u; voffB[i] = (unsigned)(Rb * ((BLK & 2) ? BK : K) + C) * 2u; }
    const size_t kstepA = (BLK & 1) ? (size_t)(2 * HTB) : (size_t)(BK * 2), kstepB = (BLK & 2) ? (size_t)(2 * HTB) : (size_t)(BK * 2);
    const size_t hstepA = (BLK & 1) ? (size_t)HTB : (size_t)HALF * K * 2, hstepB = (BLK & 2) ? (size_t)HTB : (size_t)HALF * K * 2;
    const size_t tstep = (size_t)2 * HALF * K * 2;
    const unsigned ldsb_ = (unsigned)(uintptr_t)lds;
    const unsigned ldsw = (unsigned)wid * 1024u;
    const int aoff = lds_byte(wr * 64 + fr, fq * 8), boff = lds_byte(wc * 32 + fr, fq * 8);
#define PG8_SA(b, h) (((b) * 2 + (h)) * HTB)
#define PG8_SB(b, h) ((4 + (b) * 2 + (h)) * HTB)
#define PG8_STAGE(bufoff, gbase, voff) do { _Pragma("unroll") for (int _i = 0; _i < 2; ++_i) { unsigned keep_; \
        asm volatile("s_mov_b32 %0, m0\n\ts_mov_b32 m0, %3\n\ts_nop 0\n\tglobal_load_lds_dwordx4 %1, %2\n\ts_mov_b32 m0, %0" : "=&s"(keep_) : "v"((voff)[_i]), "s"(pg8_uni((const char*)(gbase))), \
            "s"((unsigned)__builtin_amdgcn_readfirstlane((int)(ldsb_ + (unsigned)(bufoff) + ldsw + (unsigned)(_i * 8192)))) : "memory"); } } while (0)
#define PG8_CAT16(lo, hi) __builtin_bit_cast(v8i_t, __builtin_shufflevector(lo, hi, 0, 1, 2, 3, 4, 5, 6, 7, 8, 9, 10, 11, 12, 13, 14, 15))
#define PG8_LDA(dst, b, h) do { if constexpr (FP8) { _Pragma("unroll") for (int m = 0; m < 4; ++m) { const bf16x8 lo_ = *(const PG8_LAS bf16x8*)(lds + PG8_SA(b, h) + aoff + m * 2048), hi_ = *(const PG8_LAS bf16x8*)(lds + PG8_SA(b, h) + aoff + m * 2048 + 1024); dst##8[m] = PG8_CAT16(lo_, hi_); } } \
    else { _Pragma("unroll") for (int m = 0; m < 4; ++m) _Pragma("unroll") for (int k = 0; k < 2; ++k) dst[m][k] = *(const PG8_LAS bf16x8*)(lds + PG8_SA(b, h) + aoff + m * 2048 + k * 1024); } } while (0)
#define PG8_LDB(dst, b, h) do { if constexpr (FP8) { _Pragma("unroll") for (int n = 0; n < 2; ++n) { const bf16x8 lo_ = *(const PG8_LAS bf16x8*)(lds + PG8_SB(b, h) + boff + n * 2048), hi_ = *(const PG8_LAS bf16x8*)(lds + PG8_SB(b, h) + boff + n * 2048 + 1024); dst##8[n] = PG8_CAT16(lo_, hi_); } } \
    else { _Pragma("unroll") for (int n = 0; n < 2; ++n) _Pragma("unroll") for (int k = 0; k < 2; ++k) dst[n][k] = *(const PG8_LAS bf16x8*)(lds + PG8_SB(b, h) + boff + n * 2048 + k * 1024); } } while (0)
#define PG8_MMA(ai, bj, At, Bt) do { __builtin_amdgcn_s_setprio(1); \
    if constexpr (FP8) { _Pragma("unroll") for (int m = 0; m < 4; ++m) _Pragma("unroll") for (int n = 0; n < 2; ++n) \
        asm volatile("v_mfma_f32_16x16x128_f8f6f4 %0, %1, %2, %0" : "+v"(acc[ai][bj][m][n]) : "v"(Bt##8[n]), "v"(At##8[m])); } \
    else { _Pragma("unroll") for (int m = 0; m < 4; ++m) _Pragma("unroll") for (int n = 0; n < 2; ++n) _Pragma("unroll") for (int k = 0; k < 2; ++k) \
        acc[ai][bj][m][n] = __builtin_amdgcn_mfma_f32_16x16x32_bf16(Bt[n][k], At[m][k], acc[ai][bj][m][n], 0, 0, 0); } \
    __builtin_amdgcn_s_setprio(0); } while (0)
#define PG8_WAIT_V(n) asm volatile("s_waitcnt vmcnt(" #n ")" ::: "memory")
#define PG8_WAIT_L(n) asm volatile("s_waitcnt lgkmcnt(" #n ")" ::: "memory")
#define PG8_BAR __builtin_amdgcn_s_barrier()
#define PG8_SCHED __builtin_amdgcn_sched_barrier(0)
    Unit cur, nxt; int ui = 0;
    if (!S.next(0, cur)) return;
    f32x4 acc[2][2][4][2];
#pragma unroll
    for (int a = 0; a < 2; ++a)
#pragma unroll
        for (int b = 0; b < 2; ++b)
#pragma unroll
            for (int m = 0; m < 4; ++m)
#pragma unroll
                for (int n = 0; n < 2; ++n) acc[a][b][m][n] = (f32x4){0.f, 0.f, 0.f, 0.f};
    bf16x8 At[4][2], B0[2][2], B1[2][2]; v8i_t At8[4], B08[2], B18[2]; (void)At; (void)B0; (void)B1; (void)At8; (void)B08; (void)B18; int sc8_ = 0x7f7f7f7f; asm volatile("" : "+v"(sc8_)); (void)sc8_;
    const char* cA = (const char*)g.A + (size_t)cur.pm * tstep; const char* cB = (const char*)g.Bt + (size_t)cur.pb * tstep;
    const int rot = S.rot();
#define PG8_KIX(t) ((size_t)(((t) + rot) & (nt - 1)))
    const size_t k0A = PG8_KIX(0) * kstepA, k1A = PG8_KIX(1) * kstepA, k0B = PG8_KIX(0) * kstepB, k1B = PG8_KIX(1) * kstepB;
    S.a_ready(cur);
    if constexpr (SP2) {
        PG8_STAGE(PG8_SB(0, 0), cB + k0B, voffB); PG8_STAGE(PG8_SB(0, 1), cB + hstepB + k0B, voffB); PG8_STAGE(PG8_SA(0, 0), cA + k0A, voffA); PG8_STAGE(PG8_SA(0, 1), cA + hstepA + k0A, voffA);
        if (wr == 1) PG8_BAR;
        PG8_WAIT_V(2); PG8_BAR;
        PG8_STAGE(PG8_SB(1, 0), cB + k1B, voffB); PG8_STAGE(PG8_SA(1, 0), cA + k1A, voffA); PG8_STAGE(PG8_SB(1, 1), cB + hstepB + k1B, voffB);
        PG8_WAIT_V(6); PG8_BAR;
    } else {
        PG8_STAGE(PG8_SB(0, 0), cB + k0B, voffB); PG8_STAGE(PG8_SA(0, 0), cA + k0A, voffA); PG8_STAGE(PG8_SB(0, 1), cB + hstepB + k0B, voffB); PG8_STAGE(PG8_SA(0, 1), cA + hstepA + k0A, voffA);
        if (wr == 1) PG8_BAR;
        PG8_WAIT_V(4); PG8_BAR;
        PG8_STAGE(PG8_SB(1, 0), cB + k1B, voffB); PG8_STAGE(PG8_SA(1, 0), cA + k1A, voffA); PG8_STAGE(PG8_SB(1, 1), cB + hstepB + k1B, voffB);
        PG8_WAIT_V(6); PG8_BAR;
    }
    for (;;) {
        const bool has_next = S.next(ui + 1, nxt);
        const char* nA = has_next ? (const char*)g.A + (size_t)nxt.pm * tstep : cA; const char* nB = has_next ? (const char*)g.Bt + (size_t)nxt.pb * tstep : cB;
        for (int t = 0; t < nt; t += 2) {
            const bool last = (t == nt - 2);
            const char* a1 = cA + PG8_KIX(t + 1) * kstepA;
            const size_t i2 = PG8_KIX(t + 2), i3 = PG8_KIX(t + 3);
            const char* a2 = (last ? nA : cA) + i2 * kstepA; const char* b2 = (last ? nB : cB) + i2 * kstepB;
            const char* a3 = (last ? nA : cA) + i3 * kstepA; const char* b3 = (last ? nB : cB) + i3 * kstepB;
            if (last && has_next) S.a_ready(nxt);
            if constexpr (SP2) {
            PG8_LDB(B0, 0, 0); PG8_LDB(B1, 0, 1); PG8_SCHED; PG8_LDA(At, 0, 0); PG8_STAGE(PG8_SA(1, 1), a1 + hstepA, voffA);
            PG8_WAIT_V(8); PG8_WAIT_L(0); PG8_BAR; PG8_MMA(0, 0, At, B0); PG8_MMA(0, 1, At, B1); PG8_BAR; PG8_SCHED;
            PG8_LDA(At, 0, 1); PG8_STAGE(PG8_SB(0, 0), b2, voffB); PG8_STAGE(PG8_SB(0, 1), b2 + hstepB, voffB); PG8_STAGE(PG8_SA(0, 0), a2, voffA);
            PG8_WAIT_V(8); PG8_WAIT_L(0); PG8_BAR; if (!cur.half) { PG8_MMA(1, 0, At, B0); PG8_MMA(1, 1, At, B1); } PG8_BAR; PG8_SCHED;
            PG8_LDB(B0, 1, 0); PG8_LDB(B1, 1, 1); PG8_SCHED; PG8_LDA(At, 1, 0); PG8_STAGE(PG8_SA(0, 1), a2 + hstepA, voffA);
            PG8_WAIT_V(8); PG8_WAIT_L(0); PG8_BAR; PG8_MMA(0, 0, At, B0); PG8_MMA(0, 1, At, B1); PG8_BAR; PG8_SCHED;
            PG8_LDA(At, 1, 1); PG8_STAGE(PG8_SB(1, 0), b3, voffB); PG8_STAGE(PG8_SB(1, 1), b3 + hstepB, voffB); PG8_STAGE(PG8_SA(1, 0), a3, voffA);
            PG8_WAIT_V(8); PG8_WAIT_L(0); PG8_BAR; if (!cur.half) { PG8_MMA(1, 0, At, B0); PG8_MMA(1, 1, At, B1); } PG8_BAR; PG8_SCHED;
            } else {
            PG8_LDB(B0, 0, 0); PG8_SCHED; PG8_LDA(At, 0, 0); PG8_STAGE(PG8_SA(1, 1), a1 + hstepA, voffA);
            PG8_WAIT_L(8); PG8_BAR; PG8_WAIT_L(0); PG8_MMA(0, 0, At, B0); PG8_BAR; PG8_SCHED;
            PG8_LDB(B1, 0, 1); PG8_STAGE(PG8_SB(0, 0), b2, voffB);
            PG8_BAR; PG8_WAIT_L(0); PG8_MMA(0, 1, At, B1); PG8_BAR;
            PG8_LDA(At, 0, 1); PG8_STAGE(PG8_SA(0, 0), a2, voffA);
            PG8_BAR; PG8_WAIT_L(0); if (!cur.half) PG8_MMA(1, 0, At, B0); PG8_BAR; PG8_SCHED;
            PG8_STAGE(PG8_SB(0, 1), b2 + hstepB, voffB);
            PG8_WAIT_V(6); PG8_BAR; if (!cur.half) PG8_MMA(1, 1, At, B1); PG8_BAR;
            PG8_LDB(B0, 1, 0); PG8_SCHED; PG8_LDA(At, 1, 0); PG8_STAGE(PG8_SA(0, 1), a2 + hstepA, voffA);
            PG8_WAIT_L(8); PG8_BAR; PG8_WAIT_L(0); PG8_MMA(0, 0, At, B0); PG8_BAR; PG8_SCHED;
            PG8_LDB(B1, 1, 1); PG8_STAGE(PG8_SB(1, 0), b3, voffB);
            PG8_BAR; PG8_WAIT_L(0); PG8_MMA(0, 1, At, B1); PG8_BAR;
            PG8_LDA(At, 1, 1); PG8_STAGE(PG8_SA(1, 0), a3, voffA);
            PG8_BAR; PG8_WAIT_L(0); if (!cur.half) PG8_MMA(1, 0, At, B0); PG8_BAR; PG8_SCHED;
            PG8_STAGE(PG8_SB(1, 1), b3 + hstepB, voffB);
            PG8_WAIT_V(6); PG8_BAR; if (!cur.half) PG8_MMA(1, 1, At, B1); PG8_BAR;
            }
        }
        if constexpr (ALIGN_EPI) { if (wr == 0) PG8_BAR; }
        if constexpr (FP8) asm volatile("s_nop 15\n\ts_nop 15" ::: "memory");
        if constexpr (!Epi::AFTER_DRAIN) { E(acc, cur, wr, wc, fr, fq); S.done(cur); }
        if (!has_next) break;
#pragma unroll
        for (int a = 0; a < 2; ++a)
#pragma unroll
            for (int b = 0; b < 2; ++b)
#pragma unroll
                for (int m = 0; m < 4; ++m)
#pragma unroll
                    for (int n = 0; n < 2; ++n) acc[a][b][m][n] = (f32x4){0.f, 0.f, 0.f, 0.f};
        cur = nxt; cA = nA; cB = nB; ++ui;
        if constexpr (ALIGN_EPI) { if (wr == 1) PG8_BAR; }
    }
    PG8_WAIT_V(0);
    if constexpr (!ALIGN_EPI) { if (wr == 0) PG8_BAR; }
    PG8_BAR;
    if constexpr (Epi::AFTER_DRAIN) { E.fused(acc, cur, wr, wc, fr, fq, lds, wid, lane); S.done(cur); }
#undef PG8_KIX
#undef PG8_SA
#undef PG8_SB
#undef PG8_STAGE
#undef PG8_LDA
#undef PG8_LDB
#undef PG8_MMA
#undef PG8_WAIT_V
#undef PG8_WAIT_L
#undef PG8_BAR
#undef PG8_SCHED
}
}
constexpr int NWAVES = 8, NTHR = 512;
constexpr int LDS_BYTES = 147456;
constexpr int MISC_OFF = LDS_BYTES - 128;
typedef GAS unsigned gu32;
#define RLX_AGENT __ATOMIC_RELAXED, __HIP_MEMORY_SCOPE_AGENT
#define LDS_WAIT() asm volatile("s_waitcnt lgkmcnt(0)" ::: "memory")
#define VM_WAIT() asm volatile("s_waitcnt vmcnt(0)" ::: "memory")
#define XB_TMO      128
#define XB_XCNT(j)  (256  + 64 * (j))
#define XB_XSUB(j)  (1280 + 64 * (j))
#define XB_XGEN(j)  (2304 + 64 * (j))
#define XB_TOP      3328
#define XB_TOPGEN   3392
#define XCD_BAR_WORDS 3456
#define XB_SPIN_CAP (1u << 18)

__device__ __forceinline__ unsigned xb_ld(unsigned* p)              { return __hip_atomic_load(p, __ATOMIC_RELAXED, __HIP_MEMORY_SCOPE_AGENT); }
__device__ __forceinline__ unsigned xb_add(unsigned* p, unsigned v) { return __hip_atomic_fetch_add(p, v, __ATOMIC_RELAXED, __HIP_MEMORY_SCOPE_AGENT); }
__device__ __forceinline__ unsigned xb_xcc_id() { return (unsigned)__builtin_amdgcn_s_getreg((3 << 11) | 20) & 0xFu; }
#define XB_SPIN(cond, bar) do { unsigned _sp = 0; while (cond) { __builtin_amdgcn_s_sleep(1); \
    if ((++_sp & 255u) == 0u) { if (xb_ld(&(bar)[XB_TMO])) break; if (_sp > XB_SPIN_CAP) { atomicAdd(&(bar)[XB_TMO], 1u); break; } } } } while (0)

struct XcdBarrier {
    unsigned* bar; unsigned x;
    volatile LAS unsigned* st;
};

__device__ __forceinline__ XcdBarrier xcd_barrier_post(unsigned* bar, volatile LAS unsigned* st) {
    XcdBarrier b; b.bar = bar; b.x = xb_xcc_id(); b.st = st;
    if (threadIdx.x == 0) (void)xb_add(&bar[XB_XCNT(b.x)], 1u);
    return b;
}
__device__ __forceinline__ void xcd_barrier_complete(unsigned* bar, unsigned x, unsigned& nloc, unsigned& nx) {
    const unsigned G = gridDim.x * gridDim.y * gridDim.z;
    unsigned sum, cnt, mine, sp = 0u;
    for (;;) {
        sum = 0u; cnt = 0u; mine = 0u;
#pragma unroll
        for (unsigned j = 0; j < 16; ++j) { const unsigned c = xb_ld(&bar[XB_XCNT(j)]); sum += c; cnt += (c > 0u) ? 1u : 0u; mine = (j == x) ? c : mine; }
        if (sum == G) break;
        __builtin_amdgcn_s_sleep(1);
        if ((++sp & 255u) == 0u) { if (xb_ld(&bar[XB_TMO])) break; if (sp > XB_SPIN_CAP) { atomicAdd(&bar[XB_TMO], 1u); break; } }
    }
    nloc = mine > 0u ? mine : 1u; nx = cnt > 0u ? cnt : 1u;
}

__device__ __forceinline__ void xcd_barrier(const XcdBarrier& b) {
    asm volatile("s_waitcnt vmcnt(0)" ::: "memory");
    __syncthreads();
    if (threadIdx.x == 0) {
        unsigned* bar = b.bar;
        __builtin_amdgcn_s_waitcnt(0);
        unsigned nloc = b.st[0], nx = b.st[1];
        if (nloc == 0u) { xcd_barrier_complete(bar, b.x, nloc, nx); b.st[0] = nloc; b.st[1] = nx; }
        const unsigned old = xb_add(&bar[XB_XSUB(b.x)], 1u);
        const unsigned gen = old / nloc;
        if (old + 1u == (gen + 1u) * nloc) {
            __builtin_amdgcn_fence(__ATOMIC_RELEASE, "agent");
            asm volatile("s_waitcnt vmcnt(0)" ::: "memory");
            const unsigned og = xb_add(&bar[XB_TOP], 1u);
            const unsigned tg = og / nx;
            if (og + 1u == (tg + 1u) * nx) xb_add(&bar[XB_TOPGEN], 1u);
            else XB_SPIN(xb_ld(&bar[XB_TOPGEN]) == tg, bar);
            __builtin_amdgcn_fence(__ATOMIC_ACQUIRE, "agent");
            xb_add(&bar[XB_XGEN(b.x)], 1u);
            asm volatile("s_waitcnt vmcnt(0)" ::: "memory");
        } else {
            XB_SPIN(xb_ld(&bar[XB_XGEN(b.x)]) == gen, bar);
            __builtin_amdgcn_fence(__ATOMIC_ACQUIRE, "agent");
            asm volatile("s_waitcnt vmcnt(0)" ::: "memory");
        }
    }
    __syncthreads();
}
struct Ctx { LAS unsigned char* lds; int tid, lane, wave, vcu, G; };
struct Args { const float* in[19]; float* out; unsigned char* ws; int ph_lo, ph_hi; };

typedef short v4i16_t __attribute__((ext_vector_type(4)));
__device__ __forceinline__ s16x4 trr(LAS unsigned char* p) { return __builtin_bit_cast(s16x4, __builtin_amdgcn_ds_read_tr16_b64_v4i16((LAS v4i16_t*)p)); }
__device__ __forceinline__ bf16x8 cat8(s16x4 lo, s16x4 hi) { return (bf16x8){lo[0], lo[1], lo[2], lo[3], hi[0], hi[1], hi[2], hi[3]}; }
__device__ __forceinline__ float incl_sum_up(float v, int lane) {
#pragma unroll
    for (int o = 1; o < 64; o <<= 1) { const float t = __shfl_up(v, o); if (lane >= o) v += t; }
    return v;
}
__device__ __forceinline__ float incl_max_up(float v, int lane) {
#pragma unroll
    for (int o = 1; o < 64; o <<= 1) { const float t = __shfl_up(v, o); if (lane >= o) v = fmaxf(v, t); }
    return v;
}
__device__ __forceinline__ float incl_max_down(float v, int lane) {
#pragma unroll
    for (int o = 1; o < 64; o <<= 1) { const float t = __shfl_down(v, o); if (lane + o < 64) v = fmaxf(v, t); }
    return v;
}
__device__ __forceinline__ v4u scale8(v4u q, float s) {
    v4u o; o.x = pk2(bflo(q.x) * s, bfhi(q.x) * s); o.y = pk2(bflo(q.y) * s, bfhi(q.y) * s); o.z = pk2(bflo(q.z) * s, bfhi(q.z) * s); o.w = pk2(bflo(q.w) * s, bfhi(q.w) * s); return o;
}

__device__ __forceinline__ float sat8(float x) { return fminf(fmaxf(x, -448.f), 448.f); }
__device__ __forceinline__ void tr_item(const float* __restrict__ W, int ldw, int K, bf16* __restrict__ WT, int n_src0, int n_dst0, int k0, LAS unsigned char* scr, int lane) {
    const int nq = lane & 15, kg = lane >> 4;
    const float* src = W + (size_t)(k0 + 4 * kg) * ldw + n_src0 + 4 * nq;
#pragma unroll
    for (int j = 0; j < 4; ++j) {
        const float* s = src + (size_t)(16 * j) * ldw;
        const f32x4 r0 = *(const f32x4*)s, r1 = *(const f32x4*)(s + ldw), r2 = *(const f32x4*)(s + 2 * (size_t)ldw), r3 = *(const f32x4*)(s + 3 * (size_t)ldw);
#pragma unroll
        for (int c = 0; c < 4; ++c) { LAS unsigned* d = (LAS unsigned*)(scr + (4 * nq + c) * 132 + (16 * j + 4 * kg) * 2); d[0] = pk2(r0[c], r1[c]); d[1] = pk2(r2[c], r3[c]); }
    }
    const int row8 = lane >> 3, c8 = lane & 7;
#pragma unroll
    for (int jj = 0; jj < 8; ++jj) { const int row = row8 + 8 * jj; LAS unsigned char* rp = scr + row * 132 + 16 * c8;
        v4u o; o.x = *(LAS unsigned*)rp; o.y = *(LAS unsigned*)(rp + 4); o.z = *(LAS unsigned*)(rp + 8); o.w = *(LAS unsigned*)(rp + 12);
        *(v4u*)(WT + (size_t)(n_dst0 + row) * K + k0 + 8 * c8) = o; }
}
constexpr float W8SCALE = 64.f, W8INV = 1.f / 64.f;
__device__ __forceinline__ void tr8_item(const float* __restrict__ W, int ldw, int Kb, unsigned char* __restrict__ WT, int n0, int k0, LAS unsigned char* scr, int lane) {
    const int nq = lane & 15, kg = lane >> 4;
    const float* src = W + (size_t)(k0 + 4 * kg) * ldw + n0 + 4 * nq;
#pragma unroll 2
    for (int j = 0; j < 8; ++j) {
        const float* s = src + (size_t)(16 * j) * ldw;
        const f32x4 r0 = *(const f32x4*)s, r1 = *(const f32x4*)(s + ldw), r2 = *(const f32x4*)(s + 2 * (size_t)ldw), r3 = *(const f32x4*)(s + 3 * (size_t)ldw);
#pragma unroll
        for (int c = 0; c < 4; ++c) { int w = 0; w = __builtin_amdgcn_cvt_pk_fp8_f32(r0[c] * W8SCALE, r1[c] * W8SCALE, w, false); w = __builtin_amdgcn_cvt_pk_fp8_f32(r2[c] * W8SCALE, r3[c] * W8SCALE, w, true);
            *(LAS int*)(scr + (4 * nq + c) * 132 + 16 * j + 4 * kg) = w; }
    }
    const int row8 = lane >> 3, c8 = lane & 7;
#pragma unroll
    for (int jj = 0; jj < 8; ++jj) { const int row = row8 + 8 * jj; LAS unsigned char* rp = scr + row * 132 + 16 * c8;
        v4u o; o.x = *(LAS unsigned*)rp; o.y = *(LAS unsigned*)(rp + 4); o.z = *(LAS unsigned*)(rp + 8); o.w = *(LAS unsigned*)(rp + 12);
        *(v4u*)(WT + (size_t)(n0 + row) * Kb + k0 + 16 * c8) = o; }
}
__device__ __forceinline__ void p0_transposes(const Ctx& C, const Args& a) {
    const float* w_in = a.in[2]; const float* w_ml = a.in[5]; const float* w_da = a.in[10]; const float* w_o = a.in[11]; const float* w_gu = a.in[15]; const float* w_dn = a.in[17];
    bf16* WIN = (bf16*)(a.ws + WS_WIN); bf16* WML = (bf16*)(a.ws + WS_WML); bf16* WDA = (bf16*)(a.ws + WS_WDA); bf16* WO = (bf16*)(a.ws + WS_WO);
    const int gw = C.vcu * NWAVES + C.wave, NGW = C.G * NWAVES;
    constexpr int I_IN = 32 * 96, I_IN8 = 16 * 64;
    constexpr int NIT = I_IN + I_IN8;
    LAS unsigned char* scr = C.lds + C.wave * 8448;
    for (int it = gw; it < NIT; it += NGW) {
        int r = it;
        if (r < I_IN) { const int kb = r / 96, nb = r % 96, nd = nb * 64; tr_item(w_in, DIN, D, WIN, nd < G_OFF ? nd : nd + 16, nd, kb * 64, scr, C.lane); continue; } r -= I_IN;
        { const int kb = r / 64, nb = r % 64; tr8_item(w_in + (P_GM + 16), DIN, D, (unsigned char*)(a.ws + WS_WIN8), nb * 64, kb * 128, scr, C.lane); }
    }
    (void)w_ml; (void)w_da; (void)w_o; (void)WML; (void)WDA; (void)WO;
    __syncthreads();
}
__device__ __forceinline__ void p2_late_transposes(const Ctx& C, const Args& a) {
    const float* w_ml = a.in[5]; const float* w_da = a.in[10]; const float* w_o = a.in[11];
    bf16* WML = (bf16*)(a.ws + WS_WML); bf16* WDA = (bf16*)(a.ws + WS_WDA); bf16* WO = (bf16*)(a.ws + WS_WO);
    const int gw = C.vcu * NWAVES + C.wave, NGW = C.G * NWAVES;
    constexpr int I_ML = 16 * 32, I_O = 32 * 32, NIT = 2 * I_ML + I_O;
    LAS unsigned char* scr = C.lds + C.wave * 8448;
    for (int it = gw; it < NIT; it += NGW) {
        int r = it;
        if (r < I_ML) { const int kb = r / 32, nb = r % 32; tr_item(w_ml, D, MLW, WML, nb * 64, nb * 64, kb * 64, scr, C.lane); continue; } r -= I_ML;
        if (r < I_ML) { const int kb = r / 32, nb = r % 32; tr_item(w_da, D, DAW, WDA, nb * 64, nb * 64, kb * 64, scr, C.lane); continue; } r -= I_ML;
        { const int kb = r / 32, nb = r % 32; tr_item(w_o, D, D, WO, nb * 64, nb * 64, kb * 64, scr, C.lane); }
    }
    __syncthreads();
}
constexpr int CV_J_GU = 16 * 64, CV_J_DN = 16 * 32, CV_NJ = NE * (CV_J_GU + CV_J_DN);
struct ConvSet { f32x4 r[8]; };
struct Conv { int it, step; ConvSet s[2]; };
struct ConvItem { const float* src; unsigned char* dst; int ldw, Kb; };
__device__ __forceinline__ ConvItem conv_item(const Args& a, int it) {
    const float* w_gu = a.in[15]; const float* w_dn = a.in[17]; ConvItem ci;
    if (it < NE * CV_J_GU) { const int e = it / CV_J_GU, q = it % CV_J_GU, kb = q / 64, nb = q % 64; ci.ldw = 2 * DE; ci.Kb = D;
        ci.src = w_gu + (size_t)e * D * 2 * DE + (size_t)(kb * 128) * (2 * DE) + nb * 64;
        ci.dst = a.ws + WS_WGU + (size_t)e * 2 * DE * D + (size_t)(nb * 64) * D + kb * 128; }
    else { const int r = it - NE * CV_J_GU, e = r / CV_J_DN, q = r % CV_J_DN, kb = q / 32, nb = q % 32; ci.ldw = D; ci.Kb = DE;
        ci.src = w_dn + (size_t)e * DE * D + (size_t)(kb * 128) * D + nb * 64;
        ci.dst = a.ws + WS_WDN + (size_t)e * D * DE + (size_t)(nb * 64) * DE + kb * 128; }
    return ci;
}
__device__ __forceinline__ const char* uni_ptr(const void* p) { const unsigned long long v = (unsigned long long)p; const unsigned lo = __builtin_amdgcn_readfirstlane((unsigned)v), hi = __builtin_amdgcn_readfirstlane((unsigned)(v >> 32)); return (const char*)(((unsigned long long)hi << 32) | lo); }
struct ConvSrc { const float* src; int ldw; };
__device__ __forceinline__ ConvSrc conv_src(const Args& a, int it) { const int itc = it < CV_NJ ? it : CV_NJ - 1; const ConvItem ci = conv_item(a, __builtin_amdgcn_readfirstlane(itc)); ConvSrc s; s.src = ci.src; s.ldw = ci.ldw; return s; }
__device__ __forceinline__ unsigned conv_loff(const ConvSrc& cs, int lane) { return ((unsigned)(4 * (lane >> 4)) * (unsigned)cs.ldw + 4u * (lane & 15)) * 4u; }
__device__ __forceinline__ void conv_issue_one(ConvSet& S, const ConvSrc& cs, unsigned loff, int st, int q) {
    const char* sb = (const char*)(cs.src + (size_t)(16 * (2 * st + (q >> 2)) + (q & 3)) * cs.ldw);
    asm volatile("global_load_dwordx4 %0, %1, %2 nt" : "=v"(S.r[q]) : "v"(loff), "s"(sb) : "memory");
}
__device__ __forceinline__ void conv_issue(ConvSet& S, const Args& a, int it, int st, int lane) {
    const ConvSrc cs = conv_src(a, it); const unsigned loff = conv_loff(cs, lane);
#pragma unroll
    for (int q = 0; q < 8; ++q) conv_issue_one(S, cs, loff, st, q);
}
__device__ __forceinline__ void conv_next(int& it, int& st, int NGW) { if (st == 3) { st = 0; it += NGW; } else ++st; }
__device__ __forceinline__ void conv_begin(Conv& cv, const Args& a, int gw, int NGW, int lane) { cv.it = gw; cv.step = 0; conv_issue(cv.s[0], a, cv.it, cv.step, lane); }
__device__ __forceinline__ void conv_issue_next(Conv& cv, ConvSet& S, const Args& a, int NGW, int lane) { int it1 = cv.it, st1 = cv.step; conv_next(it1, st1, NGW); conv_issue(S, a, it1, st1, lane); }
template <int NW> __device__ __forceinline__ bool conv_consume(Conv& cv, ConvSet& S, const Args& a, LAS unsigned char* scr, int NGW, int lane) {
    if constexpr (NW == 12) asm volatile("s_waitcnt vmcnt(12)" : "+v"(S.r[0]), "+v"(S.r[1]), "+v"(S.r[2]), "+v"(S.r[3]), "+v"(S.r[4]), "+v"(S.r[5]), "+v"(S.r[6]), "+v"(S.r[7]) :: "memory");
    else if constexpr (NW == 8) asm volatile("s_waitcnt vmcnt(8)" : "+v"(S.r[0]), "+v"(S.r[1]), "+v"(S.r[2]), "+v"(S.r[3]), "+v"(S.r[4]), "+v"(S.r[5]), "+v"(S.r[6]), "+v"(S.r[7]) :: "memory");
    else asm volatile("s_waitcnt vmcnt(0)" : "+v"(S.r[0]), "+v"(S.r[1]), "+v"(S.r[2]), "+v"(S.r[3]), "+v"(S.r[4]), "+v"(S.r[5]), "+v"(S.r[6]), "+v"(S.r[7]) :: "memory");
    const int nq = lane & 15, kg = lane >> 4; const bool st = (cv.it < CV_NJ) && cv.step == 3;
#pragma unroll
    for (int jj = 0; jj < 2; ++jj) { const int j = 2 * cv.step + jj;
#pragma unroll
        for (int c = 0; c < 4; ++c) { int w = 0; w = __builtin_amdgcn_cvt_pk_fp8_f32(S.r[4 * jj + 0][c] * W8SCALE, S.r[4 * jj + 1][c] * W8SCALE, w, false);
            w = __builtin_amdgcn_cvt_pk_fp8_f32(S.r[4 * jj + 2][c] * W8SCALE, S.r[4 * jj + 3][c] * W8SCALE, w, true);
            *(LAS int*)(scr + (4 * nq + c) * 132 + 16 * j + 4 * kg) = w; } }
    if (st) {
        const ConvItem ci = conv_item(a, __builtin_amdgcn_readfirstlane(cv.it));
        const int row8 = lane >> 3, c8 = lane & 7;
#pragma unroll 2
        for (int jj = 0; jj < 8; ++jj) { const int row = row8 + 8 * jj; LAS unsigned char* rp = scr + row * 132 + 16 * c8;
            v4u o; o.x = *(LAS unsigned*)rp; o.y = *(LAS unsigned*)(rp + 4); o.z = *(LAS unsigned*)(rp + 8); o.w = *(LAS unsigned*)(rp + 12);
            *(v4u*)(ci.dst + (size_t)row * ci.Kb + 16 * c8) = o; }
    }
    conv_next(cv.it, cv.step, NGW);
    return st;
}
__device__ __forceinline__ void p0_xn_gates(const Ctx& C, const Args& a) {
    const float* x = a.in[0]; const float* g1 = a.in[1]; const float* w_in = a.in[2]; const float* gbias = a.in[3];
    bf16* XN = (bf16*)(a.ws + WS_XN); float* MG = (float*)(a.ws + WS_MG);
    for (int idx = C.tid; idx < D * 4; idx += NTHR) {
        const int k = idx >> 2, c = idx & 3; const f32x4 w = *(const f32x4*)(w_in + (size_t)k * DIN + G_OFF + 4 * c);
        const int r = (k & 3) * 512 + (k >> 2);
        *(LAS f32x4*)(C.lds + r * 64 + ((c ^ ((r >> 2) & 3)) * 16)) = w;
    }
    __syncthreads();
    const int gw = C.vcu * NWAVES + C.wave, NGW = C.G * NWAVES, lane = C.lane;
    for (int m = gw; m < T; m += NGW) {
        const f32x4* xr = (const f32x4*)(x + (size_t)m * D) + lane; f32x4 v[8]; float ss = 0.f;
#pragma unroll
        for (int j = 0; j < 8; ++j) { v[j] = xr[64 * j]; ss += (v[j].x * v[j].x + v[j].y * v[j].y) + (v[j].z * v[j].z + v[j].w * v[j].w); }
        const float rstd = rsqrtf(wave_sum(ss) * (1.f / D) + EPS);
        float acc[16];
#pragma unroll
        for (int i = 0; i < 16; ++i) acc[i] = 0.f;
        int lb = lane * 64; asm volatile("" : "+v"(lb));
        int lbase[4];
#pragma unroll
        for (int c = 0; c < 4; ++c) lbase[c] = lb + ((c ^ ((lane >> 2) & 3)) << 4);
#pragma unroll
        for (int j = 0; j < 8; ++j) {
            const f32x4 g = *((const f32x4*)g1 + lane + 64 * j);
            v[j].x *= rstd * g.x; v[j].y *= rstd * g.y; v[j].z *= rstd * g.z; v[j].w *= rstd * g.w;
            v2u o; o.x = pk2(v[j].x, v[j].y); o.y = pk2(v[j].z, v[j].w);
            *((v2u*)(XN + (size_t)m * D) + lane + 64 * j) = o;
            { int o8 = 0; o8 = __builtin_amdgcn_cvt_pk_fp8_f32(v[j].x, v[j].y, o8, false); o8 = __builtin_amdgcn_cvt_pk_fp8_f32(v[j].z, v[j].w, o8, true); *((int*)(a.ws + WS_XN8 + (size_t)m * D) + lane + 64 * j) = o8; }
#pragma unroll
            for (int i = 0; i < 4; ++i) {
                const float hv = v[j][i];
#pragma unroll
                for (int c = 0; c < 4; ++c) { const f32x4 w = *(const LAS f32x4*)(C.lds + lbase[c] + (i * 512 + 64 * j) * 64);
                    acc[4 * c + 0] += hv * w.x; acc[4 * c + 1] += hv * w.y; acc[4 * c + 2] += hv * w.z; acc[4 * c + 3] += hv * w.w; }
            }
        }
        float mine = 0.f;
#pragma unroll
        for (int i = 0; i < 16; ++i) { const float s = wave_sum(acc[i]); if (lane == i) mine = s; }
        if (lane < 16) MG[(size_t)m * 16 + lane] = mine + gbias[lane];
    }
}
__device__ __forceinline__ void p0_router_w(const Ctx& C, const Args& a) {
    const float* wr = a.in[13]; const float* g2 = a.in[12]; bf16* WRH = (bf16*)(a.ws + WS_WRH); bf16* WRL = (bf16*)(a.ws + WS_WRL);
    for (int g = C.vcu * NTHR + C.tid; g < D * NE; g += C.G * NTHR) { const int k = g >> 5, e = g & 31; const float w = wr[g] * g2[k];
        const int q = k & 15, idx = (((k >> 4) * 64) + ((q >> 2) & 1) * 32 + e) * 8 + (q >> 3) * 4 + (q & 3);
        const bf16 hi = f2bf(w); const bf16 lo = f2bf(w - bf2f(hi)); WRH[idx] = hi; WRL[idx] = lo; }
}
__device__ __forceinline__ void p0_rope(const Ctx& C, const Args& a) {
    float* ROPE = (float*)(a.ws + WS_ROPE);
    for (int g = C.vcu * NTHR + C.tid; g < S * 32; g += C.G * NTHR) {
        const int pos = g >> 5, i = g & 31;
        const double inv = exp2(-(double)i * (13.287712379549449 / 32.0));
        const double rev = (double)pos * inv * 0.15915494309189535;
        const double fr = rev - floor(rev + 0.5);
        const float ang = (float)(fr * 6.283185307179586);
        f32x2 cs; cs.x = cosf(ang); cs.y = sinf(ang);
        *(f32x2*)(ROPE + 2 * g) = cs;
    }
}

template <bool GATES8> struct EpiProj {
    static constexpr bool PERM = true, AFTER_DRAIN = false;
    bf16* O; unsigned char* G8;
    __device__ __forceinline__ void operator()(const pg8::f32x4 (&acc)[2][2][4][2], const pg8::Unit& u, int wr, int wc, int fr, int fq) const {
        const int pn = GATES8 ? u.pn + 24 : u.pn;
        const int row0 = u.pm * 256 + wr * 64 + fr, col0 = pn * 256 + wc * 32 + 8 * fq;
        const int mode = (pn == 2 || pn == 3) ? 1 : (((pn >= 8 && pn < 12) || pn >= 24) ? 2 : 0);
#pragma unroll
        for (int ai = 0; ai < 2; ++ai)
#pragma unroll
            for (int m = 0; m < 4; ++m) { bf16* rowp = O + (size_t)(row0 + ai * 128 + m * 16) * NPJ + col0;
#pragma unroll
                for (int bj = 0; bj < 2; ++bj) { pg8::f32x4 v0 = acc[ai][bj][m][0], v1 = acc[ai][bj][m][1];
                    if (GATES8) { v0 = v0 * W8INV; v1 = v1 * W8INV; }
                    if (mode == 1) { v0 = v0 * KSCALE; v1 = v1 * KSCALE; }
                    if (mode == 2) {
#pragma unroll
                        for (int i = 0; i < 4; ++i) { v0[i] = sigmoidf_(v0[i]); v1[i] = sigmoidf_(v1[i]); } }
                    if (GATES8) {
                        const unsigned q[8] = {(unsigned)__builtin_rintf(v0[0] * 255.f), (unsigned)__builtin_rintf(v0[1] * 255.f), (unsigned)__builtin_rintf(v0[2] * 255.f), (unsigned)__builtin_rintf(v0[3] * 255.f),
                                               (unsigned)__builtin_rintf(v1[0] * 255.f), (unsigned)__builtin_rintf(v1[1] * 255.f), (unsigned)__builtin_rintf(v1[2] * 255.f), (unsigned)__builtin_rintf(v1[3] * 255.f)};
                        v2u w; w.x = q[0] | (q[1] << 8) | (q[2] << 16) | (q[3] << 24); w.y = q[4] | (q[5] << 8) | (q[6] << 16) | (q[7] << 24);
                        *(v2u*)(G8 + (size_t)(row0 + ai * 128 + m * 16) * 4096 + u.pn * 256 + wc * 32 + 8 * fq + bj * 128) = w;
                    } else {
                    v4u w; w.x = pk2(v0[0], v0[1]); w.y = pk2(v0[2], v0[3]); w.z = pk2(v1[0], v1[1]); w.w = pk2(v1[2], v1[3]);
                    *(v4u*)(rowp + bj * 128) = w; } } }
    }
};
__device__ __forceinline__ void gate8(const unsigned char* G8, size_t row, int gcol, float (&g)[8]) {
    const v2u w = *(const v2u*)(G8 + row * 4096 + gcol); const float s = 1.f / 255.f;
    g[0] = (float)(w.x & 0xff) * s; g[1] = (float)((w.x >> 8) & 0xff) * s; g[2] = (float)((w.x >> 16) & 0xff) * s; g[3] = (float)(w.x >> 24) * s;
    g[4] = (float)(w.y & 0xff) * s; g[5] = (float)((w.y >> 8) & 0xff) * s; g[6] = (float)((w.y >> 16) & 0xff) * s; g[7] = (float)(w.y >> 24) * s;
}
template <int MODE> struct EpiGate {
    static constexpr bool PERM = true, AFTER_DRAIN = false;
    const bf16* PROJ; const bf16* T1in; bf16* O;
    __device__ __forceinline__ void operator()(const pg8::f32x4 (&acc)[2][2][4][2], const pg8::Unit& u, int wr, int wc, int fr, int fq) const {
        const int row0 = u.pm * 256 + wr * 64 + fr, col0 = u.pn * 256 + wc * 32 + 8 * fq;
#pragma unroll
        for (int ai = 0; ai < 2; ++ai)
#pragma unroll
            for (int m = 0; m < 4; ++m) { const size_t row = (size_t)(row0 + ai * 128 + m * 16);
#pragma unroll
                for (int bj = 0; bj < 2; ++bj) { const int col = col0 + bj * 128; const pg8::f32x4 v0 = acc[ai][bj][m][0], v1 = acc[ai][bj][m][1];
                    float g[8]; gate8((const unsigned char*)PROJ, row, (MODE ? 2048 : 0) + col, g);
                    float o[8] = {g[0] * v0[0], g[1] * v0[1], g[2] * v0[2], g[3] * v0[3], g[4] * v1[0], g[5] * v1[1], g[6] * v1[2], g[7] * v1[3]};
                    if (MODE == 1) { const v4u t = *(const v4u*)(T1in + row * D + col);
                        o[0] += bflo(t.x); o[1] += bfhi(t.x); o[2] += bflo(t.y); o[3] += bfhi(t.y); o[4] += bflo(t.z); o[5] += bfhi(t.z); o[6] += bflo(t.w); o[7] += bfhi(t.w); }
                    v4u w; w.x = pk2(o[0], o[1]); w.y = pk2(o[2], o[3]); w.z = pk2(o[4], o[5]); w.w = pk2(o[6], o[7]);
                    *(v4u*)(O + row * D + col) = w; } }
    }
};
struct EpiGatePair {
    static constexpr bool PERM = true, AFTER_DRAIN = false;
    const bf16* PROJ; bf16* T1; bf16* MIX;
    __device__ __forceinline__ void operator()(const pg8::f32x4 (&acc)[2][2][4][2], const pg8::Unit& u, int wr, int wc, int fr, int fq) const {
        const bool second = u.pm >= T / 256; const int pmr = second ? u.pm - T / 256 : u.pm;
        const int row0 = pmr * 256 + wr * 64 + fr, col0 = u.pn * 256 + wc * 32 + 8 * fq; const int gcol = second ? 2048 : 0; bf16* O = second ? MIX : T1;
#pragma unroll
        for (int ai = 0; ai < 2; ++ai)
#pragma unroll
            for (int m = 0; m < 4; ++m) { const size_t row = (size_t)(row0 + ai * 128 + m * 16);
#pragma unroll
                for (int bj = 0; bj < 2; ++bj) { const int col = col0 + bj * 128; const pg8::f32x4 v0 = acc[ai][bj][m][0], v1 = acc[ai][bj][m][1];
                    float g[8]; gate8((const unsigned char*)PROJ, row, gcol + col, g);
                    float o[8] = {g[0] * v0[0], g[1] * v0[1], g[2] * v0[2], g[3] * v0[3], g[4] * v1[0], g[5] * v1[1], g[6] * v1[2], g[7] * v1[3]};
                    if (second) { const v4u t = *(const v4u*)(T1 + row * D + col);
                        o[0] += bflo(t.x); o[1] += bfhi(t.x); o[2] += bflo(t.y); o[3] += bfhi(t.y); o[4] += bflo(t.z); o[5] += bfhi(t.z); o[6] += bflo(t.w); o[7] += bfhi(t.w); }
                    v4u w; w.x = pk2(o[0], o[1]); w.y = pk2(o[2], o[3]); w.z = pk2(o[4], o[5]); w.w = pk2(o[6], o[7]);
                    *(v4u*)(O + row * D + col) = w; } }
    }
};
struct PairOrder {
    pg8::StaticOrder so;
    __device__ __forceinline__ bool next(int i, pg8::Unit& u) const {
        const int per = so.nwg / so.G;
        if (i >= 2 * per) return false;
        const bool second = i >= per; if (!so.next(second ? i - per : i, u)) return false;
        if (second) { u.pm += T / 256; u.pb += D / 256; }
        return true;
    }
    __device__ __forceinline__ void a_ready(const pg8::Unit&) const {}
    __device__ __forceinline__ void done(const pg8::Unit&) const {}
    __device__ __forceinline__ int rot() const { return 0; }
};
struct EpiRes {
    static constexpr bool PERM = false, AFTER_DRAIN = false;
    const float* X; float* O;
    __device__ __forceinline__ void operator()(const pg8::f32x4 (&acc)[2][2][4][2], const pg8::Unit& u, int wr, int wc, int fr, int fq) const {
        const int row0 = u.pm * 256 + wr * 64 + fr, col0 = u.pn * 256 + wc * 32 + 4 * fq;
#pragma unroll
        for (int ai = 0; ai < 2; ++ai)
#pragma unroll
            for (int m = 0; m < 4; ++m) { const size_t off = (size_t)(row0 + ai * 128 + m * 16) * D + col0;
#pragma unroll
                for (int bj = 0; bj < 2; ++bj)
#pragma unroll
                    for (int n = 0; n < 2; ++n) { const pg8::f32x4 xv = *(const pg8::f32x4*)(X + off + bj * 128 + n * 16); *(pg8::f32x4*)(O + off + bj * 128 + n * 16) = xv + acc[ai][bj][m][n]; } }
    }
};
struct EpiAct {
    static constexpr bool PERM = true, AFTER_DRAIN = false;
    const float* bias; unsigned char* O;
    __device__ __forceinline__ void operator()(const pg8::f32x4 (&acc)[2][2][4][2], const pg8::Unit& u, int wr, int wc, int fr, int fq) const {
        const int row0 = u.pm * 256 + wr * 64 + fr, col0 = u.pn * 256 + wc * 32 + 8 * fq, e = u.pb >> 4;
        pg8::f32x4 bv[2][2];
#pragma unroll
        for (int bj = 0; bj < 2; ++bj)
#pragma unroll
            for (int n = 0; n < 2; ++n) bv[bj][n] = *(const pg8::f32x4*)(bias + (size_t)e * 2 * DE + col0 + bj * 128 + 4 * n);
#pragma unroll
        for (int ai = 0; ai < 2; ++ai)
#pragma unroll
            for (int m = 0; m < 4; ++m) { const size_t row = (size_t)(row0 + ai * 128 + m * 16);
#pragma unroll
                for (int bj = 0; bj < 2; ++bj) { const pg8::f32x4 v0 = acc[ai][bj][m][0] * W8INV + bv[bj][0], v1 = acc[ai][bj][m][1] * W8INV + bv[bj][1];
                    const float gu[8] = {v0[0], v0[1], v0[2], v0[3], v1[0], v1[1], v1[2], v1[3]}; float o[4];
#pragma unroll
                    for (int p = 0; p < 4; ++p) { const float glu = fminf(gu[2 * p], 7.f), lin = fminf(fmaxf(gu[2 * p + 1], -7.f), 7.f); o[p] = glu * sigmoidf_(1.702f * glu) * (lin + 1.f); }
                    int w = 0; w = __builtin_amdgcn_cvt_pk_fp8_f32(o[0], o[1], w, false); w = __builtin_amdgcn_cvt_pk_fp8_f32(o[2], o[3], w, true);
                    *(int*)(O + row * DE + ((col0 + bj * 128) >> 1)) = w; } }
    }
};
struct EpiY {
    static constexpr bool PERM = true, AFTER_DRAIN = false;
    const float* bias; bf16* O;
    __device__ __forceinline__ void operator()(const pg8::f32x4 (&acc)[2][2][4][2], const pg8::Unit& u, int wr, int wc, int fr, int fq) const {
        const int row0 = u.pm * 256 + wr * 64 + fr, col0 = u.pn * 256 + wc * 32 + 8 * fq, e = u.pb >> 3;
        pg8::f32x4 bv[2][2];
#pragma unroll
        for (int bj = 0; bj < 2; ++bj)
#pragma unroll
            for (int n = 0; n < 2; ++n) bv[bj][n] = *(const pg8::f32x4*)(bias + (size_t)e * D + col0 + bj * 128 + 4 * n);
#pragma unroll
        for (int ai = 0; ai < 2; ++ai)
#pragma unroll
            for (int m = 0; m < 4; ++m) { const size_t row = (size_t)(row0 + ai * 128 + m * 16);
#pragma unroll
                for (int bj = 0; bj < 2; ++bj) { const pg8::f32x4 v0 = acc[ai][bj][m][0] * W8INV + bv[bj][0], v1 = acc[ai][bj][m][1] * W8INV + bv[bj][1];
                    int a0 = 0, a1 = 0; a0 = __builtin_amdgcn_cvt_pk_fp8_f32(sat8(v0[0]), sat8(v0[1]), a0, false); a0 = __builtin_amdgcn_cvt_pk_fp8_f32(sat8(v0[2]), sat8(v0[3]), a0, true);
                    a1 = __builtin_amdgcn_cvt_pk_fp8_f32(sat8(v1[0]), sat8(v1[1]), a1, false); a1 = __builtin_amdgcn_cvt_pk_fp8_f32(sat8(v1[2]), sat8(v1[3]), a1, true);
                    v2u w; w.x = (unsigned)a0; w.y = (unsigned)a1;
                    *(v2u*)((unsigned char*)O + row * D + col0 + bj * 128) = w; } }
    }
};
struct MoeSched {
    int tsl, fin, hin, fl, F, total, NT, G, c;
    __device__ __forceinline__ void init(const int* cnt, int NT_, int G_, int c_, int lane) {
        const int cn = lane < NE ? cnt[lane] : 0, f = cn / PADM, r = cn - f * PADM;
        const int full = f + (r > PADM / 2 ? 1 : 0), half = (r > 0 && r <= PADM / 2) ? 1 : 0, tiles = full + half;
        int it = tiles, iff = full, ih = half;
#pragma unroll
        for (int o = 1; o < 32; o <<= 1) { const int t0 = __shfl_up(it, o), t1 = __shfl_up(iff, o), t2 = __shfl_up(ih, o); if (lane >= o) { it += t0; iff += t1; ih += t2; } }
        F = __shfl(iff, 31); total = F + __shfl(ih, 31);
        tsl = it - tiles; fl = full; fin = lane < NE ? iff : 0x7fffffff; hin = lane < NE ? ih : 0x7fffffff; NT = NT_; G = G_; c = c_;
    }
    __device__ __forceinline__ bool next(int i, pg8::Unit& u) const {
        int mo, pn;
        if (G == 256) { const int x = c & 7, jj = c >> 3, NPB = NT >> 3, RPM = (8 / NPB) * 4;
            mo = i * RPM + (x / NPB) * 4 + (jj & 3); pn = (x % NPB) * 8 + (jj >> 2); }
        else { const long L = (long)i * G + c; mo = (int)(L / NT); pn = (int)(L % NT); }
        if (mo >= total) return false;
        int e, mt, hf;
        if (mo < F) { e = __popcll(__ballot(fin <= mo)); mt = __shfl(tsl, e) + (mo - (__shfl(fin, e) - __shfl(fl, e))); hf = 0; }
        else { e = __popcll(__ballot(hin <= mo - F)); mt = __shfl(tsl, e) + __shfl(fl, e); hf = 1; }
        u.pm = mt; u.pn = pn; u.pb = e * NT + pn; u.half = __builtin_amdgcn_readfirstlane(hf); return true;
    }
    __device__ __forceinline__ void a_ready(const pg8::Unit&) const {}
    __device__ __forceinline__ void done(const pg8::Unit&) const {}
    __device__ __forceinline__ int rot() const { const int jj = c >> 3; return G == 256 ? ((jj >> 2) + (jj & 3)) & 15 : 0; }
};

__device__ __forceinline__ void p2_mstats(const Ctx& C, const Args& a) {
    const float* MG = (const float*)(a.ws + WS_MG); float* GA = (float*)(a.ws + WS_MSC);
    const int gw = C.vcu * NWAVES + C.wave, NGW = C.G * NWAVES, lane = C.lane;
    for (int q = gw; q < 16 * 64; q += NGW) {
        const int chain = q >> 6, c = q & 63, dir = chain & 1, hh = (chain >> 1) & 3, b = chain >> 3;
        const int p = b * S + 64 * c + (dir ? 63 - lane : lane);
        const float lf = logsigf_(MG[(size_t)p * 16 + (dir ? 12 : 4) + hh]), ig = MG[(size_t)p * 16 + (dir ? 8 : 0) + hh];
        const float bs = incl_sum_up(lf, lane), g = __shfl(bs, 63), amax = g + wave_max(ig - bs);
        if (lane == 0) { f32x2 o; o.x = g; o.y = amax; *(f32x2*)(GA + (size_t)q * 2) = o; }
    }
}
struct MScan { float mprev, mnew, dec; };
__device__ __forceinline__ float rdlane(float v, int l) { return __int_as_float(__builtin_amdgcn_readlane(__float_as_int(v), l)); }
__device__ __forceinline__ MScan mscan(const float* GA, int chain, int lane) {
    const f32x2 ga = *(const f32x2*)(GA + (size_t)(chain * 64 + lane) * 2); const int dir = chain & 1;
    MScan r; r.mprev = 0.f; r.mnew = 0.f; r.dec = 0.f; float m = 0.f;
    for (int ci = 0; ci < 64; ++ci) { const int cc = dir ? 63 - ci : ci;
        const float gc = rdlane(ga.x, cc), ac = rdlane(ga.y, cc), mnew = fmaxf(gc + m, ac);
        if (lane == cc) { r.mprev = m; r.mnew = mnew; r.dec = __expf(gc + m - mnew); }
        m = mnew; }
    return r;
}
__device__ __forceinline__ void p2_qkprep(const Ctx& C, const Args& a) {
    const bf16* PROJ = (const bf16*)(a.ws + WS_PROJ); const float* ROPE = (const float*)(a.ws + WS_ROPE);
    const float* qg = a.in[6]; const float* kg = a.in[7];
    bf16* QN = (bf16*)(a.ws + WS_QN); bf16* KN = (bf16*)(a.ws + WS_KN);
    const int gw = C.vcu * NWAVES + C.wave, NGW = C.G * NWAVES, lane = C.lane, g = lane >> 2, sub = lane & 3;
    for (int m = gw; m < T; m += NGW) {
        const int pos = m & (S - 1);
        float cs[8], sn[8];
#pragma unroll
        for (int i = 0; i < 4; ++i) { const f32x4 t = *(const f32x4*)(ROPE + ((size_t)pos * 32 + sub * 8 + 2 * i) * 2); cs[2 * i] = t.x; sn[2 * i] = t.y; cs[2 * i + 1] = t.z; sn[2 * i + 1] = t.w; }
#pragma unroll
        for (int which = 0; which < 2; ++which) {
            const bf16* src = PROJ + (size_t)m * NPJ + (which ? P_DK : P_DQ) + g * 64 + sub * 8;
            const v4u a1 = *(const v4u*)src, a2 = *(const v4u*)(src + 32);
            float x1[8] = {bflo(a1.x), bfhi(a1.x), bflo(a1.y), bfhi(a1.y), bflo(a1.z), bfhi(a1.z), bflo(a1.w), bfhi(a1.w)};
            float x2[8] = {bflo(a2.x), bfhi(a2.x), bflo(a2.y), bfhi(a2.y), bflo(a2.z), bfhi(a2.z), bflo(a2.w), bfhi(a2.w)};
            float ss = 0.f;
#pragma unroll
            for (int i = 0; i < 8; ++i) ss += x1[i] * x1[i] + x2[i] * x2[i];
            ss += __shfl_xor(ss, 1); ss += __shfl_xor(ss, 2);
            const float r = rsqrtf(ss * (1.f / 64.f) + EPS) * (which ? 1.f : QSCALE);
            const float* gn = which ? kg : qg; float o1[8], o2[8];
#pragma unroll
            for (int i = 0; i < 8; ++i) { const float u1 = x1[i] * r * gn[sub * 8 + i], u2 = x2[i] * r * gn[32 + sub * 8 + i]; o1[i] = u1 * cs[i] - u2 * sn[i]; o2[i] = u2 * cs[i] + u1 * sn[i]; }
            bf16* dst = (which ? KN : QN) + (size_t)m * 1024 + g * 64 + sub * 8;
            v4u w1, w2; w1.x = pk2(o1[0], o1[1]); w1.y = pk2(o1[2], o1[3]); w1.z = pk2(o1[4], o1[5]); w1.w = pk2(o1[6], o1[7]);
            w2.x = pk2(o2[0], o2[1]); w2.y = pk2(o2[2], o2[3]); w2.z = pk2(o2[4], o2[5]); w2.w = pk2(o2[6], o2[7]);
            *(v4u*)dst = w1; *(v4u*)(dst + 32) = w2;
        }
    }
}

__device__ __forceinline__ void mlA_unit(const Ctx& C, int u, const Args& a) {
    const bf16* PROJ = (const bf16*)(a.ws + WS_PROJ); const float* MG = (const float*)(a.ws + WS_MG); const float* MSC = (const float*)(a.ws + WS_MSC);
    bf16* U = (bf16*)(a.ws + WS_U); float* NU = (float*)(a.ws + WS_NU);
    const int b = u >> 8, hh = (u >> 6) & 3, j = u & 63, chain0 = (b * 4 + hh) * 2;
    const size_t row0 = (size_t)b * S + j * 64;
    const int tid = C.tid, lane = C.lane, w = C.wave;
    LAS unsigned char* lds = C.lds;
    constexpr int KI = 0, VI = 20480, WKF = 57344, WKB = 77824, WF = 98304;
    __syncthreads();
#pragma unroll
    for (int i = 0; i < 2; ++i) { const int p = tid + 512 * i, row = p >> 4, c = p & 15;
        *(LAS v4u*)(lds + KI + row * 320 + c * 16) = *(const v4u*)(PROJ + (row0 + row) * NPJ + P_MK + hh * 128 + c * 8); }
#pragma unroll
    for (int i = 0; i < 4; ++i) { const int p = tid + 512 * i, row = p >> 5, c = p & 31;
        *(LAS v4u*)(lds + VI + row * 576 + c * 16) = *(const v4u*)(PROJ + (row0 + row) * NPJ + P_MV + hh * 256 + c * 8); }
    if (w < 2) {
        const int dir = w, t = lane;
        const float fgv = MG[(row0 + t) * 16 + (dir ? 12 : 4) + hh], igv = MG[(row0 + t) * 16 + (dir ? 8 : 0) + hh];
        const float lf = logsigf_(fgv), P = incl_sum_up(lf, lane), Gt = __shfl(P, 63);
        const float bcur = dir ? (Gt - P + lf) : P;
        const MScan ms = mscan(MSC, chain0 + dir, lane);
        const float av = Gt - bcur + igv, mnew = rdlane(ms.mnew, j);
        ((LAS float*)(lds + WF + dir * 256))[t] = __expf(av - mnew);
    }
    __syncthreads();
#pragma unroll
    for (int i = 0; i < 2; ++i) { const int p = tid + 512 * i, row = p >> 4, c = p & 15;
        const v4u kv = *(LAS v4u*)(lds + KI + row * 320 + c * 16);
        const float wf = ((LAS float*)(lds + WF))[row], wb = ((LAS float*)(lds + WF + 256))[row];
        *(LAS v4u*)(lds + WKF + row * 320 + c * 16) = scale8(kv, wf);
        *(LAS v4u*)(lds + WKB + row * 320 + c * 16) = scale8(kv, wb); }
    if (tid < 256) { const int dir = tid >> 7, k = tid & 127; float s = 0.f;
        for (int t = 0; t < 64; ++t) s += ((LAS float*)(lds + WF + dir * 256))[t] * bf2f(*(LAS bf16*)(lds + KI + t * 320 + k * 2));
        NU[(size_t)((chain0 + dir) * 64 + j) * 128 + k] = s; }
    __syncthreads();
    const int G_ = (lane >> 4) & 1, i16 = lane & 15, q_ = i16 >> 2, p_ = i16 & 3, h = lane >> 5, r32 = lane & 31;
    f32x16 acc[2][4];
#pragma unroll
    for (int d = 0; d < 2; ++d)
#pragma unroll
        for (int n = 0; n < 4; ++n) acc[d][n] = f32x16{};
#pragma unroll
    for (int s = 0; s < 4; ++s) {
        LAS unsigned char* va = lds + VI + (16 * s + 8 * h + q_) * 576 + (32 * w + 16 * G_ + 4 * p_) * 2;
        const bf16x8 af = cat8(trr(va), trr(va + 4 * 576));
#pragma unroll
        for (int d = 0; d < 2; ++d)
#pragma unroll
            for (int n = 0; n < 4; ++n) {
                LAS unsigned char* ba = lds + (d ? WKB : WKF) + (16 * s + 8 * h + q_) * 320 + (32 * n + 16 * G_ + 4 * p_) * 2;
                const bf16x8 bfr = cat8(trr(ba), trr(ba + 4 * 320));
                acc[d][n] = __builtin_amdgcn_mfma_f32_32x32x16_bf16(bfr, af, acc[d][n], 0, 0, 0);
            }
    }
    __syncthreads();
    LAS unsigned char* ut = lds + w * 4096;
#pragma unroll
    for (int d = 0; d < 2; ++d) {
#pragma unroll
        for (int n = 0; n < 4; ++n)
#pragma unroll
            for (int g4 = 0; g4 < 4; ++g4) { int o = 0; o = __builtin_amdgcn_cvt_pk_fp8_f32(sat8(acc[d][n][4 * g4 + 0]), sat8(acc[d][n][4 * g4 + 1]), o, false); o = __builtin_amdgcn_cvt_pk_fp8_f32(sat8(acc[d][n][4 * g4 + 2]), sat8(acc[d][n][4 * g4 + 3]), o, true);
                *(LAS int*)(ut + r32 * 128 + ((32 * n + 8 * g4 + 4 * h) ^ ((r32 & 7) << 4))) = o; }
        unsigned char* ub = (unsigned char*)U + ((size_t)((chain0 + d) * 64 + j) * 256 + 32 * w) * 128;
#pragma unroll
        for (int i = 0; i < 4; ++i) { const int row = 8 * i + (lane >> 3), ch = lane & 7;
            const v4u v = *(LAS v4u*)(ut + row * 128 + ((ch ^ (row & 7)) << 4));
            *(v4u*)(ub + (size_t)row * 128 + ch * 16) = v; }
    }
}
__device__ __forceinline__ void mlB_scan(const Ctx& C, const Args& a) {
    const bf16* __restrict__ U = (const bf16*)(a.ws + WS_U); bf16* __restrict__ CP = (bf16*)(a.ws + WS_CP); const float* MSC = (const float*)(a.ws + WS_MSC);
    const float* __restrict__ NU = (const float*)(a.ws + WS_NU); float* __restrict__ NP = (float*)(a.ws + WS_NP);
    for (int g = C.vcu * NTHR + C.tid; g < 16 * 8192; g += C.G * NTHR) {
        const int chain = __builtin_amdgcn_readfirstlane(g >> 13), e4 = g & 8191, dir = chain & 1;
        const MScan ms = mscan(MSC, chain, C.lane);
        const unsigned char* ub = (const unsigned char*)U + (size_t)chain * 64 * 32768 + 4 * e4; unsigned char* cb = (unsigned char*)CP + (size_t)chain * 64 * 32768 + 4 * e4;
        f32x4 st = {0.f, 0.f, 0.f, 0.f};
#pragma unroll 8
        for (int ci = 0; ci < 64; ++ci) { const int c = dir ? 63 - ci : ci; const float dec = rdlane(ms.dec, c);
            { int o = 0; o = __builtin_amdgcn_cvt_pk_fp8_f32(sat8(st.x), sat8(st.y), o, false); o = __builtin_amdgcn_cvt_pk_fp8_f32(sat8(st.z), sat8(st.w), o, true); *(int*)(cb + (size_t)c * 32768) = o; }
            const int ur = *(const int*)(ub + (size_t)c * 32768); const f32x4 uv = {__builtin_amdgcn_cvt_f32_fp8(ur, 0), __builtin_amdgcn_cvt_f32_fp8(ur, 1), __builtin_amdgcn_cvt_f32_fp8(ur, 2), __builtin_amdgcn_cvt_f32_fp8(ur, 3)}; st = st * dec + uv; }
    }
    const int g = C.vcu * NTHR + C.tid;
    if (g < 512) { const int chain = g >> 5, k4 = g & 31, dir = chain & 1; f32x4 st = {0.f, 0.f, 0.f, 0.f};
        const int chA = __builtin_amdgcn_readfirstlane(chain); const MScan m0 = mscan(MSC, chA, C.lane), m1 = mscan(MSC, chA + 1, C.lane);
        for (int ci = 0; ci < 64; ++ci) { const int c = dir ? 63 - ci : ci; const float d0 = __shfl(m0.dec, c), d1 = __shfl(m1.dec, c); const float dec = (chain == chA) ? d0 : d1;
            *(f32x4*)(NP + (size_t)(chain * 64 + c) * 128 + 4 * k4) = st;
            const f32x4 uv = *(const f32x4*)(NU + (size_t)(chain * 64 + c) * 128 + 4 * k4); st = st * dec + uv; } }
}
__device__ __forceinline__ void mlC_unit(const Ctx& C, int u, const Args& a) {
    const bf16* PROJ = (const bf16*)(a.ws + WS_PROJ); const float* MG = (const float*)(a.ws + WS_MG); const float* MSC = (const float*)(a.ws + WS_MSC);
    const bf16* CP = (const bf16*)(a.ws + WS_CP); const float* NP = (const float*)(a.ws + WS_NP); const float* mlg = a.in[4]; bf16* HM = (bf16*)(a.ws + WS_HM);
    const int b = u >> 8, hh = (u >> 6) & 3, j = u & 63, chain0 = (b * 4 + hh) * 2;
    const size_t row0 = (size_t)b * S + j * 64;
    const int tid = C.tid, lane = C.lane, w = C.wave;
    LAS unsigned char* lds = C.lds;
    constexpr int QI = 0, KI = 17408, VI = 34816, SI = 71680, PI = 89088, SC = 98304;
    constexpr int NQ = SC + 2048, NPL = SC + 6144, SSO = SC + 7168, RS = SC + 9216;
    __syncthreads();
#pragma unroll
    for (int i = 0; i < 2; ++i) { const int p = tid + 512 * i, row = p >> 4, c = p & 15;
        *(LAS v4u*)(lds + QI + row * 272 + c * 16) = *(const v4u*)(PROJ + (row0 + row) * NPJ + P_MQ + hh * 128 + c * 8);
        *(LAS v4u*)(lds + KI + row * 272 + c * 16) = *(const v4u*)(PROJ + (row0 + row) * NPJ + P_MK + hh * 128 + c * 8); }
#pragma unroll
    for (int i = 0; i < 4; ++i) { const int p = tid + 512 * i, row = p >> 5, c = p & 31;
        *(LAS v4u*)(lds + VI + row * 576 + c * 16) = *(const v4u*)(PROJ + (row0 + row) * NPJ + P_MV + hh * 256 + c * 8); }
    if (tid < 256) ((LAS float*)(lds + NPL))[tid] = NP[(size_t)((chain0 + (tid >> 7)) * 64 + j) * 128 + (tid & 127)];
    v2u cpr[2][8];
#pragma unroll
    for (int d = 0; d < 2; ++d) { const unsigned char* cp = (const unsigned char*)CP + ((size_t)((chain0 + d) * 64 + j) * 256 + 32 * w + (lane & 31)) * 128 + 8 * (lane >> 5);
#pragma unroll
        for (int ks = 0; ks < 8; ++ks) cpr[d][ks] = *(const v2u*)(cp + 16 * ks); }
    if (w < 2) {
        const int dir = w, t = lane;
        const float fgv = MG[(row0 + t) * 16 + (dir ? 12 : 4) + hh], igv = MG[(row0 + t) * 16 + (dir ? 8 : 0) + hh];
        const float lf = logsigf_(fgv), P = incl_sum_up(lf, lane), Gt = __shfl(P, 63);
        const float bcur = dir ? (Gt - P + lf) : P, cv = igv - bcur;
        const float pm = dir ? incl_max_down(cv, lane) : incl_max_up(cv, lane);
        const MScan ms = mscan(MSC, chain0 + dir, lane); const float mprev = rdlane(ms.mprev, j);
        const float mt = bcur + fmaxf(mprev, pm), si = __expf(bcur + mprev - mt);
        LAS float* sc = (LAS float*)(lds + SC + dir * 1024);
        sc[t] = bcur; sc[64 + t] = cv; sc[128 + t] = mt; sc[192 + t] = si;
    }
    __syncthreads();
    {
        const int fr = lane & 15, fq = lane >> 4;
#pragma unroll
        for (int tt = 0; tt < 2; ++tt) { const int tile = 2 * w + tt, ti = tile >> 2, si_ = tile & 3; f32x4 acc4 = {0.f, 0.f, 0.f, 0.f};
#pragma unroll
            for (int ks = 0; ks < 4; ++ks) {
                const bf16x8 aq = *(LAS bf16x8*)(lds + QI + (16 * ti + fr) * 272 + (32 * ks + 8 * fq) * 2);
                const bf16x8 bk = *(LAS bf16x8*)(lds + KI + (16 * si_ + fr) * 272 + (32 * ks + 8 * fq) * 2);
                acc4 = __builtin_amdgcn_mfma_f32_16x16x32_bf16(aq, bk, acc4, 0, 0, 0); }
#pragma unroll
            for (int i = 0; i < 4; ++i) ((LAS float*)(lds + SI))[(16 * ti + 4 * fq + i) * 68 + 16 * si_ + fr] = acc4[i]; }
        const int t = tid & 63, part = tid >> 6;
        const v4u q0 = *(LAS v4u*)(lds + QI + t * 272 + part * 32), q1 = *(LAS v4u*)(lds + QI + t * 272 + part * 32 + 16);
        const float qv[16] = {bflo(q0.x), bfhi(q0.x), bflo(q0.y), bfhi(q0.y), bflo(q0.z), bfhi(q0.z), bflo(q0.w), bfhi(q0.w), bflo(q1.x), bfhi(q1.x), bflo(q1.y), bfhi(q1.y), bflo(q1.z), bfhi(q1.z), bflo(q1.w), bfhi(q1.w)};
#pragma unroll
        for (int d = 0; d < 2; ++d) { float s = 0.f;
#pragma unroll
            for (int k = 0; k < 16; ++k) s += ((LAS float*)(lds + NPL))[d * 128 + part * 16 + k] * qv[k];
            ((LAS float*)(lds + NQ))[(d * 8 + part) * 64 + t] = s; }
    }
    __syncthreads();
    {
        const int t = tid >> 3, sg = tid & 7, s0 = 8 * sg;
        const f32x4 sa = *(LAS f32x4*)(lds + SI + (t * 68 + s0) * 4), sb = *(LAS f32x4*)(lds + SI + (t * 68 + s0 + 4) * 4);
        const float sv[8] = {sa.x, sa.y, sa.z, sa.w, sb.x, sb.y, sb.z, sb.w};
        float p[2][8], inv[2];
#pragma unroll
        for (int d = 0; d < 2; ++d) { LAS float* sc = (LAS float*)(lds + SC + d * 1024);
            const float Bt = sc[t], MTt = sc[128 + t], SIt = sc[192 + t]; float rs = 0.f;
#pragma unroll
            for (int e = 0; e < 8; ++e) { const int s = s0 + e; const bool ok = d ? (s >= t) : (s <= t);
                const float dv = ok ? __expf(Bt + sc[64 + s] - MTt) : 0.f; p[d][e] = dv * sv[e]; rs += p[d][e]; }
            float nq = ((LAS float*)(lds + NQ))[(d * 8 + sg) * 64 + t];
            rs += __shfl_xor(rs, 1); rs += __shfl_xor(rs, 2); rs += __shfl_xor(rs, 4);
            nq += __shfl_xor(nq, 1); nq += __shfl_xor(nq, 2); nq += __shfl_xor(nq, 4);
            const float den = fmaxf(fabsf(SIt * nq + rs), __expf(-MTt)); inv[d] = 1.f / den;
            if (sg == 0) ((LAS float*)(lds + RS))[d * 64 + t] = SIt * inv[d]; }
        float o[8];
#pragma unroll
        for (int e = 0; e < 8; ++e) o[e] = p[0][e] * inv[0] + p[1][e] * inv[1];
        v4u wv; wv.x = pk2(o[0], o[1]); wv.y = pk2(o[2], o[3]); wv.z = pk2(o[4], o[5]); wv.w = pk2(o[6], o[7]);
        *(LAS v4u*)(lds + PI + t * 144 + s0 * 2) = wv;
    }
    __syncthreads();
#pragma unroll
    for (int i = 0; i < 2; ++i) { const int p = tid + 512 * i, row = p >> 4, c = p & 15;
        const v4u qv = *(LAS v4u*)(lds + QI + row * 272 + c * 16);
        const float rf = ((LAS float*)(lds + RS))[row], rb = ((LAS float*)(lds + RS))[64 + row];
        *(LAS v4u*)(lds + QI + row * 272 + c * 16) = scale8(qv, rf);
        *(LAS v4u*)(lds + KI + row * 272 + c * 16) = scale8(qv, rb); }
    __syncthreads();
    const int G_ = (lane >> 4) & 1, i16 = lane & 15, q_ = i16 >> 2, p_ = i16 & 3, h = lane >> 5, r32 = lane & 31;
    f32x16 acc[2]; acc[0] = f32x16{}; acc[1] = f32x16{};
#pragma unroll
    for (int d = 0; d < 2; ++d) {
#pragma unroll
        for (int ks = 0; ks < 8; ++ks) { const v2u cr = cpr[d][ks]; v4u a4;
            a4.x = pk2(__builtin_amdgcn_cvt_f32_fp8((int)cr.x, 0), __builtin_amdgcn_cvt_f32_fp8((int)cr.x, 1)); a4.y = pk2(__builtin_amdgcn_cvt_f32_fp8((int)cr.x, 2), __builtin_amdgcn_cvt_f32_fp8((int)cr.x, 3));
            a4.z = pk2(__builtin_amdgcn_cvt_f32_fp8((int)cr.y, 0), __builtin_amdgcn_cvt_f32_fp8((int)cr.y, 1)); a4.w = pk2(__builtin_amdgcn_cvt_f32_fp8((int)cr.y, 2), __builtin_amdgcn_cvt_f32_fp8((int)cr.y, 3));
            const bf16x8 af = __builtin_bit_cast(bf16x8, a4);
#pragma unroll
            for (int th = 0; th < 2; ++th) { const bf16x8 bq = *(LAS bf16x8*)(lds + (d ? KI : QI) + (32 * th + r32) * 272 + (16 * ks + 8 * h) * 2);
                acc[th] = __builtin_amdgcn_mfma_f32_32x32x16_bf16(af, bq, acc[th], 0, 0, 0); } } }
#pragma unroll
    for (int ks = 0; ks < 4; ++ks) { LAS unsigned char* va = lds + VI + (16 * ks + 8 * h + q_) * 576 + (32 * w + 16 * G_ + 4 * p_) * 2;
        const bf16x8 af = cat8(trr(va), trr(va + 4 * 576));
#pragma unroll
        for (int th = 0; th < 2; ++th) { const bf16x8 bp = *(LAS bf16x8*)(lds + PI + (32 * th + r32) * 144 + (16 * ks + 8 * h) * 2);
            acc[th] = __builtin_amdgcn_mfma_f32_32x32x16_bf16(af, bp, acc[th], 0, 0, 0); } }
#pragma unroll
    for (int th = 0; th < 2; ++th) { float ss = 0.f;
#pragma unroll
        for (int r = 0; r < 16; ++r) ss += acc[th][r] * acc[th][r];
        ss += __shfl_xor(ss, 32);
        if (h == 0) ((LAS float*)(lds + SSO))[w * 64 + 32 * th + r32] = ss; }
    __syncthreads();
#pragma unroll
    for (int th = 0; th < 2; ++th) { float tot = 0.f;
#pragma unroll
        for (int ww = 0; ww < 8; ++ww) tot += ((LAS float*)(lds + SSO))[ww * 64 + 32 * th + r32];
        const float rr = rsqrtf(tot * (1.f / 256.f) + EPS); const size_t tok = row0 + 32 * th + r32;
#pragma unroll
        for (int g4 = 0; g4 < 4; ++g4) { const int v0 = 32 * w + 8 * g4 + 4 * h;
            const f32x4 gn = *(const f32x4*)(mlg + v0); const v2u sm = *(const v2u*)(PROJ + tok * NPJ + P_MO + hh * 256 + v0);
            v2u o; o.x = pk2(acc[th][4 * g4 + 0] * rr * gn.x * bflo(sm.x), acc[th][4 * g4 + 1] * rr * gn.y * bfhi(sm.x));
            o.y = pk2(acc[th][4 * g4 + 2] * rr * gn.z * bflo(sm.y), acc[th][4 * g4 + 3] * rr * gn.w * bfhi(sm.y));
            *(v2u*)(HM + tok * 1024 + hh * 256 + v0) = o; } }
}

constexpr int AT_BUF = 32768, AT_K2 = 8192, AT_V = 16384, AT_CV = 65536, AT_DUMMY = AT_CV + 8 * 8448;
__device__ __forceinline__ void at_dma(unsigned off, const char* base, unsigned ldsaddr) { unsigned keep;
    asm volatile("s_mov_b32 %0, m0\n\ts_mov_b32 m0, %3\n\ts_nop 0\n\tglobal_load_lds_dwordx4 %1, %2\n\ts_mov_b32 m0, %0" : "=&s"(keep) : "v"(off), "s"(base), "s"(ldsaddr) : "memory"); }
__device__ __forceinline__ void attn_unit(const Ctx& C, int u, int uidx, const Args& a, int lam_s, Conv& cv) {
    const bf16* QN = (const bf16*)(a.ws + WS_QN); const bf16* KN = (const bf16*)(a.ws + WS_KN); const bf16* PROJ = (const bf16*)(a.ws + WS_PROJ);
    const int b = u >> 8, hh = (u >> 5) & 7, qb = u & 31;
    const int lane = C.lane, w = C.wave, rg = w >> 1, mp = w & 1, r32 = lane & 31, h = lane >> 5;
    LAS unsigned char* lds = C.lds; const unsigned ldsb = (unsigned)(uintptr_t)lds;
    const size_t rowbase = (size_t)b * S; const int NGW = C.G * NWAVES;
    unsigned ko, vo0;
    { const int row = 8 * w + (lane >> 3), c = (lane & 7) ^ ((row >> 1) & 7); ko = (unsigned)((row * 1024 + c * 8) * 2); }
    { const int row = 8 * w + (lane >> 4), ch = (lane & 15) ^ ((row & 3) << 2); vo0 = (unsigned)((row * NPJ + ch * 8) * 2); }
    const char* kbase = (const char*)(KN + rowbase * 1024 + hh * 128); const char* vbase = (const char*)(PROJ + rowbase * NPJ + P_DV + hh * 128);
#define AT_TILE_DMA(t_, bufoff_) do { const char* kb__ = uni_ptr(kbase + (size_t)(t_) * 64 * 1024 * 2); const char* vb__ = uni_ptr(vbase + (size_t)(t_) * 64 * NPJ * 2); \
        const unsigned d__ = (unsigned)__builtin_amdgcn_readfirstlane((int)(ldsb + (bufoff_))); \
        at_dma(ko, kb__, d__ + w * 1024); at_dma(ko, kb__ + 128, d__ + AT_K2 + w * 1024); at_dma(vo0, vb__, d__ + AT_V + w * 2048); at_dma(vo0, vb__ + 4 * NPJ * 2, d__ + AT_V + w * 2048 + 1024); } while (0)
    bf16x8 qf[4];
    { const bf16* qsrc = QN + (rowbase + qb * 128 + rg * 32 + r32) * 1024 + hh * 128 + mp * 64 + h * 8;
#pragma unroll
      for (int d0 = 0; d0 < 4; ++d0) qf[d0] = *(const bf16x8*)(qsrc + 16 * d0); }
    f32x16 O[4];
#pragma unroll
    for (int d0 = 0; d0 < 4; ++d0) O[d0] = f32x16{};
    float lsum = 0.f;
    const int G_ = (lane >> 4) & 1, i16 = lane & 15, q_ = i16 >> 2, p_ = i16 & 3;
    const int kofb = mp * AT_K2 + r32 * 128 + ((h ^ ((r32 >> 1) & 1)) << 4) + (((r32 >> 2) & 3) << 5);
    const int vofb = AT_V + (4 * h + q_) * 256 + (q_ << 6) + 32 * G_ + 8 * p_;
#define kof(d0) (kofb ^ ((d0) << 5))
#define vof(d0) (vofb ^ ((d0) << 6))
    asm volatile("s_waitcnt lgkmcnt(0)" ::: "memory"); __builtin_amdgcn_s_barrier(); asm volatile("" ::: "memory");
    AT_TILE_DMA(0, 0);
    asm volatile("s_waitcnt vmcnt(0)" ::: "memory"); __builtin_amdgcn_s_barrier(); asm volatile("" ::: "memory");
#define AT_ITER(t_, SET_, TICK_) do { \
        LAS unsigned char* cur = lds + ((t_) & 1) * AT_BUF; \
        if ((t_) + 1 < S / 64) AT_TILE_DMA((t_) + 1, (((t_) + 1) & 1) * AT_BUF); \
        else { const unsigned d__ = (unsigned)__builtin_amdgcn_readfirstlane((int)(ldsb + AT_DUMMY)); const char* kb__ = uni_ptr(kbase); at_dma(ko, kb__, d__); at_dma(ko, kb__, d__); at_dma(ko, kb__, d__); at_dma(ko, kb__, d__); } \
        int cit_ = cv.it, cst_ = cv.step; conv_next(cit_, cst_, NGW); const ConvSrc csrc_ = conv_src(a, cit_); const unsigned cloff_ = conv_loff(csrc_, lane); (void)cst_; (void)cloff_; \
        _Pragma("unroll") for (int hv = 0; hv < 2; ++hv) { f32x16 pp = f32x16{}; \
            _Pragma("unroll") for (int d0 = 0; d0 < 4; ++d0) { const bf16x8 ka = *(LAS bf16x8*)(cur + kof(d0) + hv * 32 * 128); pp = __builtin_amdgcn_mfma_f32_32x32x16_bf16(ka, qf[d0], pp, 0, 0, 0); } \
            if (TICK_) conv_issue_one(cv.s[(SET_) ^ 1], csrc_, cloff_, cst_, 4 * hv + 0); \
            _Pragma("unroll") for (int r = 0; r < 16; ++r) { pp[r] = __builtin_amdgcn_exp2f(pp[r]); lsum += pp[r]; } \
            if (TICK_) conv_issue_one(cv.s[(SET_) ^ 1], csrc_, cloff_, cst_, 4 * hv + 1); \
            _Pragma("unroll") for (int k2 = 0; k2 < 2; ++k2) { const int o = 8 * k2; \
                v4u t4; t4.x = pk2(pp[o + 0], pp[o + 1]); t4.y = pk2(pp[o + 2], pp[o + 3]); t4.z = pk2(pp[o + 4], pp[o + 5]); t4.w = pk2(pp[o + 6], pp[o + 7]); \
                const bf16x8 pa = __builtin_bit_cast(bf16x8, t4); \
                _Pragma("unroll") for (int d0 = 0; d0 < 4; ++d0) { LAS unsigned char* va = cur + vof(d0) + (32 * hv + 16 * k2) * 256; \
                    const bf16x8 vf = cat8(trr(va), trr(va + 8 * 256)); \
                    O[d0] = __builtin_amdgcn_mfma_f32_32x32x16_bf16(vf, pa, O[d0], 0, 0, 0); } \
                if (TICK_) conv_issue_one(cv.s[(SET_) ^ 1], csrc_, cloff_, cst_, 4 * hv + 2 + k2); } } \
        if (TICK_) { if (conv_consume<12>(cv, cv.s[SET_], a, lds + AT_CV + w * 8448, NGW, lane)) asm volatile("s_waitcnt vmcnt(16) lgkmcnt(0)" ::: "memory"); \
            else asm volatile("s_waitcnt vmcnt(8) lgkmcnt(0)" ::: "memory"); } \
        else asm volatile("s_waitcnt vmcnt(0) lgkmcnt(0)" ::: "memory"); \
        __builtin_amdgcn_s_barrier(); asm volatile("" ::: "memory"); \
    } while (0)
    { const int slot = C.vcu & 3; int pa = 64, pb = 64;
      if ((slot >> 1) == uidx) { pa = 32 * (slot & 1); pb = pa + 32; }
      int t = 0;
      for (; t < pa; t += 2) { AT_ITER(t, 0, true); AT_ITER(t + 1, 1, true); }
      for (; t < pb; t += 2) { AT_ITER(t, 0, false); AT_ITER(t + 1, 1, false); }
      for (; t < S / 64; t += 2) { AT_ITER(t, 0, true); AT_ITER(t + 1, 1, true); } }
#undef AT_ITER
#undef AT_TILE_DMA
#undef kof
#undef vof
    lsum += __shfl_xor(lsum, 32);
    const float inv = 1.f / lsum;
    int le = C.tid & 63; asm volatile("" : "+v"(le));
    LAS float* ex = (LAS float*)lds + rg * 4096;
    if (mp == 1) {
#pragma unroll
        for (int d0 = 0; d0 < 4; ++d0)
#pragma unroll
            for (int r = 0; r < 16; ++r) ex[(d0 * 16 + r) * 64 + le] = O[d0][r] * inv; }
    asm volatile("s_waitcnt lgkmcnt(0)" ::: "memory"); __builtin_amdgcn_s_barrier(); asm volatile("" ::: "memory");
    if (mp == 0) {
        float ss = 0.f; int lb_ = lam_s; asm volatile("" : "+s"(lb_)); const float lamv = __int_as_float(lb_);
#pragma unroll
        for (int d0 = 0; d0 < 4; ++d0)
#pragma unroll
            for (int r = 0; r < 16; ++r) { const float o = O[d0][r] * inv - lamv * ex[(d0 * 16 + r) * 64 + le]; O[d0][r] = o; ss += o * o; }
        ss += __shfl_xor(ss, 32);
        const float rr = rsqrtf(ss * (1.f / 128.f) + EPS) * (1.f - LAM_INIT);
        const size_t tok = (size_t)b * S + qb * 128 + rg * 32 + (le & 31); const int he = le >> 5;
        bf16* odp = (bf16*)(a.ws + WS_OD) + tok * 1024 + hh * 128 + 4 * he;
#pragma unroll
        for (int d0 = 0; d0 < 4; ++d0)
#pragma unroll
            for (int g4 = 0; g4 < 4; ++g4) { const int dv0 = 32 * d0 + 8 * g4; const f32x4 gn = *(const f32x4*)(a.in[9] + dv0 + 4 * he);
                v2u o; o.x = pk2(O[d0][4 * g4 + 0] * rr * gn.x, O[d0][4 * g4 + 1] * rr * gn.y); o.y = pk2(O[d0][4 * g4 + 2] * rr * gn.z, O[d0][4 * g4 + 3] * rr * gn.w);
                *(v2u*)(odp + dv0) = o; }
    }
}

__device__ __forceinline__ void p8_router(const Ctx& C, const Args& a) {
    const float* x1 = a.out; const float* g2 = a.in[12]; const float* br = a.in[14];
    const bf16* WRH = (const bf16*)(a.ws + WS_WRH); const bf16* WRL = (const bf16*)(a.ws + WS_WRL);
    unsigned char* H2 = a.ws + WS_H2; int* cnt = (int*)(a.ws + WS_CTL) + CW_WGCNT;
    int* TOPE = (int*)(a.ws + WS_RT); int* SLOT = TOPE + T * 4; float* WTS = (float*)(SLOT + T * 4);
    const int lane = C.lane, w = C.wave, r32 = lane & 31, h = lane >> 5;
    constexpr int XP = 4112, XT_BYTES = 32 * XP;
    LAS unsigned char* XT = C.lds;
    LAS float* PLG = (LAS float*)C.lds;
    LAS float* SSQ = (LAS float*)(C.lds + XT_BYTES);
    LAS float* LG = (LAS float*)(C.lds + XT_BYTES + 1024);
    LAS float* RSTD = (LAS float*)(C.lds + XT_BYTES + 1024 + 32 * 33 * 4);
    LAS int* lcnt = (LAS int*)(C.lds + XT_BYTES + 1024 + 32 * 33 * 4 + 128);
    static_assert(XT_BYTES + 1024 + 32 * 33 * 4 + 256 <= MISC_OFF, "router LDS");
    if (C.tid < NE) lcnt[C.tid] = 0;
    for (int m0 = C.vcu * 32; m0 < T; m0 += C.G * 32) {
        __syncthreads();
        f32x16 acc = f32x16{}; float ssq = 0.f;
        const float* xrow = x1 + (size_t)(m0 + r32) * D + 256 * w + 4 * h;
        const bf16* whp = WRH + (size_t)(w * 16 * 64 + lane) * 8; const bf16* wlp = WRL + (size_t)(w * 16 * 64 + lane) * 8;
        LAS unsigned char* xt = XT + r32 * XP + (256 * w + 4 * h) * 2;
#pragma unroll
        for (int hb = 0; hb < 2; ++hb) {
            f32x4 xa[8], xb[8]; bf16x8 wh[8], wl[8];
#pragma unroll
            for (int s8 = 0; s8 < 8; ++s8) { const int s = 8 * hb + s8; xa[s8] = *(const f32x4*)(xrow + 16 * s); xb[s8] = *(const f32x4*)(xrow + 16 * s + 8);
                wh[s8] = *(const bf16x8*)(whp + 512 * s); wl[s8] = *(const bf16x8*)(wlp + 512 * s); }
            __builtin_amdgcn_sched_barrier(0);
#pragma unroll
            for (int s8 = 0; s8 < 8; ++s8) { const int s = 8 * hb + s8;
                ssq += (xa[s8].x * xa[s8].x + xa[s8].y * xa[s8].y) + (xa[s8].z * xa[s8].z + xa[s8].w * xa[s8].w) + (xb[s8].x * xb[s8].x + xb[s8].y * xb[s8].y) + (xb[s8].z * xb[s8].z + xb[s8].w * xb[s8].w);
                const float hv[8] = {xa[s8].x, xa[s8].y, xa[s8].z, xa[s8].w, xb[s8].x, xb[s8].y, xb[s8].z, xb[s8].w};
                v4u hi4, lo4;
#pragma unroll
                for (int i = 0; i < 4; ++i) { const unsigned hp = pk2(hv[2 * i], hv[2 * i + 1]); ((unsigned*)&hi4)[i] = hp; ((unsigned*)&lo4)[i] = pk2(hv[2 * i] - bflo(hp), hv[2 * i + 1] - bfhi(hp)); }
                { v2u t0; t0.x = hi4.x; t0.y = hi4.y; v2u t1; t1.x = hi4.z; t1.y = hi4.w; *(LAS v2u*)(xt + 32 * s) = t0; *(LAS v2u*)(xt + 32 * s + 16) = t1; }
                const bf16x8 hh = __builtin_bit_cast(bf16x8, hi4), hl = __builtin_bit_cast(bf16x8, lo4);
                acc = __builtin_amdgcn_mfma_f32_32x32x16_bf16(wh[s8], hh, acc, 0, 0, 0);
                acc = __builtin_amdgcn_mfma_f32_32x32x16_bf16(wh[s8], hl, acc, 0, 0, 0);
                acc = __builtin_amdgcn_mfma_f32_32x32x16_bf16(wl[s8], hh, acc, 0, 0, 0); }
            __builtin_amdgcn_sched_barrier(0);
        }
        ssq += __shfl_xor(ssq, 32);
        if (h == 0) SSQ[w * 32 + r32] = ssq;
        __syncthreads();
        if (C.tid < 32) { float s = 0.f;
#pragma unroll
            for (int ww = 0; ww < 8; ++ww) s += SSQ[ww * 32 + C.tid];
            RSTD[C.tid] = rsqrtf(s * (1.f / D) + EPS); }
        __syncthreads();
        f32x4 gq[8];
#pragma unroll
        for (int j = 0; j < 8; ++j) gq[j] = *((const f32x4*)g2 + lane + 64 * j);
#pragma unroll
        for (int it = 0; it < 4; ++it) { const int t = 4 * w + it, m = m0 + t; const float rs = RSTD[t];
#pragma unroll
            for (int j = 0; j < 8; ++j) { const v2u q = *(const LAS v2u*)(XT + t * XP + (lane + 64 * j) * 8);
                int o = 0; o = __builtin_amdgcn_cvt_pk_fp8_f32(bflo(q.x) * rs * gq[j].x, bfhi(q.x) * rs * gq[j].y, o, false); o = __builtin_amdgcn_cvt_pk_fp8_f32(bflo(q.y) * rs * gq[j].z, bfhi(q.y) * rs * gq[j].w, o, true);
                *((int*)(H2 + (size_t)m * D) + lane + 64 * j) = o; } }
        __syncthreads();
#pragma unroll
        for (int r = 0; r < 16; ++r) PLG[(w * 16 + r) * 64 + lane] = acc[r];
        __syncthreads();
#pragma unroll
        for (int q = 0; q < 2; ++q) { const int idx = C.tid + 512 * q, r = idx >> 6, l = idx & 63; float s = 0.f;
#pragma unroll
            for (int ww = 0; ww < 8; ++ww) s += PLG[(ww * 16 + r) * 64 + l];
            const int e = (r & 3) + 8 * (r >> 2) + 4 * (l >> 5), t = l & 31;
            LG[t * 33 + e] = s * RSTD[t] + br[e]; }
        __syncthreads();
#pragma unroll
        for (int ps = 0; ps < 2; ++ps) { const int t = 4 * w + 2 * ps + h, m = m0 + t; float v = LG[t * 33 + r32]; float tv[4]; int ti[4];
#pragma unroll
            for (int k = 0; k < 4; ++k) { float best = v;
#pragma unroll
                for (int o = 1; o < 32; o <<= 1) best = fmaxf(best, __shfl_xor(best, o));
                const unsigned long long bm = __ballot(v == best); const unsigned hm = h ? (unsigned)(bm >> 32) : (unsigned)bm; const int bi = __builtin_ctz(hm);
                tv[k] = best; ti[k] = bi; v = (r32 == bi) ? -INFINITY : v; }
            const float e1 = __expf(tv[1] - tv[0]), e2 = __expf(tv[2] - tv[0]), e3 = __expf(tv[3] - tv[0]); const float inv = 1.f / (1.f + e1 + e2 + e3);
            if (r32 < 4) { const int k = r32; const int tk = k == 0 ? ti[0] : k == 1 ? ti[1] : k == 2 ? ti[2] : ti[3]; const float wk = (k == 0 ? 1.f : k == 1 ? e1 : k == 2 ? e2 : e3) * inv;
                TOPE[m * 4 + k] = tk; SLOT[m * 4 + k] = __hip_atomic_fetch_add(lcnt + tk, 1, __ATOMIC_RELAXED, __HIP_MEMORY_SCOPE_WORKGROUP); WTS[m * 4 + k] = wk; } }
    }
    __syncthreads();
    if (C.tid < NE) cnt[C.vcu * NE + C.tid] = lcnt[C.tid];
}
__device__ __forceinline__ void p9_gather(const Ctx& C, const Args& a) {
    const unsigned char* H2 = a.ws + WS_H2; const int* wgcnt = (const int*)(a.ws + WS_CTL) + CW_WGCNT; int* cnt = (int*)(a.ws + WS_CTL) + CW_CNT;
    const int* TOPE = (const int*)(a.ws + WS_RT); const int* SLOT = TOPE + T * 4; int* DEST = (int*)(a.ws + WS_RT) + 3 * T * 4; unsigned char* XG = a.ws + WS_XG;
    const int gw = C.vcu * NWAVES + C.wave, NGW = C.G * NWAVES, lane = C.lane;
    int mycnt = 0, mybase = 0;
#pragma unroll 8
    for (int w = 0; w < C.G; ++w) { const int v = wgcnt[w * NE + (lane & 31)]; mycnt += v; mybase += (w < C.vcu) ? v : 0; }
    if (lane >= NE) { mycnt = 0; mybase = 0; }
    int tiles = (mycnt + PADM - 1) / PADM, inc = tiles;
#pragma unroll
    for (int o = 1; o < 32; o <<= 1) { const int t = __shfl_up(inc, o); if (lane >= o) inc += t; }
    const int startrow = (inc - tiles) * PADM;
    if (gw == 0 && lane < NE) cnt[lane] = mycnt;
    for (int m0 = C.vcu * 32; m0 < T; m0 += C.G * 32) for (int it = 0; it < 4; ++it) { const int t = m0 + 4 * C.wave + it;
#pragma unroll
        for (int k = 0; k < 4; ++k) { const int q = t * 4 + k, e = TOPE[q]; const int row = __shfl(startrow, e) + __shfl(mybase, e) + SLOT[q];
            if (lane == 0) DEST[q] = row;
            const v4u* src = (const v4u*)(H2 + (size_t)t * D) + lane; v4u* dst = (v4u*)(XG + (size_t)row * D) + lane;
            dst[0] = src[0]; dst[64] = src[64]; } }
    for (int p = gw; p < NE * PADM; p += NGW) { const int e = p / PADM, qq = p % PADM; const int c = __shfl(mycnt, e), st = __shfl(startrow, e), tl = __shfl(tiles, e);
        if (c + qq < tl * PADM) { v4u* dst = (v4u*)(XG + (size_t)(st + c + qq) * D) + lane; const v4u z = {0u, 0u, 0u, 0u}; dst[0] = z; dst[64] = z; } }
}
__device__ __forceinline__ void p12_combine(const Ctx& C, const Args& a) {
    const bf16* Y = (const bf16*)(a.ws + WS_Y); const float* WTS = (const float*)(a.ws + WS_RT) + 2 * T * 4; const int* DEST = (const int*)(a.ws + WS_RT) + 3 * T * 4; float* out = a.out;
    const int gw = C.vcu * NWAVES + C.wave, NGW = C.G * NWAVES, lane = C.lane;
    for (int m = gw; m < T; m += NGW) { int d[4]; float wv[4];
#pragma unroll
        for (int k = 0; k < 4; ++k) { d[k] = DEST[m * 4 + k]; wv[k] = WTS[m * 4 + k]; }
#pragma unroll
        for (int j = 0; j < 8; ++j) { f32x4 o = *((const f32x4*)(out + (size_t)m * D) + lane + 64 * j);
#pragma unroll
            for (int k = 0; k < 4; ++k) { const int y = *((const int*)((const unsigned char*)Y + (size_t)d[k] * D) + lane + 64 * j);
                o.x += wv[k] * __builtin_amdgcn_cvt_f32_fp8(y, 0); o.y += wv[k] * __builtin_amdgcn_cvt_f32_fp8(y, 1); o.z += wv[k] * __builtin_amdgcn_cvt_f32_fp8(y, 2); o.w += wv[k] * __builtin_amdgcn_cvt_f32_fp8(y, 3); }
            *((f32x4*)(out + (size_t)m * D) + lane + 64 * j) = o; } }
}

constexpr int N_PHASES = 14;
__global__ void __launch_bounds__(NTHR, 2) mega_fwd(Args args) {
    extern __shared__ __attribute__((aligned(16))) unsigned char lds_raw[];
    Ctx C; C.lds = (LAS unsigned char*)lds_raw; C.tid = threadIdx.x; C.lane = C.tid & 63; C.wave = __builtin_amdgcn_readfirstlane(C.tid >> 6);
    C.G = gridDim.x; { const int bx = blockIdx.x; C.vcu = (C.G % 8 == 0) ? (bx % 8) * (C.G / 8) + bx / 8 : bx; }
    volatile LAS unsigned* MISC = (volatile LAS unsigned*)(C.lds + MISC_OFF);
    if (C.tid < 32) MISC[C.tid] = 0u;
    __syncthreads();
    unsigned* ctl = (unsigned*)(args.ws + WS_CTL);
    XcdBarrier bar = xcd_barrier_post(ctl + CW_BAR, MISC + 8);
    const int lo = args.ph_lo, hi = args.ph_hi;
#ifndef ONLY_MASK
#define ONLY_MASK 0xFFFF
#endif
#define IN(k) (((ONLY_MASK >> (k)) & 1) && lo <= (k) && (k) < hi)
#ifndef DBL_MASK
#define DBL_MASK 0
#endif
#define REP(k) for (int rep_ = 0; rep_ < (((DBL_MASK >> (k)) & 1) ? 2 : 1); ++rep_, (((DBL_MASK >> (k)) & 1) && rep_ == 1 ? xcd_barrier(bar) : (void)0))
#define SEAM(k) do { if (IN(k) && IN((k) + 1)) xcd_barrier(bar); } while (0)
    if (IN(0)) REP(0) { p0_transposes(C, args); p0_rope(C, args); p0_router_w(C, args); p0_xn_gates(C, args); }
    SEAM(0);
    if (IN(1)) REP(1) { p2_mstats(C, args);
        { pg8::Gemm g{(const bf16*)(args.ws + WS_XN), (const bf16*)(args.ws + WS_WIN), T, 6144, D}; pg8::StaticOrder So; So.init(T, 6144, C.G, (int)blockIdx.x);
          EpiProj<false> E{(bf16*)(args.ws + WS_PROJ), nullptr}; pg8::gemm_phase<EpiProj<false>, pg8::StaticOrder, true, true>(C.lds, g, So, E); }
        __syncthreads();
        { pg8::Gemm g{(const bf16*)(args.ws + WS_XN8), (const bf16*)(args.ws + WS_WIN8), T, 4096, D / 2}; pg8::StaticOrder So; So.init(T, 4096, C.G, (int)blockIdx.x);
          EpiProj<true> E{(bf16*)(args.ws + WS_PROJ), args.ws + WS_G8}; pg8::gemm_phase<EpiProj<true>, pg8::StaticOrder, true, true, true>(C.lds, g, So, E); } }
    SEAM(1);
    if (IN(2)) REP(2) { p2_late_transposes(C, args); p2_qkprep(C, args); }
    if (!(IN(2) && IN(3))) SEAM(2);
    if (IN(3)) REP(3) { for (int u = C.vcu; u < 512; u += C.G) mlA_unit(C, u, args); }
    SEAM(3);
    if (IN(4)) REP(4) { mlB_scan(C, args); }
    SEAM(4);
    if (IN(5)) REP(5) { for (int u = C.vcu; u < 512; u += C.G) mlC_unit(C, u, args); }
    if (IN(6)) REP(6) {
        const float* lp = args.in[8]; const float sa = wave_sum(lp[C.lane] * lp[64 + C.lane]), sb = wave_sum(lp[128 + C.lane] * lp[192 + C.lane]);
        const float lam = __expf(sa) - __expf(sb) + LAM_INIT;
        Conv cv; conv_begin(cv, args, C.vcu * NWAVES + C.wave, C.G * NWAVES, C.lane);
        int lam_s = __builtin_amdgcn_readfirstlane(__float_as_int(lam)); asm volatile("" : "+s"(lam_s));
        { int uidx = 0; for (int u = C.vcu; u < 512; u += C.G, ++uidx) attn_unit(C, u, uidx, args, lam_s, cv); }
        asm volatile("s_waitcnt lgkmcnt(0)" ::: "memory"); __builtin_amdgcn_s_barrier(); asm volatile("" ::: "memory");
        while (cv.it < CV_NJ) { conv_issue_next(cv, cv.s[1], args, C.G * NWAVES, C.lane); (void)conv_consume<8>(cv, cv.s[0], args, C.lds + AT_CV + C.wave * 8448, C.G * NWAVES, C.lane);
            conv_issue_next(cv, cv.s[0], args, C.G * NWAVES, C.lane); (void)conv_consume<8>(cv, cv.s[1], args, C.lds + AT_CV + C.wave * 8448, C.G * NWAVES, C.lane); }
        asm volatile("s_waitcnt vmcnt(0)" ::: "memory");
    }
    SEAM(6);
    if (IN(7)) REP(7) { __syncthreads();
        pg8::StaticOrder So; So.init(T, D, C.G, (int)blockIdx.x);
        if (So.nwg % C.G == 0) {
            static_assert(WS_OD - WS_HM == (size_t)T * MLW * 2 && WS_WDA - WS_WML == (size_t)D * MLW * 2 && MLW == DAW, "pair stream: operands of the two products must be adjacent");
            pg8::Gemm g{(const bf16*)(args.ws + WS_HM), (const bf16*)(args.ws + WS_WML), 2 * T, D, MLW}; PairOrder Po{So};
            EpiGatePair E{(const bf16*)(args.ws + WS_G8), (bf16*)(args.ws + WS_T1), (bf16*)(args.ws + WS_MIX)}; pg8::gemm_phase<EpiGatePair, PairOrder, true, true>(C.lds, g, Po, E);
        } else {
        { pg8::Gemm g{(const bf16*)(args.ws + WS_HM), (const bf16*)(args.ws + WS_WML), T, D, MLW};
          EpiGate<0> E{(const bf16*)(args.ws + WS_G8), nullptr, (bf16*)(args.ws + WS_T1)}; pg8::gemm_phase<EpiGate<0>, pg8::StaticOrder, true, true>(C.lds, g, So, E); }
        __syncthreads();
        { pg8::Gemm g{(const bf16*)(args.ws + WS_OD), (const bf16*)(args.ws + WS_WDA), T, D, DAW};
          EpiGate<1> E{(const bf16*)(args.ws + WS_G8), (const bf16*)(args.ws + WS_T1), (bf16*)(args.ws + WS_MIX)}; pg8::gemm_phase<EpiGate<1>, pg8::StaticOrder, true, true>(C.lds, g, So, E); }
        }
    }
    SEAM(7);
    if (IN(8)) REP(8) { pg8::Gemm g{(const bf16*)(args.ws + WS_MIX), (const bf16*)(args.ws + WS_WO), T, D, D}; pg8::StaticOrder So; So.init(T, D, C.G, (int)blockIdx.x);
        EpiRes E{args.in[0], args.out}; pg8::gemm_phase<EpiRes, pg8::StaticOrder, true, true>(C.lds, g, So, E); }
    SEAM(8);
    if (IN(9)) REP(9) { p8_router(C, args); }
    SEAM(9);
    if (IN(10)) REP(10) { p9_gather(C, args); }
    SEAM(10);
    if (IN(11)) REP(11) { MoeSched Ms; Ms.init((const int*)(args.ws + WS_CTL) + CW_CNT, 16, C.G, (int)blockIdx.x, C.lane);
        pg8::Gemm g{(const bf16*)(args.ws + WS_XG), (const bf16*)(args.ws + WS_WGU), MAXROWS, 2 * DE, D / 2};
        EpiAct E{args.in[16], args.ws + WS_ACT}; pg8::gemm_phase<EpiAct, MoeSched, true, true, true>(C.lds, g, Ms, E); }
    SEAM(11);
    if (IN(12)) REP(12) { MoeSched Ms; Ms.init((const int*)(args.ws + WS_CTL) + CW_CNT, 8, C.G, (int)blockIdx.x, C.lane);
        pg8::Gemm g{(const bf16*)(args.ws + WS_ACT), (const bf16*)(args.ws + WS_WDN), MAXROWS, D, DE / 2};
        EpiY E{args.in[18], (bf16*)(args.ws + WS_Y)}; pg8::gemm_phase<EpiY, MoeSched, true, true, true>(C.lds, g, Ms, E); }
    SEAM(12);
    if (IN(13)) REP(13) { p12_combine(C, args); }
#undef IN
#undef SEAM
}
#ifdef DEV_NAIVE
constexpr size_t NV_XN32 = WS_NAIVE, NV_PROJ32 = NV_XN32 + 64 * MiB, NV_F = NV_PROJ32 + 322 * MiB, NV_HF = NV_F + 1 * MiB, NV_OD32 = NV_HF + 64 * MiB, NV_MIX32 = NV_OD32 + 32 * MiB, NV_END = NV_MIX32 + 64 * MiB;
__device__ __forceinline__ float ldf(const float* p) { return *p; }
__device__ __forceinline__ float ldf(const bf16* p) { return bf2f(*p); }
__global__ __launch_bounds__(256) void k_rmsnorm(const float* __restrict__ x, const float* __restrict__ g, float* __restrict__ y) {
    const int row = blockIdx.x * 4 + (threadIdx.x >> 6), lane = threadIdx.x & 63;
    const float* xr = x + (size_t)row * D; float v[32]; float s = 0.f;
#pragma unroll
    for (int j = 0; j < 32; ++j) { v[j] = xr[lane + 64 * j]; s += v[j] * v[j]; }
    s = wave_sum(s); const float r = rsqrtf(s * (1.f / D) + EPS);
#pragma unroll
    for (int j = 0; j < 32; ++j) y[(size_t)row * D + lane + 64 * j] = v[j] * r * g[lane + 64 * j];
}
struct GArgs { const void* A; const float* B; void* C; int M, N, K, lda, ldb, ldc; const void* aux0; const void* aux1; const int* cnt; };
template <int EPI, typename TA> __global__ __launch_bounds__(256) void k_gemm(GArgs g) {
    __shared__ float As[16][64 + 4], Bs[16][64 + 4];
    const int tx = threadIdx.x & 15, ty = threadIdx.x >> 4;
    int m0 = blockIdx.y * 64, n0 = blockIdx.x * 64;
    const TA* A = (const TA*)g.A; const float* Bp = g.B; int M = g.M; int rowbase = 0; int e = 0;
    if (EPI == 4 || EPI == 5) {
        e = blockIdx.z; int start = 0;
        for (int i = 0; i < e; ++i) start += (g.cnt[i] + PADM - 1) / PADM * PADM;
        const int c = g.cnt[e]; if (m0 >= c) return;
        M = (c + PADM - 1) / PADM * PADM; rowbase = start;
        A = (const TA*)g.A + (size_t)rowbase * g.lda; Bp = g.B + (size_t)e * g.K * g.ldb;
    }
    float acc[4][4] = {};
    for (int k0 = 0; k0 < g.K; k0 += 16) {
        for (int i = threadIdx.x; i < 64 * 16; i += 256) { const int mm = i >> 4, kk = i & 15; const int m = m0 + mm; As[kk][mm] = (m < M) ? ldf(A + (size_t)m * g.lda + k0 + kk) : 0.f; }
        for (int i = threadIdx.x; i < 16 * 64; i += 256) { const int kk = i >> 6, nn = i & 63; const int n = n0 + nn; Bs[kk][nn] = (n < g.N) ? Bp[(size_t)(k0 + kk) * g.ldb + n] : 0.f; }
        __syncthreads();
#pragma unroll
        for (int kk = 0; kk < 16; ++kk) {
            float a[4], b[4];
#pragma unroll
            for (int i = 0; i < 4; ++i) { a[i] = As[kk][ty * 4 + i]; b[i] = Bs[kk][tx * 4 + i]; }
#pragma unroll
            for (int i = 0; i < 4; ++i)
#pragma unroll
                for (int j = 0; j < 4; ++j) acc[i][j] += a[i] * b[j];
        }
        __syncthreads();
    }
#pragma unroll
    for (int i = 0; i < 4; ++i) {
        const int m = m0 + ty * 4 + i; if (m >= M) continue;
        if (EPI == 4) {
            const float* bias = (const float*)g.aux0 + (size_t)e * g.N;
#pragma unroll
            for (int j = 0; j < 4; j += 2) {
                const int n = n0 + tx * 4 + j;
                float glu = acc[i][j] + bias[n], lin = acc[i][j + 1] + bias[n + 1];
                glu = fminf(glu, 7.f); lin = fminf(fmaxf(lin, -7.f), 7.f);
                ((bf16*)g.C)[(size_t)(rowbase + m) * g.ldc + (n >> 1)] = f2bf(glu * sigmoidf_(1.702f * glu) * (lin + 1.f));
            }
        } else {
#pragma unroll
            for (int j = 0; j < 4; ++j) {
                const int n = n0 + tx * 4 + j; if (n >= g.N) continue;
                const float v = acc[i][j];
                if (EPI == 0) ((float*)g.C)[(size_t)m * g.ldc + n] = v;
                if (EPI == 1) ((float*)g.C)[(size_t)m * g.ldc + n] = bf2f(((const bf16*)g.aux0)[(size_t)m * NPJ + P_GM + n]) * v;
                if (EPI == 2) ((float*)g.C)[(size_t)m * g.ldc + n] += bf2f(((const bf16*)g.aux0)[(size_t)m * NPJ + P_GD + n]) * v;
                if (EPI == 3) ((float*)g.C)[(size_t)m * g.ldc + n] = ((const float*)g.aux0)[(size_t)m * g.ldc + n] + v;
                if (EPI == 5) ((bf16*)g.C)[(size_t)(rowbase + m) * g.ldc + n] = f2bf(v + ((const float*)g.aux0)[(size_t)e * g.N + n]);
            }
        }
    }
}
__global__ __launch_bounds__(256) void k_pack(const float* __restrict__ P32, const float* __restrict__ gbias, bf16* __restrict__ PROJ, float* __restrict__ MG) {
    const int t = blockIdx.x;
    for (int c = threadIdx.x; c < NPJ; c += 256) { const int src = c < G_OFF ? c : c + 16; float v = P32[(size_t)t * DIN + src];
        if (c >= P_MK && c < P_MV) v *= KSCALE;
        if ((c >= P_MO && c < P_DQ) || c >= P_GM) v = sigmoidf_(v);
        PROJ[(size_t)t * NPJ + c] = f2bf(v); }
    if (threadIdx.x < 16) MG[(size_t)t * 16 + threadIdx.x] = P32[(size_t)t * DIN + G_OFF + threadIdx.x] + gbias[threadIdx.x];
}
__global__ __launch_bounds__(256) void k_rope(float* __restrict__ ROPE) {
    const int g = blockIdx.x * 256 + threadIdx.x; const int pos = g >> 5, i = g & 31;
    const double inv = exp2(-(double)i * (13.287712379549449 / 32.0));
    const float ang = (float)pos * (float)inv;
    ROPE[2 * g] = cosf(ang); ROPE[2 * g + 1] = sinf(ang);
}
__global__ __launch_bounds__(256) void k_qkprep(const bf16* __restrict__ PROJ, const float* __restrict__ ROPE, const float* __restrict__ qg, const float* __restrict__ kg, bf16* __restrict__ QN, bf16* __restrict__ KN) {
    const int t = blockIdx.x * 4 + (threadIdx.x >> 6), lane = threadIdx.x & 63;
    const int pos = t % S, g = lane >> 2, sub = lane & 3;
    for (int which = 0; which < 2; ++which) {
        const bf16* src = PROJ + (size_t)t * NPJ + (which ? P_DK : P_DQ) + g * 64;
        const float* gn = which ? kg : qg; bf16* dst = (which ? KN : QN) + (size_t)t * 1024 + g * 64;
        float x1[8], x2[8]; float ss = 0.f;
#pragma unroll
        for (int i = 0; i < 8; ++i) { x1[i] = bf2f(src[sub * 8 + i]); x2[i] = bf2f(src[32 + sub * 8 + i]); ss += x1[i] * x1[i] + x2[i] * x2[i]; }
        ss += __shfl_xor(ss, 1); ss += __shfl_xor(ss, 2);
        const float r = rsqrtf(ss * (1.f / 64.f) + EPS) * (which ? 1.f : QSCALE);
#pragma unroll
        for (int i = 0; i < 8; ++i) {
            const int fi = sub * 8 + i; const float c = ROPE[((size_t)pos * 32 + fi) * 2], s = ROPE[((size_t)pos * 32 + fi) * 2 + 1];
            const float a = x1[i] * r * gn[fi], b = x2[i] * r * gn[32 + fi];
            dst[fi] = f2bf(a * c - b * s); dst[32 + fi] = f2bf(b * c + a * s);
        }
    }
}
__global__ void k_mlF(const float* __restrict__ MG, float* __restrict__ F) {
    const int chain = threadIdx.x; if (chain >= 16) return;
    const int dir = chain & 1, h = (chain >> 1) & 3, b = chain >> 3;
    const int col = (dir ? 12 : 4) + h; float acc = 0.f;
    if (!dir) { for (int p = 0; p < S; ++p) { acc += logsigf_(MG[(size_t)(b * S + p) * 16 + col]); F[chain * S + p] = acc; } }
    else      { for (int p = S - 1; p >= 0; --p) { acc += logsigf_(MG[(size_t)(b * S + p) * 16 + col]); F[chain * S + p] = acc; } }
}
__global__ __launch_bounds__(256) void k_mlquad(const bf16* __restrict__ PROJ, const float* __restrict__ MG, const float* __restrict__ F, float* __restrict__ HF) {
    __shared__ float qs[16][128 + 1], ks[64][128 + 1], sc[16][64 + 1], rs[16];
    const int chain = blockIdx.y, dir = chain & 1, h = (chain >> 1) & 3, b = chain >> 3;
    const int t0 = blockIdx.x * 16, tid = threadIdx.x; const int icol = (dir ? 8 : 0) + h;
    for (int i = tid; i < 16 * 128; i += 256) { const int tt = i >> 7, kk = i & 127; qs[tt][kk] = bf2f(PROJ[(size_t)(b * S + t0 + tt) * NPJ + P_MQ + h * 128 + kk]); }
    float acc[16];
#pragma unroll
    for (int i = 0; i < 16; ++i) acc[i] = 0.f;
    if (tid < 16) rs[tid] = 0.f;
    const int sbeg = dir ? (t0 / 64) * 64 : 0, send = dir ? S : (t0 + 16 + 63) / 64 * 64;
    for (int s0 = sbeg; s0 < send; s0 += 64) {
        __syncthreads();
        for (int i = tid; i < 64 * 128; i += 256) { const int ss = i >> 7, kk = i & 127; ks[ss][kk] = bf2f(PROJ[(size_t)(b * S + s0 + ss) * NPJ + P_MK + h * 128 + kk]); }
        __syncthreads();
        for (int i = tid; i < 1024; i += 256) {
            const int tt = i >> 6, ss = i & 63; const int t = t0 + tt, s = s0 + ss; float v = 0.f;
            const bool ok = dir ? (s >= t) : (s <= t);
            if (ok) { float d = 0.f; for (int kk = 0; kk < 128; ++kk) d += qs[tt][kk] * ks[ss][kk];
                v = d * __expf(F[chain * S + t] - F[chain * S + s] + MG[(size_t)(b * S + s) * 16 + icol]); }
            sc[tt][ss] = v;
        }
        __syncthreads();
        if (tid < 16) { float r = 0.f; for (int ss = 0; ss < 64; ++ss) r += sc[tid][ss]; rs[tid] += r; }
        for (int ss = 0; ss < 64; ++ss) { const float vv = bf2f(PROJ[(size_t)(b * S + s0 + ss) * NPJ + P_MV + h * 256 + tid]);
#pragma unroll
            for (int tt = 0; tt < 16; ++tt) acc[tt] += sc[tt][ss] * vv; }
    }
    __syncthreads();
#pragma unroll
    for (int tt = 0; tt < 16; ++tt) HF[((size_t)dir * T + (b * S + t0 + tt)) * 1024 + h * 256 + tid] = acc[tt] / fmaxf(fabsf(rs[tt]), 1.f);
}
__global__ __launch_bounds__(256) void k_mlpost(const float* __restrict__ HF, const bf16* __restrict__ PROJ, const float* __restrict__ g, bf16* __restrict__ HM) {
    const int w = blockIdx.x * 4 + (threadIdx.x >> 6), lane = threadIdx.x & 63; const int t = w >> 2, h = w & 3;
    float v[4]; float ss = 0.f;
#pragma unroll
    for (int j = 0; j < 4; ++j) { const int c = h * 256 + lane + 64 * j; v[j] = HF[(size_t)t * 1024 + c] + HF[((size_t)T + t) * 1024 + c]; ss += v[j] * v[j]; }
    ss = wave_sum(ss); const float r = rsqrtf(ss * (1.f / 256.f) + EPS);
#pragma unroll
    for (int j = 0; j < 4; ++j) { const int c = h * 256 + lane + 64 * j; HM[(size_t)t * 1024 + c] = f2bf(v[j] * r * g[lane + 64 * j] * bf2f(PROJ[(size_t)t * NPJ + P_MO + c])); }
}
__global__ __launch_bounds__(256) void k_attn(const bf16* __restrict__ QN, const bf16* __restrict__ KN, const bf16* __restrict__ PROJ, const float* __restrict__ lamp, float* __restrict__ OD32) {
    __shared__ float qs[2][16][64 + 1], ks[2][64][64 + 1], sc[2][16][64 + 1], ls[2][16];
    const int bh = blockIdx.y, b = bh >> 3, h = bh & 7, t0 = blockIdx.x * 16, tid = threadIdx.x;
    const int v = tid & 127, mp = tid >> 7;
    for (int i = tid; i < 2 * 16 * 64; i += 256) { const int m = i >> 10, tt = (i >> 6) & 15, dd = i & 63; qs[m][tt][dd] = bf2f(QN[(size_t)(b * S + t0 + tt) * 1024 + h * 128 + m * 64 + dd]); }
    if (tid < 32) ls[tid >> 4][tid & 15] = 0.f;
    float acc[16];
#pragma unroll
    for (int i = 0; i < 16; ++i) acc[i] = 0.f;
    for (int s0 = 0; s0 < S; s0 += 64) {
        __syncthreads();
        for (int i = tid; i < 2 * 64 * 64; i += 256) { const int m = i >> 12, ss = (i >> 6) & 63, dd = i & 63; ks[m][ss][dd] = bf2f(KN[(size_t)(b * S + s0 + ss) * 1024 + h * 128 + m * 64 + dd]); }
        __syncthreads();
        for (int i = tid; i < 2 * 16 * 64; i += 256) { const int m = i >> 10, tt = (i >> 6) & 15, ss = i & 63; float d = 0.f;
            for (int dd = 0; dd < 64; ++dd) d += qs[m][tt][dd] * ks[m][ss][dd];
            sc[m][tt][ss] = exp2f(d); }
        __syncthreads();
        if (tid < 32) { const int m = tid >> 4, tt = tid & 15; float r = 0.f; for (int ss = 0; ss < 64; ++ss) r += sc[m][tt][ss]; ls[m][tt] += r; }
        for (int ss = 0; ss < 64; ++ss) { const float vv = bf2f(PROJ[(size_t)(b * S + s0 + ss) * NPJ + P_DV + h * 128 + v]);
#pragma unroll
            for (int tt = 0; tt < 16; ++tt) acc[tt] += sc[mp][tt][ss] * vv; }
    }
    __syncthreads();
    float s01 = 0.f, s23 = 0.f;
    for (int i = 0; i < 64; ++i) { s01 += lamp[i] * lamp[64 + i]; s23 += lamp[128 + i] * lamp[192 + i]; }
    const float lam = __expf(s01) - __expf(s23) + LAM_INIT;
    float* ob = &ks[0][0][0];
    if (mp == 1) { for (int tt = 0; tt < 16; ++tt) ob[tt * 128 + v] = acc[tt] / ls[1][tt]; }
    __syncthreads();
    if (mp == 0) { for (int tt = 0; tt < 16; ++tt) OD32[(size_t)(b * S + t0 + tt) * 1024 + h * 128 + v] = acc[tt] / ls[0][tt] - lam * ob[tt * 128 + v]; }
}
__global__ __launch_bounds__(256) void k_dapost(const float* __restrict__ OD32, const float* __restrict__ g, bf16* __restrict__ OD) {
    const int w = blockIdx.x * 4 + (threadIdx.x >> 6), lane = threadIdx.x & 63; const int t = w >> 3, h = w & 7;
    float v[2]; float ss = 0.f;
#pragma unroll
    for (int j = 0; j < 2; ++j) { v[j] = OD32[(size_t)t * 1024 + h * 128 + lane + 64 * j]; ss += v[j] * v[j]; }
    ss = wave_sum(ss); const float r = rsqrtf(ss * (1.f / 128.f) + EPS);
#pragma unroll
    for (int j = 0; j < 2; ++j) OD[(size_t)t * 1024 + h * 128 + lane + 64 * j] = f2bf(v[j] * r * g[lane + 64 * j] * (1.f - LAM_INIT));
}
__global__ __launch_bounds__(256) void k_route1(const float* __restrict__ x1, const float* __restrict__ g2, const float* __restrict__ wr, const float* __restrict__ br,
                                                bf16* __restrict__ H2, int* __restrict__ cnt, int* __restrict__ TOPE, int* __restrict__ SLOT, float* __restrict__ WTS) {
    const int t = blockIdx.x * 4 + (threadIdx.x >> 6), lane = threadIdx.x & 63;
    const float* xr = x1 + (size_t)t * D; float v[32]; float s = 0.f;
#pragma unroll
    for (int j = 0; j < 32; ++j) { v[j] = xr[lane + 64 * j]; s += v[j] * v[j]; }
    s = wave_sum(s); const float r = rsqrtf(s * (1.f / D) + EPS);
#pragma unroll
    for (int j = 0; j < 32; ++j) { v[j] = v[j] * r * g2[lane + 64 * j]; H2[(size_t)t * D + lane + 64 * j] = f2bf(v[j]); }
    float mylogit = -INFINITY;
    for (int e = 0; e < NE; ++e) { float p = 0.f;
#pragma unroll
        for (int j = 0; j < 32; ++j) p += v[j] * wr[(size_t)(lane + 64 * j) * NE + e];
        p = wave_sum(p) + br[e]; if (lane == e) mylogit = p; }
    float tv[4]; int ti[4]; float cur = mylogit;
#pragma unroll
    for (int k = 0; k < 4; ++k) { const float m = wave_max(cur); const unsigned long long bal = __ballot(cur == m && lane < NE); const int idx = __ffsll((long long)bal) - 1; tv[k] = m; ti[k] = idx; if (lane == idx) cur = -INFINITY; }
    if (lane == 0) { const float e1 = __expf(tv[1] - tv[0]), e2 = __expf(tv[2] - tv[0]), e3 = __expf(tv[3] - tv[0]); const float inv = 1.f / (1.f + e1 + e2 + e3);
        const float w[4] = {inv, e1 * inv, e2 * inv, e3 * inv};
#pragma unroll
        for (int k = 0; k < 4; ++k) { TOPE[t * 4 + k] = ti[k]; SLOT[t * 4 + k] = atomicAdd(&cnt[ti[k]], 1); WTS[t * 4 + k] = w[k]; } }
}
__global__ __launch_bounds__(256) void k_route2(const bf16* __restrict__ H2, const int* __restrict__ cnt, const int* __restrict__ TOPE, const int* __restrict__ SLOT, int* __restrict__ DEST, bf16* __restrict__ XG) {
    const int a = blockIdx.x * 4 + (threadIdx.x >> 6), lane = threadIdx.x & 63;
    if (a < T * TOPK) { const int t = a >> 2, e = TOPE[a]; int start = 0;
        for (int i = 0; i < e; ++i) start += (cnt[i] + PADM - 1) / PADM * PADM;
        const int row = start + SLOT[a]; if (lane == 0) DEST[a] = row;
        for (int j = 0; j < 32; ++j) XG[(size_t)row * D + lane + 64 * j] = H2[(size_t)t * D + lane + 64 * j];
    } else { const int p = a - T * TOPK; if (p >= NE * PADM) return;
        const int e = p / PADM, q = p % PADM; int start = 0;
        for (int i = 0; i < e; ++i) start += (cnt[i] + PADM - 1) / PADM * PADM;
        const int c = cnt[e], padded = (c + PADM - 1) / PADM * PADM;
        if (c + q < padded) { const int row = start + c + q; for (int j = 0; j < 32; ++j) XG[(size_t)row * D + lane + 64 * j] = 0; } }
}
__global__ __launch_bounds__(256) void k_combine(float* __restrict__ out, const bf16* __restrict__ Y, const int* __restrict__ DEST, const float* __restrict__ WTS) {
    const int t = blockIdx.x * 4 + (threadIdx.x >> 6), lane = threadIdx.x & 63; int d[4]; float w[4];
#pragma unroll
    for (int k = 0; k < 4; ++k) { d[k] = DEST[t * 4 + k]; w[k] = WTS[t * 4 + k]; }
    for (int j = 0; j < 32; ++j) { const int c = lane + 64 * j; float a = out[(size_t)t * D + c];
#pragma unroll
        for (int k = 0; k < 4; ++k) a += w[k] * bf2f(Y[(size_t)d[k] * D + c]);
        out[(size_t)t * D + c] = a; }
}
#endif
#ifndef MEGA_MASK
#define MEGA_MASK 0xFF
#endif
static int g_grid = 0;
static void launch_mega(Args a, int lo, int hi, hipStream_t stream) {
    (void)hipMemsetAsync(a.ws + WS_CTL + CW_BAR * 4, 0, XCD_BAR_WORDS * 4, stream);
    a.ph_lo = lo; a.ph_hi = hi;
    hipLaunchKernelGGL(mega_fwd, dim3(g_grid), dim3(NTHR), LDS_BYTES, stream, a);
}
extern "C" void kernel_launch(void* const* d_in, const int* in_sizes, int n_in, void* d_out, int out_size, void* d_ws, size_t ws_size, hipStream_t stream) {
    if (g_grid == 0) {
        int dev = 0, cus = 0;
        if (n_in != 19 || out_size != T * D || hipGetDevice(&dev) != hipSuccess || hipDeviceGetAttribute(&cus, hipDeviceAttributeMultiprocessorCount, dev) != hipSuccess) { g_grid = -1; return; }
        if (hipFuncSetAttribute((const void*)mega_fwd, hipFuncAttributeMaxDynamicSharedMemorySize, LDS_BYTES) != hipSuccess) { g_grid = -1; return; }
        int per_cu = 0; (void)hipOccupancyMaxActiveBlocksPerMultiprocessor(&per_cu, (const void*)mega_fwd, NTHR, LDS_BYTES); (void)hipGetLastError();
        g_grid = cus;
    }
    if (g_grid < 0) return;
    Args a{};
    for (int i = 0; i < 19; ++i) a.in[i] = (const float*)d_in[i];
    a.out = (float*)d_out; a.ws = (unsigned char*)d_ws;
    (void)hipMemsetAsync(a.ws + WS_CTL, 0, 4096 * 4, stream);
#ifdef DEV_NAIVE
    unsigned char* ws = a.ws; const int mask = MEGA_MASK;
    bf16* PROJ = (bf16*)(ws + WS_PROJ); float* MG = (float*)(ws + WS_MG); float* ROPE = (float*)(ws + WS_ROPE);
    bf16* QN = (bf16*)(ws + WS_QN); bf16* KN = (bf16*)(ws + WS_KN); bf16* HM = (bf16*)(ws + WS_HM); bf16* OD = (bf16*)(ws + WS_OD);
    bf16* H2 = (bf16*)(ws + WS_H2); bf16* XG = (bf16*)(ws + WS_XG); bf16* ACT = (bf16*)(ws + WS_ACT); bf16* Y = (bf16*)(ws + WS_Y);
    int* cnt = (int*)(ws + WS_CTL) + CW_CNT; int* TOPE = (int*)(ws + WS_RT); int* SLOT = TOPE + T * 4; float* WTS = (float*)(SLOT + T * 4); int* DEST = (int*)(WTS + T * 4);
    float* XN32 = (float*)(ws + NV_XN32); float* PROJ32 = (float*)(ws + NV_PROJ32); float* F = (float*)(ws + NV_F); float* HF = (float*)(ws + NV_HF); float* OD32 = (float*)(ws + NV_OD32); float* MIX32 = (float*)(ws + NV_MIX32);
    const float* x = a.in[0]; float* out = a.out;
    static const int ranges[8][2] = {{0, 2}, {2, 3}, {3, 6}, {6, 7}, {7, 9}, {9, 11}, {11, 13}, {13, 14}};
    for (int s = 0; s < 8; ++s) {
        if (mask & (1 << s)) { int e = s; while (e + 1 < 8 && (mask & (1 << (e + 1)))) ++e; launch_mega(a, ranges[s][0], ranges[e][1], stream); s = e; continue; }
        switch (s) {
        case 0: { k_rmsnorm<<<T / 4, 256, 0, stream>>>(x, a.in[1], XN32);
            GArgs g{}; g.A = XN32; g.B = a.in[2]; g.C = PROJ32; g.M = T; g.N = DIN; g.K = D; g.lda = D; g.ldb = DIN; g.ldc = DIN;
            k_gemm<0, float><<<dim3((DIN + 63) / 64, T / 64), 256, 0, stream>>>(g);
            k_pack<<<T, 256, 0, stream>>>(PROJ32, a.in[3], PROJ, MG); k_rope<<<S * 32 / 256, 256, 0, stream>>>(ROPE); } break;
        case 1: k_qkprep<<<T / 4, 256, 0, stream>>>(PROJ, ROPE, a.in[6], a.in[7], QN, KN); break;
        case 2: k_mlF<<<1, 64, 0, stream>>>(MG, F); k_mlquad<<<dim3(S / 16, 16), 256, 0, stream>>>(PROJ, MG, F, HF); k_mlpost<<<T, 256, 0, stream>>>(HF, PROJ, a.in[4], HM); break;
        case 3: k_attn<<<dim3(S / 16, 16), 256, 0, stream>>>(QN, KN, PROJ, a.in[8], OD32); k_dapost<<<T * 2, 256, 0, stream>>>(OD32, a.in[9], OD); break;
        case 4: { GArgs g{}; g.A = HM; g.B = a.in[5]; g.C = MIX32; g.M = T; g.N = D; g.K = MLW; g.lda = MLW; g.ldb = D; g.ldc = D; g.aux0 = PROJ;
            k_gemm<1, bf16><<<dim3(D / 64, T / 64), 256, 0, stream>>>(g);
            g.A = OD; g.B = a.in[10]; g.K = DAW; g.lda = DAW; k_gemm<2, bf16><<<dim3(D / 64, T / 64), 256, 0, stream>>>(g);
            GArgs h{}; h.A = MIX32; h.B = a.in[11]; h.C = out; h.M = T; h.N = D; h.K = D; h.lda = D; h.ldb = D; h.ldc = D; h.aux0 = x;
            k_gemm<3, float><<<dim3(D / 64, T / 64), 256, 0, stream>>>(h); } break;
        case 5: k_route1<<<T / 4, 256, 0, stream>>>(out, a.in[12], a.in[13], a.in[14], H2, cnt, TOPE, SLOT, WTS);
            k_route2<<<(T * TOPK + NE * PADM) / 4, 256, 0, stream>>>(H2, cnt, TOPE, SLOT, DEST, XG); break;
        case 6: { GArgs g{}; g.A = XG; g.B = a.in[15]; g.C = ACT; g.N = 2 * DE; g.K = D; g.lda = D; g.ldb = 2 * DE; g.ldc = DE; g.aux0 = a.in[16]; g.cnt = cnt;
            k_gemm<4, bf16><<<dim3(2 * DE / 64, T / 64, NE), 256, 0, stream>>>(g);
            GArgs h{}; h.A = ACT; h.B = a.in[17]; h.C = Y; h.N = D; h.K = DE; h.lda = DE; h.ldb = D; h.ldc = D; h.aux0 = a.in[18]; h.cnt = cnt;
            k_gemm<5, bf16><<<dim3(D / 64, T / 64, NE), 256, 0, stream>>>(h); } break;
        case 7: k_combine<<<T / 4, 256, 0, stream>>>(out, Y, DEST, WTS); break;
        }
    }
#else
    launch_mega(a, 0, N_PHASES, stream);
#endif
}
```

```cpp
#include <hip/hip_runtime.h>
#include <cstdio>
#include <cstdint>
#include <math.h>

constexpr int D = 2048, NB = 2, S = 4096, T = NB * S;
constexpr int MLH = 4, MLDK = 128, MLDV = 256, MLW = 1024, NCH = 64;
constexpr int DAH = 8, DAD = 64, DADV = 128, DAW = 1024;
constexpr int NE = 32, TOPK = 4, DE = 2048;
constexpr int DIN = 10256, NPJ = 10240;
constexpr int G_OFF = 3072;
constexpr int P_MQ = 0, P_MK = 512, P_MV = 1024, P_MO = 2048, P_DQ = 3072, P_DK = 4096, P_DV = 5120, P_GM = 6144, P_GD = 8192;
constexpr float EPS = 1e-6f;
constexpr int PADM = 256;
constexpr int MAXROWS = T * TOPK + NE * PADM;
constexpr float LAM_INIT = 0.2f;
constexpr float QSCALE = 0.125f * 1.4426950408889634f;
constexpr float KSCALE = 0.08838834764831845f;

constexpr size_t MiB = 1ull << 20;
constexpr size_t WS_CTL = 0, CTL_ZERO_BYTES = 1 * MiB;
constexpr size_t WS_MSC = 1 * MiB;
constexpr size_t WS_RT = 2 * MiB;
constexpr size_t WS_ROPE = 3 * MiB;
constexpr size_t WS_MG = 4 * MiB;
constexpr size_t WS_NU = 5 * MiB;
constexpr size_t WS_NP = 6 * MiB;
constexpr size_t WS_WRH = 7 * MiB, WS_WRL = 7 * MiB + 256 * 1024;
constexpr size_t WS_WIN = 8 * MiB;
constexpr size_t WS_WIN8 = 32 * MiB;
constexpr size_t WS_WML = 48 * MiB;
constexpr size_t WS_WDA = 52 * MiB;
constexpr size_t WS_WO = 56 * MiB;
constexpr size_t WS_WGU = 64 * MiB;
constexpr size_t WS_WDN = 576 * MiB;
constexpr size_t WS_XN = 832 * MiB;
constexpr size_t WS_PROJ = 864 * MiB;
constexpr size_t WS_QN = 1024 * MiB;
constexpr size_t WS_KN = 1040 * MiB;
constexpr size_t WS_U = 1056 * MiB;
constexpr size_t WS_CP = 1184 * MiB;
constexpr size_t WS_HM = 1248 * MiB;
constexpr size_t WS_OD = 1264 * MiB;
constexpr size_t WS_XN8 = 1280 * MiB;
constexpr size_t WS_T1 = 1280 * MiB;
constexpr size_t WS_MIX = 1312 * MiB;
constexpr size_t WS_H2 = 1344 * MiB;
constexpr size_t WS_XG = 1376 * MiB;
constexpr size_t WS_ACT = 1536 * MiB;
constexpr size_t WS_Y = 1696 * MiB;
constexpr size_t WS_G8 = 1856 * MiB;
constexpr size_t WS_NAIVE = 1920 * MiB;
constexpr size_t WS_END = 2500 * MiB;
constexpr int CW_CNT = 64;
constexpr int CW_BAR = 4096;
constexpr int CW_WGCNT = 8192;

typedef unsigned short bf16;
typedef unsigned v4u __attribute__((ext_vector_type(4)));
typedef unsigned v2u __attribute__((ext_vector_type(2)));
typedef float f32x4 __attribute__((ext_vector_type(4)));
typedef float f32x2 __attribute__((ext_vector_type(2)));
typedef float f32x16 __attribute__((ext_vector_type(16)));
typedef short bf16x8 __attribute__((ext_vector_type(8)));
typedef short s16x4 __attribute__((ext_vector_type(4)));
typedef __bf16 bf16x2_t __attribute__((ext_vector_type(2)));
#define GAS __attribute__((address_space(1)))
#define LAS __attribute__((address_space(3)))

__device__ __forceinline__ float bf2f(unsigned v) { return __uint_as_float(v << 16); }
__device__ __forceinline__ float bflo(unsigned w) { return __uint_as_float(w << 16); }
__device__ __forceinline__ float bfhi(unsigned w) { return __uint_as_float(w & 0xffff0000u); }
__device__ __forceinline__ unsigned pk2(float lo, float hi) { f32x2 v = {lo, hi}; bf16x2_t b = __builtin_convertvector(v, bf16x2_t); return __builtin_bit_cast(unsigned, b); }
__device__ __forceinline__ bf16 f2bf(float f) { return (bf16)(pk2(f, 0.f) & 0xffffu); }
__device__ __forceinline__ float sigmoidf_(float x) { return 1.f / (1.f + __expf(-x)); }
__device__ __forceinline__ float logsigf_(float x) { return x >= 0.f ? -log1pf(__expf(-x)) : x - log1pf(__expf(x)); }
__device__ __forceinline__ float wave_sum(float v) {
#pragma unroll
    for (int o = 1; o < 64; o <<= 1) v += __shfl_xor(v, o);
    return v;
}
__device__ __forceinline__ float wave_max(float v) {
#pragma unroll
    for (int o = 1; o < 64; o <<= 1) v = fmaxf(v, __shfl_xor(v, o));
    return v;
}
namespace pg8 {
#define PG8_LAS __attribute__((address_space(3)))
typedef unsigned short bf16_t;
typedef short bf16x8 __attribute__((ext_vector_type(8)));
typedef float f32x4 __attribute__((ext_vector_type(4)));
typedef unsigned u32x4 __attribute__((ext_vector_type(4)));
constexpr int BM = 256, BK = 64, HALF = 128, HTB = HALF * BK * 2  , STAGE_BYTES = 8 * HTB, NXCD = 8, WGM = 8;

__host__ __device__ __forceinline__ int lds_byte(int r, int c) { const int st = (r >> 4) * 2 + (c >> 5), rr = r & 15, cc = c & 31, ob = rr * 64 + cc * 2; return st * 1024 + (ob ^ (((ob >> 9) & 1) << 5)); }
__host__ __device__ __forceinline__ void stage_rc(int b, int& R, int& C) { const int st = b / 1024, sb = b % 1024, swz = sb ^ (((sb >> 9) & 1) << 5); R = (st >> 1) * 16 + swz / 64; C = (st & 1) * 32 + (swz % 64) / 2; }
__host__ __device__ __forceinline__ int perm32(int rho) { const int n = rho >> 4, i = rho & 15; return 8 * (i >> 2) + 4 * n + (i & 3); }

struct Unit { int pm, pn, pb, half; };
struct Gemm { const bf16_t* A; const bf16_t* Bt; int M, N, K; };

struct StaticOrder {
    int nM, nN, nwg, G, c;
    __host__ __device__ void init(int M, int N, int G_, int c_) { nM = M / BM; nN = N / BM; nwg = nM * nN; G = G_; c = c_; }
    __host__ __device__ bool next(int i, Unit& u) const {
        const long L = (long)i * G + c; if (L >= nwg) return false;
        int wgid = (int)L; { const int q = nwg / NXCD, r = nwg % NXCD, xcd = wgid % NXCD, off = wgid / NXCD; wgid = (xcd < r ? xcd * (q + 1) : r * (q + 1) + (xcd - r) * q) + off; }
        const int nig = WGM * nN, gid = wgid / nig, fm = gid * WGM, gsz = (nM - fm) < WGM ? (nM - fm) : WGM;
        u.pm = fm + ((wgid % nig) % gsz); u.pn = (wgid % nig) / gsz; u.pb = u.pn; u.half = 0; return true;
    }
    __device__ __forceinline__ void a_ready(const Unit&) const {}
    __device__ __forceinline__ void done(const Unit&) const {}
    __device__ __forceinline__ int rot() const { return 0; }
};

__device__ __forceinline__ unsigned cvt_pk_bf16(float lo, float hi) { unsigned r; asm volatile("v_cvt_pk_bf16_f32 %0, %1, %2" : "=v"(r) : "v"(lo), "v"(hi)); return r; }
typedef float f32x2 __attribute__((ext_vector_type(2)));
typedef int v8i_t __attribute__((ext_vector_type(8)));
__device__ __forceinline__ const char* pg8_uni(const char* p) { const unsigned long long v = (unsigned long long)p; const unsigned lo = __builtin_amdgcn_readfirstlane((unsigned)v), hi = __builtin_amdgcn_readfirstlane((unsigned)(v >> 32)); return (const char*)(((unsigned long long)hi << 32) | lo); }
template <class Epi, class Sched, bool ALIGN_EPI = false, bool SP2 = false, bool FP8 = false, int BLK = 0>
__device__ __forceinline__ void gemm_phase(PG8_LAS unsigned char* lds, const Gemm g, const Sched& S, const Epi& E) {
    const int tid = threadIdx.x, wid = __builtin_amdgcn_readfirstlane(tid >> 6), lane = tid & 63, wr = wid >> 2, wc = wid & 3, fr = lane & 15, fq = lane >> 4;
    const int K = g.K, nt = K / BK;
    unsigned voffA[2], voffB[2];
#pragma unroll
    for (int i = 0; i < 2; ++i) { int R, C; stage_rc(tid * 16 + i * 8192, R, C); const int Rb = Epi::PERM ? ((R & ~31) + perm32(R & 31)) : R;
        voffA[i] = (unsigned)(R * ((BLK & 1) ? BK : K) + C) * 2u; voffB[i] = (unsigned)(Rb * ((BLK & 2) ? BK : K) + C) * 2u; }
    const size_t kstepA = (BLK & 1) ? (size_t)(2 * HTB) : (size_t)(BK * 2), kstepB = (BLK & 2) ? (size_t)(2 * HTB) : (size_t)(BK * 2);
    const size_t hstepA = (BLK & 1) ? (size_t)HTB : (size_t)HALF * K * 2, hstepB = (BLK & 2) ? (size_t)HTB : (size_t)HALF * K * 2;
    const size_t tstep = (size_t)2 * HALF * K * 2;
    const unsigned ldsb_ = (unsigned)(uintptr_t)lds;
    const unsigned ldsw = (unsigned)wid * 1024u;
    const int aoff = lds_byte(wr * 64 + fr, fq * 8), boff = lds_byte(wc * 32 + fr, fq * 8);
#define PG8_SA(b, h) (((b) * 2 + (h)) * HTB)
#define PG8_SB(b, h) ((4 + (b) * 2 + (h)) * HTB)
#define PG8_STAGE(bufoff, gbase, voff) do { _Pragma("unroll") for (int _i = 0; _i < 2; ++_i) { unsigned keep_; \
        asm volatile("s_mov_b32 %0, m0\n\ts_mov_b32 m0, %3\n\ts_nop 0\n\tglobal_load_lds_dwordx4 %1, %2\n\ts_mov_b32 m0, %0" : "=&s"(keep_) : "v"((voff)[_i]), "s"(pg8_uni((const char*)(gbase))), \
            "s"((unsigned)__builtin_amdgcn_readfirstlane((int)(ldsb_ + (unsigned)(bufoff) + ldsw + (unsigned)(_i * 8192)))) : "memory"); } } while (0)
#define PG8_CAT16(lo, hi) __builtin_bit_cast(v8i_t, __builtin_shufflevector(lo, hi, 0, 1, 2, 3, 4, 5, 6, 7, 8, 9, 10, 11, 12, 13, 14, 15))
#define PG8_LDA(dst, b, h) do { if constexpr (FP8) { _Pragma("unroll") for (int m = 0; m < 4; ++m) { const bf16x8 lo_ = *(const PG8_LAS bf16x8*)(lds + PG8_SA(b, h) + aoff + m * 2048), hi_ = *(const PG8_LAS bf16x8*)(lds + PG8_SA(b, h) + aoff + m * 2048 + 1024); dst##8[m] = PG8_CAT16(lo_, hi_); } } \
    else { _Pragma("unroll") for (int m = 0; m < 4; ++m) _Pragma("unroll") for (int k = 0; k < 2; ++k) dst[m][k] = *(const PG8_LAS bf16x8*)(lds + PG8_SA(b, h) + aoff + m * 2048 + k * 1024); } } while (0)
#define PG8_LDB(dst, b, h) do { if constexpr (FP8) { _Pragma("unroll") for (int n = 0; n < 2; ++n) { const bf16x8 lo_ = *(const PG8_LAS bf16x8*)(lds + PG8_SB(b, h) + boff + n * 2048), hi_ = *(const PG8_LAS bf16x8*)(lds + PG8_SB(b, h) + boff + n * 2048 + 1024); dst##8[n] = PG8_CAT16(lo_, hi_); } } \
    else { _Pragma("unroll") for (int n = 0; n < 2; ++n) _Pragma("unroll") for (int k = 0; k < 2; ++k) dst[n][k] = *(const PG8_LAS bf16x8*)(lds + PG8_SB(b, h) + boff + n * 2048 + k * 1024); } } while (0)
#define PG8_MMA(ai, bj, At, Bt) do { __builtin_amdgcn_s_setprio(1); \
    if constexpr (FP8) { _Pragma("unroll") for (int m = 0; m < 4; ++m) _Pragma("unroll") for (int n = 0; n < 2; ++n) \
        asm volatile("v_mfma_f32_16x16x128_f8f6f4 %0, %1, %2, %0" : "+v"(acc[ai][bj][m][n]) : "v"(Bt##8[n]), "v"(At##8[m])); } \
    else { _Pragma("unroll") for (int m = 0; m < 4; ++m) _Pragma("unroll") for (int n = 0; n < 2; ++n) _Pragma("unroll") for (int k = 0; k < 2; ++k) \
        acc[ai][bj][m][n] = __builtin_amdgcn_mfma_f32_16x16x32_bf16(Bt[n][k], At[m][k], acc[ai][bj][m][n], 0, 0, 0); } \
    __builtin_amdgcn_s_setprio(0); } while (0)
#define PG8_WAIT_V(n) asm volatile("s_waitcnt vmcnt(" #n ")" ::: "memory")
#define PG8_WAIT_L(n) asm volatile("s_waitcnt lgkmcnt(" #n ")" ::: "memory")
#define PG8_BAR __builtin_amdgcn_s_barrier()
#define PG8_SCHED __builtin_amdgcn_sched_barrier(0)
    Unit cur, nxt; int ui = 0;
    if (!S.next(0, cur)) return;
    f32x4 acc[2][2][4][2];
#pragma unroll
    for (int a = 0; a < 2; ++a)
#pragma unroll
        for (int b = 0; b < 2; ++b)
#pragma unroll
            for (int m = 0; m < 4; ++m)
#pragma unroll
                for (int n = 0; n < 2; ++n) acc[a][b][m][n] = (f32x4){0.f, 0.f, 0.f, 0.f};
    bf16x8 At[4][2], B0[2][2], B1[2][2]; v8i_t At8[4], B08[2], B18[2]; (void)At; (void)B0; (void)B1; (void)At8; (void)B08; (void)B18; int sc8_ = 0x7f7f7f7f; asm volatile("" : "+v"(sc8_)); (void)sc8_;
    const char* cA = (const char*)g.A + (size_t)cur.pm * tstep; const char* cB = (const char*)g.Bt + (size_t)cur.pb * tstep;
    const int rot = S.rot();
#define PG8_KIX(t) ((size_t)(((t) + rot) & (nt - 1)))
    const size_t k0A = PG8_KIX(0) * kstepA, k1A = PG8_KIX(1) * kstepA, k0B = PG8_KIX(0) * kstepB, k1B = PG8_KIX(1) * kstepB;
    S.a_ready(cur);
    if constexpr (SP2) {
        PG8_STAGE(PG8_SB(0, 0), cB + k0B, voffB); PG8_STAGE(PG8_SB(0, 1), cB + hstepB + k0B, voffB); PG8_STAGE(PG8_SA(0, 0), cA + k0A, voffA); PG8_STAGE(PG8_SA(0, 1), cA + hstepA + k0A, voffA);
        if (wr == 1) PG8_BAR;
        PG8_WAIT_V(2); PG8_BAR;
        PG8_STAGE(PG8_SB(1, 0), cB + k1B, voffB); PG8_STAGE(PG8_SA(1, 0), cA + k1A, voffA); PG8_STAGE(PG8_SB(1, 1), cB + hstepB + k1B, voffB);
        PG8_WAIT_V(6); PG8_BAR;
    } else {
        PG8_STAGE(PG8_SB(0, 0), cB + k0B, voffB); PG8_STAGE(PG8_SA(0, 0), cA + k0A, voffA); PG8_STAGE(PG8_SB(0, 1), cB + hstepB + k0B, voffB); PG8_STAGE(PG8_SA(0, 1), cA + hstepA + k0A, voffA);
        if (wr == 1) PG8_BAR;
        PG8_WAIT_V(4); PG8_BAR;
        PG8_STAGE(PG8_SB(1, 0), cB + k1B, voffB); PG8_STAGE(PG8_SA(1, 0), cA + k1A, voffA); PG8_STAGE(PG8_SB(1, 1), cB + hstepB + k1B, voffB);
        PG8_WAIT_V(6); PG8_BAR;
    }
    for (;;) {
        const bool has_next = S.next(ui + 1, nxt);
        const char* nA = has_next ? (const char*)g.A + (size_t)nxt.pm * tstep : cA; const char* nB = has_next ? (const char*)g.Bt + (size_t)nxt.pb * tstep : cB;
        for (int t = 0; t < nt; t += 2) {
            const bool last = (t == nt - 2);
            const char* a1 = cA + PG8_KIX(t + 1) * kstepA;
            const size_t i2 = PG8_KIX(t + 2), i3 = PG8_KIX(t + 3);
            const char* a2 = (last ? nA : cA) + i2 * kstepA; const char* b2 = (last ? nB : cB) + i2 * kstepB;
            const char* a3 = (last ? nA : cA) + i3 * kstepA; const char* b3 = (last ? nB : cB) + i3 * kstepB;
            if (last && has_next) S.a_ready(nxt);
            if constexpr (SP2) {
            PG8_LDB(B0, 0, 0); PG8_LDB(B1, 0, 1); PG8_SCHED; PG8_LDA(At, 0, 0); PG8_STAGE(PG8_SA(1, 1), a1 + hstepA, voffA);
            PG8_WAIT_V(8); PG8_WAIT_L(0); PG8_BAR; PG8_MMA(0, 0, At, B0); PG8_MMA(0, 1, At, B1); PG8_BAR; PG8_SCHED;
            PG8_LDA(At, 0, 1); PG8_STAGE(PG8_SB(0, 0), b2, voffB); PG8_STAGE(PG8_SB(0, 1), b2 + hstepB, voffB); PG8_STAGE(PG8_SA(0, 0), a2, voffA);
            PG8_WAIT_V(8); PG8_WAIT_L(0); PG8_BAR; if (!cur.half) { PG8_MMA(1, 0, At, B0); PG8_MMA(1, 1, At, B1); } PG8_BAR; PG8_SCHED;
            PG8_LDB(B0, 1, 0); PG8_LDB(B1, 1, 1); PG8_SCHED; PG8_LDA(At, 1, 0); PG8_STAGE(PG8_SA(0, 1), a2 + hstepA, voffA);
            PG8_WAIT_V(8); PG8_WAIT_L(0); PG8_BAR; PG8_MMA(0, 0, At, B0); PG8_MMA(0, 1, At, B1); PG8_BAR; PG8_SCHED;
            PG8_LDA(At, 1, 1); PG8_STAGE(PG8_SB(1, 0), b3, voffB); PG8_STAGE(PG8_SB(1, 1), b3 + hstepB, voffB); PG8_STAGE(PG8_SA(1, 0), a3, voffA);
            PG8_WAIT_V(8); PG8_WAIT_L(0); PG8_BAR; if (!cur.half) { PG8_MMA(1, 0, At, B0); PG8_MMA(1, 1, At, B1); } PG8_BAR; PG8_SCHED;
            } else {
            PG8_LDB(B0, 0, 0); PG8_SCHED; PG8_LDA(At, 0, 0); PG8_STAGE(PG8_SA(1, 1), a1 + hstepA, voffA);
            PG8_WAIT_L(8); PG8_BAR; PG8_WAIT_L(0); PG8_MMA(0, 0, At, B0); PG8_BAR; PG8_SCHED;
            PG8_LDB(B1, 0, 1); PG8_STAGE(PG8_SB(0, 0), b2, voffB);
            PG8_BAR; PG8_WAIT_L(0); PG8_MMA(0, 1, At, B1); PG8_BAR;
            PG8_LDA(At, 0, 1); PG8_STAGE(PG8_SA(0, 0), a2, voffA);
            PG8_BAR; PG8_WAIT_L(0); if (!cur.half) PG8_MMA(1, 0, At, B0); PG8_BAR; PG8_SCHED;
            PG8_STAGE(PG8_SB(0, 1), b2 + hstepB, voffB);
            PG8_WAIT_V(6); PG8_BAR; if (!cur.half) PG8_MMA(1, 1, At, B1); PG8_BAR;
            PG8_LDB(B0, 1, 0); PG8_SCHED; PG8_LDA(At, 1, 0); PG8_STAGE(PG8_SA(0, 1), a2 + hstepA, voffA);
            PG8_WAIT_L(8); PG8_BAR; PG8_WAIT_L(0); PG8_MMA(0, 0, At, B0); PG8_BAR; PG8_SCHED;
            PG8_LDB(B1, 1, 1); PG8_STAGE(PG8_SB(1, 0), b3, voffB);
            PG8_BAR; PG8_WAIT_L(0); PG8_MMA(0, 1, At, B1); PG8_BAR;
            PG8_LDA(At, 1, 1); PG8_STAGE(PG8_SA(1, 0), a3, voffA);
            PG8_BAR; PG8_WAIT_L(0); if (!cur.half) PG8_MMA(1, 0, At, B0); PG8_BAR; PG8_SCHED;
            PG8_STAGE(PG8_SB(1, 1), b3 + hstepB, voffB);
            PG8_WAIT_V(6); PG8_BAR; if (!cur.half) PG8_MMA(1, 1, At, B1); PG8_BAR;
            }
        }
        if constexpr (ALIGN_EPI) { if (wr == 0) PG8_BAR; }
        if constexpr (FP8) asm volatile("s_nop 15\n\ts_nop 15" ::: "memory");
        if constexpr (!Epi::AFTER_DRAIN) { E(acc, cur, wr, wc, fr, fq); S.done(cur); }
        if (!has_next) break;
#pragma unroll
        for (int a = 0; a < 2; ++a)
#pragma unroll
            for (int b = 0; b < 2; ++b)
#pragma unroll
                for (int m = 0; m < 4; ++m)
#pragma unroll
                    for (int n = 0; n < 2; ++n) acc[a][b][m][n] = (f32x4){0.f, 0.f, 0.f, 0.f};
        cur = nxt; cA = nA; cB = nB; ++ui;
        if constexpr (ALIGN_EPI) { if (wr == 1) PG8_BAR; }
    }
    PG8_WAIT_V(0);
    if constexpr (!ALIGN_EPI) { if (wr == 0) PG8_BAR; }
    PG8_BAR;
    if constexpr (Epi::AFTER_DRAIN) { E.fused(acc, cur, wr, wc, fr, fq, lds, wid, lane); S.done(cur); }
#undef PG8_KIX
#undef PG8_SA
#undef PG8_SB
#undef PG8_STAGE
#undef PG8_LDA
#undef PG8_LDB
#undef PG8_MMA
#undef PG8_WAIT_V
#undef PG8_WAIT_L
#undef PG8_BAR
#undef PG8_SCHED
}
}
constexpr int NWAVES = 8, NTHR = 512;
constexpr int LDS_BYTES = 147456;
constexpr int MISC_OFF = LDS_BYTES - 128;
typedef GAS unsigned gu32;
#define RLX_AGENT __ATOMIC_RELAXED, __HIP_MEMORY_SCOPE_AGENT
#define LDS_WAIT() asm volatile("s_waitcnt lgkmcnt(0)" ::: "memory")
#define VM_WAIT() asm volatile("s_waitcnt vmcnt(0)" ::: "memory")
#define XB_TMO      128
#define XB_XCNT(j)  (256  + 64 * (j))
#define XB_XSUB(j)  (1280 + 64 * (j))
#define XB_XGEN(j)  (2304 + 64 * (j))
#define XB_TOP      3328
#define XB_TOPGEN   3392
#define XCD_BAR_WORDS 3456
#define XB_SPIN_CAP (1u << 18)

__device__ __forceinline__ unsigned xb_ld(unsigned* p)              { return __hip_atomic_load(p, __ATOMIC_RELAXED, __HIP_MEMORY_SCOPE_AGENT); }
__device__ __forceinline__ unsigned xb_add(unsigned* p, unsigned v) { return __hip_atomic_fetch_add(p, v, __ATOMIC_RELAXED, __HIP_MEMORY_SCOPE_AGENT); }
__device__ __forceinline__ unsigned xb_xcc_id() { return (unsigned)__builtin_amdgcn_s_getreg((3 << 11) | 20) & 0xFu; }
#define XB_SPIN(cond, bar) do { unsigned _sp = 0; while (cond) { __builtin_amdgcn_s_sleep(1); \
    if ((++_sp & 255u) == 0u) { if (xb_ld(&(bar)[XB_TMO])) break; if (_sp > XB_SPIN_CAP) { atomicAdd(&(bar)[XB_TMO], 1u); break; } } } } while (0)

struct XcdBarrier {
    unsigned* bar; unsigned x;
    volatile LAS unsigned* st;
};

__device__ __forceinline__ XcdBarrier xcd_barrier_post(unsigned* bar, volatile LAS unsigned* st) {
    XcdBarrier b; b.bar = bar; b.x = xb_xcc_id(); b.st = st;
    if (threadIdx.x == 0) (void)xb_add(&bar[XB_XCNT(b.x)], 1u);
    return b;
}
__device__ __forceinline__ void xcd_barrier_complete(unsigned* bar, unsigned x, unsigned& nloc, unsigned& nx) {
    const unsigned G = gridDim.x * gridDim.y * gridDim.z;
    unsigned sum, cnt, mine, sp = 0u;
    for (;;) {
        sum = 0u; cnt = 0u; mine = 0u;
#pragma unroll
        for (unsigned j = 0; j < 16; ++j) { const unsigned c = xb_ld(&bar[XB_XCNT(j)]); sum += c; cnt += (c > 0u) ? 1u : 0u; mine = (j == x) ? c : mine; }
        if (sum == G) break;
        __builtin_amdgcn_s_sleep(1);
        if ((++sp & 255u) == 0u) { if (xb_ld(&bar[XB_TMO])) break; if (sp > XB_SPIN_CAP) { atomicAdd(&bar[XB_TMO], 1u); break; } }
    }
    nloc = mine > 0u ? mine : 1u; nx = cnt > 0u ? cnt : 1u;
}

__device__ __forceinline__ void xcd_barrier(const XcdBarrier& b) {
    asm volatile("s_waitcnt vmcnt(0)" ::: "memory");
    __syncthreads();
    if (threadIdx.x == 0) {
        unsigned* bar = b.bar;
        __builtin_amdgcn_s_waitcnt(0);
        unsigned nloc = b.st[0], nx = b.st[1];
        if (nloc == 0u) { xcd_barrier_complete(bar, b.x, nloc, nx); b.st[0] = nloc; b.st[1] = nx; }
        const unsigned old = xb_add(&bar[XB_XSUB(b.x)], 1u);
        const unsigned gen = old / nloc;
        if (old + 1u == (gen + 1u) * nloc) {
            __builtin_amdgcn_fence(__ATOMIC_RELEASE, "agent");
            asm volatile("s_waitcnt vmcnt(0)" ::: "memory");
            const unsigned og = xb_add(&bar[XB_TOP], 1u);
            const unsigned tg = og / nx;
            if (og + 1u == (tg + 1u) * nx) xb_add(&bar[XB_TOPGEN], 1u);
            else XB_SPIN(xb_ld(&bar[XB_TOPGEN]) == tg, bar);
            __builtin_amdgcn_fence(__ATOMIC_ACQUIRE, "agent");
            xb_add(&bar[XB_XGEN(b.x)], 1u);
            asm volatile("s_waitcnt vmcnt(0)" ::: "memory");
        } else {
            XB_SPIN(xb_ld(&bar[XB_XGEN(b.x)]) == gen, bar);
            __builtin_amdgcn_fence(__ATOMIC_ACQUIRE, "agent");
            asm volatile("s_waitcnt vmcnt(0)" ::: "memory");
        }
    }
    __syncthreads();
}
struct Ctx { LAS unsigned char* lds; int tid, lane, wave, vcu, G; };
struct Args { const float* in[19]; float* out; unsigned char* ws; int ph_lo, ph_hi; };

typedef short v4i16_t __attribute__((ext_vector_type(4)));
__device__ __forceinline__ s16x4 trr(LAS unsigned char* p) { return __builtin_bit_cast(s16x4, __builtin_amdgcn_ds_read_tr16_b64_v4i16((LAS v4i16_t*)p)); }
__device__ __forceinline__ bf16x8 cat8(s16x4 lo, s16x4 hi) { return (bf16x8){lo[0], lo[1], lo[2], lo[3], hi[0], hi[1], hi[2], hi[3]}; }
__device__ __forceinline__ float incl_sum_up(float v, int lane) {
#pragma unroll
    for (int o = 1; o < 64; o <<= 1) { const float t = __shfl_up(v, o); if (lane >= o) v += t; }
    return v;
}
__device__ __forceinline__ float incl_max_up(float v, int lane) {
#pragma unroll
    for (int o = 1; o < 64; o <<= 1) { const float t = __shfl_up(v, o); if (lane >= o) v = fmaxf(v, t); }
    return v;
}
__device__ __forceinline__ float incl_max_down(float v, int lane) {
#pragma unroll
    for (int o = 1; o < 64; o <<= 1) { const float t = __shfl_down(v, o); if (lane + o < 64) v = fmaxf(v, t); }
    return v;
}
__device__ __forceinline__ v4u scale8(v4u q, float s) {
    v4u o; o.x = pk2(bflo(q.x) * s, bfhi(q.x) * s); o.y = pk2(bflo(q.y) * s, bfhi(q.y) * s); o.z = pk2(bflo(q.z) * s, bfhi(q.z) * s); o.w = pk2(bflo(q.w) * s, bfhi(q.w) * s); return o;
}

__device__ __forceinline__ float sat8(float x) { return fminf(fmaxf(x, -448.f), 448.f); }
__device__ __forceinline__ void tr_item(const float* __restrict__ W, int ldw, int K, bf16* __restrict__ WT, int n_src0, int n_dst0, int k0, LAS unsigned char* scr, int lane) {
    const int nq = lane & 15, kg = lane >> 4;
    const float* src = W + (size_t)(k0 + 4 * kg) * ldw + n_src0 + 4 * nq;
    f32x4 rr[4][4];
#pragma unroll
    for (int j = 0; j < 4; ++j)
#pragma unroll
        for (int q = 0; q < 4; ++q) rr[j][q] = *(const f32x4*)(src + (size_t)(16 * j + q) * ldw);
    __builtin_amdgcn_sched_barrier(0);
#pragma unroll
    for (int j = 0; j < 4; ++j) {
#pragma unroll
        for (int c = 0; c < 4; ++c) { LAS unsigned* d = (LAS unsigned*)(scr + (4 * nq + c) * 132 + (16 * j + 4 * kg) * 2); d[0] = pk2(rr[j][0][c], rr[j][1][c]); d[1] = pk2(rr[j][2][c], rr[j][3][c]); }
    }
    const int row8 = lane >> 3, c8 = lane & 7;
#pragma unroll
    for (int jj = 0; jj < 8; ++jj) { const int row = row8 + 8 * jj; LAS unsigned char* rp = scr + row * 132 + 16 * c8;
        v4u o; o.x = *(LAS unsigned*)rp; o.y = *(LAS unsigned*)(rp + 4); o.z = *(LAS unsigned*)(rp + 8); o.w = *(LAS unsigned*)(rp + 12);
        *(v4u*)(WT + (size_t)(n_dst0 + row) * K + k0 + 8 * c8) = o; }
}
constexpr float W8SCALE = 64.f, W8INV = 1.f / 64.f;
__device__ __forceinline__ void tr8_item(const float* __restrict__ W, int ldw, int Kb, unsigned char* __restrict__ WT, int n0, int k0, LAS unsigned char* scr, int lane) {
    const int nq = lane & 15, kg = lane >> 4;
    const float* src = W + (size_t)(k0 + 4 * kg) * ldw + n0 + 4 * nq;
#pragma unroll
    for (int jh = 0; jh < 2; ++jh) {
        f32x4 rr[4][4];
#pragma unroll
        for (int j = 0; j < 4; ++j)
#pragma unroll
            for (int q = 0; q < 4; ++q) rr[j][q] = *(const f32x4*)(src + (size_t)(16 * (4 * jh + j) + q) * ldw);
        __builtin_amdgcn_sched_barrier(0);
#pragma unroll
        for (int j = 0; j < 4; ++j)
#pragma unroll
            for (int c = 0; c < 4; ++c) { int w = 0; w = __builtin_amdgcn_cvt_pk_fp8_f32(rr[j][0][c] * W8SCALE, rr[j][1][c] * W8SCALE, w, false); w = __builtin_amdgcn_cvt_pk_fp8_f32(rr[j][2][c] * W8SCALE, rr[j][3][c] * W8SCALE, w, true);
                *(LAS int*)(scr + (4 * nq + c) * 132 + 16 * (4 * jh + j) + 4 * kg) = w; }
        __builtin_amdgcn_sched_barrier(0);
    }
    const int row8 = lane >> 3, c8 = lane & 7;
#pragma unroll
    for (int jj = 0; jj < 8; ++jj) { const int row = row8 + 8 * jj; LAS unsigned char* rp = scr + row * 132 + 16 * c8;
        v4u o; o.x = *(LAS unsigned*)rp; o.y = *(LAS unsigned*)(rp + 4); o.z = *(LAS unsigned*)(rp + 8); o.w = *(LAS unsigned*)(rp + 12);
        *(v4u*)(WT + (size_t)(n0 + row) * Kb + k0 + 16 * c8) = o; }
}
__device__ __forceinline__ void p0_transposes(const Ctx& C, const Args& a) {
    const float* w_in = a.in[2]; const float* w_ml = a.in[5]; const float* w_da = a.in[10]; const float* w_o = a.in[11]; const float* w_gu = a.in[15]; const float* w_dn = a.in[17];
    bf16* WIN = (bf16*)(a.ws + WS_WIN); bf16* WML = (bf16*)(a.ws + WS_WML); bf16* WDA = (bf16*)(a.ws + WS_WDA); bf16* WO = (bf16*)(a.ws + WS_WO);
    const int gw = C.vcu * NWAVES + C.wave, NGW = C.G * NWAVES;
    constexpr int I_IN = 32 * 96, I_IN8 = 16 * 64;
    constexpr int NIT = I_IN + I_IN8;
    LAS unsigned char* scr = C.lds + C.wave * 8448;
    for (int it = gw; it < NIT; it += NGW) {
        int r = it;
        if (r < I_IN) { const int kb = r / 96, nb = r % 96, nd = nb * 64; tr_item(w_in, DIN, D, WIN, nd < G_OFF ? nd : nd + 16, nd, kb * 64, scr, C.lane); continue; } r -= I_IN;
        { const int kb = r / 64, nb = r % 64; tr8_item(w_in + (P_GM + 16), DIN, D, (unsigned char*)(a.ws + WS_WIN8), nb * 64, kb * 128, scr, C.lane); }
    }
    (void)w_ml; (void)w_da; (void)w_o; (void)WML; (void)WDA; (void)WO;
    __syncthreads();
}
__device__ __forceinline__ void p2_late_transposes(const Ctx& C, const Args& a) {
    const float* w_ml = a.in[5]; const float* w_da = a.in[10]; const float* w_o = a.in[11];
    bf16* WML = (bf16*)(a.ws + WS_WML); bf16* WDA = (bf16*)(a.ws + WS_WDA); bf16* WO = (bf16*)(a.ws + WS_WO);
    const int gw = C.vcu * NWAVES + C.wave, NGW = C.G * NWAVES;
    constexpr int I_ML = 16 * 32, I_O = 32 * 32, NIT = 2 * I_ML + I_O;
    LAS unsigned char* scr = C.lds + C.wave * 8448;
    for (int it = gw; it < NIT; it += NGW) {
        int r = it;
        if (r < I_ML) { const int kb = r / 32, nb = r % 32; tr_item(w_ml, D, MLW, WML, nb * 64, nb * 64, kb * 64, scr, C.lane); continue; } r -= I_ML;
        if (r < I_ML) { const int kb = r / 32, nb = r % 32; tr_item(w_da, D, DAW, WDA, nb * 64, nb * 64, kb * 64, scr, C.lane); continue; } r -= I_ML;
        { const int kb = r / 32, nb = r % 32; tr_item(w_o, D, D, WO, nb * 64, nb * 64, kb * 64, scr, C.lane); }
    }
    __syncthreads();
}
constexpr int CV_J_GU = 16 * 64, CV_J_DN = 16 * 32, CV_NJ = NE * (CV_J_GU + CV_J_DN);
struct ConvSet { f32x4 r[8]; };
struct Conv { int it, step; ConvSet s[2]; };
struct ConvItem { const float* src; unsigned char* dst; int ldw, Kb; };
__device__ __forceinline__ ConvItem conv_item(const Args& a, int it) {
    const float* w_gu = a.in[15]; const float* w_dn = a.in[17]; ConvItem ci;
    if (it < NE * CV_J_GU) { const int e = it / CV_J_GU, q = it % CV_J_GU, kb = q / 64, nb = q % 64; ci.ldw = 2 * DE; ci.Kb = D;
        ci.src = w_gu + (size_t)e * D * 2 * DE + (size_t)(kb * 128) * (2 * DE) + nb * 64;
        ci.dst = a.ws + WS_WGU + (size_t)e * 2 * DE * D + (size_t)(nb * 64) * D + kb * 128; }
    else { const int r = it - NE * CV_J_GU, e = r / CV_J_DN, q = r % CV_J_DN, kb = q / 32, nb = q % 32; ci.ldw = D; ci.Kb = DE;
        ci.src = w_dn + (size_t)e * DE * D + (size_t)(kb * 128) * D + nb * 64;
        ci.dst = a.ws + WS_WDN + (size_t)e * D * DE + (size_t)(nb * 64) * DE + kb * 128; }
    return ci;
}
__device__ __forceinline__ const char* uni_ptr(const void* p) { const unsigned long long v = (unsigned long long)p; const unsigned lo = __builtin_amdgcn_readfirstlane((unsigned)v), hi = __builtin_amdgcn_readfirstlane((unsigned)(v >> 32)); return (const char*)(((unsigned long long)hi << 32) | lo); }
struct ConvSrc { const float* src; int ldw; };
__device__ __forceinline__ ConvSrc conv_src(const Args& a, int it) { const int itc = it < CV_NJ ? it : CV_NJ - 1; const ConvItem ci = conv_item(a, __builtin_amdgcn_readfirstlane(itc)); ConvSrc s; s.src = ci.src; s.ldw = ci.ldw; return s; }
__device__ __forceinline__ unsigned conv_loff(const ConvSrc& cs, int lane) { return ((unsigned)(4 * (lane >> 4)) * (unsigned)cs.ldw + 4u * (lane & 15)) * 4u; }
__device__ __forceinline__ void conv_issue_one(ConvSet& S, const ConvSrc& cs, unsigned loff, int st, int q) {
    const char* sb = (const char*)(cs.src + (size_t)(16 * (2 * st + (q >> 2)) + (q & 3)) * cs.ldw);
    asm volatile("global_load_dwordx4 %0, %1, %2 nt" : "=v"(S.r[q]) : "v"(loff), "s"(sb) : "memory");
}
__device__ __forceinline__ void conv_issue(ConvSet& S, const Args& a, int it, int st, int lane) {
    const ConvSrc cs = conv_src(a, it); const unsigned loff = conv_loff(cs, lane);
#pragma unroll
    for (int q = 0; q < 8; ++q) conv_issue_one(S, cs, loff, st, q);
}
__device__ __forceinline__ void conv_next(int& it, int& st, int NGW) { if (st == 3) { st = 0; it += NGW; } else ++st; }
__device__ __forceinline__ void conv_begin(Conv& cv, const Args& a, int gw, int NGW, int lane) { cv.it = gw; cv.step = 0; conv_issue(cv.s[0], a, cv.it, cv.step, lane); }
__device__ __forceinline__ void conv_issue_next(Conv& cv, ConvSet& S, const Args& a, int NGW, int lane) { int it1 = cv.it, st1 = cv.step; conv_next(it1, st1, NGW); conv_issue(S, a, it1, st1, lane); }
template <int NW> __device__ __forceinline__ bool conv_consume(Conv& cv, ConvSet& S, const Args& a, LAS unsigned char* scr, int NGW, int lane) {
    if constexpr (NW == 12) asm volatile("s_waitcnt vmcnt(12)" : "+v"(S.r[0]), "+v"(S.r[1]), "+v"(S.r[2]), "+v"(S.r[3]), "+v"(S.r[4]), "+v"(S.r[5]), "+v"(S.r[6]), "+v"(S.r[7]) :: "memory");
    else if constexpr (NW == 8) asm volatile("s_waitcnt vmcnt(8)" : "+v"(S.r[0]), "+v"(S.r[1]), "+v"(S.r[2]), "+v"(S.r[3]), "+v"(S.r[4]), "+v"(S.r[5]), "+v"(S.r[6]), "+v"(S.r[7]) :: "memory");
    else asm volatile("s_waitcnt vmcnt(0)" : "+v"(S.r[0]), "+v"(S.r[1]), "+v"(S.r[2]), "+v"(S.r[3]), "+v"(S.r[4]), "+v"(S.r[5]), "+v"(S.r[6]), "+v"(S.r[7]) :: "memory");
    const int nq = lane & 15, kg = lane >> 4; const bool st = (cv.it < CV_NJ) && cv.step == 3;
#pragma unroll
    for (int jj = 0; jj < 2; ++jj) { const int j = 2 * cv.step + jj;
#pragma unroll
        for (int c = 0; c < 4; ++c) { int w = 0; w = __builtin_amdgcn_cvt_pk_fp8_f32(S.r[4 * jj + 0][c] * W8SCALE, S.r[4 * jj + 1][c] * W8SCALE, w, false);
            w = __builtin_amdgcn_cvt_pk_fp8_f32(S.r[4 * jj + 2][c] * W8SCALE, S.r[4 * jj + 3][c] * W8SCALE, w, true);
            *(LAS int*)(scr + (4 * nq + c) * 132 + 16 * j + 4 * kg) = w; } }
    if (st) {
        const ConvItem ci = conv_item(a, __builtin_amdgcn_readfirstlane(cv.it));
        const int row8 = lane >> 3, c8 = lane & 7;
#pragma unroll 2
        for (int jj = 0; jj < 8; ++jj) { const int row = row8 + 8 * jj; LAS unsigned char* rp = scr + row * 132 + 16 * c8;
            v4u o; o.x = *(LAS unsigned*)rp; o.y = *(LAS unsigned*)(rp + 4); o.z = *(LAS unsigned*)(rp + 8); o.w = *(LAS unsigned*)(rp + 12);
            *(v4u*)(ci.dst + (size_t)row * ci.Kb + 16 * c8) = o; }
    }
    conv_next(cv.it, cv.step, NGW);
    return st;
}
__device__ __forceinline__ void p0_xn_gates(const Ctx& C, const Args& a) {
    const float* x = a.in[0]; const float* g1 = a.in[1]; const float* w_in = a.in[2]; const float* gbias = a.in[3];
    bf16* XN = (bf16*)(a.ws + WS_XN); float* MG = (float*)(a.ws + WS_MG);
    for (int idx = C.tid; idx < D * 4; idx += NTHR) {
        const int k = idx >> 2, c = idx & 3; const f32x4 w = *(const f32x4*)(w_in + (size_t)k * DIN + G_OFF + 4 * c);
        const int r = (k & 3) * 512 + (k >> 2);
        *(LAS f32x4*)(C.lds + r * 64 + ((c ^ ((r >> 2) & 3)) * 16)) = w;
    }
    __syncthreads();
    const int gw = C.vcu * NWAVES + C.wave, NGW = C.G * NWAVES, lane = C.lane;
    for (int m = gw; m < T; m += NGW) {
        const f32x4* xr = (const f32x4*)(x + (size_t)m * D) + lane; f32x4 v[8]; float ss = 0.f;
#pragma unroll
        for (int j = 0; j < 8; ++j) { v[j] = xr[64 * j]; ss += (v[j].x * v[j].x + v[j].y * v[j].y) + (v[j].z * v[j].z + v[j].w * v[j].w); }
        const float rstd = rsqrtf(wave_sum(ss) * (1.f / D) + EPS);
        float acc[16];
#pragma unroll
        for (int i = 0; i < 16; ++i) acc[i] = 0.f;
        int lb = lane * 64; asm volatile("" : "+v"(lb));
        int lbase[4];
#pragma unroll
        for (int c = 0; c < 4; ++c) lbase[c] = lb + ((c ^ ((lane >> 2) & 3)) << 4);
#pragma unroll
        for (int j = 0; j < 8; ++j) {
            const f32x4 g = *((const f32x4*)g1 + lane + 64 * j);
            v[j].x *= rstd * g.x; v[j].y *= rstd * g.y; v[j].z *= rstd * g.z; v[j].w *= rstd * g.w;
            v2u o; o.x = pk2(v[j].x, v[j].y); o.y = pk2(v[j].z, v[j].w);
            *((v2u*)(XN + (size_t)m * D) + lane + 64 * j) = o;
            { int o8 = 0; o8 = __builtin_amdgcn_cvt_pk_fp8_f32(v[j].x, v[j].y, o8, false); o8 = __builtin_amdgcn_cvt_pk_fp8_f32(v[j].z, v[j].w, o8, true); *((int*)(a.ws + WS_XN8 + (size_t)m * D) + lane + 64 * j) = o8; }
#pragma unroll
            for (int i = 0; i < 4; ++i) {
                const float hv = v[j][i];
#pragma unroll
                for (int c = 0; c < 4; ++c) { const f32x4 w = *(const LAS f32x4*)(C.lds + lbase[c] + (i * 512 + 64 * j) * 64);
                    acc[4 * c + 0] += hv * w.x; acc[4 * c + 1] += hv * w.y; acc[4 * c + 2] += hv * w.z; acc[4 * c + 3] += hv * w.w; }
            }
        }
        float mine = 0.f;
#pragma unroll
        for (int i = 0; i < 16; ++i) { const float s = wave_sum(acc[i]); if (lane == i) mine = s; }
        if (lane < 16) MG[(size_t)m * 16 + lane] = mine + gbias[lane];
    }
}
__device__ __forceinline__ void p0_router_w(const Ctx& C, const Args& a) {
    const float* wr = a.in[13]; const float* g2 = a.in[12]; bf16* WRH = (bf16*)(a.ws + WS_WRH); bf16* WRL = (bf16*)(a.ws + WS_WRL);
    for (int g = C.vcu * NTHR + C.tid; g < D * NE; g += C.G * NTHR) { const int k = g >> 5, e = g & 31; const float w = wr[g] * g2[k];
        const int q = k & 15, idx = (((k >> 4) * 64) + ((q >> 2) & 1) * 32 + e) * 8 + (q >> 3) * 4 + (q & 3);
        const bf16 hi = f2bf(w); const bf16 lo = f2bf(w - bf2f(hi)); WRH[idx] = hi; WRL[idx] = lo; }
}
__device__ __forceinline__ void p0_rope(const Ctx& C, const Args& a) {
    float* ROPE = (float*)(a.ws + WS_ROPE);
    for (int g = C.vcu * NTHR + C.tid; g < S * 32; g += C.G * NTHR) {
        const int pos = g >> 5, i = g & 31;
        const double inv = exp2(-(double)i * (13.287712379549449 / 32.0));
        const double rev = (double)pos * inv * 0.15915494309189535;
        const double fr = rev - floor(rev + 0.5);
        const float ang = (float)(fr * 6.283185307179586);
        f32x2 cs; cs.x = cosf(ang); cs.y = sinf(ang);
        *(f32x2*)(ROPE + 2 * g) = cs;
    }
}

template <bool GATES8> struct EpiProj {
    static constexpr bool PERM = true, AFTER_DRAIN = false;
    bf16* O; unsigned char* G8;
    __device__ __forceinline__ void operator()(const pg8::f32x4 (&acc)[2][2][4][2], const pg8::Unit& u, int wr, int wc, int fr, int fq) const {
        const int pn = GATES8 ? u.pn + 24 : u.pn;
        const int row0 = u.pm * 256 + wr * 64 + fr, col0 = pn * 256 + wc * 32 + 8 * fq;
        const int mode = (pn == 2 || pn == 3) ? 1 : (((pn >= 8 && pn < 12) || pn >= 24) ? 2 : 0);
#pragma unroll
        for (int ai = 0; ai < 2; ++ai)
#pragma unroll
            for (int m = 0; m < 4; ++m) { bf16* rowp = O + (size_t)(row0 + ai * 128 + m * 16) * NPJ + col0;
#pragma unroll
                for (int bj = 0; bj < 2; ++bj) { pg8::f32x4 v0 = acc[ai][bj][m][0], v1 = acc[ai][bj][m][1];
                    if (GATES8) { v0 = v0 * W8INV; v1 = v1 * W8INV; }
                    if (mode == 1) { v0 = v0 * KSCALE; v1 = v1 * KSCALE; }
                    if (mode == 2) {
#pragma unroll
                        for (int i = 0; i < 4; ++i) { v0[i] = sigmoidf_(v0[i]); v1[i] = sigmoidf_(v1[i]); } }
                    if (GATES8) {
                        const unsigned q[8] = {(unsigned)__builtin_rintf(v0[0] * 255.f), (unsigned)__builtin_rintf(v0[1] * 255.f), (unsigned)__builtin_rintf(v0[2] * 255.f), (unsigned)__builtin_rintf(v0[3] * 255.f),
                                               (unsigned)__builtin_rintf(v1[0] * 255.f), (unsigned)__builtin_rintf(v1[1] * 255.f), (unsigned)__builtin_rintf(v1[2] * 255.f), (unsigned)__builtin_rintf(v1[3] * 255.f)};
                        v2u w; w.x = q[0] | (q[1] << 8) | (q[2] << 16) | (q[3] << 24); w.y = q[4] | (q[5] << 8) | (q[6] << 16) | (q[7] << 24);
                        *(v2u*)(G8 + (size_t)(row0 + ai * 128 + m * 16) * 4096 + u.pn * 256 + wc * 32 + 8 * fq + bj * 128) = w;
                    } else {
                    v4u w; w.x = pk2(v0[0], v0[1]); w.y = pk2(v0[2], v0[3]); w.z = pk2(v1[0], v1[1]); w.w = pk2(v1[2], v1[3]);
                    *(v4u*)(rowp + bj * 128) = w; } } }
    }
};
__device__ __forceinline__ void gate8(const unsigned char* G8, size_t row, int gcol, float (&g)[8]) {
    const v2u w = *(const v2u*)(G8 + row * 4096 + gcol); const float s = 1.f / 255.f;
    g[0] = (float)(w.x & 0xff) * s; g[1] = (float)((w.x >> 8) & 0xff) * s; g[2] = (float)((w.x >> 16) & 0xff) * s; g[3] = (float)(w.x >> 24) * s;
    g[4] = (float)(w.y & 0xff) * s; g[5] = (float)((w.y >> 8) & 0xff) * s; g[6] = (float)((w.y >> 16) & 0xff) * s; g[7] = (float)(w.y >> 24) * s;
}
template <int MODE> struct EpiGate {
    static constexpr bool PERM = true, AFTER_DRAIN = false;
    const bf16* PROJ; const bf16* T1in; bf16* O;
    __device__ __forceinline__ void operator()(const pg8::f32x4 (&acc)[2][2][4][2], const pg8::Unit& u, int wr, int wc, int fr, int fq) const {
        const int row0 = u.pm * 256 + wr * 64 + fr, col0 = u.pn * 256 + wc * 32 + 8 * fq;
#pragma unroll
        for (int ai = 0; ai < 2; ++ai)
#pragma unroll
            for (int m = 0; m < 4; ++m) { const size_t row = (size_t)(row0 + ai * 128 + m * 16);
#pragma unroll
                for (int bj = 0; bj < 2; ++bj) { const int col = col0 + bj * 128; const pg8::f32x4 v0 = acc[ai][bj][m][0], v1 = acc[ai][bj][m][1];
                    float g[8]; gate8((const unsigned char*)PROJ, row, (MODE ? 2048 : 0) + col, g);
                    float o[8] = {g[0] * v0[0], g[1] * v0[1], g[2] * v0[2], g[3] * v0[3], g[4] * v1[0], g[5] * v1[1], g[6] * v1[2], g[7] * v1[3]};
                    if (MODE == 1) { const v4u t = *(const v4u*)(T1in + row * D + col);
                        o[0] += bflo(t.x); o[1] += bfhi(t.x); o[2] += bflo(t.y); o[3] += bfhi(t.y); o[4] += bflo(t.z); o[5] += bfhi(t.z); o[6] += bflo(t.w); o[7] += bfhi(t.w); }
                    v4u w; w.x = pk2(o[0], o[1]); w.y = pk2(o[2], o[3]); w.z = pk2(o[4], o[5]); w.w = pk2(o[6], o[7]);
                    *(v4u*)(O + row * D + col) = w; } }
    }
};
struct EpiGatePair {
    static constexpr bool PERM = true, AFTER_DRAIN = false;
    const bf16* PROJ; bf16* T1; bf16* MIX;
    __device__ __forceinline__ void operator()(const pg8::f32x4 (&acc)[2][2][4][2], const pg8::Unit& u, int wr, int wc, int fr, int fq) const {
        const bool second = u.pm >= T / 256; const int pmr = second ? u.pm - T / 256 : u.pm;
        const int row0 = pmr * 256 + wr * 64 + fr, col0 = u.pn * 256 + wc * 32 + 8 * fq; const int gcol = second ? 2048 : 0; bf16* O = second ? MIX : T1;
        const unsigned char* G8 = (const unsigned char*)PROJ;
#pragma unroll
        for (int ai = 0; ai < 2; ++ai) {
            v2u gw[4][2]; v4u tw[4][2];
#pragma unroll
            for (int m = 0; m < 4; ++m)
#pragma unroll
                for (int bj = 0; bj < 2; ++bj) { const size_t row = (size_t)(row0 + ai * 128 + m * 16); const int col = col0 + bj * 128;
                    gw[m][bj] = *(const v2u*)(G8 + row * 4096 + gcol + col); if (second) tw[m][bj] = *(const v4u*)(T1 + row * D + col); }
            __builtin_amdgcn_sched_barrier(0);
#pragma unroll
            for (int m = 0; m < 4; ++m) { const size_t row = (size_t)(row0 + ai * 128 + m * 16);
#pragma unroll
                for (int bj = 0; bj < 2; ++bj) { const int col = col0 + bj * 128; const pg8::f32x4 v0 = acc[ai][bj][m][0], v1 = acc[ai][bj][m][1];
                    const v2u w8 = gw[m][bj]; const float s = 1.f / 255.f;
                    const float g[8] = {(float)(w8.x & 0xff) * s, (float)((w8.x >> 8) & 0xff) * s, (float)((w8.x >> 16) & 0xff) * s, (float)(w8.x >> 24) * s,
                                        (float)(w8.y & 0xff) * s, (float)((w8.y >> 8) & 0xff) * s, (float)((w8.y >> 16) & 0xff) * s, (float)(w8.y >> 24) * s};
                    float o[8] = {g[0] * v0[0], g[1] * v0[1], g[2] * v0[2], g[3] * v0[3], g[4] * v1[0], g[5] * v1[1], g[6] * v1[2], g[7] * v1[3]};
                    if (second) { const v4u t = tw[m][bj];
                        o[0] += bflo(t.x); o[1] += bfhi(t.x); o[2] += bflo(t.y); o[3] += bfhi(t.y); o[4] += bflo(t.z); o[5] += bfhi(t.z); o[6] += bflo(t.w); o[7] += bfhi(t.w); }
                    v4u w; w.x = pk2(o[0], o[1]); w.y = pk2(o[2], o[3]); w.z = pk2(o[4], o[5]); w.w = pk2(o[6], o[7]);
                    *(v4u*)(O + row * D + col) = w; } }
            __builtin_amdgcn_sched_barrier(0);
        }
    }
};
struct PairOrder {
    pg8::StaticOrder so;
    __device__ __forceinline__ bool next(int i, pg8::Unit& u) const {
        const int per = so.nwg / so.G;
        if (i >= 2 * per) return false;
        const bool second = i >= per; if (!so.next(second ? i - per : i, u)) return false;
        if (second) { u.pm += T / 256; u.pb += D / 256; }
        return true;
    }
    __device__ __forceinline__ void a_ready(const pg8::Unit&) const {}
    __device__ __forceinline__ void done(const pg8::Unit&) const {}
    __device__ __forceinline__ int rot() const { return 0; }
};
struct EpiRes {
    static constexpr bool PERM = false, AFTER_DRAIN = false;
    const float* X; float* O;
    __device__ __forceinline__ void operator()(const pg8::f32x4 (&acc)[2][2][4][2], const pg8::Unit& u, int wr, int wc, int fr, int fq) const {
        const int row0 = u.pm * 256 + wr * 64 + fr, col0 = u.pn * 256 + wc * 32 + 4 * fq;
#pragma unroll
        for (int ai = 0; ai < 2; ++ai) { pg8::f32x4 xv[4][2][2];
#pragma unroll
            for (int m = 0; m < 4; ++m) { const size_t off = (size_t)(row0 + ai * 128 + m * 16) * D + col0;
#pragma unroll
                for (int bj = 0; bj < 2; ++bj)
#pragma unroll
                    for (int n = 0; n < 2; ++n) xv[m][bj][n] = *(const pg8::f32x4*)(X + off + bj * 128 + n * 16); }
            __builtin_amdgcn_sched_barrier(0);
#pragma unroll
            for (int m = 0; m < 4; ++m) { const size_t off = (size_t)(row0 + ai * 128 + m * 16) * D + col0;
#pragma unroll
                for (int bj = 0; bj < 2; ++bj)
#pragma unroll
                    for (int n = 0; n < 2; ++n) *(pg8::f32x4*)(O + off + bj * 128 + n * 16) = xv[m][bj][n] + acc[ai][bj][m][n]; }
            __builtin_amdgcn_sched_barrier(0); }
    }
};
struct EpiAct {
    static constexpr bool PERM = true, AFTER_DRAIN = false;
    const float* bias; unsigned char* O;
    __device__ __forceinline__ void operator()(const pg8::f32x4 (&acc)[2][2][4][2], const pg8::Unit& u, int wr, int wc, int fr, int fq) const {
        const int row0 = u.pm * 256 + wr * 64 + fr, col0 = u.pn * 256 + wc * 32 + 8 * fq, e = u.pb >> 4;
        pg8::f32x4 bv[2][2];
#pragma unroll
        for (int bj = 0; bj < 2; ++bj)
#pragma unroll
            for (int n = 0; n < 2; ++n) bv[bj][n] = *(const pg8::f32x4*)(bias + (size_t)e * 2 * DE + col0 + bj * 128 + 4 * n);
#pragma unroll
        for (int ai = 0; ai < 2; ++ai)
#pragma unroll
            for (int m = 0; m < 4; ++m) { const size_t row = (size_t)(row0 + ai * 128 + m * 16);
#pragma unroll
                for (int bj = 0; bj < 2; ++bj) { const pg8::f32x4 v0 = acc[ai][bj][m][0] * W8INV + bv[bj][0], v1 = acc[ai][bj][m][1] * W8INV + bv[bj][1];
                    const float gu[8] = {v0[0], v0[1], v0[2], v0[3], v1[0], v1[1], v1[2], v1[3]}; float o[4];
#pragma unroll
                    for (int p = 0; p < 4; ++p) { const float glu = fminf(gu[2 * p], 7.f), lin = fminf(fmaxf(gu[2 * p + 1], -7.f), 7.f); o[p] = glu * sigmoidf_(1.702f * glu) * (lin + 1.f); }
                    int w = 0; w = __builtin_amdgcn_cvt_pk_fp8_f32(o[0], o[1], w, false); w = __builtin_amdgcn_cvt_pk_fp8_f32(o[2], o[3], w, true);
                    *(int*)(O + row * DE + ((col0 + bj * 128) >> 1)) = w; } }
    }
};
struct EpiY {
    static constexpr bool PERM = true, AFTER_DRAIN = false;
    const float* bias; bf16* O;
    __device__ __forceinline__ void operator()(const pg8::f32x4 (&acc)[2][2][4][2], const pg8::Unit& u, int wr, int wc, int fr, int fq) const {
        const int row0 = u.pm * 256 + wr * 64 + fr, col0 = u.pn * 256 + wc * 32 + 8 * fq, e = u.pb >> 3;
        pg8::f32x4 bv[2][2];
#pragma unroll
        for (int bj = 0; bj < 2; ++bj)
#pragma unroll
            for (int n = 0; n < 2; ++n) bv[bj][n] = *(const pg8::f32x4*)(bias + (size_t)e * D + col0 + bj * 128 + 4 * n);
#pragma unroll
        for (int ai = 0; ai < 2; ++ai)
#pragma unroll
            for (int m = 0; m < 4; ++m) { const size_t row = (size_t)(row0 + ai * 128 + m * 16);
#pragma unroll
                for (int bj = 0; bj < 2; ++bj) { const pg8::f32x4 v0 = acc[ai][bj][m][0] * W8INV + bv[bj][0], v1 = acc[ai][bj][m][1] * W8INV + bv[bj][1];
                    int a0 = 0, a1 = 0; a0 = __builtin_amdgcn_cvt_pk_fp8_f32(sat8(v0[0]), sat8(v0[1]), a0, false); a0 = __builtin_amdgcn_cvt_pk_fp8_f32(sat8(v0[2]), sat8(v0[3]), a0, true);
                    a1 = __builtin_amdgcn_cvt_pk_fp8_f32(sat8(v1[0]), sat8(v1[1]), a1, false); a1 = __builtin_amdgcn_cvt_pk_fp8_f32(sat8(v1[2]), sat8(v1[3]), a1, true);
                    v2u w; w.x = (unsigned)a0; w.y = (unsigned)a1;
                    *(v2u*)((unsigned char*)O + row * D + col0 + bj * 128) = w; } }
    }
};
struct MoeSched {
    int tsl, fin, hin, fl, F, total, NT, G, c;
    __device__ __forceinline__ void init(const int* cnt, int NT_, int G_, int c_, int lane) {
        const int cn = lane < NE ? cnt[lane] : 0, f = cn / PADM, r = cn - f * PADM;
        const int full = f + (r > PADM / 2 ? 1 : 0), half = (r > 0 && r <= PADM / 2) ? 1 : 0, tiles = full + half;
        int it = tiles, iff = full, ih = half;
#pragma unroll
        for (int o = 1; o < 32; o <<= 1) { const int t0 = __shfl_up(it, o), t1 = __shfl_up(iff, o), t2 = __shfl_up(ih, o); if (lane >= o) { it += t0; iff += t1; ih += t2; } }
        F = __shfl(iff, 31); total = F + __shfl(ih, 31);
        tsl = it - tiles; fl = full; fin = lane < NE ? iff : 0x7fffffff; hin = lane < NE ? ih : 0x7fffffff; NT = NT_; G = G_; c = c_;
    }
    __device__ __forceinline__ bool next(int i, pg8::Unit& u) const {
        int mo, pn;
        if (G == 256) { const int x = c & 7, jj = c >> 3, NPB = NT >> 3, RPM = (8 / NPB) * 4;
            mo = i * RPM + (x / NPB) * 4 + (jj & 3); pn = (x % NPB) * 8 + (jj >> 2); }
        else { const long L = (long)i * G + c; mo = (int)(L / NT); pn = (int)(L % NT); }
        if (mo >= total) return false;
        int e, mt, hf;
        if (mo < F) { e = __popcll(__ballot(fin <= mo)); mt = __shfl(tsl, e) + (mo - (__shfl(fin, e) - __shfl(fl, e))); hf = 0; }
        else { e = __popcll(__ballot(hin <= mo - F)); mt = __shfl(tsl, e) + __shfl(fl, e); hf = 1; }
        u.pm = mt; u.pn = pn; u.pb = e * NT + pn; u.half = __builtin_amdgcn_readfirstlane(hf); return true;
    }
    __device__ __forceinline__ void a_ready(const pg8::Unit&) const {}
    __device__ __forceinline__ void done(const pg8::Unit&) const {}
    __device__ __forceinline__ int rot() const { const int jj = c >> 3; return G == 256 ? ((jj >> 2) + (jj & 3)) & 15 : 0; }
};

__device__ __forceinline__ void p2_mstats(const Ctx& C, const Args& a) {
    const float* MG = (const float*)(a.ws + WS_MG); float* GA = (float*)(a.ws + WS_MSC);
    const int gw = C.vcu * NWAVES + C.wave, NGW = C.G * NWAVES, lane = C.lane;
    for (int q = gw; q < 16 * 64; q += NGW) {
        const int chain = q >> 6, c = q & 63, dir = chain & 1, hh = (chain >> 1) & 3, b = chain >> 3;
        const int p = b * S + 64 * c + (dir ? 63 - lane : lane);
        const float lf = logsigf_(MG[(size_t)p * 16 + (dir ? 12 : 4) + hh]), ig = MG[(size_t)p * 16 + (dir ? 8 : 0) + hh];
        const float bs = incl_sum_up(lf, lane), g = __shfl(bs, 63), amax = g + wave_max(ig - bs);
        if (lane == 0) { f32x2 o; o.x = g; o.y = amax; *(f32x2*)(GA + (size_t)q * 2) = o; }
    }
}
struct MScan { float mprev, mnew, dec; };
__device__ __forceinline__ float rdlane(float v, int l) { return __int_as_float(__builtin_amdgcn_readlane(__float_as_int(v), l)); }
__device__ __forceinline__ MScan mscan(const float* GA, int chain, int lane) {
    const f32x2 ga = *(const f32x2*)(GA + (size_t)(chain * 64 + lane) * 2); const int dir = chain & 1;
    MScan r; r.mprev = 0.f; r.mnew = 0.f; r.dec = 0.f; float m = 0.f;
    for (int ci = 0; ci < 64; ++ci) { const int cc = dir ? 63 - ci : ci;
        const float gc = rdlane(ga.x, cc), ac = rdlane(ga.y, cc), mnew = fmaxf(gc + m, ac);
        if (lane == cc) { r.mprev = m; r.mnew = mnew; r.dec = __expf(gc + m - mnew); }
        m = mnew; }
    return r;
}
constexpr size_t WS_MSV = WS_MSC + 65536;
__device__ __forceinline__ MScan mscan_ld(const unsigned char* ws, int chain, int lane) { const f32x4 v = *(const f32x4*)(ws + WS_MSV + (size_t)(chain * 64 + lane) * 16); MScan r; r.mprev = v.x; r.mnew = v.y; r.dec = v.z; return r; }
__device__ __forceinline__ void p2_qkprep(const Ctx& C, const Args& a) {
    const bf16* PROJ = (const bf16*)(a.ws + WS_PROJ); const float* ROPE = (const float*)(a.ws + WS_ROPE);
    const float* qg = a.in[6]; const float* kg = a.in[7];
    bf16* QN = (bf16*)(a.ws + WS_QN); bf16* KN = (bf16*)(a.ws + WS_KN);
    const int gw = C.vcu * NWAVES + C.wave, NGW = C.G * NWAVES, lane = C.lane, g = lane >> 2, sub = lane & 3;
    float gq1[8], gq2[8], gk1[8], gk2[8];
#pragma unroll
    for (int i = 0; i < 8; ++i) { gq1[i] = qg[sub * 8 + i]; gq2[i] = qg[32 + sub * 8 + i]; gk1[i] = kg[sub * 8 + i]; gk2[i] = kg[32 + sub * 8 + i]; }
    for (int mb = gw; mb < T; mb += 4 * NGW) {
        f32x4 rp[4][4]; v4u qa1[4], qa2[4], ka1[4], ka2[4];
#pragma unroll
        for (int tt = 0; tt < 4; ++tt) { const int m = mb + tt * NGW < T ? mb + tt * NGW : mb, pos = m & (S - 1);
#pragma unroll
            for (int i = 0; i < 4; ++i) rp[tt][i] = *(const f32x4*)(ROPE + ((size_t)pos * 32 + sub * 8 + 2 * i) * 2);
            const bf16* sq = PROJ + (size_t)m * NPJ + P_DQ + g * 64 + sub * 8; const bf16* sk = PROJ + (size_t)m * NPJ + P_DK + g * 64 + sub * 8;
            qa1[tt] = *(const v4u*)sq; qa2[tt] = *(const v4u*)(sq + 32); ka1[tt] = *(const v4u*)sk; ka2[tt] = *(const v4u*)(sk + 32); }
        __builtin_amdgcn_sched_barrier(0);
#pragma unroll
        for (int tt = 0; tt < 4; ++tt) { const int m = mb + tt * NGW; if (m < T) {
            float cs[8], sn[8];
#pragma unroll
            for (int i = 0; i < 4; ++i) { const f32x4 t = rp[tt][i]; cs[2 * i] = t.x; sn[2 * i] = t.y; cs[2 * i + 1] = t.z; sn[2 * i + 1] = t.w; }
#pragma unroll
            for (int which = 0; which < 2; ++which) {
                const v4u a1 = which ? ka1[tt] : qa1[tt], a2 = which ? ka2[tt] : qa2[tt];
                float x1[8] = {bflo(a1.x), bfhi(a1.x), bflo(a1.y), bfhi(a1.y), bflo(a1.z), bfhi(a1.z), bflo(a1.w), bfhi(a1.w)};
                float x2[8] = {bflo(a2.x), bfhi(a2.x), bflo(a2.y), bfhi(a2.y), bflo(a2.z), bfhi(a2.z), bflo(a2.w), bfhi(a2.w)};
                float ss = 0.f;
#pragma unroll
                for (int i = 0; i < 8; ++i) ss += x1[i] * x1[i] + x2[i] * x2[i];
                ss += __shfl_xor(ss, 1); ss += __shfl_xor(ss, 2);
                const float r = rsqrtf(ss * (1.f / 64.f) + EPS) * (which ? 1.f : QSCALE);
                float o1[8], o2[8];
#pragma unroll
                for (int i = 0; i < 8; ++i) { const float u1 = x1[i] * r * (which ? gk1[i] : gq1[i]), u2 = x2[i] * r * (which ? gk2[i] : gq2[i]); o1[i] = u1 * cs[i] - u2 * sn[i]; o2[i] = u2 * cs[i] + u1 * sn[i]; }
                bf16* dst = (which ? KN : QN) + (size_t)m * 1024 + g * 64 + sub * 8;
                v4u w1, w2; w1.x = pk2(o1[0], o1[1]); w1.y = pk2(o1[2], o1[3]); w1.z = pk2(o1[4], o1[5]); w1.w = pk2(o1[6], o1[7]);
                w2.x = pk2(o2[0], o2[1]); w2.y = pk2(o2[2], o2[3]); w2.z = pk2(o2[4], o2[5]); w2.w = pk2(o2[6], o2[7]);
                *(v4u*)dst = w1; *(v4u*)(dst + 32) = w2;
            } } }
        __builtin_amdgcn_sched_barrier(0);
    }
}

__device__ __forceinline__ void mlA_unit(const Ctx& C, int u, const Args& a) {
    const bf16* PROJ = (const bf16*)(a.ws + WS_PROJ); const float* MG = (const float*)(a.ws + WS_MG); const float* MSC = (const float*)(a.ws + WS_MSC);
    bf16* U = (bf16*)(a.ws + WS_U); float* NU = (float*)(a.ws + WS_NU);
    const int b = u >> 8, hh = (u >> 6) & 3, j = u & 63, chain0 = (b * 4 + hh) * 2;
    const size_t row0 = (size_t)b * S + j * 64;
    const int tid = C.tid, lane = C.lane, w = C.wave;
    LAS unsigned char* lds = C.lds;
    constexpr int KI = 0, VI = 20480, WKF = 57344, WKB = 77824, WF = 98304;
    __syncthreads();
#pragma unroll
    for (int i = 0; i < 2; ++i) { const int p = tid + 512 * i, row = p >> 4, c = p & 15;
        *(LAS v4u*)(lds + KI + row * 320 + c * 16) = *(const v4u*)(PROJ + (row0 + row) * NPJ + P_MK + hh * 128 + c * 8); }
#pragma unroll
    for (int i = 0; i < 4; ++i) { const int p = tid + 512 * i, row = p >> 5, c = p & 31;
        *(LAS v4u*)(lds + VI + row * 576 + c * 16) = *(const v4u*)(PROJ + (row0 + row) * NPJ + P_MV + hh * 256 + c * 8); }
    if (w < 2) {
        const int dir = w, t = lane;
        const float fgv = MG[(row0 + t) * 16 + (dir ? 12 : 4) + hh], igv = MG[(row0 + t) * 16 + (dir ? 8 : 0) + hh];
        const float lf = logsigf_(fgv), P = incl_sum_up(lf, lane), Gt = __shfl(P, 63);
        const float bcur = dir ? (Gt - P + lf) : P;
        const MScan ms = mscan(MSC, chain0 + dir, lane);
        if (j == 0) { f32x4 o; o.x = ms.mprev; o.y = ms.mnew; o.z = ms.dec; o.w = 0.f; *(f32x4*)(a.ws + WS_MSV + (size_t)((chain0 + dir) * 64 + lane) * 16) = o; }
        const float av = Gt - bcur + igv, mnew = rdlane(ms.mnew, j);
        ((LAS float*)(lds + WF + dir * 256))[t] = __expf(av - mnew);
    }
    __syncthreads();
#pragma unroll
    for (int i = 0; i < 2; ++i) { const int p = tid + 512 * i, row = p >> 4, c = p & 15;
        const v4u kv = *(LAS v4u*)(lds + KI + row * 320 + c * 16);
        const float wf = ((LAS float*)(lds + WF))[row], wb = ((LAS float*)(lds + WF + 256))[row];
        *(LAS v4u*)(lds + WKF + row * 320 + c * 16) = scale8(kv, wf);
        *(LAS v4u*)(lds + WKB + row * 320 + c * 16) = scale8(kv, wb); }
    if (tid < 256) { const int dir = tid >> 7, k = tid & 127; float s = 0.f;
        for (int t = 0; t < 64; ++t) s += ((LAS float*)(lds + WF + dir * 256))[t] * bf2f(*(LAS bf16*)(lds + KI + t * 320 + k * 2));
        NU[(size_t)((chain0 + dir) * 64 + j) * 128 + k] = s; }
    __syncthreads();
    const int G_ = (lane >> 4) & 1, i16 = lane & 15, q_ = i16 >> 2, p_ = i16 & 3, h = lane >> 5, r32 = lane & 31;
    f32x16 acc[2][4];
#pragma unroll
    for (int d = 0; d < 2; ++d)
#pragma unroll
        for (int n = 0; n < 4; ++n) acc[d][n] = f32x16{};
#pragma unroll
    for (int s = 0; s < 4; ++s) {
        LAS unsigned char* va = lds + VI + (16 * s + 8 * h + q_) * 576 + (32 * w + 16 * G_ + 4 * p_) * 2;
        const bf16x8 af = cat8(trr(va), trr(va + 4 * 576));
#pragma unroll
        for (int d = 0; d < 2; ++d)
#pragma unroll
            for (int n = 0; n < 4; ++n) {
                LAS unsigned char* ba = lds + (d ? WKB : WKF) + (16 * s + 8 * h + q_) * 320 + (32 * n + 16 * G_ + 4 * p_) * 2;
                const bf16x8 bfr = cat8(trr(ba), trr(ba + 4 * 320));
                acc[d][n] = __builtin_amdgcn_mfma_f32_32x32x16_bf16(bfr, af, acc[d][n], 0, 0, 0);
            }
    }
    __syncthreads();
    LAS unsigned char* ut = lds + w * 4096;
#pragma unroll
    for (int d = 0; d < 2; ++d) {
#pragma unroll
        for (int n = 0; n < 4; ++n)
#pragma unroll
            for (int g4 = 0; g4 < 4; ++g4) { int o = 0; o = __builtin_amdgcn_cvt_pk_fp8_f32(sat8(acc[d][n][4 * g4 + 0]), sat8(acc[d][n][4 * g4 + 1]), o, false); o = __builtin_amdgcn_cvt_pk_fp8_f32(sat8(acc[d][n][4 * g4 + 2]), sat8(acc[d][n][4 * g4 + 3]), o, true);
                *(LAS int*)(ut + r32 * 128 + ((32 * n + 8 * g4 + 4 * h) ^ ((r32 & 7) << 4))) = o; }
        unsigned char* ub = (unsigned char*)U + ((size_t)((chain0 + d) * 64 + j) * 256 + 32 * w) * 128;
#pragma unroll
        for (int i = 0; i < 4; ++i) { const int row = 8 * i + (lane >> 3), ch = lane & 7;
            const v4u v = *(LAS v4u*)(ut + row * 128 + ((ch ^ (row & 7)) << 4));
            *(v4u*)(ub + (size_t)row * 128 + ch * 16) = v; }
    }
}
__device__ __forceinline__ void mlB_scan(const Ctx& C, const Args& a) {
    const bf16* __restrict__ U = (const bf16*)(a.ws + WS_U); bf16* __restrict__ CP = (bf16*)(a.ws + WS_CP); const float* MSC = (const float*)(a.ws + WS_MSC);
    const float* __restrict__ NU = (const float*)(a.ws + WS_NU); float* __restrict__ NP = (float*)(a.ws + WS_NP);
    for (int g = C.vcu * NTHR + C.tid; g < 16 * 8192; g += C.G * NTHR) {
        const int chain = __builtin_amdgcn_readfirstlane(g >> 13), e4 = g & 8191, dir = chain & 1;
        const MScan ms = mscan_ld(a.ws, chain, C.lane);
        const unsigned char* ub = (const unsigned char*)U + (size_t)chain * 64 * 32768 + 4 * e4; unsigned char* cb = (unsigned char*)CP + (size_t)chain * 64 * 32768 + 4 * e4;
        int ur[64];
#pragma unroll
        for (int ci = 0; ci < 64; ++ci) { const int c = dir ? 63 - ci : ci; ur[ci] = *(const int*)(ub + (size_t)c * 32768); }
        __builtin_amdgcn_sched_barrier(0);
        f32x4 st = {0.f, 0.f, 0.f, 0.f};
#pragma unroll
        for (int ci = 0; ci < 64; ++ci) { const int c = dir ? 63 - ci : ci; const float dec = rdlane(ms.dec, c);
            { int o = 0; o = __builtin_amdgcn_cvt_pk_fp8_f32(sat8(st.x), sat8(st.y), o, false); o = __builtin_amdgcn_cvt_pk_fp8_f32(sat8(st.z), sat8(st.w), o, true); *(int*)(cb + (size_t)c * 32768) = o; }
            const f32x4 uv = {__builtin_amdgcn_cvt_f32_fp8(ur[ci], 0), __builtin_amdgcn_cvt_f32_fp8(ur[ci], 1), __builtin_amdgcn_cvt_f32_fp8(ur[ci], 2), __builtin_amdgcn_cvt_f32_fp8(ur[ci], 3)}; st = st * dec + uv; }
    }
    const int g = C.vcu * NTHR + C.tid;
    if (g < 2048) { const int chain = __builtin_amdgcn_readfirstlane(g >> 7), k = g & 127, dir = chain & 1; const MScan ms = mscan_ld(a.ws, chain, C.lane);
        float nu[64];
#pragma unroll
        for (int ci = 0; ci < 64; ++ci) { const int c = dir ? 63 - ci : ci; nu[ci] = NU[(size_t)(chain * 64 + c) * 128 + k]; }
        __builtin_amdgcn_sched_barrier(0);
        float st = 0.f;
#pragma unroll
        for (int ci = 0; ci < 64; ++ci) { const int c = dir ? 63 - ci : ci; NP[(size_t)(chain * 64 + c) * 128 + k] = st; st = st * rdlane(ms.dec, c) + nu[ci]; } }
}
__device__ __forceinline__ void mlC_unit(const Ctx& C, int u, const Args& a) {
    const bf16* PROJ = (const bf16*)(a.ws + WS_PROJ); const float* MG = (const float*)(a.ws + WS_MG); const float* MSC = (const float*)(a.ws + WS_MSC);
    const bf16* CP = (const bf16*)(a.ws + WS_CP); const float* NP = (const float*)(a.ws + WS_NP); const float* mlg = a.in[4]; bf16* HM = (bf16*)(a.ws + WS_HM);
    const int b = u >> 8, hh = (u >> 6) & 3, j = u & 63, chain0 = (b * 4 + hh) * 2;
    const size_t row0 = (size_t)b * S + j * 64;
    const int tid = C.tid, lane = C.lane, w = C.wave;
    LAS unsigned char* lds = C.lds;
    constexpr int QI = 0, KI = 17408, VI = 34816, SI = 71680, PI = 89088, SC = 98304;
    constexpr int NQ = SC + 2048, NPL = SC + 6144, SSO = SC + 7168, RS = SC + 9216;
    __syncthreads();
#pragma unroll
    for (int i = 0; i < 2; ++i) { const int p = tid + 512 * i, row = p >> 4, c = p & 15;
        *(LAS v4u*)(lds + QI + row * 272 + c * 16) = *(const v4u*)(PROJ + (row0 + row) * NPJ + P_MQ + hh * 128 + c * 8);
        *(LAS v4u*)(lds + KI + row * 272 + c * 16) = *(const v4u*)(PROJ + (row0 + row) * NPJ + P_MK + hh * 128 + c * 8); }
#pragma unroll
    for (int i = 0; i < 4; ++i) { const int p = tid + 512 * i, row = p >> 5, c = p & 31;
        *(LAS v4u*)(lds + VI + row * 576 + c * 16) = *(const v4u*)(PROJ + (row0 + row) * NPJ + P_MV + hh * 256 + c * 8); }
    if (tid < 256) ((LAS float*)(lds + NPL))[tid] = NP[(size_t)((chain0 + (tid >> 7)) * 64 + j) * 128 + (tid & 127)];
    v2u cpr[2][8];
#pragma unroll
    for (int d = 0; d < 2; ++d) { const unsigned char* cp = (const unsigned char*)CP + ((size_t)((chain0 + d) * 64 + j) * 256 + 32 * w + (lane & 31)) * 128 + 8 * (lane >> 5);
#pragma unroll
        for (int ks = 0; ks < 8; ++ks) cpr[d][ks] = *(const v2u*)(cp + 16 * ks); }
    f32x4 gnr[4]; v2u smr[2][4];
#pragma unroll
    for (int g4 = 0; g4 < 4; ++g4) { const int v0 = 32 * w + 8 * g4 + 4 * (lane >> 5); gnr[g4] = *(const f32x4*)(mlg + v0);
#pragma unroll
        for (int th = 0; th < 2; ++th) smr[th][g4] = *(const v2u*)(PROJ + (row0 + 32 * th + (lane & 31)) * NPJ + P_MO + hh * 256 + v0); }
    if (w < 2) {
        const int dir = w, t = lane;
        const float fgv = MG[(row0 + t) * 16 + (dir ? 12 : 4) + hh], igv = MG[(row0 + t) * 16 + (dir ? 8 : 0) + hh];
        const float lf = logsigf_(fgv), P = incl_sum_up(lf, lane), Gt = __shfl(P, 63);
        const float bcur = dir ? (Gt - P + lf) : P, cv = igv - bcur;
        const float pm = dir ? incl_max_down(cv, lane) : incl_max_up(cv, lane);
        const MScan ms = mscan_ld(a.ws, chain0 + dir, lane); const float mprev = rdlane(ms.mprev, j);
        const float mt = bcur + fmaxf(mprev, pm), si = __expf(bcur + mprev - mt);
        LAS float* sc = (LAS float*)(lds + SC + dir * 1024);
        sc[t] = bcur; sc[64 + t] = cv; sc[128 + t] = mt; sc[192 + t] = si;
    }
    __syncthreads();
    {
        const int fr = lane & 15, fq = lane >> 4;
#pragma unroll
        for (int tt = 0; tt < 2; ++tt) { const int tile = 2 * w + tt, ti = tile >> 2, si_ = tile & 3; f32x4 acc4 = {0.f, 0.f, 0.f, 0.f};
#pragma unroll
            for (int ks = 0; ks < 4; ++ks) {
                const bf16x8 aq = *(LAS bf16x8*)(lds + QI + (16 * ti + fr) * 272 + (32 * ks + 8 * fq) * 2);
                const bf16x8 bk = *(LAS bf16x8*)(lds + KI + (16 * si_ + fr) * 272 + (32 * ks + 8 * fq) * 2);
                acc4 = __builtin_amdgcn_mfma_f32_16x16x32_bf16(aq, bk, acc4, 0, 0, 0); }
#pragma unroll
            for (int i = 0; i < 4; ++i) ((LAS float*)(lds + SI))[(16 * ti + 4 * fq + i) * 68 + 16 * si_ + fr] = acc4[i]; }
        const int t = tid & 63, part = tid >> 6;
        const v4u q0 = *(LAS v4u*)(lds + QI + t * 272 + part * 32), q1 = *(LAS v4u*)(lds + QI + t * 272 + part * 32 + 16);
        const float qv[16] = {bflo(q0.x), bfhi(q0.x), bflo(q0.y), bfhi(q0.y), bflo(q0.z), bfhi(q0.z), bflo(q0.w), bfhi(q0.w), bflo(q1.x), bfhi(q1.x), bflo(q1.y), bfhi(q1.y), bflo(q1.z), bfhi(q1.z), bflo(q1.w), bfhi(q1.w)};
#pragma unroll
        for (int d = 0; d < 2; ++d) { float s = 0.f;
#pragma unroll
            for (int k = 0; k < 16; ++k) s += ((LAS float*)(lds + NPL))[d * 128 + part * 16 + k] * qv[k];
            ((LAS float*)(lds + NQ))[(d * 8 + part) * 64 + t] = s; }
    }
    __syncthreads();
    {
        const int t = tid >> 3, sg = tid & 7, s0 = 8 * sg;
        const f32x4 sa = *(LAS f32x4*)(lds + SI + (t * 68 + s0) * 4), sb = *(LAS f32x4*)(lds + SI + (t * 68 + s0 + 4) * 4);
        const float sv[8] = {sa.x, sa.y, sa.z, sa.w, sb.x, sb.y, sb.z, sb.w};
        float p[2][8], inv[2];
#pragma unroll
        for (int d = 0; d < 2; ++d) { LAS float* sc = (LAS float*)(lds + SC + d * 1024);
            const float Bt = sc[t], MTt = sc[128 + t], SIt = sc[192 + t]; float rs = 0.f;
#pragma unroll
            for (int e = 0; e < 8; ++e) { const int s = s0 + e; const bool ok = d ? (s >= t) : (s <= t);
                const float dv = ok ? __expf(Bt + sc[64 + s] - MTt) : 0.f; p[d][e] = dv * sv[e]; rs += p[d][e]; }
            float nq = ((LAS float*)(lds + NQ))[(d * 8 + sg) * 64 + t];
            rs += __shfl_xor(rs, 1); rs += __shfl_xor(rs, 2); rs += __shfl_xor(rs, 4);
            nq += __shfl_xor(nq, 1); nq += __shfl_xor(nq, 2); nq += __shfl_xor(nq, 4);
            const float den = fmaxf(fabsf(SIt * nq + rs), __expf(-MTt)); inv[d] = 1.f / den;
            if (sg == 0) ((LAS float*)(lds + RS))[d * 64 + t] = SIt * inv[d]; }
        float o[8];
#pragma unroll
        for (int e = 0; e < 8; ++e) o[e] = p[0][e] * inv[0] + p[1][e] * inv[1];
        v4u wv; wv.x = pk2(o[0], o[1]); wv.y = pk2(o[2], o[3]); wv.z = pk2(o[4], o[5]); wv.w = pk2(o[6], o[7]);
        *(LAS v4u*)(lds + PI + t * 144 + s0 * 2) = wv;
    }
    __syncthreads();
#pragma unroll
    for (int i = 0; i < 2; ++i) { const int p = tid + 512 * i, row = p >> 4, c = p & 15;
        const v4u qv = *(LAS v4u*)(lds + QI + row * 272 + c * 16);
        const float rf = ((LAS float*)(lds + RS))[row], rb = ((LAS float*)(lds + RS))[64 + row];
        *(LAS v4u*)(lds + QI + row * 272 + c * 16) = scale8(qv, rf);
        *(LAS v4u*)(lds + KI + row * 272 + c * 16) = scale8(qv, rb); }
    __syncthreads();
    const int G_ = (lane >> 4) & 1, i16 = lane & 15, q_ = i16 >> 2, p_ = i16 & 3, h = lane >> 5, r32 = lane & 31;
    f32x16 acc[2]; acc[0] = f32x16{}; acc[1] = f32x16{};
#pragma unroll
    for (int d = 0; d < 2; ++d) {
#pragma unroll
        for (int ks = 0; ks < 8; ++ks) { const v2u cr = cpr[d][ks]; v4u a4;
            a4.x = pk2(__builtin_amdgcn_cvt_f32_fp8((int)cr.x, 0), __builtin_amdgcn_cvt_f32_fp8((int)cr.x, 1)); a4.y = pk2(__builtin_amdgcn_cvt_f32_fp8((int)cr.x, 2), __builtin_amdgcn_cvt_f32_fp8((int)cr.x, 3));
            a4.z = pk2(__builtin_amdgcn_cvt_f32_fp8((int)cr.y, 0), __builtin_amdgcn_cvt_f32_fp8((int)cr.y, 1)); a4.w = pk2(__builtin_amdgcn_cvt_f32_fp8((int)cr.y, 2), __builtin_amdgcn_cvt_f32_fp8((int)cr.y, 3));
            const bf16x8 af = __builtin_bit_cast(bf16x8, a4);
#pragma unroll
            for (int th = 0; th < 2; ++th) { const bf16x8 bq = *(LAS bf16x8*)(lds + (d ? KI : QI) + (32 * th + r32) * 272 + (16 * ks + 8 * h) * 2);
                acc[th] = __builtin_amdgcn_mfma_f32_32x32x16_bf16(af, bq, acc[th], 0, 0, 0); } } }
#pragma unroll
    for (int ks = 0; ks < 4; ++ks) { LAS unsigned char* va = lds + VI + (16 * ks + 8 * h + q_) * 576 + (32 * w + 16 * G_ + 4 * p_) * 2;
        const bf16x8 af = cat8(trr(va), trr(va + 4 * 576));
#pragma unroll
        for (int th = 0; th < 2; ++th) { const bf16x8 bp = *(LAS bf16x8*)(lds + PI + (32 * th + r32) * 144 + (16 * ks + 8 * h) * 2);
            acc[th] = __builtin_amdgcn_mfma_f32_32x32x16_bf16(af, bp, acc[th], 0, 0, 0); } }
#pragma unroll
    for (int th = 0; th < 2; ++th) { float ss = 0.f;
#pragma unroll
        for (int r = 0; r < 16; ++r) ss += acc[th][r] * acc[th][r];
        ss += __shfl_xor(ss, 32);
        if (h == 0) ((LAS float*)(lds + SSO))[w * 64 + 32 * th + r32] = ss; }
    __syncthreads();
#pragma unroll
    for (int th = 0; th < 2; ++th) { float tot = 0.f;
#pragma unroll
        for (int ww = 0; ww < 8; ++ww) tot += ((LAS float*)(lds + SSO))[ww * 64 + 32 * th + r32];
        const float rr = rsqrtf(tot * (1.f / 256.f) + EPS); const size_t tok = row0 + 32 * th + r32;
#pragma unroll
        for (int g4 = 0; g4 < 4; ++g4) { const int v0 = 32 * w + 8 * g4 + 4 * h;
            const f32x4 gn = gnr[g4]; const v2u sm = smr[th][g4];
            v2u o; o.x = pk2(acc[th][4 * g4 + 0] * rr * gn.x * bflo(sm.x), acc[th][4 * g4 + 1] * rr * gn.y * bfhi(sm.x));
            o.y = pk2(acc[th][4 * g4 + 2] * rr * gn.z * bflo(sm.y), acc[th][4 * g4 + 3] * rr * gn.w * bfhi(sm.y));
            *(v2u*)(HM + tok * 1024 + hh * 256 + v0) = o; } }
}

constexpr int AT_BUF = 32768, AT_K2 = 8192, AT_V = 16384, AT_CV = 65536, AT_DUMMY = AT_CV + 8 * 8448;
__device__ __forceinline__ void at_dma(unsigned off, const char* base, unsigned ldsaddr) { unsigned keep;
    asm volatile("s_mov_b32 %0, m0\n\ts_mov_b32 m0, %3\n\ts_nop 0\n\tglobal_load_lds_dwordx4 %1, %2\n\ts_mov_b32 m0, %0" : "=&s"(keep) : "v"(off), "s"(base), "s"(ldsaddr) : "memory"); }
__device__ __forceinline__ void attn_unit(const Ctx& C, int u, int uidx, const Args& a, int lam_s, Conv& cv) {
    const bf16* QN = (const bf16*)(a.ws + WS_QN); const bf16* KN = (const bf16*)(a.ws + WS_KN); const bf16* PROJ = (const bf16*)(a.ws + WS_PROJ);
    const int b = u >> 8, hh = (u >> 5) & 7, qb = u & 31;
    const int lane = C.lane, w = C.wave, rg = w >> 1, mp = w & 1, r32 = lane & 31, h = lane >> 5;
    LAS unsigned char* lds = C.lds; const unsigned ldsb = (unsigned)(uintptr_t)lds;
    const size_t rowbase = (size_t)b * S; const int NGW = C.G * NWAVES;
    unsigned ko, vo0;
    { const int row = 8 * w + (lane >> 3), c = (lane & 7) ^ ((row >> 1) & 7); ko = (unsigned)((row * 1024 + c * 8) * 2); }
    { const int row = 8 * w + (lane >> 4), ch = (lane & 15) ^ ((row & 3) << 2); vo0 = (unsigned)((row * NPJ + ch * 8) * 2); }
    const char* kbase = (const char*)(KN + rowbase * 1024 + hh * 128); const char* vbase = (const char*)(PROJ + rowbase * NPJ + P_DV + hh * 128);
#define AT_TILE_DMA(t_, bufoff_) do { const char* kb__ = uni_ptr(kbase + (size_t)(t_) * 64 * 1024 * 2); const char* vb__ = uni_ptr(vbase + (size_t)(t_) * 64 * NPJ * 2); \
        const unsigned d__ = (unsigned)__builtin_amdgcn_readfirstlane((int)(ldsb + (bufoff_))); \
        at_dma(ko, kb__, d__ + w * 1024); at_dma(ko, kb__ + 128, d__ + AT_K2 + w * 1024); at_dma(vo0, vb__, d__ + AT_V + w * 2048); at_dma(vo0, vb__ + 4 * NPJ * 2, d__ + AT_V + w * 2048 + 1024); } while (0)
    bf16x8 qf[4];
    { const bf16* qsrc = QN + (rowbase + qb * 128 + rg * 32 + r32) * 1024 + hh * 128 + mp * 64 + h * 8;
#pragma unroll
      for (int d0 = 0; d0 < 4; ++d0) qf[d0] = *(const bf16x8*)(qsrc + 16 * d0); }
    f32x16 O[4];
#pragma unroll
    for (int d0 = 0; d0 < 4; ++d0) O[d0] = f32x16{};
    float lsum = 0.f;
    const int G_ = (lane >> 4) & 1, i16 = lane & 15, q_ = i16 >> 2, p_ = i16 & 3;
    const int kofb = mp * AT_K2 + r32 * 128 + ((h ^ ((r32 >> 1) & 1)) << 4) + (((r32 >> 2) & 3) << 5);
    const int vofb = AT_V + (4 * h + q_) * 256 + (q_ << 6) + 32 * G_ + 8 * p_;
#define kof(d0) (kofb ^ ((d0) << 5))
#define vof(d0) (vofb ^ ((d0) << 6))
    asm volatile("s_waitcnt lgkmcnt(0)" ::: "memory"); __builtin_amdgcn_s_barrier(); asm volatile("" ::: "memory");
    AT_TILE_DMA(0, 0);
    asm volatile("s_waitcnt vmcnt(0)" ::: "memory"); __builtin_amdgcn_s_barrier(); asm volatile("" ::: "memory");
#define AT_ITER(t_, SET_, TICK_) do { \
        LAS unsigned char* cur = lds + ((t_) & 1) * AT_BUF; \
        if ((t_) + 1 < S / 64) AT_TILE_DMA((t_) + 1, (((t_) + 1) & 1) * AT_BUF); \
        else { const unsigned d__ = (unsigned)__builtin_amdgcn_readfirstlane((int)(ldsb + AT_DUMMY)); const char* kb__ = uni_ptr(kbase); at_dma(ko, kb__, d__); at_dma(ko, kb__, d__); at_dma(ko, kb__, d__); at_dma(ko, kb__, d__); } \
        int cit_ = cv.it, cst_ = cv.step; conv_next(cit_, cst_, NGW); const ConvSrc csrc_ = conv_src(a, cit_); const unsigned cloff_ = conv_loff(csrc_, lane); (void)cst_; (void)cloff_; \
        _Pragma("unroll") for (int hv = 0; hv < 2; ++hv) { f32x16 pp = f32x16{}; \
            _Pragma("unroll") for (int d0 = 0; d0 < 4; ++d0) { const bf16x8 ka = *(LAS bf16x8*)(cur + kof(d0) + hv * 32 * 128); pp = __builtin_amdgcn_mfma_f32_32x32x16_bf16(ka, qf[d0], pp, 0, 0, 0); } \
            if (TICK_) conv_issue_one(cv.s[(SET_) ^ 1], csrc_, cloff_, cst_, 4 * hv + 0); \
            _Pragma("unroll") for (int r = 0; r < 16; ++r) { pp[r] = __builtin_amdgcn_exp2f(pp[r]); lsum += pp[r]; } \
            if (TICK_) conv_issue_one(cv.s[(SET_) ^ 1], csrc_, cloff_, cst_, 4 * hv + 1); \
            _Pragma("unroll") for (int k2 = 0; k2 < 2; ++k2) { const int o = 8 * k2; \
                v4u t4; t4.x = pk2(pp[o + 0], pp[o + 1]); t4.y = pk2(pp[o + 2], pp[o + 3]); t4.z = pk2(pp[o + 4], pp[o + 5]); t4.w = pk2(pp[o + 6], pp[o + 7]); \
                const bf16x8 pa = __builtin_bit_cast(bf16x8, t4); \
                _Pragma("unroll") for (int d0 = 0; d0 < 4; ++d0) { LAS unsigned char* va = cur + vof(d0) + (32 * hv + 16 * k2) * 256; \
                    const bf16x8 vf = cat8(trr(va), trr(va + 8 * 256)); \
                    O[d0] = __builtin_amdgcn_mfma_f32_32x32x16_bf16(vf, pa, O[d0], 0, 0, 0); } \
                if (TICK_) conv_issue_one(cv.s[(SET_) ^ 1], csrc_, cloff_, cst_, 4 * hv + 2 + k2); } } \
        if (TICK_) { if (conv_consume<12>(cv, cv.s[SET_], a, lds + AT_CV + w * 8448, NGW, lane)) asm volatile("s_waitcnt vmcnt(16) lgkmcnt(0)" ::: "memory"); \
            else asm volatile("s_waitcnt vmcnt(8) lgkmcnt(0)" ::: "memory"); } \
        else asm volatile("s_waitcnt vmcnt(0) lgkmcnt(0)" ::: "memory"); \
        __builtin_amdgcn_s_barrier(); asm volatile("" ::: "memory"); \
    } while (0)
    { const int slot = C.vcu & 3; int pa = 64, pb = 64;
      if ((slot >> 1) == uidx) { pa = 32 * (slot & 1); pb = pa + 32; }
      int t = 0;
      for (; t < pa; t += 2) { AT_ITER(t, 0, true); AT_ITER(t + 1, 1, true); }
      for (; t < pb; t += 2) { AT_ITER(t, 0, false); AT_ITER(t + 1, 1, false); }
      for (; t < S / 64; t += 2) { AT_ITER(t, 0, true); AT_ITER(t + 1, 1, true); } }
#undef AT_ITER
#undef AT_TILE_DMA
#undef kof
#undef vof
    lsum += __shfl_xor(lsum, 32);
    const float inv = 1.f / lsum;
    int le = C.tid & 63; asm volatile("" : "+v"(le));
    LAS float* ex = (LAS float*)lds + rg * 4096;
    if (mp == 1) {
#pragma unroll
        for (int d0 = 0; d0 < 4; ++d0)
#pragma unroll
            for (int r = 0; r < 16; ++r) ex[(d0 * 16 + r) * 64 + le] = O[d0][r] * inv; }
    asm volatile("s_waitcnt lgkmcnt(0)" ::: "memory"); __builtin_amdgcn_s_barrier(); asm volatile("" ::: "memory");
    if (mp == 0) {
        float ss = 0.f; int lb_ = lam_s; asm volatile("" : "+s"(lb_)); const float lamv = __int_as_float(lb_);
#pragma unroll
        for (int d0 = 0; d0 < 4; ++d0)
#pragma unroll
            for (int r = 0; r < 16; ++r) { const float o = O[d0][r] * inv - lamv * ex[(d0 * 16 + r) * 64 + le]; O[d0][r] = o; ss += o * o; }
        ss += __shfl_xor(ss, 32);
        const float rr = rsqrtf(ss * (1.f / 128.f) + EPS) * (1.f - LAM_INIT);
        const size_t tok = (size_t)b * S + qb * 128 + rg * 32 + (le & 31); const int he = le >> 5;
        bf16* odp = (bf16*)(a.ws + WS_OD) + tok * 1024 + hh * 128 + 4 * he;
#pragma unroll
        for (int dh = 0; dh < 2; ++dh) { f32x4 gn[8];
#pragma unroll
            for (int i = 0; i < 8; ++i) gn[i] = *(const f32x4*)(a.in[9] + 32 * (2 * dh + (i >> 2)) + 8 * (i & 3) + 4 * he);
            __builtin_amdgcn_sched_barrier(0);
#pragma unroll
            for (int i = 0; i < 8; ++i) { const int d0 = 2 * dh + (i >> 2), g4 = i & 3, dv0 = 32 * d0 + 8 * g4;
                v2u o; o.x = pk2(O[d0][4 * g4 + 0] * rr * gn[i].x, O[d0][4 * g4 + 1] * rr * gn[i].y); o.y = pk2(O[d0][4 * g4 + 2] * rr * gn[i].z, O[d0][4 * g4 + 3] * rr * gn[i].w);
                *(v2u*)(odp + dv0) = o; } }
    }
}

__device__ __forceinline__ void p8_router(const Ctx& C, const Args& a) {
    const float* x1 = a.out; const float* g2 = a.in[12]; const float* br = a.in[14];
    const bf16* WRH = (const bf16*)(a.ws + WS_WRH); const bf16* WRL = (const bf16*)(a.ws + WS_WRL);
    unsigned char* H2 = a.ws + WS_H2; int* cnt = (int*)(a.ws + WS_CTL) + CW_WGCNT;
    int* TOPE = (int*)(a.ws + WS_RT); int* SLOT = TOPE + T * 4; float* WTS = (float*)(SLOT + T * 4);
    const int lane = C.lane, w = C.wave, r32 = lane & 31, h = lane >> 5;
    constexpr int XP = 4112, XT_BYTES = 32 * XP;
    LAS unsigned char* XT = C.lds;
    LAS float* PLG = (LAS float*)C.lds;
    LAS float* SSQ = (LAS float*)(C.lds + XT_BYTES);
    LAS float* LG = (LAS float*)(C.lds + XT_BYTES + 1024);
    LAS float* RSTD = (LAS float*)(C.lds + XT_BYTES + 1024 + 32 * 33 * 4);
    LAS int* lcnt = (LAS int*)(C.lds + XT_BYTES + 1024 + 32 * 33 * 4 + 128);
    static_assert(XT_BYTES + 1024 + 32 * 33 * 4 + 256 <= MISC_OFF, "router LDS");
    if (C.tid < NE) lcnt[C.tid] = 0;
    for (int m0 = C.vcu * 32; m0 < T; m0 += C.G * 32) {
        __syncthreads();
        f32x16 acc = f32x16{}; float ssq = 0.f;
        const float* xrow = x1 + (size_t)(m0 + r32) * D + 256 * w + 4 * h;
        const bf16* whp = WRH + (size_t)(w * 16 * 64 + lane) * 8; const bf16* wlp = WRL + (size_t)(w * 16 * 64 + lane) * 8;
        LAS unsigned char* xt = XT + r32 * XP + (256 * w + 4 * h) * 2;
#pragma unroll
        for (int hb = 0; hb < 2; ++hb) {
            f32x4 xa[8], xb[8]; bf16x8 wh[8], wl[8];
#pragma unroll
            for (int s8 = 0; s8 < 8; ++s8) { const int s = 8 * hb + s8; xa[s8] = *(const f32x4*)(xrow + 16 * s); xb[s8] = *(const f32x4*)(xrow + 16 * s + 8);
                wh[s8] = *(const bf16x8*)(whp + 512 * s); wl[s8] = *(const bf16x8*)(wlp + 512 * s); }
            __builtin_amdgcn_sched_barrier(0);
#pragma unroll
            for (int s8 = 0; s8 < 8; ++s8) { const int s = 8 * hb + s8;
                ssq += (xa[s8].x * xa[s8].x + xa[s8].y * xa[s8].y) + (xa[s8].z * xa[s8].z + xa[s8].w * xa[s8].w) + (xb[s8].x * xb[s8].x + xb[s8].y * xb[s8].y) + (xb[s8].z * xb[s8].z + xb[s8].w * xb[s8].w);
                const float hv[8] = {xa[s8].x, xa[s8].y, xa[s8].z, xa[s8].w, xb[s8].x, xb[s8].y, xb[s8].z, xb[s8].w};
                v4u hi4, lo4;
#pragma unroll
                for (int i = 0; i < 4; ++i) { const unsigned hp = pk2(hv[2 * i], hv[2 * i + 1]); ((unsigned*)&hi4)[i] = hp; ((unsigned*)&lo4)[i] = pk2(hv[2 * i] - bflo(hp), hv[2 * i + 1] - bfhi(hp)); }
                { v2u t0; t0.x = hi4.x; t0.y = hi4.y; v2u t1; t1.x = hi4.z; t1.y = hi4.w; *(LAS v2u*)(xt + 32 * s) = t0; *(LAS v2u*)(xt + 32 * s + 16) = t1; }
                const bf16x8 hh = __builtin_bit_cast(bf16x8, hi4), hl = __builtin_bit_cast(bf16x8, lo4);
                acc = __builtin_amdgcn_mfma_f32_32x32x16_bf16(wh[s8], hh, acc, 0, 0, 0);
                acc = __builtin_amdgcn_mfma_f32_32x32x16_bf16(wh[s8], hl, acc, 0, 0, 0);
                acc = __builtin_amdgcn_mfma_f32_32x32x16_bf16(wl[s8], hh, acc, 0, 0, 0); }
            __builtin_amdgcn_sched_barrier(0);
        }
        ssq += __shfl_xor(ssq, 32);
        if (h == 0) SSQ[w * 32 + r32] = ssq;
        __syncthreads();
        if (C.tid < 32) { float s = 0.f;
#pragma unroll
            for (int ww = 0; ww < 8; ++ww) s += SSQ[ww * 32 + C.tid];
            RSTD[C.tid] = rsqrtf(s * (1.f / D) + EPS); }
        __syncthreads();
        f32x4 gq[8];
#pragma unroll
        for (int j = 0; j < 8; ++j) gq[j] = *((const f32x4*)g2 + lane + 64 * j);
#pragma unroll
        for (int it = 0; it < 4; ++it) { const int t = 4 * w + it, m = m0 + t; const float rs = RSTD[t];
#pragma unroll
            for (int j = 0; j < 8; ++j) { const v2u q = *(const LAS v2u*)(XT + t * XP + (lane + 64 * j) * 8);
                int o = 0; o = __builtin_amdgcn_cvt_pk_fp8_f32(bflo(q.x) * rs * gq[j].x, bfhi(q.x) * rs * gq[j].y, o, false); o = __builtin_amdgcn_cvt_pk_fp8_f32(bflo(q.y) * rs * gq[j].z, bfhi(q.y) * rs * gq[j].w, o, true);
                *((int*)(H2 + (size_t)m * D) + lane + 64 * j) = o; } }
        __syncthreads();
#pragma unroll
        for (int r = 0; r < 16; ++r) PLG[(w * 16 + r) * 64 + lane] = acc[r];
        __syncthreads();
#pragma unroll
        for (int q = 0; q < 2; ++q) { const int idx = C.tid + 512 * q, r = idx >> 6, l = idx & 63; float s = 0.f;
#pragma unroll
            for (int ww = 0; ww < 8; ++ww) s += PLG[(ww * 16 + r) * 64 + l];
            const int e = (r & 3) + 8 * (r >> 2) + 4 * (l >> 5), t = l & 31;
            LG[t * 33 + e] = s * RSTD[t] + br[e]; }
        __syncthreads();
#pragma unroll
        for (int ps = 0; ps < 2; ++ps) { const int t = 4 * w + 2 * ps + h, m = m0 + t; float v = LG[t * 33 + r32]; float tv[4]; int ti[4];
#pragma unroll
            for (int k = 0; k < 4; ++k) { float best = v;
#pragma unroll
                for (int o = 1; o < 32; o <<= 1) best = fmaxf(best, __shfl_xor(best, o));
                const unsigned long long bm = __ballot(v == best); const unsigned hm = h ? (unsigned)(bm >> 32) : (unsigned)bm; const int bi = __builtin_ctz(hm);
                tv[k] = best; ti[k] = bi; v = (r32 == bi) ? -INFINITY : v; }
            const float e1 = __expf(tv[1] - tv[0]), e2 = __expf(tv[2] - tv[0]), e3 = __expf(tv[3] - tv[0]); const float inv = 1.f / (1.f + e1 + e2 + e3);
            if (r32 < 4) { const int k = r32; const int tk = k == 0 ? ti[0] : k == 1 ? ti[1] : k == 2 ? ti[2] : ti[3]; const float wk = (k == 0 ? 1.f : k == 1 ? e1 : k == 2 ? e2 : e3) * inv;
                TOPE[m * 4 + k] = tk; SLOT[m * 4 + k] = __hip_atomic_fetch_add(lcnt + tk, 1, __ATOMIC_RELAXED, __HIP_MEMORY_SCOPE_WORKGROUP); WTS[m * 4 + k] = wk; } }
    }
    __syncthreads();
    if (C.tid < NE) cnt[C.vcu * NE + C.tid] = lcnt[C.tid];
}
__device__ __forceinline__ void p9_gather(const Ctx& C, const Args& a) {
    const unsigned char* H2 = a.ws + WS_H2; const int* wgcnt = (const int*)(a.ws + WS_CTL) + CW_WGCNT; int* cnt = (int*)(a.ws + WS_CTL) + CW_CNT;
    const int* TOPE = (const int*)(a.ws + WS_RT); const int* SLOT = TOPE + T * 4; int* DEST = (int*)(a.ws + WS_RT) + 3 * T * 4; unsigned char* XG = a.ws + WS_XG;
    const int gw = C.vcu * NWAVES + C.wave, NGW = C.G * NWAVES, lane = C.lane;
    int mycnt = 0, mybase = 0;
    if (C.G == 256) {
        LAS int* ps = (LAS int*)C.lds; int v[32], tot = 0, bas = 0;
#pragma unroll
        for (int i = 0; i < 32; ++i) v[i] = wgcnt[(32 * C.wave + i) * NE + (lane & 31)];
#pragma unroll
        for (int i = 0; i < 32; ++i) { tot += v[i]; bas += (32 * C.wave + i < C.vcu) ? v[i] : 0; }
        __syncthreads();
        if (lane < NE) { ps[(C.wave * 2 + 0) * 32 + lane] = tot; ps[(C.wave * 2 + 1) * 32 + lane] = bas; }
        __syncthreads();
#pragma unroll
        for (int w8 = 0; w8 < 8; ++w8) { mycnt += ps[(w8 * 2 + 0) * 32 + (lane & 31)]; mybase += ps[(w8 * 2 + 1) * 32 + (lane & 31)]; }
    } else {
#pragma unroll 8
    for (int w = 0; w < C.G; ++w) { const int v = wgcnt[w * NE + (lane & 31)]; mycnt += v; mybase += (w < C.vcu) ? v : 0; }
    }
    if (lane >= NE) { mycnt = 0; mybase = 0; }
    int tiles = (mycnt + PADM - 1) / PADM, inc = tiles;
#pragma unroll
    for (int o = 1; o < 32; o <<= 1) { const int t = __shfl_up(inc, o); if (lane >= o) inc += t; }
    const int startrow = (inc - tiles) * PADM;
    if (gw == 0 && lane < NE) cnt[lane] = mycnt;
    for (int m0 = C.vcu * 32; m0 < T; m0 += C.G * 32) {
        const int t0 = m0 + 4 * C.wave, qi = t0 * 4 + (lane & 15);
        const int te = TOPE[qi], ts = SLOT[qi];
        v4u s0[4], s1[4];
#pragma unroll
        for (int it = 0; it < 4; ++it) { const v4u* src = (const v4u*)(H2 + (size_t)(t0 + it) * D) + lane; s0[it] = src[0]; s1[it] = src[64]; }
        const int rowl = __shfl(startrow, te) + __shfl(mybase, te) + ts;
        if (lane < 16) DEST[qi] = rowl;
#pragma unroll
        for (int i = 0; i < 16; ++i) { const int row = __shfl(rowl, i); v4u* dst = (v4u*)(XG + (size_t)row * D) + lane; dst[0] = s0[i >> 2]; dst[64] = s1[i >> 2]; } }
    for (int p = gw; p < NE * PADM; p += NGW) { const int e = p / PADM, qq = p % PADM; const int c = __shfl(mycnt, e), st = __shfl(startrow, e), tl = __shfl(tiles, e);
        if (c + qq < tl * PADM) { v4u* dst = (v4u*)(XG + (size_t)(st + c + qq) * D) + lane; const v4u z = {0u, 0u, 0u, 0u}; dst[0] = z; dst[64] = z; } }
}
__device__ __forceinline__ void p12_combine(const Ctx& C, const Args& a) {
    const bf16* Y = (const bf16*)(a.ws + WS_Y); const float* WTS = (const float*)(a.ws + WS_RT) + 2 * T * 4; const int* DEST = (const int*)(a.ws + WS_RT) + 3 * T * 4; float* out = a.out;
    const int gw = C.vcu * NWAVES + C.wave, NGW = C.G * NWAVES, lane = C.lane;
    int dn[4]; float wn[4];
    if (gw < T) {
#pragma unroll
        for (int k = 0; k < 4; ++k) { dn[k] = DEST[gw * 4 + k]; wn[k] = WTS[gw * 4 + k]; } }
    for (int m = gw; m < T; m += NGW) { int d[4]; float wv[4];
#pragma unroll
        for (int k = 0; k < 4; ++k) { d[k] = dn[k]; wv[k] = wn[k]; }
        f32x4 o[8]; int y[4][8];
#pragma unroll
        for (int j = 0; j < 8; ++j) { o[j] = *((const f32x4*)(out + (size_t)m * D) + lane + 64 * j);
#pragma unroll
            for (int k = 0; k < 4; ++k) y[k][j] = *((const int*)((const unsigned char*)Y + (size_t)d[k] * D) + lane + 64 * j); }
        if (m + NGW < T) {
#pragma unroll
            for (int k = 0; k < 4; ++k) { dn[k] = DEST[(m + NGW) * 4 + k]; wn[k] = WTS[(m + NGW) * 4 + k]; } }
        __builtin_amdgcn_sched_barrier(0);
#pragma unroll
        for (int j = 0; j < 8; ++j) {
#pragma unroll
            for (int k = 0; k < 4; ++k) { const int yy = y[k][j];
                o[j].x += wv[k] * __builtin_amdgcn_cvt_f32_fp8(yy, 0); o[j].y += wv[k] * __builtin_amdgcn_cvt_f32_fp8(yy, 1); o[j].z += wv[k] * __builtin_amdgcn_cvt_f32_fp8(yy, 2); o[j].w += wv[k] * __builtin_amdgcn_cvt_f32_fp8(yy, 3); }
            *((f32x4*)(out + (size_t)m * D) + lane + 64 * j) = o[j]; }
        __builtin_amdgcn_sched_barrier(0);
    }
}

constexpr int N_PHASES = 14;
__global__ void __launch_bounds__(NTHR, 2) mega_fwd(Args args) {
    extern __shared__ __attribute__((aligned(16))) unsigned char lds_raw[];
    Ctx C; C.lds = (LAS unsigned char*)lds_raw; C.tid = threadIdx.x; C.lane = C.tid & 63; C.wave = __builtin_amdgcn_readfirstlane(C.tid >> 6);
    C.G = gridDim.x; { const int bx = blockIdx.x; C.vcu = (C.G % 8 == 0) ? (bx % 8) * (C.G / 8) + bx / 8 : bx; }
    volatile LAS unsigned* MISC = (volatile LAS unsigned*)(C.lds + MISC_OFF);
    if (C.tid < 32) MISC[C.tid] = 0u;
    __syncthreads();
    unsigned* ctl = (unsigned*)(args.ws + WS_CTL);
    XcdBarrier bar = xcd_barrier_post(ctl + CW_BAR, MISC + 8);
    const int lo = args.ph_lo, hi = args.ph_hi;
#ifndef ONLY_MASK
#define ONLY_MASK 0xFFFF
#endif
#define IN(k) (((ONLY_MASK >> (k)) & 1) && lo <= (k) && (k) < hi)
#ifndef DBL_MASK
#define DBL_MASK 0
#endif
#define REP(k) for (int rep_ = 0; rep_ < (((DBL_MASK >> (k)) & 1) ? 2 : 1); ++rep_, (((DBL_MASK >> (k)) & 1) && rep_ == 1 ? xcd_barrier(bar) : (void)0))
#define SEAM(k) do { if (IN(k) && IN((k) + 1)) xcd_barrier(bar); } while (0)
    if (IN(0)) REP(0) { p0_transposes(C, args); p0_rope(C, args); p0_router_w(C, args); p0_xn_gates(C, args); }
    SEAM(0);
    if (IN(1)) REP(1) { p2_mstats(C, args);
        { pg8::Gemm g{(const bf16*)(args.ws + WS_XN), (const bf16*)(args.ws + WS_WIN), T, 6144, D}; pg8::StaticOrder So; So.init(T, 6144, C.G, (int)blockIdx.x);
          EpiProj<false> E{(bf16*)(args.ws + WS_PROJ), nullptr}; pg8::gemm_phase<EpiProj<false>, pg8::StaticOrder, true, true>(C.lds, g, So, E); }
        __syncthreads();
        { pg8::Gemm g{(const bf16*)(args.ws + WS_XN8), (const bf16*)(args.ws + WS_WIN8), T, 4096, D / 2}; pg8::StaticOrder So; So.init(T, 4096, C.G, (int)blockIdx.x);
          EpiProj<true> E{(bf16*)(args.ws + WS_PROJ), args.ws + WS_G8}; pg8::gemm_phase<EpiProj<true>, pg8::StaticOrder, true, true, true>(C.lds, g, So, E); } }
    SEAM(1);
    if (IN(2)) REP(2) { p2_late_transposes(C, args); p2_qkprep(C, args); }
    if (!(IN(2) && IN(3))) SEAM(2);
    if (IN(3)) REP(3) { for (int u = C.vcu; u < 512; u += C.G) mlA_unit(C, u, args); }
    SEAM(3);
    if (IN(4)) REP(4) { mlB_scan(C, args); }
    SEAM(4);
    if (IN(5)) REP(5) { for (int u = C.vcu; u < 512; u += C.G) mlC_unit(C, u, args); }
    if (IN(6)) REP(6) {
        const float* lp = args.in[8]; const float sa = wave_sum(lp[C.lane] * lp[64 + C.lane]), sb = wave_sum(lp[128 + C.lane] * lp[192 + C.lane]);
        const float lam = __expf(sa) - __expf(sb) + LAM_INIT;
        Conv cv; conv_begin(cv, args, C.vcu * NWAVES + C.wave, C.G * NWAVES, C.lane);
        int lam_s = __builtin_amdgcn_readfirstlane(__float_as_int(lam)); asm volatile("" : "+s"(lam_s));
        { int uidx = 0; for (int u = C.vcu; u < 512; u += C.G, ++uidx) attn_unit(C, u, uidx, args, lam_s, cv); }
        asm volatile("s_waitcnt lgkmcnt(0)" ::: "memory"); __builtin_amdgcn_s_barrier(); asm volatile("" ::: "memory");
        while (cv.it < CV_NJ) { conv_issue_next(cv, cv.s[1], args, C.G * NWAVES, C.lane); (void)conv_consume<8>(cv, cv.s[0], args, C.lds + AT_CV + C.wave * 8448, C.G * NWAVES, C.lane);
            conv_issue_next(cv, cv.s[0], args, C.G * NWAVES, C.lane); (void)conv_consume<8>(cv, cv.s[1], args, C.lds + AT_CV + C.wave * 8448, C.G * NWAVES, C.lane); }
        asm volatile("s_waitcnt vmcnt(0)" ::: "memory");
    }
    SEAM(6);
    if (IN(7)) REP(7) { __syncthreads();
        pg8::StaticOrder So; So.init(T, D, C.G, (int)blockIdx.x);
        if (So.nwg % C.G == 0) {
            static_assert(WS_OD - WS_HM == (size_t)T * MLW * 2 && WS_WDA - WS_WML == (size_t)D * MLW * 2 && MLW == DAW, "pair stream: operands of the two products must be adjacent");
            pg8::Gemm g{(const bf16*)(args.ws + WS_HM), (const bf16*)(args.ws + WS_WML), 2 * T, D, MLW}; PairOrder Po{So};
            EpiGatePair E{(const bf16*)(args.ws + WS_G8), (bf16*)(args.ws + WS_T1), (bf16*)(args.ws + WS_MIX)}; pg8::gemm_phase<EpiGatePair, PairOrder, true, true>(C.lds, g, Po, E);
        } else {
        { pg8::Gemm g{(const bf16*)(args.ws + WS_HM), (const bf16*)(args.ws + WS_WML), T, D, MLW};
          EpiGate<0> E{(const bf16*)(args.ws + WS_G8), nullptr, (bf16*)(args.ws + WS_T1)}; pg8::gemm_phase<EpiGate<0>, pg8::StaticOrder, true, true>(C.lds, g, So, E); }
        __syncthreads();
        { pg8::Gemm g{(const bf16*)(args.ws + WS_OD), (const bf16*)(args.ws + WS_WDA), T, D, DAW};
          EpiGate<1> E{(const bf16*)(args.ws + WS_G8), (const bf16*)(args.ws + WS_T1), (bf16*)(args.ws + WS_MIX)}; pg8::gemm_phase<EpiGate<1>, pg8::StaticOrder, true, true>(C.lds, g, So, E); }
        }
    }
    SEAM(7);
    if (IN(8)) REP(8) { pg8::Gemm g{(const bf16*)(args.ws + WS_MIX), (const bf16*)(args.ws + WS_WO), T, D, D}; pg8::StaticOrder So; So.init(T, D, C.G, (int)blockIdx.x);
        EpiRes E{args.in[0], args.out}; pg8::gemm_phase<EpiRes, pg8::StaticOrder, true, true>(C.lds, g, So, E); }
    SEAM(8);
    if (IN(9)) REP(9) { p8_router(C, args); }
    SEAM(9);
    if (IN(10)) REP(10) { p9_gather(C, args); }
    SEAM(10);
    if (IN(11)) REP(11) { MoeSched Ms; Ms.init((const int*)(args.ws + WS_CTL) + CW_CNT, 16, C.G, (int)blockIdx.x, C.lane);
        pg8::Gemm g{(const bf16*)(args.ws + WS_XG), (const bf16*)(args.ws + WS_WGU), MAXROWS, 2 * DE, D / 2};
        EpiAct E{args.in[16], args.ws + WS_ACT}; pg8::gemm_phase<EpiAct, MoeSched, true, true, true>(C.lds, g, Ms, E); }
    SEAM(11);
    if (IN(12)) REP(12) { MoeSched Ms; Ms.init((const int*)(args.ws + WS_CTL) + CW_CNT, 8, C.G, (int)blockIdx.x, C.lane);
        pg8::Gemm g{(const bf16*)(args.ws + WS_ACT), (const bf16*)(args.ws + WS_WDN), MAXROWS, D, DE / 2};
        EpiY E{args.in[18], (bf16*)(args.ws + WS_Y)}; pg8::gemm_phase<EpiY, MoeSched, true, true, true>(C.lds, g, Ms, E); }
    SEAM(12);
    if (IN(13)) REP(13) { p12_combine(C, args); }
#undef IN
#undef SEAM
}
#ifdef DEV_NAIVE
constexpr size_t NV_XN32 = WS_NAIVE, NV_PROJ32 = NV_XN32 + 64 * MiB, NV_F = NV_PROJ32 + 322 * MiB, NV_HF = NV_F + 1 * MiB, NV_OD32 = NV_HF + 64 * MiB, NV_MIX32 = NV_OD32 + 32 * MiB, NV_END = NV_MIX32 + 64 * MiB;
__device__ __forceinline__ float ldf(const float* p) { return *p; }
__device__ __forceinline__ float ldf(const bf16* p) { return bf2f(*p); }
__global__ __launch_bounds__(256) void k_rmsnorm(const float* __restrict__ x, const float* __restrict__ g, float* __restrict__ y) {
    const int row = blockIdx.x * 4 + (threadIdx.x >> 6), lane = threadIdx.x & 63;
    const float* xr = x + (size_t)row * D; float v[32]; float s = 0.f;
#pragma unroll
    for (int j = 0; j < 32; ++j) { v[j] = xr[lane + 64 * j]; s += v[j] * v[j]; }
    s = wave_sum(s); const float r = rsqrtf(s * (1.f / D) + EPS);
#pragma unroll
    for (int j = 0; j < 32; ++j) y[(size_t)row * D + lane + 64 * j] = v[j] * r * g[lane + 64 * j];
}
struct GArgs { const void* A; const float* B; void* C; int M, N, K, lda, ldb, ldc; const void* aux0; const void* aux1; const int* cnt; };
template <int EPI, typename TA> __global__ __launch_bounds__(256) void k_gemm(GArgs g) {
    __shared__ float As[16][64 + 4], Bs[16][64 + 4];
    const int tx = threadIdx.x & 15, ty = threadIdx.x >> 4;
    int m0 = blockIdx.y * 64, n0 = blockIdx.x * 64;
    const TA* A = (const TA*)g.A; const float* Bp = g.B; int M = g.M; int rowbase = 0; int e = 0;
    if (EPI == 4 || EPI == 5) {
        e = blockIdx.z; int start = 0;
        for (int i = 0; i < e; ++i) start += (g.cnt[i] + PADM - 1) / PADM * PADM;
        const int c = g.cnt[e]; if (m0 >= c) return;
        M = (c + PADM - 1) / PADM * PADM; rowbase = start;
        A = (const TA*)g.A + (size_t)rowbase * g.lda; Bp = g.B + (size_t)e * g.K * g.ldb;
    }
    float acc[4][4] = {};
    for (int k0 = 0; k0 < g.K; k0 += 16) {
        for (int i = threadIdx.x; i < 64 * 16; i += 256) { const int mm = i >> 4, kk = i & 15; const int m = m0 + mm; As[kk][mm] = (m < M) ? ldf(A + (size_t)m * g.lda + k0 + kk) : 0.f; }
        for (int i = threadIdx.x; i < 16 * 64; i += 256) { const int kk = i >> 6, nn = i & 63; const int n = n0 + nn; Bs[kk][nn] = (n < g.N) ? Bp[(size_t)(k0 + kk) * g.ldb + n] : 0.f; }
        __syncthreads();
#pragma unroll
        for (int kk = 0; kk < 16; ++kk) {
            float a[4], b[4];
#pragma unroll
            for (int i = 0; i < 4; ++i) { a[i] = As[kk][ty * 4 + i]; b[i] = Bs[kk][tx * 4 + i]; }
#pragma unroll
            for (int i = 0; i < 4; ++i)
#pragma unroll
                for (int j = 0; j < 4; ++j) acc[i][j] += a[i] * b[j];
        }
        __syncthreads();
    }
#pragma unroll
    for (int i = 0; i < 4; ++i) {
        const int m = m0 + ty * 4 + i; if (m >= M) continue;
        if (EPI == 4) {
            const float* bias = (const float*)g.aux0 + (size_t)e * g.N;
#pragma unroll
            for (int j = 0; j < 4; j += 2) {
                const int n = n0 + tx * 4 + j;
                float glu = acc[i][j] + bias[n], lin = acc[i][j + 1] + bias[n + 1];
                glu = fminf(glu, 7.f); lin = fminf(fmaxf(lin, -7.f), 7.f);
                ((bf16*)g.C)[(size_t)(rowbase + m) * g.ldc + (n >> 1)] = f2bf(glu * sigmoidf_(1.702f * glu) * (lin + 1.f));
            }
        } else {
#pragma unroll
            for (int j = 0; j < 4; ++j) {
                const int n = n0 + tx * 4 + j; if (n >= g.N) continue;
                const float v = acc[i][j];
                if (EPI == 0) ((float*)g.C)[(size_t)m * g.ldc + n] = v;
                if (EPI == 1) ((float*)g.C)[(size_t)m * g.ldc + n] = bf2f(((const bf16*)g.aux0)[(size_t)m * NPJ + P_GM + n]) * v;
                if (EPI == 2) ((float*)g.C)[(size_t)m * g.ldc + n] += bf2f(((const bf16*)g.aux0)[(size_t)m * NPJ + P_GD + n]) * v;
                if (EPI == 3) ((float*)g.C)[(size_t)m * g.ldc + n] = ((const float*)g.aux0)[(size_t)m * g.ldc + n] + v;
                if (EPI == 5) ((bf16*)g.C)[(size_t)(rowbase + m) * g.ldc + n] = f2bf(v + ((const float*)g.aux0)[(size_t)e * g.N + n]);
            }
        }
    }
}
__global__ __launch_bounds__(256) void k_pack(const float* __restrict__ P32, const float* __restrict__ gbias, bf16* __restrict__ PROJ, float* __restrict__ MG) {
    const int t = blockIdx.x;
    for (int c = threadIdx.x; c < NPJ; c += 256) { const int src = c < G_OFF ? c : c + 16; float v = P32[(size_t)t * DIN + src];
        if (c >= P_MK && c < P_MV) v *= KSCALE;
        if ((c >= P_MO && c < P_DQ) || c >= P_GM) v = sigmoidf_(v);
        PROJ[(size_t)t * NPJ + c] = f2bf(v); }
    if (threadIdx.x < 16) MG[(size_t)t * 16 + threadIdx.x] = P32[(size_t)t * DIN + G_OFF + threadIdx.x] + gbias[threadIdx.x];
}
__global__ __launch_bounds__(256) void k_rope(float* __restrict__ ROPE) {
    const int g = blockIdx.x * 256 + threadIdx.x; const int pos = g >> 5, i = g & 31;
    const double inv = exp2(-(double)i * (13.287712379549449 / 32.0));
    const float ang = (float)pos * (float)inv;
    ROPE[2 * g] = cosf(ang); ROPE[2 * g + 1] = sinf(ang);
}
__global__ __launch_bounds__(256) void k_qkprep(const bf16* __restrict__ PROJ, const float* __restrict__ ROPE, const float* __restrict__ qg, const float* __restrict__ kg, bf16* __restrict__ QN, bf16* __restrict__ KN) {
    const int t = blockIdx.x * 4 + (threadIdx.x >> 6), lane = threadIdx.x & 63;
    const int pos = t % S, g = lane >> 2, sub = lane & 3;
    for (int which = 0; which < 2; ++which) {
        const bf16* src = PROJ + (size_t)t * NPJ + (which ? P_DK : P_DQ) + g * 64;
        const float* gn = which ? kg : qg; bf16* dst = (which ? KN : QN) + (size_t)t * 1024 + g * 64;
        float x1[8], x2[8]; float ss = 0.f;
#pragma unroll
        for (int i = 0; i < 8; ++i) { x1[i] = bf2f(src[sub * 8 + i]); x2[i] = bf2f(src[32 + sub * 8 + i]); ss += x1[i] * x1[i] + x2[i] * x2[i]; }
        ss += __shfl_xor(ss, 1); ss += __shfl_xor(ss, 2);
        const float r = rsqrtf(ss * (1.f / 64.f) + EPS) * (which ? 1.f : QSCALE);
#pragma unroll
        for (int i = 0; i < 8; ++i) {
            const int fi = sub * 8 + i; const float c = ROPE[((size_t)pos * 32 + fi) * 2], s = ROPE[((size_t)pos * 32 + fi) * 2 + 1];
            const float a = x1[i] * r * gn[fi], b = x2[i] * r * gn[32 + fi];
            dst[fi] = f2bf(a * c - b * s); dst[32 + fi] = f2bf(b * c + a * s);
        }
    }
}
__global__ void k_mlF(const float* __restrict__ MG, float* __restrict__ F) {
    const int chain = threadIdx.x; if (chain >= 16) return;
    const int dir = chain & 1, h = (chain >> 1) & 3, b = chain >> 3;
    const int col = (dir ? 12 : 4) + h; float acc = 0.f;
    if (!dir) { for (int p = 0; p < S; ++p) { acc += logsigf_(MG[(size_t)(b * S + p) * 16 + col]); F[chain * S + p] = acc; } }
    else      { for (int p = S - 1; p >= 0; --p) { acc += logsigf_(MG[(size_t)(b * S + p) * 16 + col]); F[chain * S + p] = acc; } }
}
__global__ __launch_bounds__(256) void k_mlquad(const bf16* __restrict__ PROJ, const float* __restrict__ MG, const float* __restrict__ F, float* __restrict__ HF) {
    __shared__ float qs[16][128 + 1], ks[64][128 + 1], sc[16][64 + 1], rs[16];
    const int chain = blockIdx.y, dir = chain & 1, h = (chain >> 1) & 3, b = chain >> 3;
    const int t0 = blockIdx.x * 16, tid = threadIdx.x; const int icol = (dir ? 8 : 0) + h;
    for (int i = tid; i < 16 * 128; i += 256) { const int tt = i >> 7, kk = i & 127; qs[tt][kk] = bf2f(PROJ[(size_t)(b * S + t0 + tt) * NPJ + P_MQ + h * 128 + kk]); }
    float acc[16];
#pragma unroll
    for (int i = 0; i < 16; ++i) acc[i] = 0.f;
    if (tid < 16) rs[tid] = 0.f;
    const int sbeg = dir ? (t0 / 64) * 64 : 0, send = dir ? S : (t0 + 16 + 63) / 64 * 64;
    for (int s0 = sbeg; s0 < send; s0 += 64) {
        __syncthreads();
        for (int i = tid; i < 64 * 128; i += 256) { const int ss = i >> 7, kk = i & 127; ks[ss][kk] = bf2f(PROJ[(size_t)(b * S + s0 + ss) * NPJ + P_MK + h * 128 + kk]); }
        __syncthreads();
        for (int i = tid; i < 1024; i += 256) {
            const int tt = i >> 6, ss = i & 63; const int t = t0 + tt, s = s0 + ss; float v = 0.f;
            const bool ok = dir ? (s >= t) : (s <= t);
            if (ok) { float d = 0.f; for (int kk = 0; kk < 128; ++kk) d += qs[tt][kk] * ks[ss][kk];
                v = d * __expf(F[chain * S + t] - F[chain * S + s] + MG[(size_t)(b * S + s) * 16 + icol]); }
            sc[tt][ss] = v;
        }
        __syncthreads();
        if (tid < 16) { float r = 0.f; for (int ss = 0; ss < 64; ++ss) r += sc[tid][ss]; rs[tid] += r; }
        for (int ss = 0; ss < 64; ++ss) { const float vv = bf2f(PROJ[(size_t)(b * S + s0 + ss) * NPJ + P_MV + h * 256 + tid]);
#pragma unroll
            for (int tt = 0; tt < 16; ++tt) acc[tt] += sc[tt][ss] * vv; }
    }
    __syncthreads();
#pragma unroll
    for (int tt = 0; tt < 16; ++tt) HF[((size_t)dir * T + (b * S + t0 + tt)) * 1024 + h * 256 + tid] = acc[tt] / fmaxf(fabsf(rs[tt]), 1.f);
}
__global__ __launch_bounds__(256) void k_mlpost(const float* __restrict__ HF, const bf16* __restrict__ PROJ, const float* __restrict__ g, bf16* __restrict__ HM) {
    const int w = blockIdx.x * 4 + (threadIdx.x >> 6), lane = threadIdx.x & 63; const int t = w >> 2, h = w & 3;
    float v[4]; float ss = 0.f;
#pragma unroll
    for (int j = 0; j < 4; ++j) { const int c = h * 256 + lane + 64 * j; v[j] = HF[(size_t)t * 1024 + c] + HF[((size_t)T + t) * 1024 + c]; ss += v[j] * v[j]; }
    ss = wave_sum(ss); const float r = rsqrtf(ss * (1.f / 256.f) + EPS);
#pragma unroll
    for (int j = 0; j < 4; ++j) { const int c = h * 256 + lane + 64 * j; HM[(size_t)t * 1024 + c] = f2bf(v[j] * r * g[lane + 64 * j] * bf2f(PROJ[(size_t)t * NPJ + P_MO + c])); }
}
__global__ __launch_bounds__(256) void k_attn(const bf16* __restrict__ QN, const bf16* __restrict__ KN, const bf16* __restrict__ PROJ, const float* __restrict__ lamp, float* __restrict__ OD32) {
    __shared__ float qs[2][16][64 + 1], ks[2][64][64 + 1], sc[2][16][64 + 1], ls[2][16];
    const int bh = blockIdx.y, b = bh >> 3, h = bh & 7, t0 = blockIdx.x * 16, tid = threadIdx.x;
    const int v = tid & 127, mp = tid >> 7;
    for (int i = tid; i < 2 * 16 * 64; i += 256) { const int m = i >> 10, tt = (i >> 6) & 15, dd = i & 63; qs[m][tt][dd] = bf2f(QN[(size_t)(b * S + t0 + tt) * 1024 + h * 128 + m * 64 + dd]); }
    if (tid < 32) ls[tid >> 4][tid & 15] = 0.f;
    float acc[16];
#pragma unroll
    for (int i = 0; i < 16; ++i) acc[i] = 0.f;
    for (int s0 = 0; s0 < S; s0 += 64) {
        __syncthreads();
        for (int i = tid; i < 2 * 64 * 64; i += 256) { const int m = i >> 12, ss = (i >> 6) & 63, dd = i & 63; ks[m][ss][dd] = bf2f(KN[(size_t)(b * S + s0 + ss) * 1024 + h * 128 + m * 64 + dd]); }
        __syncthreads();
        for (int i = tid; i < 2 * 16 * 64; i += 256) { const int m = i >> 10, tt = (i >> 6) & 15, ss = i & 63; float d = 0.f;
            for (int dd = 0; dd < 64; ++dd) d += qs[m][tt][dd] * ks[m][ss][dd];
            sc[m][tt][ss] = exp2f(d); }
        __syncthreads();
        if (tid < 32) { const int m = tid >> 4, tt = tid & 15; float r = 0.f; for (int ss = 0; ss < 64; ++ss) r += sc[m][tt][ss]; ls[m][tt] += r; }
        for (int ss = 0; ss < 64; ++ss) { const float vv = bf2f(PROJ[(size_t)(b * S + s0 + ss) * NPJ + P_DV + h * 128 + v]);
#pragma unroll
            for (int tt = 0; tt < 16; ++tt) acc[tt] += sc[mp][tt][ss] * vv; }
    }
    __syncthreads();
    float s01 = 0.f, s23 = 0.f;
    for (int i = 0; i < 64; ++i) { s01 += lamp[i] * lamp[64 + i]; s23 += lamp[128 + i] * lamp[192 + i]; }
    const float lam = __expf(s01) - __expf(s23) + LAM_INIT;
    float* ob = &ks[0][0][0];
    if (mp == 1) { for (int tt = 0; tt < 16; ++tt) ob[tt * 128 + v] = acc[tt] / ls[1][tt]; }
    __syncthreads();
    if (mp == 0) { for (int tt = 0; tt < 16; ++tt) OD32[(size_t)(b * S + t0 + tt) * 1024 + h * 128 + v] = acc[tt] / ls[0][tt] - lam * ob[tt * 128 + v]; }
}
__global__ __launch_bounds__(256) void k_dapost(const float* __restrict__ OD32, const float* __restrict__ g, bf16* __restrict__ OD) {
    const int w = blockIdx.x * 4 + (threadIdx.x >> 6), lane = threadIdx.x & 63; const int t = w >> 3, h = w & 7;
    float v[2]; float ss = 0.f;
#pragma unroll
    for (int j = 0; j < 2; ++j) { v[j] = OD32[(size_t)t * 1024 + h * 128 + lane + 64 * j]; ss += v[j] * v[j]; }
    ss = wave_sum(ss); const float r = rsqrtf(ss * (1.f / 128.f) + EPS);
#pragma unroll
    for (int j = 0; j < 2; ++j) OD[(size_t)t * 1024 + h * 128 + lane + 64 * j] = f2bf(v[j] * r * g[lane + 64 * j] * (1.f - LAM_INIT));
}
__global__ __launch_bounds__(256) void k_route1(const float* __restrict__ x1, const float* __restrict__ g2, const float* __restrict__ wr, const float* __restrict__ br,
                                                bf16* __restrict__ H2, int* __restrict__ cnt, int* __restrict__ TOPE, int* __restrict__ SLOT, float* __restrict__ WTS) {
    const int t = blockIdx.x * 4 + (threadIdx.x >> 6), lane = threadIdx.x & 63;
    const float* xr = x1 + (size_t)t * D; float v[32]; float s = 0.f;
#pragma unroll
    for (int j = 0; j < 32; ++j) { v[j] = xr[lane + 64 * j]; s += v[j] * v[j]; }
    s = wave_sum(s); const float r = rsqrtf(s * (1.f / D) + EPS);
#pragma unroll
    for (int j = 0; j < 32; ++j) { v[j] = v[j] * r * g2[lane + 64 * j]; H2[(size_t)t * D + lane + 64 * j] = f2bf(v[j]); }
    float mylogit = -INFINITY;
    for (int e = 0; e < NE; ++e) { float p = 0.f;
#pragma unroll
        for (int j = 0; j < 32; ++j) p += v[j] * wr[(size_t)(lane + 64 * j) * NE + e];
        p = wave_sum(p) + br[e]; if (lane == e) mylogit = p; }
    float tv[4]; int ti[4]; float cur = mylogit;
#pragma unroll
    for (int k = 0; k < 4; ++k) { const float m = wave_max(cur); const unsigned long long bal = __ballot(cur == m && lane < NE); const int idx = __ffsll((long long)bal) - 1; tv[k] = m; ti[k] = idx; if (lane == idx) cur = -INFINITY; }
    if (lane == 0) { const float e1 = __expf(tv[1] - tv[0]), e2 = __expf(tv[2] - tv[0]), e3 = __expf(tv[3] - tv[0]); const float inv = 1.f / (1.f + e1 + e2 + e3);
        const float w[4] = {inv, e1 * inv, e2 * inv, e3 * inv};
#pragma unroll
        for (int k = 0; k < 4; ++k) { TOPE[t * 4 + k] = ti[k]; SLOT[t * 4 + k] = atomicAdd(&cnt[ti[k]], 1); WTS[t * 4 + k] = w[k]; } }
}
__global__ __launch_bounds__(256) void k_route2(const bf16* __restrict__ H2, const int* __restrict__ cnt, const int* __restrict__ TOPE, const int* __restrict__ SLOT, int* __restrict__ DEST, bf16* __restrict__ XG) {
    const int a = blockIdx.x * 4 + (threadIdx.x >> 6), lane = threadIdx.x & 63;
    if (a < T * TOPK) { const int t = a >> 2, e = TOPE[a]; int start = 0;
        for (int i = 0; i < e; ++i) start += (cnt[i] + PADM - 1) / PADM * PADM;
        const int row = start + SLOT[a]; if (lane == 0) DEST[a] = row;
        for (int j = 0; j < 32; ++j) XG[(size_t)row * D + lane + 64 * j] = H2[(size_t)t * D + lane + 64 * j];
    } else { const int p = a - T * TOPK; if (p >= NE * PADM) return;
        const int e = p / PADM, q = p % PADM; int start = 0;
        for (int i = 0; i < e; ++i) start += (cnt[i] + PADM - 1) / PADM * PADM;
        const int c = cnt[e], padded = (c + PADM - 1) / PADM * PADM;
        if (c + q < padded) { const int row = start + c + q; for (int j = 0; j < 32; ++j) XG[(size_t)row * D + lane + 64 * j] = 0; } }
}
__global__ __launch_bounds__(256) void k_combine(float* __restrict__ out, const bf16* __restrict__ Y, const int* __restrict__ DEST, const float* __restrict__ WTS) {
    const int t = blockIdx.x * 4 + (threadIdx.x >> 6), lane = threadIdx.x & 63; int d[4]; float w[4];
#pragma unroll
    for (int k = 0; k < 4; ++k) { d[k] = DEST[t * 4 + k]; w[k] = WTS[t * 4 + k]; }
    for (int j = 0; j < 32; ++j) { const int c = lane + 64 * j; float a = out[(size_t)t * D + c];
#pragma unroll
        for (int k = 0; k < 4; ++k) a += w[k] * bf2f(Y[(size_t)d[k] * D + c]);
        out[(size_t)t * D + c] = a; }
}
#endif
#ifndef MEGA_MASK
#define MEGA_MASK 0xFF
#endif
static int g_grid = 0;
static void launch_mega(Args a, int lo, int hi, hipStream_t stream) {
    (void)hipMemsetAsync(a.ws + WS_CTL + CW_BAR * 4, 0, XCD_BAR_WORDS * 4, stream);
    a.ph_lo = lo; a.ph_hi = hi;
    hipLaunchKernelGGL(mega_fwd, dim3(g_grid), dim3(NTHR), LDS_BYTES, stream, a);
}
extern "C" void kernel_launch(void* const* d_in, const int* in_sizes, int n_in, void* d_out, int out_size, void* d_ws, size_t ws_size, hipStream_t stream) {
    if (g_grid == 0) {
        int dev = 0, cus = 0;
        if (n_in != 19 || out_size != T * D || hipGetDevice(&dev) != hipSuccess || hipDeviceGetAttribute(&cus, hipDeviceAttributeMultiprocessorCount, dev) != hipSuccess) { g_grid = -1; return; }
        if (hipFuncSetAttribute((const void*)mega_fwd, hipFuncAttributeMaxDynamicSharedMemorySize, LDS_BYTES) != hipSuccess) { g_grid = -1; return; }
        int per_cu = 0; (void)hipOccupancyMaxActiveBlocksPerMultiprocessor(&per_cu, (const void*)mega_fwd, NTHR, LDS_BYTES); (void)hipGetLastError();
        g_grid = cus;
    }
    if (g_grid < 0) return;
    Args a{};
    for (int i = 0; i < 19; ++i) a.in[i] = (const float*)d_in[i];
    a.out = (float*)d_out; a.ws = (unsigned char*)d_ws;
    (void)hipMemsetAsync(a.ws + WS_CTL, 0, 4096 * 4, stream);
#ifdef DEV_NAIVE
    unsigned char* ws = a.ws; const int mask = MEGA_MASK;
    bf16* PROJ = (bf16*)(ws + WS_PROJ); float* MG = (float*)(ws + WS_MG); float* ROPE = (float*)(ws + WS_ROPE);
    bf16* QN = (bf16*)(ws + WS_QN); bf16* KN = (bf16*)(ws + WS_KN); bf16* HM = (bf16*)(ws + WS_HM); bf16* OD = (bf16*)(ws + WS_OD);
    bf16* H2 = (bf16*)(ws + WS_H2); bf16* XG = (bf16*)(ws + WS_XG); bf16* ACT = (bf16*)(ws + WS_ACT); bf16* Y = (bf16*)(ws + WS_Y);
    int* cnt = (int*)(ws + WS_CTL) + CW_CNT; int* TOPE = (int*)(ws + WS_RT); int* SLOT = TOPE + T * 4; float* WTS = (float*)(SLOT + T * 4); int* DEST = (int*)(WTS + T * 4);
    float* XN32 = (float*)(ws + NV_XN32); float* PROJ32 = (float*)(ws + NV_PROJ32); float* F = (float*)(ws + NV_F); float* HF = (float*)(ws + NV_HF); float* OD32 = (float*)(ws + NV_OD32); float* MIX32 = (float*)(ws + NV_MIX32);
    const float* x = a.in[0]; float* out = a.out;
    static const int ranges[8][2] = {{0, 2}, {2, 3}, {3, 6}, {6, 7}, {7, 9}, {9, 11}, {11, 13}, {13, 14}};
    for (int s = 0; s < 8; ++s) {
        if (mask & (1 << s)) { int e = s; while (e + 1 < 8 && (mask & (1 << (e + 1)))) ++e; launch_mega(a, ranges[s][0], ranges[e][1], stream); s = e; continue; }
        switch (s) {
        case 0: { k_rmsnorm<<<T / 4, 256, 0, stream>>>(x, a.in[1], XN32);
            GArgs g{}; g.A = XN32; g.B = a.in[2]; g.C = PROJ32; g.M = T; g.N = DIN; g.K = D; g.lda = D; g.ldb = DIN; g.ldc = DIN;
            k_gemm<0, float><<<dim3((DIN + 63) / 64, T / 64), 256, 0, stream>>>(g);
            k_pack<<<T, 256, 0, stream>>>(PROJ32, a.in[3], PROJ, MG); k_rope<<<S * 32 / 256, 256, 0, stream>>>(ROPE); } break;
        case 1: k_qkprep<<<T / 4, 256, 0, stream>>>(PROJ, ROPE, a.in[6], a.in[7], QN, KN); break;
        case 2: k_mlF<<<1, 64, 0, stream>>>(MG, F); k_mlquad<<<dim3(S / 16, 16), 256, 0, stream>>>(PROJ, MG, F, HF); k_mlpost<<<T, 256, 0, stream>>>(HF, PROJ, a.in[4], HM); break;
        case 3: k_attn<<<dim3(S / 16, 16), 256, 0, stream>>>(QN, KN, PROJ, a.in[8], OD32); k_dapost<<<T * 2, 256, 0, stream>>>(OD32, a.in[9], OD); break;
        case 4: { GArgs g{}; g.A = HM; g.B = a.in[5]; g.C = MIX32; g.M = T; g.N = D; g.K = MLW; g.lda = MLW; g.ldb = D; g.ldc = D; g.aux0 = PROJ;
            k_gemm<1, bf16><<<dim3(D / 64, T / 64), 256, 0, stream>>>(g);
            g.A = OD; g.B = a.in[10]; g.K = DAW; g.lda = DAW; k_gemm<2, bf16><<<dim3(D / 64, T / 64), 256, 0, stream>>>(g);
            GArgs h{}; h.A = MIX32; h.B = a.in[11]; h.C = out; h.M = T; h.N = D; h.K = D; h.lda = D; h.ldb = D; h.ldc = D; h.aux0 = x;
            k_gemm<3, float><<<dim3(D / 64, T / 64), 256, 0, stream>>>(h); } break;
        case 5: k_route1<<<T / 4, 256, 0, stream>>>(out, a.in[12], a.in[13], a.in[14], H2, cnt, TOPE, SLOT, WTS);
            k_route2<<<(T * TOPK + NE * PADM) / 4, 256, 0, stream>>>(H2, cnt, TOPE, SLOT, DEST, XG); break;
        case 6: { GArgs g{}; g.A = XG; g.B = a.in[15]; g.C = ACT; g.N = 2 * DE; g.K = D; g.lda = D; g.ldb = 2 * DE; g.ldc = DE; g.aux0 = a.in[16]; g.cnt = cnt;
            k_gemm<4, bf16><<<dim3(2 * DE / 64, T / 64, NE), 256, 0, stream>>>(g);
            GArgs h{}; h.A = ACT; h.B = a.in[17]; h.C = Y; h.N = D; h.K = DE; h.lda = DE; h.ldb = D; h.ldc = D; h.aux0 = a.in[18]; h.cnt = cnt;
            k_gemm<5, bf16><<<dim3(D / 64, T / 64, NE), 256, 0, stream>>>(h); } break;
        case 7: k_combine<<<T / 4, 256, 0, stream>>>(out, Y, DEST, WTS); break;
        }
    }
#else
    launch_mega(a, 0, N_PHASES, stream);
#endif
}
```

```cpp
#include <hip/hip_runtime.h>
#include <cstdio>
#include <cstdint>
#include <math.h>

constexpr int D = 2048, NB = 2, S = 4096, T = NB * S;
constexpr int MLH = 4, MLDK = 128, MLDV = 256, MLW = 1024, NCH = 64;
constexpr int DAH = 8, DAD = 64, DADV = 128, DAW = 1024;
constexpr int NE = 32, TOPK = 4, DE = 2048;
constexpr int DIN = 10256, NPJ = 10240;
constexpr int G_OFF = 3072;
constexpr int P_MQ = 0, P_MK = 512, P_MV = 1024, P_MO = 2048, P_DQ = 3072, P_DK = 4096, P_DV = 5120, P_GM = 6144, P_GD = 8192;
constexpr float EPS = 1e-6f;
constexpr int PADM = 256;
constexpr int MAXROWS = T * TOPK + NE * PADM;
constexpr float LAM_INIT = 0.2f;
constexpr float QSCALE = 0.125f * 1.4426950408889634f;
constexpr float KSCALE = 0.08838834764831845f;

constexpr size_t MiB = 1ull << 20;
constexpr size_t WS_CTL = 0, CTL_ZERO_BYTES = 1 * MiB;
constexpr size_t WS_MSC = 1 * MiB;
constexpr size_t WS_RT = 2 * MiB;
constexpr size_t WS_ROPE = 3 * MiB;
constexpr size_t WS_MG = 4 * MiB;
constexpr size_t WS_NU = 5 * MiB;
constexpr size_t WS_NP = 6 * MiB;
constexpr size_t WS_WRH = 7 * MiB, WS_WRL = 7 * MiB + 256 * 1024;
constexpr size_t WS_WIN = 8 * MiB;
constexpr size_t WS_WIN8 = 32 * MiB;
constexpr size_t WS_WML = 48 * MiB;
constexpr size_t WS_WDA = 52 * MiB;
constexpr size_t WS_WO = 56 * MiB;
constexpr size_t WS_WGU = 64 * MiB;
constexpr size_t WS_WDN = 576 * MiB;
constexpr size_t WS_XN = 832 * MiB;
constexpr size_t WS_PROJ = 864 * MiB;
constexpr size_t WS_QN = 1024 * MiB;
constexpr size_t WS_KN = 1040 * MiB;
constexpr size_t WS_U = 1056 * MiB;
constexpr size_t WS_CP = 1184 * MiB;
constexpr size_t WS_HM = 1248 * MiB;
constexpr size_t WS_OD = 1264 * MiB;
constexpr size_t WS_XN8 = 1280 * MiB;
constexpr size_t WS_T1 = 1280 * MiB;
constexpr size_t WS_MIX = 1312 * MiB;
constexpr size_t WS_H2 = 1344 * MiB;
constexpr size_t WS_XG = 1376 * MiB;
constexpr size_t WS_ACT = 1536 * MiB;
constexpr size_t WS_Y = 1696 * MiB;
constexpr size_t WS_G8 = 1856 * MiB;
constexpr size_t WS_NAIVE = 1920 * MiB;
constexpr size_t WS_END = 2500 * MiB;
constexpr int CW_CNT = 64;
constexpr int CW_BAR = 4096;
constexpr int CW_WGCNT = 8192;

typedef unsigned short bf16;
typedef unsigned v4u __attribute__((ext_vector_type(4)));
typedef unsigned v2u __attribute__((ext_vector_type(2)));
typedef float f32x4 __attribute__((ext_vector_type(4)));
typedef float f32x2 __attribute__((ext_vector_type(2)));
typedef float f32x16 __attribute__((ext_vector_type(16)));
typedef short bf16x8 __attribute__((ext_vector_type(8)));
typedef short s16x4 __attribute__((ext_vector_type(4)));
typedef __bf16 bf16x2_t __attribute__((ext_vector_type(2)));
#define GAS __attribute__((address_space(1)))
#define LAS __attribute__((address_space(3)))

__device__ __forceinline__ float bf2f(unsigned v) { return __uint_as_float(v << 16); }
__device__ __forceinline__ float bflo(unsigned w) { return __uint_as_float(w << 16); }
__device__ __forceinline__ float bfhi(unsigned w) { return __uint_as_float(w & 0xffff0000u); }
__device__ __forceinline__ unsigned pk2(float lo, float hi) { f32x2 v = {lo, hi}; bf16x2_t b = __builtin_convertvector(v, bf16x2_t); return __builtin_bit_cast(unsigned, b); }
__device__ __forceinline__ bf16 f2bf(float f) { return (bf16)(pk2(f, 0.f) & 0xffffu); }
__device__ __forceinline__ float sigmoidf_(float x) { return 1.f / (1.f + __expf(-x)); }
__device__ __forceinline__ float logsigf_(float x) { return x >= 0.f ? -log1pf(__expf(-x)) : x - log1pf(__expf(x)); }
__device__ __forceinline__ float wave_sum(float v) {
#pragma unroll
    for (int o = 1; o < 64; o <<= 1) v += __shfl_xor(v, o);
    return v;
}
__device__ __forceinline__ float wave_max(float v) {
#pragma unroll
    for (int o = 1; o < 64; o <<= 1) v = fmaxf(v, __shfl_xor(v, o));
    return v;
}
namespace pg8 {
#define PG8_LAS __attribute__((address_space(3)))
typedef unsigned short bf16_t;
typedef short bf16x8 __attribute__((ext_vector_type(8)));
typedef float f32x4 __attribute__((ext_vector_type(4)));
typedef unsigned u32x4 __attribute__((ext_vector_type(4)));
constexpr int BM = 256, BK = 64, HALF = 128, HTB = HALF * BK * 2  , STAGE_BYTES = 8 * HTB, NXCD = 8, WGM = 8;

__host__ __device__ __forceinline__ int lds_byte(int r, int c) { const int st = (r >> 4) * 2 + (c >> 5), rr = r & 15, cc = c & 31, ob = rr * 64 + cc * 2; return st * 1024 + (ob ^ (((ob >> 9) & 1) << 5)); }
__host__ __device__ __forceinline__ void stage_rc(int b, int& R, int& C) { const int st = b / 1024, sb = b % 1024, swz = sb ^ (((sb >> 9) & 1) << 5); R = (st >> 1) * 16 + swz / 64; C = (st & 1) * 32 + (swz % 64) / 2; }
__host__ __device__ __forceinline__ int perm32(int rho) { const int n = rho >> 4, i = rho & 15; return 8 * (i >> 2) + 4 * n + (i & 3); }

struct Unit { int pm, pn, pb, half; };
struct Gemm { const bf16_t* A; const bf16_t* Bt; int M, N, K; };

struct StaticOrder {
    int nM, nN, nwg, G, c;
    __host__ __device__ void init(int M, int N, int G_, int c_) { nM = M / BM; nN = N / BM; nwg = nM * nN; G = G_; c = c_; }
    __host__ __device__ bool next(int i, Unit& u) const {
        const long L = (long)i * G + c; if (L >= nwg) return false;
        int wgid = (int)L; { const int q = nwg / NXCD, r = nwg % NXCD, xcd = wgid % NXCD, off = wgid / NXCD; wgid = (xcd < r ? xcd * (q + 1) : r * (q + 1) + (xcd - r) * q) + off; }
        const int nig = WGM * nN, gid = wgid / nig, fm = gid * WGM, gsz = (nM - fm) < WGM ? (nM - fm) : WGM;
        u.pm = fm + ((wgid % nig) % gsz); u.pn = (wgid % nig) / gsz; u.pb = u.pn; u.half = 0; return true;
    }
    __device__ __forceinline__ void a_ready(const Unit&) const {}
    __device__ __forceinline__ void done(const Unit&) const {}
    __device__ __forceinline__ int rot() const { return 0; }
};

__device__ __forceinline__ unsigned cvt_pk_bf16(float lo, float hi) { unsigned r; asm volatile("v_cvt_pk_bf16_f32 %0, %1, %2" : "=v"(r) : "v"(lo), "v"(hi)); return r; }
typedef float f32x2 __attribute__((ext_vector_type(2)));
typedef int v8i_t __attribute__((ext_vector_type(8)));
__device__ __forceinline__ const char* pg8_uni(const char* p) { const unsigned long long v = (unsigned long long)p; const unsigned lo = __builtin_amdgcn_readfirstlane((unsigned)v), hi = __builtin_amdgcn_readfirstlane((unsigned)(v >> 32)); return (const char*)(((unsigned long long)hi << 32) | lo); }
template <class Epi, class Sched, bool ALIGN_EPI = false, bool SP2 = false, bool FP8 = false, int BLK = 0>
__device__ __forceinline__ void gemm_phase(PG8_LAS unsigned char* lds, const Gemm g, const Sched& S, const Epi& E) {
    const int tid = threadIdx.x, wid = __builtin_amdgcn_readfirstlane(tid >> 6), lane = tid & 63, wr = wid >> 2, wc = wid & 3, fr = lane & 15, fq = lane >> 4;
    const int K = g.K, nt = K / BK;
    unsigned voffA[2], voffB[2];
#pragma unroll
    for (int i = 0; i < 2; ++i) { int R, C; stage_rc(tid * 16 + i * 8192, R, C); const int Rb = Epi::PERM ? ((R & ~31) + perm32(R & 31)) : R;
        voffA[i] = (unsigned)(R * ((BLK & 1) ? BK : K) + C) * 2u; voffB[i] = (unsigned)(Rb * ((BLK & 2) ? BK : K) + C) * 2u; }
    const size_t kstepA = (BLK & 1) ? (size_t)(2 * HTB) : (size_t)(BK * 2), kstepB = (BLK & 2) ? (size_t)(2 * HTB) : (size_t)(BK * 2);
    const size_t hstepA = (BLK & 1) ? (size_t)HTB : (size_t)HALF * K * 2, hstepB = (BLK & 2) ? (size_t)HTB : (size_t)HALF * K * 2;
    const size_t tstep = (size_t)2 * HALF * K * 2;
    const unsigned ldsb_ = (unsigned)(uintptr_t)lds;
    const unsigned ldsw = (unsigned)wid * 1024u;
    const int aoff = lds_byte(wr * 64 + fr, fq * 8), boff = lds_byte(wc * 32 + fr, fq * 8);
#define PG8_SA(b, h) (((b) * 2 + (h)) * HTB)
#define PG8_SB(b, h) ((4 + (b) * 2 + (h)) * HTB)
#define PG8_STAGE(bufoff, gbase, voff) do { _Pragma("unroll") for (int _i = 0; _i < 2; ++_i) { unsigned keep_; \
        asm volatile("s_mov_b32 %0, m0\n\ts_mov_b32 m0, %3\n\ts_nop 0\n\tglobal_load_lds_dwordx4 %1, %2\n\ts_mov_b32 m0, %0" : "=&s"(keep_) : "v"((voff)[_i]), "s"(pg8_uni((const char*)(gbase))), \
            "s"((unsigned)__builtin_amdgcn_readfirstlane((int)(ldsb_ + (unsigned)(bufoff) + ldsw + (unsigned)(_i * 8192)))) : "memory"); } } while (0)
#define PG8_CAT16(lo, hi) __builtin_bit_cast(v8i_t, __builtin_shufflevector(lo, hi, 0, 1, 2, 3, 4, 5, 6, 7, 8, 9, 10, 11, 12, 13, 14, 15))
#define PG8_LDA(dst, b, h) do { if constexpr (FP8) { _Pragma("unroll") for (int m = 0; m < 4; ++m) { const bf16x8 lo_ = *(const PG8_LAS bf16x8*)(lds + PG8_SA(b, h) + aoff + m * 2048), hi_ = *(const PG8_LAS bf16x8*)(lds + PG8_SA(b, h) + aoff + m * 2048 + 1024); dst##8[m] = PG8_CAT16(lo_, hi_); } } \
    else { _Pragma("unroll") for (int m = 0; m < 4; ++m) _Pragma("unroll") for (int k = 0; k < 2; ++k) dst[m][k] = *(const PG8_LAS bf16x8*)(lds + PG8_SA(b, h) + aoff + m * 2048 + k * 1024); } } while (0)
#define PG8_LDB(dst, b, h) do { if constexpr (FP8) { _Pragma("unroll") for (int n = 0; n < 2; ++n) { const bf16x8 lo_ = *(const PG8_LAS bf16x8*)(lds + PG8_SB(b, h) + boff + n * 2048), hi_ = *(const PG8_LAS bf16x8*)(lds + PG8_SB(b, h) + boff + n * 2048 + 1024); dst##8[n] = PG8_CAT16(lo_, hi_); } } \
    else { _Pragma("unroll") for (int n = 0; n < 2; ++n) _Pragma("unroll") for (int k = 0; k < 2; ++k) dst[n][k] = *(const PG8_LAS bf16x8*)(lds + PG8_SB(b, h) + boff + n * 2048 + k * 1024); } } while (0)
#define PG8_MMA(ai, bj, At, Bt) do { __builtin_amdgcn_s_setprio(1); \
    if constexpr (FP8) { _Pragma("unroll") for (int m = 0; m < 4; ++m) _Pragma("unroll") for (int n = 0; n < 2; ++n) \
        asm volatile("v_mfma_f32_16x16x128_f8f6f4 %0, %1, %2, %0" : "+v"(acc[ai][bj][m][n]) : "v"(Bt##8[n]), "v"(At##8[m])); } \
    else { _Pragma("unroll") for (int m = 0; m < 4; ++m) _Pragma("unroll") for (int n = 0; n < 2; ++n) _Pragma("unroll") for (int k = 0; k < 2; ++k) \
        acc[ai][bj][m][n] = __builtin_amdgcn_mfma_f32_16x16x32_bf16(Bt[n][k], At[m][k], acc[ai][bj][m][n], 0, 0, 0); } \
    __builtin_amdgcn_s_setprio(0); } while (0)
#define PG8_WAIT_V(n) asm volatile("s_waitcnt vmcnt(" #n ")" ::: "memory")
#define PG8_WAIT_L(n) asm volatile("s_waitcnt lgkmcnt(" #n ")" ::: "memory")
#define PG8_BAR __builtin_amdgcn_s_barrier()
#define PG8_SCHED __builtin_amdgcn_sched_barrier(0)
    Unit cur, nxt; int ui = 0;
    if (!S.next(0, cur)) return;
    f32x4 acc[2][2][4][2];
#pragma unroll
    for (int a = 0; a < 2; ++a)
#pragma unroll
        for (int b = 0; b < 2; ++b)
#pragma unroll
            for (int m = 0; m < 4; ++m)
#pragma unroll
                for (int n = 0; n < 2; ++n) acc[a][b][m][n] = (f32x4){0.f, 0.f, 0.f, 0.f};
    bf16x8 At[4][2], B0[2][2], B1[2][2]; v8i_t At8[4], B08[2], B18[2]; (void)At; (void)B0; (void)B1; (void)At8; (void)B08; (void)B18; int sc8_ = 0x7f7f7f7f; asm volatile("" : "+v"(sc8_)); (void)sc8_;
    const char* cA = (const char*)g.A + (size_t)cur.pm * tstep; const char* cB = (const char*)g.Bt + (size_t)cur.pb * tstep;
    const int rot = S.rot();
#define PG8_KIX(t) ((size_t)(((t) + rot) & (nt - 1)))
    const size_t k0A = PG8_KIX(0) * kstepA, k1A = PG8_KIX(1) * kstepA, k0B = PG8_KIX(0) * kstepB, k1B = PG8_KIX(1) * kstepB;
    S.a_ready(cur);
    if constexpr (SP2) {
        PG8_STAGE(PG8_SB(0, 0), cB + k0B, voffB); PG8_STAGE(PG8_SB(0, 1), cB + hstepB + k0B, voffB); PG8_STAGE(PG8_SA(0, 0), cA + k0A, voffA); PG8_STAGE(PG8_SA(0, 1), cA + hstepA + k0A, voffA);
        if (wr == 1) PG8_BAR;
        PG8_WAIT_V(2); PG8_BAR;
        PG8_STAGE(PG8_SB(1, 0), cB + k1B, voffB); PG8_STAGE(PG8_SA(1, 0), cA + k1A, voffA); PG8_STAGE(PG8_SB(1, 1), cB + hstepB + k1B, voffB);
        PG8_WAIT_V(6); PG8_BAR;
    } else {
        PG8_STAGE(PG8_SB(0, 0), cB + k0B, voffB); PG8_STAGE(PG8_SA(0, 0), cA + k0A, voffA); PG8_STAGE(PG8_SB(0, 1), cB + hstepB + k0B, voffB); PG8_STAGE(PG8_SA(0, 1), cA + hstepA + k0A, voffA);
        if (wr == 1) PG8_BAR;
        PG8_WAIT_V(4); PG8_BAR;
        PG8_STAGE(PG8_SB(1, 0), cB + k1B, voffB); PG8_STAGE(PG8_SA(1, 0), cA + k1A, voffA); PG8_STAGE(PG8_SB(1, 1), cB + hstepB + k1B, voffB);
        PG8_WAIT_V(6); PG8_BAR;
    }
    for (;;) {
        const bool has_next = S.next(ui + 1, nxt);
        const char* nA = has_next ? (const char*)g.A + (size_t)nxt.pm * tstep : cA; const char* nB = has_next ? (const char*)g.Bt + (size_t)nxt.pb * tstep : cB;
        for (int t = 0; t < nt; t += 2) {
            const bool last = (t == nt - 2);
            const char* a1 = cA + PG8_KIX(t + 1) * kstepA;
            const size_t i2 = PG8_KIX(t + 2), i3 = PG8_KIX(t + 3);
            const char* a2 = (last ? nA : cA) + i2 * kstepA; const char* b2 = (last ? nB : cB) + i2 * kstepB;
            const char* a3 = (last ? nA : cA) + i3 * kstepA; const char* b3 = (last ? nB : cB) + i3 * kstepB;
            if (last && has_next) S.a_ready(nxt);
            if constexpr (SP2) {
            PG8_LDB(B0, 0, 0); PG8_LDB(B1, 0, 1); PG8_SCHED; PG8_LDA(At, 0, 0); PG8_STAGE(PG8_SA(1, 1), a1 + hstepA, voffA);
            PG8_WAIT_V(8); PG8_WAIT_L(0); PG8_BAR; PG8_MMA(0, 0, At, B0); PG8_MMA(0, 1, At, B1); PG8_BAR; PG8_SCHED;
            PG8_LDA(At, 0, 1); PG8_STAGE(PG8_SB(0, 0), b2, voffB); PG8_STAGE(PG8_SB(0, 1), b2 + hstepB, voffB); PG8_STAGE(PG8_SA(0, 0), a2, voffA);
            PG8_WAIT_V(8); PG8_WAIT_L(0); PG8_BAR; if (!cur.half) { PG8_MMA(1, 0, At, B0); PG8_MMA(1, 1, At, B1); } PG8_BAR; PG8_SCHED;
            PG8_LDB(B0, 1, 0); PG8_LDB(B1, 1, 1); PG8_SCHED; PG8_LDA(At, 1, 0); PG8_STAGE(PG8_SA(0, 1), a2 + hstepA, voffA);
            PG8_WAIT_V(8); PG8_WAIT_L(0); PG8_BAR; PG8_MMA(0, 0, At, B0); PG8_MMA(0, 1, At, B1); PG8_BAR; PG8_SCHED;
            PG8_LDA(At, 1, 1); PG8_STAGE(PG8_SB(1, 0), b3, voffB); PG8_STAGE(PG8_SB(1, 1), b3 + hstepB, voffB); PG8_STAGE(PG8_SA(1, 0), a3, voffA);
            PG8_WAIT_V(8); PG8_WAIT_L(0); PG8_BAR; if (!cur.half) { PG8_MMA(1, 0, At, B0); PG8_MMA(1, 1, At, B1); } PG8_BAR; PG8_SCHED;
            } else {
            PG8_LDB(B0, 0, 0); PG8_SCHED; PG8_LDA(At, 0, 0); PG8_STAGE(PG8_SA(1, 1), a1 + hstepA, voffA);
            PG8_WAIT_L(8); PG8_BAR; PG8_WAIT_L(0); PG8_MMA(0, 0, At, B0); PG8_BAR; PG8_SCHED;
            PG8_LDB(B1, 0, 1); PG8_STAGE(PG8_SB(0, 0), b2, voffB);
            PG8_BAR; PG8_WAIT_L(0); PG8_MMA(0, 1, At, B1); PG8_BAR;
            PG8_LDA(At, 0, 1); PG8_STAGE(PG8_SA(0, 0), a2, voffA);
            PG8_BAR; PG8_WAIT_L(0); if (!cur.half) PG8_MMA(1, 0, At, B0); PG8_BAR; PG8_SCHED;
            PG8_STAGE(PG8_SB(0, 1), b2 + hstepB, voffB);
            PG8_WAIT_V(6); PG8_BAR; if (!cur.half) PG8_MMA(1, 1, At, B1); PG8_BAR;
            PG8_LDB(B0, 1, 0); PG8_SCHED; PG8_LDA(At, 1, 0); PG8_STAGE(PG8_SA(0, 1), a2 + hstepA, voffA);
            PG8_WAIT_L(8); PG8_BAR; PG8_WAIT_L(0); PG8_MMA(0, 0, At, B0); PG8_BAR; PG8_SCHED;
            PG8_LDB(B1, 1, 1); PG8_STAGE(PG8_SB(1, 0), b3, voffB);
            PG8_BAR; PG8_WAIT_L(0); PG8_MMA(0, 1, At, B1); PG8_BAR;
            PG8_LDA(At, 1, 1); PG8_STAGE(PG8_SA(1, 0), a3, voffA);
            PG8_BAR; PG8_WAIT_L(0); if (!cur.half) PG8_MMA(1, 0, At, B0); PG8_BAR; PG8_SCHED;
            PG8_STAGE(PG8_SB(1, 1), b3 + hstepB, voffB);
            PG8_WAIT_V(6); PG8_BAR; if (!cur.half) PG8_MMA(1, 1, At, B1); PG8_BAR;
            }
        }
        if constexpr (ALIGN_EPI) { if (wr == 0) PG8_BAR; }
        if constexpr (FP8) asm volatile("s_nop 15\n\ts_nop 15" ::: "memory");
        if constexpr (!Epi::AFTER_DRAIN) { E(acc, cur, wr, wc, fr, fq); S.done(cur); }
        if (!has_next) break;
#pragma unroll
        for (int a = 0; a < 2; ++a)
#pragma unroll
            for (int b = 0; b < 2; ++b)
#pragma unroll
                for (int m = 0; m < 4; ++m)
#pragma unroll
                    for (int n = 0; n < 2; ++n) acc[a][b][m][n] = (f32x4){0.f, 0.f, 0.f, 0.f};
        cur = nxt; cA = nA; cB = nB; ++ui;
        if constexpr (ALIGN_EPI) { if (wr == 1) PG8_BAR; }
    }
    PG8_WAIT_V(0);
    if constexpr (!ALIGN_EPI) { if (wr == 0) PG8_BAR; }
    PG8_BAR;
    if constexpr (Epi::AFTER_DRAIN) { E.fused(acc, cur, wr, wc, fr, fq, lds, wid, lane); S.done(cur); }
#undef PG8_KIX
#undef PG8_SA
#undef PG8_SB
#undef PG8_STAGE
#undef PG8_LDA
#undef PG8_LDB
#undef PG8_MMA
#undef PG8_WAIT_V
#undef PG8_WAIT_L
#undef PG8_BAR
#undef PG8_SCHED
}
}
constexpr int NWAVES = 8, NTHR = 512;
constexpr int LDS_BYTES = 147456;
constexpr int MISC_OFF = LDS_BYTES - 128;
typedef GAS unsigned gu32;
#define RLX_AGENT __ATOMIC_RELAXED, __HIP_MEMORY_SCOPE_AGENT
#define LDS_WAIT() asm volatile("s_waitcnt lgkmcnt(0)" ::: "memory")
#define VM_WAIT() asm volatile("s_waitcnt vmcnt(0)" ::: "memory")
#define XB_TMO      128
#define XB_XCNT(j)  (256  + 64 * (j))
#define XB_XSUB(j)  (1280 + 64 * (j))
#define XB_XGEN(j)  (2304 + 64 * (j))
#define XB_TOP      3328
#define XB_TOPGEN   3392
#define XCD_BAR_WORDS 3456
#define XB_SPIN_CAP (1u << 18)

__device__ __forceinline__ unsigned xb_ld(unsigned* p)              { return __hip_atomic_load(p, __ATOMIC_RELAXED, __HIP_MEMORY_SCOPE_AGENT); }
__device__ __forceinline__ unsigned xb_add(unsigned* p, unsigned v) { return __hip_atomic_fetch_add(p, v, __ATOMIC_RELAXED, __HIP_MEMORY_SCOPE_AGENT); }
__device__ __forceinline__ unsigned xb_xcc_id() { return (unsigned)__builtin_amdgcn_s_getreg((3 << 11) | 20) & 0xFu; }
#define XB_SPIN(cond, bar) do { unsigned _sp = 0; while (cond) { __builtin_amdgcn_s_sleep(1); \
    if ((++_sp & 255u) == 0u) { if (xb_ld(&(bar)[XB_TMO])) break; if (_sp > XB_SPIN_CAP) { atomicAdd(&(bar)[XB_TMO], 1u); break; } } } } while (0)

struct XcdBarrier {
    unsigned* bar; unsigned x;
    volatile LAS unsigned* st;
};

__device__ __forceinline__ XcdBarrier xcd_barrier_post(unsigned* bar, volatile LAS unsigned* st) {
    XcdBarrier b; b.bar = bar; b.x = xb_xcc_id(); b.st = st;
    if (threadIdx.x == 0) (void)xb_add(&bar[XB_XCNT(b.x)], 1u);
    return b;
}
__device__ __forceinline__ void xcd_barrier_complete(unsigned* bar, unsigned x, unsigned& nloc, unsigned& nx) {
    const unsigned G = gridDim.x * gridDim.y * gridDim.z;
    unsigned sum, cnt, mine, sp = 0u;
    for (;;) {
        sum = 0u; cnt = 0u; mine = 0u;
#pragma unroll
        for (unsigned j = 0; j < 16; ++j) { const unsigned c = xb_ld(&bar[XB_XCNT(j)]); sum += c; cnt += (c > 0u) ? 1u : 0u; mine = (j == x) ? c : mine; }
        if (sum == G) break;
        __builtin_amdgcn_s_sleep(1);
        if ((++sp & 255u) == 0u) { if (xb_ld(&bar[XB_TMO])) break; if (sp > XB_SPIN_CAP) { atomicAdd(&bar[XB_TMO], 1u); break; } }
    }
    nloc = mine > 0u ? mine : 1u; nx = cnt > 0u ? cnt : 1u;
}

__device__ __forceinline__ void xcd_barrier(const XcdBarrier& b) {
    asm volatile("s_waitcnt vmcnt(0)" ::: "memory");
    __syncthreads();
    if (threadIdx.x == 0) {
        unsigned* bar = b.bar;
        __builtin_amdgcn_s_waitcnt(0);
        unsigned nloc = b.st[0], nx = b.st[1];
        if (nloc == 0u) { xcd_barrier_complete(bar, b.x, nloc, nx); b.st[0] = nloc; b.st[1] = nx; }
        const unsigned old = xb_add(&bar[XB_XSUB(b.x)], 1u);
        const unsigned gen = old / nloc;
        if (old + 1u == (gen + 1u) * nloc) {
            __builtin_amdgcn_fence(__ATOMIC_RELEASE, "agent");
            asm volatile("s_waitcnt vmcnt(0)" ::: "memory");
            const unsigned og = xb_add(&bar[XB_TOP], 1u);
            const unsigned tg = og / nx;
            if (og + 1u == (tg + 1u) * nx) xb_add(&bar[XB_TOPGEN], 1u);
            else XB_SPIN(xb_ld(&bar[XB_TOPGEN]) == tg, bar);
            __builtin_amdgcn_fence(__ATOMIC_ACQUIRE, "agent");
            xb_add(&bar[XB_XGEN(b.x)], 1u);
            asm volatile("s_waitcnt vmcnt(0)" ::: "memory");
        } else {
            XB_SPIN(xb_ld(&bar[XB_XGEN(b.x)]) == gen, bar);
            __builtin_amdgcn_fence(__ATOMIC_ACQUIRE, "agent");
            asm volatile("s_waitcnt vmcnt(0)" ::: "memory");
        }
    }
    __syncthreads();
}
struct Ctx { LAS unsigned char* lds; int tid, lane, wave, vcu, G; };
struct Args { const float* in[19]; float* out; unsigned char* ws; int ph_lo, ph_hi; };

typedef short v4i16_t __attribute__((ext_vector_type(4)));
__device__ __forceinline__ s16x4 trr(LAS unsigned char* p) { return __builtin_bit_cast(s16x4, __builtin_amdgcn_ds_read_tr16_b64_v4i16((LAS v4i16_t*)p)); }
__device__ __forceinline__ bf16x8 cat8(s16x4 lo, s16x4 hi) { return (bf16x8){lo[0], lo[1], lo[2], lo[3], hi[0], hi[1], hi[2], hi[3]}; }
__device__ __forceinline__ float incl_sum_up(float v, int lane) {
#pragma unroll
    for (int o = 1; o < 64; o <<= 1) { const float t = __shfl_up(v, o); if (lane >= o) v += t; }
    return v;
}
__device__ __forceinline__ float incl_max_up(float v, int lane) {
#pragma unroll
    for (int o = 1; o < 64; o <<= 1) { const float t = __shfl_up(v, o); if (lane >= o) v = fmaxf(v, t); }
    return v;
}
__device__ __forceinline__ float incl_max_down(float v, int lane) {
#pragma unroll
    for (int o = 1; o < 64; o <<= 1) { const float t = __shfl_down(v, o); if (lane + o < 64) v = fmaxf(v, t); }
    return v;
}
__device__ __forceinline__ v4u scale8(v4u q, float s) {
    v4u o; o.x = pk2(bflo(q.x) * s, bfhi(q.x) * s); o.y = pk2(bflo(q.y) * s, bfhi(q.y) * s); o.z = pk2(bflo(q.z) * s, bfhi(q.z) * s); o.w = pk2(bflo(q.w) * s, bfhi(q.w) * s); return o;
}

__device__ __forceinline__ float sat8(float x) { return fminf(fmaxf(x, -448.f), 448.f); }
__device__ __forceinline__ void tr_item(const float* __restrict__ W, int ldw, int K, bf16* __restrict__ WT, int n_src0, int n_dst0, int k0, LAS unsigned char* scr, int lane) {
    const int nq = lane & 15, kg = lane >> 4;
    const float* src = W + (size_t)(k0 + 4 * kg) * ldw + n_src0 + 4 * nq;
    f32x4 rr[4][4];
#pragma unroll
    for (int j = 0; j < 4; ++j)
#pragma unroll
        for (int q = 0; q < 4; ++q) rr[j][q] = *(const f32x4*)(src + (size_t)(16 * j + q) * ldw);
    __builtin_amdgcn_sched_barrier(0);
#pragma unroll
    for (int j = 0; j < 4; ++j) {
#pragma unroll
        for (int c = 0; c < 4; ++c) { LAS unsigned* d = (LAS unsigned*)(scr + (4 * nq + c) * 132 + (16 * j + 4 * kg) * 2); d[0] = pk2(rr[j][0][c], rr[j][1][c]); d[1] = pk2(rr[j][2][c], rr[j][3][c]); }
    }
    const int row8 = lane >> 3, c8 = lane & 7;
#pragma unroll
    for (int jj = 0; jj < 8; ++jj) { const int row = row8 + 8 * jj; LAS unsigned char* rp = scr + row * 132 + 16 * c8;
        v4u o; o.x = *(LAS unsigned*)rp; o.y = *(LAS unsigned*)(rp + 4); o.z = *(LAS unsigned*)(rp + 8); o.w = *(LAS unsigned*)(rp + 12);
        *(v4u*)(WT + (size_t)(n_dst0 + row) * K + k0 + 8 * c8) = o; }
}
constexpr float W8SCALE = 64.f, W8INV = 1.f / 64.f;
__device__ __forceinline__ void tr8_item(const float* __restrict__ W, int ldw, int Kb, unsigned char* __restrict__ WT, int n0, int k0, LAS unsigned char* scr, int lane) {
    const int nq = lane & 15, kg = lane >> 4;
    const float* src = W + (size_t)(k0 + 4 * kg) * ldw + n0 + 4 * nq;
#pragma unroll
    for (int jh = 0; jh < 2; ++jh) {
        f32x4 rr[4][4];
#pragma unroll
        for (int j = 0; j < 4; ++j)
#pragma unroll
            for (int q = 0; q < 4; ++q) rr[j][q] = *(const f32x4*)(src + (size_t)(16 * (4 * jh + j) + q) * ldw);
        __builtin_amdgcn_sched_barrier(0);
#pragma unroll
        for (int j = 0; j < 4; ++j)
#pragma unroll
            for (int c = 0; c < 4; ++c) { int w = 0; w = __builtin_amdgcn_cvt_pk_fp8_f32(rr[j][0][c] * W8SCALE, rr[j][1][c] * W8SCALE, w, false); w = __builtin_amdgcn_cvt_pk_fp8_f32(rr[j][2][c] * W8SCALE, rr[j][3][c] * W8SCALE, w, true);
                *(LAS int*)(scr + (4 * nq + c) * 132 + 16 * (4 * jh + j) + 4 * kg) = w; }
        __builtin_amdgcn_sched_barrier(0);
    }
    const int row8 = lane >> 3, c8 = lane & 7;
#pragma unroll
    for (int jj = 0; jj < 8; ++jj) { const int row = row8 + 8 * jj; LAS unsigned char* rp = scr + row * 132 + 16 * c8;
        v4u o; o.x = *(LAS unsigned*)rp; o.y = *(LAS unsigned*)(rp + 4); o.z = *(LAS unsigned*)(rp + 8); o.w = *(LAS unsigned*)(rp + 12);
        *(v4u*)(WT + (size_t)(n0 + row) * Kb + k0 + 16 * c8) = o; }
}
__device__ __forceinline__ void p0_transposes(const Ctx& C, const Args& a) {
    const float* w_in = a.in[2]; const float* w_ml = a.in[5]; const float* w_da = a.in[10]; const float* w_o = a.in[11]; const float* w_gu = a.in[15]; const float* w_dn = a.in[17];
    bf16* WIN = (bf16*)(a.ws + WS_WIN); bf16* WML = (bf16*)(a.ws + WS_WML); bf16* WDA = (bf16*)(a.ws + WS_WDA); bf16* WO = (bf16*)(a.ws + WS_WO);
    const int gw = C.vcu * NWAVES + C.wave, NGW = C.G * NWAVES;
    constexpr int I_IN = 32 * 96, I_IN8 = 16 * 64;
    constexpr int NIT = I_IN + I_IN8;
    LAS unsigned char* scr = C.lds + C.wave * 8448;
    for (int it = gw; it < NIT; it += NGW) {
        int r = it;
        if (r < I_IN) { const int kb = r / 96, nb = r % 96, nd = nb * 64; tr_item(w_in, DIN, D, WIN, nd < G_OFF ? nd : nd + 16, nd, kb * 64, scr, C.lane); continue; } r -= I_IN;
        { const int kb = r / 64, nb = r % 64; tr8_item(w_in + (P_GM + 16), DIN, D, (unsigned char*)(a.ws + WS_WIN8), nb * 64, kb * 128, scr, C.lane); }
    }
    (void)w_ml; (void)w_da; (void)w_o; (void)WML; (void)WDA; (void)WO;
    __syncthreads();
}
__device__ __forceinline__ void p2_late_transposes(const Ctx& C, const Args& a) {
    const float* w_ml = a.in[5]; const float* w_da = a.in[10]; const float* w_o = a.in[11];
    bf16* WML = (bf16*)(a.ws + WS_WML); bf16* WDA = (bf16*)(a.ws + WS_WDA); bf16* WO = (bf16*)(a.ws + WS_WO);
    const int gw = C.vcu * NWAVES + C.wave, NGW = C.G * NWAVES;
    constexpr int I_ML = 16 * 32, I_O = 32 * 32, NIT = 2 * I_ML + I_O;
    LAS unsigned char* scr = C.lds + C.wave * 8448;
    for (int it = gw; it < NIT; it += NGW) {
        int r = it;
        if (r < I_ML) { const int kb = r / 32, nb = r % 32; tr_item(w_ml, D, MLW, WML, nb * 64, nb * 64, kb * 64, scr, C.lane); continue; } r -= I_ML;
        if (r < I_ML) { const int kb = r / 32, nb = r % 32; tr_item(w_da, D, DAW, WDA, nb * 64, nb * 64, kb * 64, scr, C.lane); continue; } r -= I_ML;
        { const int kb = r / 32, nb = r % 32; tr_item(w_o, D, D, WO, nb * 64, nb * 64, kb * 64, scr, C.lane); }
    }
    __syncthreads();
}
constexpr int CV_J_GU = 16 * 64, CV_J_DN = 16 * 32, CV_NJ = NE * (CV_J_GU + CV_J_DN);
struct ConvSet { f32x4 r[8]; };
struct Conv { int it, step; ConvSet s[2]; };
struct ConvItem { const float* src; unsigned char* dst; int ldw, Kb; };
__device__ __forceinline__ ConvItem conv_item(const Args& a, int it) {
    const float* w_gu = a.in[15]; const float* w_dn = a.in[17]; ConvItem ci;
    if (it < NE * CV_J_GU) { const int e = it / CV_J_GU, q = it % CV_J_GU, kb = q / 64, nb = q % 64; ci.ldw = 2 * DE; ci.Kb = D;
        ci.src = w_gu + (size_t)e * D * 2 * DE + (size_t)(kb * 128) * (2 * DE) + nb * 64;
        ci.dst = a.ws + WS_WGU + (size_t)e * 2 * DE * D + (size_t)(nb * 64) * D + kb * 128; }
    else { const int r = it - NE * CV_J_GU, e = r / CV_J_DN, q = r % CV_J_DN, kb = q / 32, nb = q % 32; ci.ldw = D; ci.Kb = DE;
        ci.src = w_dn + (size_t)e * DE * D + (size_t)(kb * 128) * D + nb * 64;
        ci.dst = a.ws + WS_WDN + (size_t)e * D * DE + (size_t)(nb * 64) * DE + kb * 128; }
    return ci;
}
__device__ __forceinline__ const char* uni_ptr(const void* p) { const unsigned long long v = (unsigned long long)p; const unsigned lo = __builtin_amdgcn_readfirstlane((unsigned)v), hi = __builtin_amdgcn_readfirstlane((unsigned)(v >> 32)); return (const char*)(((unsigned long long)hi << 32) | lo); }
struct ConvSrc { const float* src; int ldw; };
__device__ __forceinline__ ConvSrc conv_src(const Args& a, int it) { const int itc = it < CV_NJ ? it : CV_NJ - 1; const ConvItem ci = conv_item(a, __builtin_amdgcn_readfirstlane(itc)); ConvSrc s; s.src = ci.src; s.ldw = ci.ldw; return s; }
__device__ __forceinline__ unsigned conv_loff(const ConvSrc& cs, int lane) { return ((unsigned)(4 * (lane >> 4)) * (unsigned)cs.ldw + 4u * (lane & 15)) * 4u; }
__device__ __forceinline__ void conv_issue_one(ConvSet& S, const ConvSrc& cs, unsigned loff, int st, int q) {
    const char* sb = (const char*)(cs.src + (size_t)(16 * (2 * st + (q >> 2)) + (q & 3)) * cs.ldw);
    asm volatile("global_load_dwordx4 %0, %1, %2 nt" : "=v"(S.r[q]) : "v"(loff), "s"(sb) : "memory");
}
__device__ __forceinline__ void conv_issue(ConvSet& S, const Args& a, int it, int st, int lane) {
    const ConvSrc cs = conv_src(a, it); const unsigned loff = conv_loff(cs, lane);
#pragma unroll
    for (int q = 0; q < 8; ++q) conv_issue_one(S, cs, loff, st, q);
}
__device__ __forceinline__ void conv_next(int& it, int& st, int NGW) { if (st == 3) { st = 0; it += NGW; } else ++st; }
__device__ __forceinline__ void conv_begin(Conv& cv, const Args& a, int gw, int NGW, int lane) { cv.it = gw; cv.step = 0; conv_issue(cv.s[0], a, cv.it, cv.step, lane); }
__device__ __forceinline__ void conv_issue_next(Conv& cv, ConvSet& S, const Args& a, int NGW, int lane) { int it1 = cv.it, st1 = cv.step; conv_next(it1, st1, NGW); conv_issue(S, a, it1, st1, lane); }
template <int NW> __device__ __forceinline__ bool conv_consume(Conv& cv, ConvSet& S, const Args& a, LAS unsigned char* scr, int NGW, int lane) {
    if constexpr (NW == 12) asm volatile("s_waitcnt vmcnt(12)" : "+v"(S.r[0]), "+v"(S.r[1]), "+v"(S.r[2]), "+v"(S.r[3]), "+v"(S.r[4]), "+v"(S.r[5]), "+v"(S.r[6]), "+v"(S.r[7]) :: "memory");
    else if constexpr (NW == 8) asm volatile("s_waitcnt vmcnt(8)" : "+v"(S.r[0]), "+v"(S.r[1]), "+v"(S.r[2]), "+v"(S.r[3]), "+v"(S.r[4]), "+v"(S.r[5]), "+v"(S.r[6]), "+v"(S.r[7]) :: "memory");
    else asm volatile("s_waitcnt vmcnt(0)" : "+v"(S.r[0]), "+v"(S.r[1]), "+v"(S.r[2]), "+v"(S.r[3]), "+v"(S.r[4]), "+v"(S.r[5]), "+v"(S.r[6]), "+v"(S.r[7]) :: "memory");
    const int nq = lane & 15, kg = lane >> 4; const bool st = (cv.it < CV_NJ) && cv.step == 3;
#pragma unroll
    for (int jj = 0; jj < 2; ++jj) { const int j = 2 * cv.step + jj;
#pragma unroll
        for (int c = 0; c < 4; ++c) { int w = 0; w = __builtin_amdgcn_cvt_pk_fp8_f32(S.r[4 * jj + 0][c] * W8SCALE, S.r[4 * jj + 1][c] * W8SCALE, w, false);
            w = __builtin_amdgcn_cvt_pk_fp8_f32(S.r[4 * jj + 2][c] * W8SCALE, S.r[4 * jj + 3][c] * W8SCALE, w, true);
            *(LAS int*)(scr + (4 * nq + c) * 132 + 16 * j + 4 * kg) = w; } }
    if (st) {
        const ConvItem ci = conv_item(a, __builtin_amdgcn_readfirstlane(cv.it));
        const int row8 = lane >> 3, c8 = lane & 7;
#pragma unroll 2
        for (int jj = 0; jj < 8; ++jj) { const int row = row8 + 8 * jj; LAS unsigned char* rp = scr + row * 132 + 16 * c8;
            v4u o; o.x = *(LAS unsigned*)rp; o.y = *(LAS unsigned*)(rp + 4); o.z = *(LAS unsigned*)(rp + 8); o.w = *(LAS unsigned*)(rp + 12);
            *(v4u*)(ci.dst + (size_t)row * ci.Kb + 16 * c8) = o; }
    }
    conv_next(cv.it, cv.step, NGW);
    return st;
}
__device__ __forceinline__ void p0_xn_gates(const Ctx& C, const Args& a) {
    const float* x = a.in[0]; const float* g1 = a.in[1]; const float* w_in = a.in[2]; const float* gbias = a.in[3];
    bf16* XN = (bf16*)(a.ws + WS_XN); float* MG = (float*)(a.ws + WS_MG);
    for (int idx = C.tid; idx < D * 4; idx += NTHR) {
        const int k = idx >> 2, c = idx & 3; const f32x4 w = *(const f32x4*)(w_in + (size_t)k * DIN + G_OFF + 4 * c);
        const int r = (k & 3) * 512 + (k >> 2);
        *(LAS f32x4*)(C.lds + r * 64 + ((c ^ ((r >> 2) & 3)) * 16)) = w;
    }
    __syncthreads();
    const int gw = C.vcu * NWAVES + C.wave, NGW = C.G * NWAVES, lane = C.lane;
    f32x4 g1r[8];
#pragma unroll
    for (int j = 0; j < 8; ++j) g1r[j] = *((const f32x4*)g1 + lane + 64 * j);
    for (int m = gw; m < T; m += NGW) {
        const f32x4* xr = (const f32x4*)(x + (size_t)m * D) + lane; f32x4 v[8]; float ss = 0.f;
#pragma unroll
        for (int j = 0; j < 8; ++j) { v[j] = xr[64 * j]; ss += (v[j].x * v[j].x + v[j].y * v[j].y) + (v[j].z * v[j].z + v[j].w * v[j].w); }
        const float rstd = rsqrtf(wave_sum(ss) * (1.f / D) + EPS);
        float acc[16];
#pragma unroll
        for (int i = 0; i < 16; ++i) acc[i] = 0.f;
        int lb = lane * 64; asm volatile("" : "+v"(lb));
        int lbase[4];
#pragma unroll
        for (int c = 0; c < 4; ++c) lbase[c] = lb + ((c ^ ((lane >> 2) & 3)) << 4);
#pragma unroll
        for (int j = 0; j < 8; ++j) {
            const f32x4 g = g1r[j];
            v[j].x *= rstd * g.x; v[j].y *= rstd * g.y; v[j].z *= rstd * g.z; v[j].w *= rstd * g.w;
            v2u o; o.x = pk2(v[j].x, v[j].y); o.y = pk2(v[j].z, v[j].w);
            *((v2u*)(XN + (size_t)m * D) + lane + 64 * j) = o;
            { int o8 = 0; o8 = __builtin_amdgcn_cvt_pk_fp8_f32(v[j].x, v[j].y, o8, false); o8 = __builtin_amdgcn_cvt_pk_fp8_f32(v[j].z, v[j].w, o8, true); *((int*)(a.ws + WS_XN8 + (size_t)m * D) + lane + 64 * j) = o8; }
#pragma unroll
            for (int i = 0; i < 4; ++i) {
                const float hv = v[j][i];
#pragma unroll
                for (int c = 0; c < 4; ++c) { const f32x4 w = *(const LAS f32x4*)(C.lds + lbase[c] + (i * 512 + 64 * j) * 64);
                    acc[4 * c + 0] += hv * w.x; acc[4 * c + 1] += hv * w.y; acc[4 * c + 2] += hv * w.z; acc[4 * c + 3] += hv * w.w; }
            }
        }
        float mine = 0.f;
#pragma unroll
        for (int i = 0; i < 16; ++i) { const float s = wave_sum(acc[i]); if (lane == i) mine = s; }
        if (lane < 16) MG[(size_t)m * 16 + lane] = mine + gbias[lane];
    }
}
__device__ __forceinline__ void p0_router_w(const Ctx& C, const Args& a) {
    const float* wr = a.in[13]; const float* g2 = a.in[12]; bf16* WRH = (bf16*)(a.ws + WS_WRH); bf16* WRL = (bf16*)(a.ws + WS_WRL);
    for (int g = C.vcu * NTHR + C.tid; g < D * NE; g += C.G * NTHR) { const int k = g >> 5, e = g & 31; const float w = wr[g] * g2[k];
        const int q = k & 15, idx = (((k >> 4) * 64) + ((q >> 2) & 1) * 32 + e) * 8 + (q >> 3) * 4 + (q & 3);
        const bf16 hi = f2bf(w); const bf16 lo = f2bf(w - bf2f(hi)); WRH[idx] = hi; WRL[idx] = lo; }
}
__device__ __forceinline__ void p0_rope(const Ctx& C, const Args& a) {
    float* ROPE = (float*)(a.ws + WS_ROPE);
    for (int g = C.vcu * NTHR + C.tid; g < S * 32; g += C.G * NTHR) {
        const int pos = g >> 5, i = g & 31;
        const double inv = exp2(-(double)i * (13.287712379549449 / 32.0));
        const double rev = (double)pos * inv * 0.15915494309189535;
        const double fr = rev - floor(rev + 0.5);
        const float ang = (float)(fr * 6.283185307179586);
        f32x2 cs; cs.x = cosf(ang); cs.y = sinf(ang);
        *(f32x2*)(ROPE + 2 * g) = cs;
    }
}

template <bool GATES8> struct EpiProj {
    static constexpr bool PERM = true, AFTER_DRAIN = false;
    bf16* O; unsigned char* G8;
    __device__ __forceinline__ void operator()(const pg8::f32x4 (&acc)[2][2][4][2], const pg8::Unit& u, int wr, int wc, int fr, int fq) const {
        const int pn = GATES8 ? u.pn + 24 : u.pn;
        const int row0 = u.pm * 256 + wr * 64 + fr, col0 = pn * 256 + wc * 32 + 8 * fq;
        const int mode = (pn == 2 || pn == 3) ? 1 : (((pn >= 8 && pn < 12) || pn >= 24) ? 2 : 0);
#pragma unroll
        for (int ai = 0; ai < 2; ++ai)
#pragma unroll
            for (int m = 0; m < 4; ++m) { bf16* rowp = O + (size_t)(row0 + ai * 128 + m * 16) * NPJ + col0;
#pragma unroll
                for (int bj = 0; bj < 2; ++bj) { pg8::f32x4 v0 = acc[ai][bj][m][0], v1 = acc[ai][bj][m][1];
                    if (GATES8) { v0 = v0 * W8INV; v1 = v1 * W8INV; }
                    if (mode == 1) { v0 = v0 * KSCALE; v1 = v1 * KSCALE; }
                    if (mode == 2) {
#pragma unroll
                        for (int i = 0; i < 4; ++i) { v0[i] = sigmoidf_(v0[i]); v1[i] = sigmoidf_(v1[i]); } }
                    if (GATES8) {
                        const unsigned q[8] = {(unsigned)__builtin_rintf(v0[0] * 255.f), (unsigned)__builtin_rintf(v0[1] * 255.f), (unsigned)__builtin_rintf(v0[2] * 255.f), (unsigned)__builtin_rintf(v0[3] * 255.f),
                                               (unsigned)__builtin_rintf(v1[0] * 255.f), (unsigned)__builtin_rintf(v1[1] * 255.f), (unsigned)__builtin_rintf(v1[2] * 255.f), (unsigned)__builtin_rintf(v1[3] * 255.f)};
                        v2u w; w.x = q[0] | (q[1] << 8) | (q[2] << 16) | (q[3] << 24); w.y = q[4] | (q[5] << 8) | (q[6] << 16) | (q[7] << 24);
                        *(v2u*)(G8 + (size_t)(row0 + ai * 128 + m * 16) * 4096 + u.pn * 256 + wc * 32 + 8 * fq + bj * 128) = w;
                    } else {
                    v4u w; w.x = pk2(v0[0], v0[1]); w.y = pk2(v0[2], v0[3]); w.z = pk2(v1[0], v1[1]); w.w = pk2(v1[2], v1[3]);
                    *(v4u*)(rowp + bj * 128) = w; } } }
    }
};
__device__ __forceinline__ void gate8(const unsigned char* G8, size_t row, int gcol, float (&g)[8]) {
    const v2u w = *(const v2u*)(G8 + row * 4096 + gcol); const float s = 1.f / 255.f;
    g[0] = (float)(w.x & 0xff) * s; g[1] = (float)((w.x >> 8) & 0xff) * s; g[2] = (float)((w.x >> 16) & 0xff) * s; g[3] = (float)(w.x >> 24) * s;
    g[4] = (float)(w.y & 0xff) * s; g[5] = (float)((w.y >> 8) & 0xff) * s; g[6] = (float)((w.y >> 16) & 0xff) * s; g[7] = (float)(w.y >> 24) * s;
}
template <int MODE> struct EpiGate {
    static constexpr bool PERM = true, AFTER_DRAIN = false;
    const bf16* PROJ; const bf16* T1in; bf16* O;
    __device__ __forceinline__ void operator()(const pg8::f32x4 (&acc)[2][2][4][2], const pg8::Unit& u, int wr, int wc, int fr, int fq) const {
        const int row0 = u.pm * 256 + wr * 64 + fr, col0 = u.pn * 256 + wc * 32 + 8 * fq;
#pragma unroll
        for (int ai = 0; ai < 2; ++ai)
#pragma unroll
            for (int m = 0; m < 4; ++m) { const size_t row = (size_t)(row0 + ai * 128 + m * 16);
#pragma unroll
                for (int bj = 0; bj < 2; ++bj) { const int col = col0 + bj * 128; const pg8::f32x4 v0 = acc[ai][bj][m][0], v1 = acc[ai][bj][m][1];
                    float g[8]; gate8((const unsigned char*)PROJ, row, (MODE ? 2048 : 0) + col, g);
                    float o[8] = {g[0] * v0[0], g[1] * v0[1], g[2] * v0[2], g[3] * v0[3], g[4] * v1[0], g[5] * v1[1], g[6] * v1[2], g[7] * v1[3]};
                    if (MODE == 1) { const v4u t = *(const v4u*)(T1in + row * D + col);
                        o[0] += bflo(t.x); o[1] += bfhi(t.x); o[2] += bflo(t.y); o[3] += bfhi(t.y); o[4] += bflo(t.z); o[5] += bfhi(t.z); o[6] += bflo(t.w); o[7] += bfhi(t.w); }
                    v4u w; w.x = pk2(o[0], o[1]); w.y = pk2(o[2], o[3]); w.z = pk2(o[4], o[5]); w.w = pk2(o[6], o[7]);
                    *(v4u*)(O + row * D + col) = w; } }
    }
};
struct EpiGatePair {
    static constexpr bool PERM = true, AFTER_DRAIN = false;
    const bf16* PROJ; bf16* T1; bf16* MIX;
    __device__ __forceinline__ void operator()(const pg8::f32x4 (&acc)[2][2][4][2], const pg8::Unit& u, int wr, int wc, int fr, int fq) const {
        const bool second = u.pm >= T / 256; const int pmr = second ? u.pm - T / 256 : u.pm;
        const int row0 = pmr * 256 + wr * 64 + fr, col0 = u.pn * 256 + wc * 32 + 8 * fq; const int gcol = second ? 2048 : 0; bf16* O = second ? MIX : T1;
        const unsigned char* G8 = (const unsigned char*)PROJ;
#pragma unroll
        for (int ai = 0; ai < 2; ++ai) {
            v2u gw[4][2]; v4u tw[4][2];
#pragma unroll
            for (int m = 0; m < 4; ++m)
#pragma unroll
                for (int bj = 0; bj < 2; ++bj) { const size_t row = (size_t)(row0 + ai * 128 + m * 16); const int col = col0 + bj * 128;
                    gw[m][bj] = *(const v2u*)(G8 + row * 4096 + gcol + col); if (second) tw[m][bj] = *(const v4u*)(T1 + row * D + col); }
            __builtin_amdgcn_sched_barrier(0);
#pragma unroll
            for (int m = 0; m < 4; ++m) { const size_t row = (size_t)(row0 + ai * 128 + m * 16);
#pragma unroll
                for (int bj = 0; bj < 2; ++bj) { const int col = col0 + bj * 128; const pg8::f32x4 v0 = acc[ai][bj][m][0], v1 = acc[ai][bj][m][1];
                    const v2u w8 = gw[m][bj]; const float s = 1.f / 255.f;
                    const float g[8] = {(float)(w8.x & 0xff) * s, (float)((w8.x >> 8) & 0xff) * s, (float)((w8.x >> 16) & 0xff) * s, (float)(w8.x >> 24) * s,
                                        (float)(w8.y & 0xff) * s, (float)((w8.y >> 8) & 0xff) * s, (float)((w8.y >> 16) & 0xff) * s, (float)(w8.y >> 24) * s};
                    float o[8] = {g[0] * v0[0], g[1] * v0[1], g[2] * v0[2], g[3] * v0[3], g[4] * v1[0], g[5] * v1[1], g[6] * v1[2], g[7] * v1[3]};
                    if (second) { const v4u t = tw[m][bj];
                        o[0] += bflo(t.x); o[1] += bfhi(t.x); o[2] += bflo(t.y); o[3] += bfhi(t.y); o[4] += bflo(t.z); o[5] += bfhi(t.z); o[6] += bflo(t.w); o[7] += bfhi(t.w); }
                    v4u w; w.x = pk2(o[0], o[1]); w.y = pk2(o[2], o[3]); w.z = pk2(o[4], o[5]); w.w = pk2(o[6], o[7]);
                    *(v4u*)(O + row * D + col) = w; } }
            __builtin_amdgcn_sched_barrier(0);
        }
    }
};
struct PairOrder {
    pg8::StaticOrder so;
    __device__ __forceinline__ bool next(int i, pg8::Unit& u) const {
        const int per = so.nwg / so.G;
        if (i >= 2 * per) return false;
        const bool second = i >= per; if (!so.next(second ? i - per : i, u)) return false;
        if (second) { u.pm += T / 256; u.pb += D / 256; }
        return true;
    }
    __device__ __forceinline__ void a_ready(const pg8::Unit&) const {}
    __device__ __forceinline__ void done(const pg8::Unit&) const {}
    __device__ __forceinline__ int rot() const { return 0; }
};
struct EpiRes {
    static constexpr bool PERM = false, AFTER_DRAIN = false;
    const float* X; float* O;
    __device__ __forceinline__ void operator()(const pg8::f32x4 (&acc)[2][2][4][2], const pg8::Unit& u, int wr, int wc, int fr, int fq) const {
        const int row0 = u.pm * 256 + wr * 64 + fr, col0 = u.pn * 256 + wc * 32 + 4 * fq;
#pragma unroll
        for (int ai = 0; ai < 2; ++ai) { pg8::f32x4 xv[4][2][2];
#pragma unroll
            for (int m = 0; m < 4; ++m) { const size_t off = (size_t)(row0 + ai * 128 + m * 16) * D + col0;
#pragma unroll
                for (int bj = 0; bj < 2; ++bj)
#pragma unroll
                    for (int n = 0; n < 2; ++n) xv[m][bj][n] = *(const pg8::f32x4*)(X + off + bj * 128 + n * 16); }
            __builtin_amdgcn_sched_barrier(0);
#pragma unroll
            for (int m = 0; m < 4; ++m) { const size_t off = (size_t)(row0 + ai * 128 + m * 16) * D + col0;
#pragma unroll
                for (int bj = 0; bj < 2; ++bj)
#pragma unroll
                    for (int n = 0; n < 2; ++n) *(pg8::f32x4*)(O + off + bj * 128 + n * 16) = xv[m][bj][n] + acc[ai][bj][m][n]; }
            __builtin_amdgcn_sched_barrier(0); }
    }
};
struct EpiAct {
    static constexpr bool PERM = true, AFTER_DRAIN = false;
    const float* bias; unsigned char* O;
    __device__ __forceinline__ void operator()(const pg8::f32x4 (&acc)[2][2][4][2], const pg8::Unit& u, int wr, int wc, int fr, int fq) const {
        const int row0 = u.pm * 256 + wr * 64 + fr, col0 = u.pn * 256 + wc * 32 + 8 * fq, e = u.pb >> 4;
        pg8::f32x4 bv[2][2];
#pragma unroll
        for (int bj = 0; bj < 2; ++bj)
#pragma unroll
            for (int n = 0; n < 2; ++n) bv[bj][n] = *(const pg8::f32x4*)(bias + (size_t)e * 2 * DE + col0 + bj * 128 + 4 * n);
#pragma unroll
        for (int ai = 0; ai < 2; ++ai)
#pragma unroll
            for (int m = 0; m < 4; ++m) { const size_t row = (size_t)(row0 + ai * 128 + m * 16);
#pragma unroll
                for (int bj = 0; bj < 2; ++bj) { const pg8::f32x4 v0 = acc[ai][bj][m][0] * W8INV + bv[bj][0], v1 = acc[ai][bj][m][1] * W8INV + bv[bj][1];
                    const float gu[8] = {v0[0], v0[1], v0[2], v0[3], v1[0], v1[1], v1[2], v1[3]}; float o[4];
#pragma unroll
                    for (int p = 0; p < 4; ++p) { const float glu = fminf(gu[2 * p], 7.f), lin = fminf(fmaxf(gu[2 * p + 1], -7.f), 7.f); o[p] = glu * sigmoidf_(1.702f * glu) * (lin + 1.f); }
                    int w = 0; w = __builtin_amdgcn_cvt_pk_fp8_f32(o[0], o[1], w, false); w = __builtin_amdgcn_cvt_pk_fp8_f32(o[2], o[3], w, true);
                    *(int*)(O + row * DE + ((col0 + bj * 128) >> 1)) = w; } }
    }
};
struct EpiY {
    static constexpr bool PERM = true, AFTER_DRAIN = false;
    const float* bias; bf16* O;
    __device__ __forceinline__ void operator()(const pg8::f32x4 (&acc)[2][2][4][2], const pg8::Unit& u, int wr, int wc, int fr, int fq) const {
        const int row0 = u.pm * 256 + wr * 64 + fr, col0 = u.pn * 256 + wc * 32 + 8 * fq, e = u.pb >> 3;
        pg8::f32x4 bv[2][2];
#pragma unroll
        for (int bj = 0; bj < 2; ++bj)
#pragma unroll
            for (int n = 0; n < 2; ++n) bv[bj][n] = *(const pg8::f32x4*)(bias + (size_t)e * D + col0 + bj * 128 + 4 * n);
#pragma unroll
        for (int ai = 0; ai < 2; ++ai)
#pragma unroll
            for (int m = 0; m < 4; ++m) { const size_t row = (size_t)(row0 + ai * 128 + m * 16);
#pragma unroll
                for (int bj = 0; bj < 2; ++bj) { const pg8::f32x4 v0 = acc[ai][bj][m][0] * W8INV + bv[bj][0], v1 = acc[ai][bj][m][1] * W8INV + bv[bj][1];
                    int a0 = 0, a1 = 0; a0 = __builtin_amdgcn_cvt_pk_fp8_f32(sat8(v0[0]), sat8(v0[1]), a0, false); a0 = __builtin_amdgcn_cvt_pk_fp8_f32(sat8(v0[2]), sat8(v0[3]), a0, true);
                    a1 = __builtin_amdgcn_cvt_pk_fp8_f32(sat8(v1[0]), sat8(v1[1]), a1, false); a1 = __builtin_amdgcn_cvt_pk_fp8_f32(sat8(v1[2]), sat8(v1[3]), a1, true);
                    v2u w; w.x = (unsigned)a0; w.y = (unsigned)a1;
                    *(v2u*)((unsigned char*)O + row * D + col0 + bj * 128) = w; } }
    }
};
struct MoeSched {
    int tsl, fin, hin, fl, F, total, NT, G, c;
    __device__ __forceinline__ void init(const int* cnt, int NT_, int G_, int c_, int lane) {
        const int cn = lane < NE ? cnt[lane] : 0, f = cn / PADM, r = cn - f * PADM;
        const int full = f + (r > PADM / 2 ? 1 : 0), half = (r > 0 && r <= PADM / 2) ? 1 : 0, tiles = full + half;
        int it = tiles, iff = full, ih = half;
#pragma unroll
        for (int o = 1; o < 32; o <<= 1) { const int t0 = __shfl_up(it, o), t1 = __shfl_up(iff, o), t2 = __shfl_up(ih, o); if (lane >= o) { it += t0; iff += t1; ih += t2; } }
        F = __shfl(iff, 31); total = F + __shfl(ih, 31);
        tsl = it - tiles; fl = full; fin = lane < NE ? iff : 0x7fffffff; hin = lane < NE ? ih : 0x7fffffff; NT = NT_; G = G_; c = c_;
    }
    __device__ __forceinline__ bool next(int i, pg8::Unit& u) const {
        int mo, pn;
        if (G == 256) { const int x = c & 7, jj = c >> 3, NPB = NT >> 3, RPM = (8 / NPB) * 4;
            mo = i * RPM + (x / NPB) * 4 + (jj & 3); pn = (x % NPB) * 8 + (jj >> 2); }
        else { const long L = (long)i * G + c; mo = (int)(L / NT); pn = (int)(L % NT); }
        if (mo >= total) return false;
        int e, mt, hf;
        if (mo < F) { e = __popcll(__ballot(fin <= mo)); mt = __shfl(tsl, e) + (mo - (__shfl(fin, e) - __shfl(fl, e))); hf = 0; }
        else { e = __popcll(__ballot(hin <= mo - F)); mt = __shfl(tsl, e) + __shfl(fl, e); hf = 1; }
        u.pm = mt; u.pn = pn; u.pb = e * NT + pn; u.half = __builtin_amdgcn_readfirstlane(hf); return true;
    }
    __device__ __forceinline__ void a_ready(const pg8::Unit&) const {}
    __device__ __forceinline__ void done(const pg8::Unit&) const {}
    __device__ __forceinline__ int rot() const { const int jj = c >> 3; return G == 256 ? ((jj >> 2) + (jj & 3)) & 15 : 0; }
};

__device__ __forceinline__ void p2_mstats(const Ctx& C, const Args& a) {
    const float* MG = (const float*)(a.ws + WS_MG); float* GA = (float*)(a.ws + WS_MSC);
    const int gw = C.vcu * NWAVES + C.wave, NGW = C.G * NWAVES, lane = C.lane;
    for (int q = gw; q < 16 * 64; q += NGW) {
        const int chain = q >> 6, c = q & 63, dir = chain & 1, hh = (chain >> 1) & 3, b = chain >> 3;
        const int p = b * S + 64 * c + (dir ? 63 - lane : lane);
        const float lf = logsigf_(MG[(size_t)p * 16 + (dir ? 12 : 4) + hh]), ig = MG[(size_t)p * 16 + (dir ? 8 : 0) + hh];
        const float bs = incl_sum_up(lf, lane), g = __shfl(bs, 63), amax = g + wave_max(ig - bs);
        if (lane == 0) { f32x2 o; o.x = g; o.y = amax; *(f32x2*)(GA + (size_t)q * 2) = o; }
    }
}
struct MScan { float mprev, mnew, dec; };
__device__ __forceinline__ float rdlane(float v, int l) { return __int_as_float(__builtin_amdgcn_readlane(__float_as_int(v), l)); }
__device__ __forceinline__ MScan mscan_ga(const f32x2 ga, int dir, int lane);
__device__ __forceinline__ MScan mscan(const float* GA, int chain, int lane) { return mscan_ga(*(const f32x2*)(GA + (size_t)(chain * 64 + lane) * 2), chain & 1, lane); }
__device__ __forceinline__ MScan mscan_ga(const f32x2 ga, int dir, int lane) {
    float G = ga.x, A = ga.y;
#pragma unroll
    for (int o = 1; o < 64; o <<= 1) { const float Gp = dir ? __shfl_down(G, o) : __shfl_up(G, o), Ap = dir ? __shfl_down(A, o) : __shfl_up(A, o);
        const bool ok = dir ? (lane + o < 64) : (lane >= o); if (ok) { A = fmaxf(Ap + G, A); G = Gp + G; } }
    MScan r; r.mnew = fmaxf(G, A);
    const float mp = dir ? __shfl_down(r.mnew, 1) : __shfl_up(r.mnew, 1); r.mprev = (dir ? lane == 63 : lane == 0) ? 0.f : mp;
    r.dec = __expf(ga.x + r.mprev - r.mnew);
    return r;
}
constexpr size_t WS_MSV = WS_MSC + 65536;
__device__ __forceinline__ MScan mscan_ld(const unsigned char* ws, int chain, int lane) { const f32x4 v = *(const f32x4*)(ws + WS_MSV + (size_t)(chain * 64 + lane) * 16); MScan r; r.mprev = v.x; r.mnew = v.y; r.dec = v.z; return r; }
__device__ __forceinline__ void p2_qkprep(const Ctx& C, const Args& a) {
    const bf16* PROJ = (const bf16*)(a.ws + WS_PROJ); const float* ROPE = (const float*)(a.ws + WS_ROPE);
    const float* qg = a.in[6]; const float* kg = a.in[7];
    bf16* QN = (bf16*)(a.ws + WS_QN); bf16* KN = (bf16*)(a.ws + WS_KN);
    const int gw = C.vcu * NWAVES + C.wave, NGW = C.G * NWAVES, lane = C.lane, g = lane >> 2, sub = lane & 3;
    float gq1[8], gq2[8], gk1[8], gk2[8];
#pragma unroll
    for (int i = 0; i < 8; ++i) { gq1[i] = qg[sub * 8 + i]; gq2[i] = qg[32 + sub * 8 + i]; gk1[i] = kg[sub * 8 + i]; gk2[i] = kg[32 + sub * 8 + i]; }
    for (int mb = gw; mb < T; mb += 4 * NGW) {
        f32x4 rp[4][4]; v4u qa1[4], qa2[4], ka1[4], ka2[4];
#pragma unroll
        for (int tt = 0; tt < 4; ++tt) { const int m = mb + tt * NGW < T ? mb + tt * NGW : mb, pos = m & (S - 1);
#pragma unroll
            for (int i = 0; i < 4; ++i) rp[tt][i] = *(const f32x4*)(ROPE + ((size_t)pos * 32 + sub * 8 + 2 * i) * 2);
            const bf16* sq = PROJ + (size_t)m * NPJ + P_DQ + g * 64 + sub * 8; const bf16* sk = PROJ + (size_t)m * NPJ + P_DK + g * 64 + sub * 8;
            qa1[tt] = *(const v4u*)sq; qa2[tt] = *(const v4u*)(sq + 32); ka1[tt] = *(const v4u*)sk; ka2[tt] = *(const v4u*)(sk + 32); }
        __builtin_amdgcn_sched_barrier(0);
#pragma unroll
        for (int tt = 0; tt < 4; ++tt) { const int m = mb + tt * NGW; if (m < T) {
            float cs[8], sn[8];
#pragma unroll
            for (int i = 0; i < 4; ++i) { const f32x4 t = rp[tt][i]; cs[2 * i] = t.x; sn[2 * i] = t.y; cs[2 * i + 1] = t.z; sn[2 * i + 1] = t.w; }
#pragma unroll
            for (int which = 0; which < 2; ++which) {
                const v4u a1 = which ? ka1[tt] : qa1[tt], a2 = which ? ka2[tt] : qa2[tt];
                float x1[8] = {bflo(a1.x), bfhi(a1.x), bflo(a1.y), bfhi(a1.y), bflo(a1.z), bfhi(a1.z), bflo(a1.w), bfhi(a1.w)};
                float x2[8] = {bflo(a2.x), bfhi(a2.x), bflo(a2.y), bfhi(a2.y), bflo(a2.z), bfhi(a2.z), bflo(a2.w), bfhi(a2.w)};
                float ss = 0.f;
#pragma unroll
                for (int i = 0; i < 8; ++i) ss += x1[i] * x1[i] + x2[i] * x2[i];
                ss += __shfl_xor(ss, 1); ss += __shfl_xor(ss, 2);
                const float r = rsqrtf(ss * (1.f / 64.f) + EPS) * (which ? 1.f : QSCALE);
                float o1[8], o2[8];
#pragma unroll
                for (int i = 0; i < 8; ++i) { const float u1 = x1[i] * r * (which ? gk1[i] : gq1[i]), u2 = x2[i] * r * (which ? gk2[i] : gq2[i]); o1[i] = u1 * cs[i] - u2 * sn[i]; o2[i] = u2 * cs[i] + u1 * sn[i]; }
                bf16* dst = (which ? KN : QN) + (size_t)m * 1024 + g * 64 + sub * 8;
                v4u w1, w2; w1.x = pk2(o1[0], o1[1]); w1.y = pk2(o1[2], o1[3]); w1.z = pk2(o1[4], o1[5]); w1.w = pk2(o1[6], o1[7]);
                w2.x = pk2(o2[0], o2[1]); w2.y = pk2(o2[2], o2[3]); w2.z = pk2(o2[4], o2[5]); w2.w = pk2(o2[6], o2[7]);
                *(v4u*)dst = w1; *(v4u*)(dst + 32) = w2;
            } } }
        __builtin_amdgcn_sched_barrier(0);
    }
}

__device__ __forceinline__ void mlA_unit(const Ctx& C, int u, const Args& a) {
    const bf16* PROJ = (const bf16*)(a.ws + WS_PROJ); const float* MG = (const float*)(a.ws + WS_MG); const float* MSC = (const float*)(a.ws + WS_MSC);
    bf16* U = (bf16*)(a.ws + WS_U); float* NU = (float*)(a.ws + WS_NU);
    const int b = u >> 8, hh = (u >> 6) & 3, j = u & 63, chain0 = (b * 4 + hh) * 2;
    const size_t row0 = (size_t)b * S + j * 64;
    const int tid = C.tid, lane = C.lane, w = C.wave;
    LAS unsigned char* lds = C.lds;
    constexpr int KI = 0, VI = 20480, WKF = 57344, WKB = 77824, WF = 98304;
    float fgv = 0.f, igv = 0.f; f32x2 ga; ga.x = 0.f; ga.y = 0.f;
    if (w < 2) { fgv = MG[(row0 + lane) * 16 + (w ? 12 : 4) + hh]; igv = MG[(row0 + lane) * 16 + (w ? 8 : 0) + hh]; ga = *(const f32x2*)(MSC + (size_t)((chain0 + w) * 64 + lane) * 2); }
    __syncthreads();
#pragma unroll
    for (int i = 0; i < 2; ++i) { const int p = tid + 512 * i, row = p >> 4, c = p & 15;
        *(LAS v4u*)(lds + KI + row * 320 + c * 16) = *(const v4u*)(PROJ + (row0 + row) * NPJ + P_MK + hh * 128 + c * 8); }
#pragma unroll
    for (int i = 0; i < 4; ++i) { const int p = tid + 512 * i, row = p >> 5, c = p & 31;
        *(LAS v4u*)(lds + VI + row * 576 + c * 16) = *(const v4u*)(PROJ + (row0 + row) * NPJ + P_MV + hh * 256 + c * 8); }
    if (w < 2) {
        const int dir = w, t = lane;
        const float lf = logsigf_(fgv), P = incl_sum_up(lf, lane), Gt = __shfl(P, 63);
        const float bcur = dir ? (Gt - P + lf) : P;
        const MScan ms = mscan_ga(ga, dir, lane);
        if (j == 0) { f32x4 o; o.x = ms.mprev; o.y = ms.mnew; o.z = ms.dec; o.w = 0.f; *(f32x4*)(a.ws + WS_MSV + (size_t)((chain0 + dir) * 64 + lane) * 16) = o; }
        const float av = Gt - bcur + igv, mnew = rdlane(ms.mnew, j);
        ((LAS float*)(lds + WF + dir * 256))[t] = __expf(av - mnew);
    }
    __syncthreads();
#pragma unroll
    for (int i = 0; i < 2; ++i) { const int p = tid + 512 * i, row = p >> 4, c = p & 15;
        const v4u kv = *(LAS v4u*)(lds + KI + row * 320 + c * 16);
        const float wf = ((LAS float*)(lds + WF))[row], wb = ((LAS float*)(lds + WF + 256))[row];
        *(LAS v4u*)(lds + WKF + row * 320 + c * 16) = scale8(kv, wf);
        *(LAS v4u*)(lds + WKB + row * 320 + c * 16) = scale8(kv, wb); }
    if (tid < 256) { const int dir = tid >> 7, k = tid & 127; float s = 0.f;
        for (int t = 0; t < 64; ++t) s += ((LAS float*)(lds + WF + dir * 256))[t] * bf2f(*(LAS bf16*)(lds + KI + t * 320 + k * 2));
        NU[(size_t)((chain0 + dir) * 64 + j) * 128 + k] = s; }
    __syncthreads();
    const int G_ = (lane >> 4) & 1, i16 = lane & 15, q_ = i16 >> 2, p_ = i16 & 3, h = lane >> 5, r32 = lane & 31;
    f32x16 acc[2][4];
#pragma unroll
    for (int d = 0; d < 2; ++d)
#pragma unroll
        for (int n = 0; n < 4; ++n) acc[d][n] = f32x16{};
#pragma unroll
    for (int s = 0; s < 4; ++s) {
        LAS unsigned char* va = lds + VI + (16 * s + 8 * h + q_) * 576 + (32 * w + 16 * G_ + 4 * p_) * 2;
        const bf16x8 af = cat8(trr(va), trr(va + 4 * 576));
#pragma unroll
        for (int d = 0; d < 2; ++d)
#pragma unroll
            for (int n = 0; n < 4; ++n) {
                LAS unsigned char* ba = lds + (d ? WKB : WKF) + (16 * s + 8 * h + q_) * 320 + (32 * n + 16 * G_ + 4 * p_) * 2;
                const bf16x8 bfr = cat8(trr(ba), trr(ba + 4 * 320));
                acc[d][n] = __builtin_amdgcn_mfma_f32_32x32x16_bf16(bfr, af, acc[d][n], 0, 0, 0);
            }
    }
    __syncthreads();
    LAS unsigned char* ut = lds + w * 4096;
#pragma unroll
    for (int d = 0; d < 2; ++d) {
#pragma unroll
        for (int n = 0; n < 4; ++n)
#pragma unroll
            for (int g4 = 0; g4 < 4; ++g4) { int o = 0; o = __builtin_amdgcn_cvt_pk_fp8_f32(sat8(acc[d][n][4 * g4 + 0]), sat8(acc[d][n][4 * g4 + 1]), o, false); o = __builtin_amdgcn_cvt_pk_fp8_f32(sat8(acc[d][n][4 * g4 + 2]), sat8(acc[d][n][4 * g4 + 3]), o, true);
                *(LAS int*)(ut + r32 * 128 + ((32 * n + 8 * g4 + 4 * h) ^ ((r32 & 7) << 4))) = o; }
        unsigned char* ub = (unsigned char*)U + ((size_t)((chain0 + d) * 64 + j) * 256 + 32 * w) * 128;
#pragma unroll
        for (int i = 0; i < 4; ++i) { const int row = 8 * i + (lane >> 3), ch = lane & 7;
            const v4u v = *(LAS v4u*)(ut + row * 128 + ((ch ^ (row & 7)) << 4));
            *(v4u*)(ub + (size_t)row * 128 + ch * 16) = v; }
    }
}
__device__ __forceinline__ void mlB_scan(const Ctx& C, const Args& a) {
    const bf16* __restrict__ U = (const bf16*)(a.ws + WS_U); bf16* __restrict__ CP = (bf16*)(a.ws + WS_CP); const float* MSC = (const float*)(a.ws + WS_MSC);
    const float* __restrict__ NU = (const float*)(a.ws + WS_NU); float* __restrict__ NP = (float*)(a.ws + WS_NP);
    for (int g = C.vcu * NTHR + C.tid; g < 16 * 8192; g += C.G * NTHR) {
        const int chain = __builtin_amdgcn_readfirstlane(g >> 13), e4 = g & 8191, dir = chain & 1;
        const MScan ms = mscan_ld(a.ws, chain, C.lane);
        const unsigned char* ub = (const unsigned char*)U + (size_t)chain * 64 * 32768 + 4 * e4; unsigned char* cb = (unsigned char*)CP + (size_t)chain * 64 * 32768 + 4 * e4;
        int ur[64];
#pragma unroll
        for (int ci = 0; ci < 64; ++ci) { const int c = dir ? 63 - ci : ci; ur[ci] = *(const int*)(ub + (size_t)c * 32768); }
        __builtin_amdgcn_sched_barrier(0);
        f32x4 st = {0.f, 0.f, 0.f, 0.f};
#pragma unroll
        for (int ci = 0; ci < 64; ++ci) { const int c = dir ? 63 - ci : ci; const float dec = rdlane(ms.dec, c);
            { int o = 0; o = __builtin_amdgcn_cvt_pk_fp8_f32(sat8(st.x), sat8(st.y), o, false); o = __builtin_amdgcn_cvt_pk_fp8_f32(sat8(st.z), sat8(st.w), o, true); *(int*)(cb + (size_t)c * 32768) = o; }
            const f32x4 uv = {__builtin_amdgcn_cvt_f32_fp8(ur[ci], 0), __builtin_amdgcn_cvt_f32_fp8(ur[ci], 1), __builtin_amdgcn_cvt_f32_fp8(ur[ci], 2), __builtin_amdgcn_cvt_f32_fp8(ur[ci], 3)}; st = st * dec + uv; }
    }
    const int g = C.vcu * NTHR + C.tid;
    if (g < 2048) { const int chain = __builtin_amdgcn_readfirstlane(g >> 7), k = g & 127, dir = chain & 1; const MScan ms = mscan_ld(a.ws, chain, C.lane);
        float nu[64];
#pragma unroll
        for (int ci = 0; ci < 64; ++ci) { const int c = dir ? 63 - ci : ci; nu[ci] = NU[(size_t)(chain * 64 + c) * 128 + k]; }
        __builtin_amdgcn_sched_barrier(0);
        float st = 0.f;
#pragma unroll
        for (int ci = 0; ci < 64; ++ci) { const int c = dir ? 63 - ci : ci; NP[(size_t)(chain * 64 + c) * 128 + k] = st; st = st * rdlane(ms.dec, c) + nu[ci]; } }
}
__device__ __forceinline__ void mlC_unit(const Ctx& C, int u, const Args& a) {
    const bf16* PROJ = (const bf16*)(a.ws + WS_PROJ); const float* MG = (const float*)(a.ws + WS_MG); const float* MSC = (const float*)(a.ws + WS_MSC);
    const bf16* CP = (const bf16*)(a.ws + WS_CP); const float* NP = (const float*)(a.ws + WS_NP); const float* mlg = a.in[4]; bf16* HM = (bf16*)(a.ws + WS_HM);
    const int b = u >> 8, hh = (u >> 6) & 3, j = u & 63, chain0 = (b * 4 + hh) * 2;
    const size_t row0 = (size_t)b * S + j * 64;
    const int tid = C.tid, lane = C.lane, w = C.wave;
    LAS unsigned char* lds = C.lds;
    constexpr int QI = 0, KI = 17408, VI = 34816, SI = 71680, PI = 89088, SC = 98304;
    constexpr int NQ = SC + 2048, NPL = SC + 6144, SSO = SC + 7168, RS = SC + 9216;
    float fgv = 0.f, igv = 0.f; MScan ms; ms.mprev = 0.f; ms.mnew = 0.f; ms.dec = 0.f;
    if (w < 2) { fgv = MG[(row0 + lane) * 16 + (w ? 12 : 4) + hh]; igv = MG[(row0 + lane) * 16 + (w ? 8 : 0) + hh]; ms = mscan_ld(a.ws, chain0 + w, lane); }
    __syncthreads();
#pragma unroll
    for (int i = 0; i < 2; ++i) { const int p = tid + 512 * i, row = p >> 4, c = p & 15;
        *(LAS v4u*)(lds + QI + row * 272 + c * 16) = *(const v4u*)(PROJ + (row0 + row) * NPJ + P_MQ + hh * 128 + c * 8);
        *(LAS v4u*)(lds + KI + row * 272 + c * 16) = *(const v4u*)(PROJ + (row0 + row) * NPJ + P_MK + hh * 128 + c * 8); }
#pragma unroll
    for (int i = 0; i < 4; ++i) { const int p = tid + 512 * i, row = p >> 5, c = p & 31;
        *(LAS v4u*)(lds + VI + row * 576 + c * 16) = *(const v4u*)(PROJ + (row0 + row) * NPJ + P_MV + hh * 256 + c * 8); }
    if (tid < 256) ((LAS float*)(lds + NPL))[tid] = NP[(size_t)((chain0 + (tid >> 7)) * 64 + j) * 128 + (tid & 127)];
    if (w < 2) {
        const int dir = w, t = lane;
        const float lf = logsigf_(fgv), P = incl_sum_up(lf, lane), Gt = __shfl(P, 63);
        const float bcur = dir ? (Gt - P + lf) : P, cv = igv - bcur;
        const float pm = dir ? incl_max_down(cv, lane) : incl_max_up(cv, lane);
        const float mprev = rdlane(ms.mprev, j);
        const float mt = bcur + fmaxf(mprev, pm), si = __expf(bcur + mprev - mt);
        LAS float* sc = (LAS float*)(lds + SC + dir * 1024);
        sc[t] = bcur; sc[64 + t] = cv; sc[128 + t] = mt; sc[192 + t] = si;
    }
    asm volatile("" ::: "memory");
    v2u cpr[2][8];
#pragma unroll
    for (int d = 0; d < 2; ++d) { const unsigned char* cp = (const unsigned char*)CP + ((size_t)((chain0 + d) * 64 + j) * 256 + 32 * w + (lane & 31)) * 128 + 8 * (lane >> 5);
#pragma unroll
        for (int ks = 0; ks < 8; ++ks) cpr[d][ks] = *(const v2u*)(cp + 16 * ks); }
    f32x4 gnr[4]; v2u smr[2][4];
#pragma unroll
    for (int g4 = 0; g4 < 4; ++g4) { const int v0 = 32 * w + 8 * g4 + 4 * (lane >> 5); gnr[g4] = *(const f32x4*)(mlg + v0);
#pragma unroll
        for (int th = 0; th < 2; ++th) smr[th][g4] = *(const v2u*)(PROJ + (row0 + 32 * th + (lane & 31)) * NPJ + P_MO + hh * 256 + v0); }
    __syncthreads();
    {
        const int fr = lane & 15, fq = lane >> 4;
#pragma unroll
        for (int tt = 0; tt < 2; ++tt) { const int tile = 2 * w + tt, ti = tile >> 2, si_ = tile & 3; f32x4 acc4 = {0.f, 0.f, 0.f, 0.f};
#pragma unroll
            for (int ks = 0; ks < 4; ++ks) {
                const bf16x8 aq = *(LAS bf16x8*)(lds + QI + (16 * ti + fr) * 272 + (32 * ks + 8 * fq) * 2);
                const bf16x8 bk = *(LAS bf16x8*)(lds + KI + (16 * si_ + fr) * 272 + (32 * ks + 8 * fq) * 2);
                acc4 = __builtin_amdgcn_mfma_f32_16x16x32_bf16(aq, bk, acc4, 0, 0, 0); }
#pragma unroll
            for (int i = 0; i < 4; ++i) ((LAS float*)(lds + SI))[(16 * ti + 4 * fq + i) * 68 + 16 * si_ + fr] = acc4[i]; }
        const int t = tid & 63, part = tid >> 6;
        const v4u q0 = *(LAS v4u*)(lds + QI + t * 272 + part * 32), q1 = *(LAS v4u*)(lds + QI + t * 272 + part * 32 + 16);
        const float qv[16] = {bflo(q0.x), bfhi(q0.x), bflo(q0.y), bfhi(q0.y), bflo(q0.z), bfhi(q0.z), bflo(q0.w), bfhi(q0.w), bflo(q1.x), bfhi(q1.x), bflo(q1.y), bfhi(q1.y), bflo(q1.z), bfhi(q1.z), bflo(q1.w), bfhi(q1.w)};
#pragma unroll
        for (int d = 0; d < 2; ++d) { float s = 0.f;
#pragma unroll
            for (int k = 0; k < 16; ++k) s += ((LAS float*)(lds + NPL))[d * 128 + part * 16 + k] * qv[k];
            ((LAS float*)(lds + NQ))[(d * 8 + part) * 64 + t] = s; }
    }
    __syncthreads();
    {
        const int t = tid >> 3, sg = tid & 7, s0 = 8 * sg;
        const f32x4 sa = *(LAS f32x4*)(lds + SI + (t * 68 + s0) * 4), sb = *(LAS f32x4*)(lds + SI + (t * 68 + s0 + 4) * 4);
        const float sv[8] = {sa.x, sa.y, sa.z, sa.w, sb.x, sb.y, sb.z, sb.w};
        float p[2][8], inv[2];
#pragma unroll
        for (int d = 0; d < 2; ++d) { LAS float* sc = (LAS float*)(lds + SC + d * 1024);
            const float Bt = sc[t], MTt = sc[128 + t], SIt = sc[192 + t]; float rs = 0.f;
#pragma unroll
            for (int e = 0; e < 8; ++e) { const int s = s0 + e; const bool ok = d ? (s >= t) : (s <= t);
                const float dv = ok ? __expf(Bt + sc[64 + s] - MTt) : 0.f; p[d][e] = dv * sv[e]; rs += p[d][e]; }
            float nq = ((LAS float*)(lds + NQ))[(d * 8 + sg) * 64 + t];
            rs += __shfl_xor(rs, 1); rs += __shfl_xor(rs, 2); rs += __shfl_xor(rs, 4);
            nq += __shfl_xor(nq, 1); nq += __shfl_xor(nq, 2); nq += __shfl_xor(nq, 4);
            const float den = fmaxf(fabsf(SIt * nq + rs), __expf(-MTt)); inv[d] = 1.f / den;
            if (sg == 0) ((LAS float*)(lds + RS))[d * 64 + t] = SIt * inv[d]; }
        float o[8];
#pragma unroll
        for (int e = 0; e < 8; ++e) o[e] = p[0][e] * inv[0] + p[1][e] * inv[1];
        v4u wv; wv.x = pk2(o[0], o[1]); wv.y = pk2(o[2], o[3]); wv.z = pk2(o[4], o[5]); wv.w = pk2(o[6], o[7]);
        *(LAS v4u*)(lds + PI + t * 144 + s0 * 2) = wv;
    }
    __syncthreads();
#pragma unroll
    for (int i = 0; i < 2; ++i) { const int p = tid + 512 * i, row = p >> 4, c = p & 15;
        const v4u qv = *(LAS v4u*)(lds + QI + row * 272 + c * 16);
        const float rf = ((LAS float*)(lds + RS))[row], rb = ((LAS float*)(lds + RS))[64 + row];
        *(LAS v4u*)(lds + QI + row * 272 + c * 16) = scale8(qv, rf);
        *(LAS v4u*)(lds + KI + row * 272 + c * 16) = scale8(qv, rb); }
    __syncthreads();
    const int G_ = (lane >> 4) & 1, i16 = lane & 15, q_ = i16 >> 2, p_ = i16 & 3, h = lane >> 5, r32 = lane & 31;
    f32x16 acc[2]; acc[0] = f32x16{}; acc[1] = f32x16{};
#pragma unroll
    for (int d = 0; d < 2; ++d) {
#pragma unroll
        for (int ks = 0; ks < 8; ++ks) { const v2u cr = cpr[d][ks]; v4u a4;
            a4.x = pk2(__builtin_amdgcn_cvt_f32_fp8((int)cr.x, 0), __builtin_amdgcn_cvt_f32_fp8((int)cr.x, 1)); a4.y = pk2(__builtin_amdgcn_cvt_f32_fp8((int)cr.x, 2), __builtin_amdgcn_cvt_f32_fp8((int)cr.x, 3));
            a4.z = pk2(__builtin_amdgcn_cvt_f32_fp8((int)cr.y, 0), __builtin_amdgcn_cvt_f32_fp8((int)cr.y, 1)); a4.w = pk2(__builtin_amdgcn_cvt_f32_fp8((int)cr.y, 2), __builtin_amdgcn_cvt_f32_fp8((int)cr.y, 3));
            const bf16x8 af = __builtin_bit_cast(bf16x8, a4);
#pragma unroll
            for (int th = 0; th < 2; ++th) { const bf16x8 bq = *(LAS bf16x8*)(lds + (d ? KI : QI) + (32 * th + r32) * 272 + (16 * ks + 8 * h) * 2);
                acc[th] = __builtin_amdgcn_mfma_f32_32x32x16_bf16(af, bq, acc[th], 0, 0, 0); } } }
#pragma unroll
    for (int ks = 0; ks < 4; ++ks) { LAS unsigned char* va = lds + VI + (16 * ks + 8 * h + q_) * 576 + (32 * w + 16 * G_ + 4 * p_) * 2;
        const bf16x8 af = cat8(trr(va), trr(va + 4 * 576));
#pragma unroll
        for (int th = 0; th < 2; ++th) { const bf16x8 bp = *(LAS bf16x8*)(lds + PI + (32 * th + r32) * 144 + (16 * ks + 8 * h) * 2);
            acc[th] = __builtin_amdgcn_mfma_f32_32x32x16_bf16(af, bp, acc[th], 0, 0, 0); } }
#pragma unroll
    for (int th = 0; th < 2; ++th) { float ss = 0.f;
#pragma unroll
        for (int r = 0; r < 16; ++r) ss += acc[th][r] * acc[th][r];
        ss += __shfl_xor(ss, 32);
        if (h == 0) ((LAS float*)(lds + SSO))[w * 64 + 32 * th + r32] = ss; }
    __syncthreads();
#pragma unroll
    for (int th = 0; th < 2; ++th) { float tot = 0.f;
#pragma unroll
        for (int ww = 0; ww < 8; ++ww) tot += ((LAS float*)(lds + SSO))[ww * 64 + 32 * th + r32];
        const float rr = rsqrtf(tot * (1.f / 256.f) + EPS); const size_t tok = row0 + 32 * th + r32;
#pragma unroll
        for (int g4 = 0; g4 < 4; ++g4) { const int v0 = 32 * w + 8 * g4 + 4 * h;
            const f32x4 gn = gnr[g4]; const v2u sm = smr[th][g4];
            v2u o; o.x = pk2(acc[th][4 * g4 + 0] * rr * gn.x * bflo(sm.x), acc[th][4 * g4 + 1] * rr * gn.y * bfhi(sm.x));
            o.y = pk2(acc[th][4 * g4 + 2] * rr * gn.z * bflo(sm.y), acc[th][4 * g4 + 3] * rr * gn.w * bfhi(sm.y));
            *(v2u*)(HM + tok * 1024 + hh * 256 + v0) = o; } }
}

constexpr int AT_BUF = 32768, AT_K2 = 8192, AT_V = 16384, AT_CV = 65536, AT_DUMMY = AT_CV + 8 * 8448;
__device__ __forceinline__ void at_dma(unsigned off, const char* base, unsigned ldsaddr) { unsigned keep;
    asm volatile("s_mov_b32 %0, m0\n\ts_mov_b32 m0, %3\n\ts_nop 0\n\tglobal_load_lds_dwordx4 %1, %2\n\ts_mov_b32 m0, %0" : "=&s"(keep) : "v"(off), "s"(base), "s"(ldsaddr) : "memory"); }
__device__ __forceinline__ void attn_unit(const Ctx& C, int u, int uidx, const Args& a, int lam_s, Conv& cv) {
    const bf16* QN = (const bf16*)(a.ws + WS_QN); const bf16* KN = (const bf16*)(a.ws + WS_KN); const bf16* PROJ = (const bf16*)(a.ws + WS_PROJ);
    const int b = u >> 8, hh = (u >> 5) & 7, qb = u & 31;
    const int lane = C.lane, w = C.wave, rg = w >> 1, mp = w & 1, r32 = lane & 31, h = lane >> 5;
    LAS unsigned char* lds = C.lds; const unsigned ldsb = (unsigned)(uintptr_t)lds;
    const size_t rowbase = (size_t)b * S; const int NGW = C.G * NWAVES;
    unsigned ko, vo0;
    { const int row = 8 * w + (lane >> 3), c = (lane & 7) ^ ((row >> 1) & 7); ko = (unsigned)((row * 1024 + c * 8) * 2); }
    { const int row = 8 * w + (lane >> 4), ch = (lane & 15) ^ ((row & 3) << 2); vo0 = (unsigned)((row * NPJ + ch * 8) * 2); }
    const char* kbase = (const char*)(KN + rowbase * 1024 + hh * 128); const char* vbase = (const char*)(PROJ + rowbase * NPJ + P_DV + hh * 128);
#define AT_TILE_DMA(t_, bufoff_) do { const char* kb__ = uni_ptr(kbase + (size_t)(t_) * 64 * 1024 * 2); const char* vb__ = uni_ptr(vbase + (size_t)(t_) * 64 * NPJ * 2); \
        const unsigned d__ = (unsigned)__builtin_amdgcn_readfirstlane((int)(ldsb + (bufoff_))); \
        at_dma(ko, kb__, d__ + w * 1024); at_dma(ko, kb__ + 128, d__ + AT_K2 + w * 1024); at_dma(vo0, vb__, d__ + AT_V + w * 2048); at_dma(vo0, vb__ + 4 * NPJ * 2, d__ + AT_V + w * 2048 + 1024); } while (0)
    bf16x8 qf[4];
    { const bf16* qsrc = QN + (rowbase + qb * 128 + rg * 32 + r32) * 1024 + hh * 128 + mp * 64 + h * 8;
#pragma unroll
      for (int d0 = 0; d0 < 4; ++d0) qf[d0] = *(const bf16x8*)(qsrc + 16 * d0); }
    f32x16 O[4];
#pragma unroll
    for (int d0 = 0; d0 < 4; ++d0) O[d0] = f32x16{};
    float lsum = 0.f;
    const int G_ = (lane >> 4) & 1, i16 = lane & 15, q_ = i16 >> 2, p_ = i16 & 3;
    const int kofb = mp * AT_K2 + r32 * 128 + ((h ^ ((r32 >> 1) & 1)) << 4) + (((r32 >> 2) & 3) << 5);
    const int vofb = AT_V + (4 * h + q_) * 256 + (q_ << 6) + 32 * G_ + 8 * p_;
#define kof(d0) (kofb ^ ((d0) << 5))
#define vof(d0) (vofb ^ ((d0) << 6))
    asm volatile("s_waitcnt lgkmcnt(0)" ::: "memory"); __builtin_amdgcn_s_barrier(); asm volatile("" ::: "memory");
    AT_TILE_DMA(0, 0);
    asm volatile("s_waitcnt vmcnt(0)" ::: "memory"); __builtin_amdgcn_s_barrier(); asm volatile("" ::: "memory");
#define AT_ITER(t_, SET_, TICK_) do { \
        LAS unsigned char* cur = lds + ((t_) & 1) * AT_BUF; \
        if ((t_) + 1 < S / 64) AT_TILE_DMA((t_) + 1, (((t_) + 1) & 1) * AT_BUF); \
        else { const unsigned d__ = (unsigned)__builtin_amdgcn_readfirstlane((int)(ldsb + AT_DUMMY)); const char* kb__ = uni_ptr(kbase); at_dma(ko, kb__, d__); at_dma(ko, kb__, d__); at_dma(ko, kb__, d__); at_dma(ko, kb__, d__); } \
        int cit_ = cv.it, cst_ = cv.step; conv_next(cit_, cst_, NGW); const ConvSrc csrc_ = conv_src(a, cit_); const unsigned cloff_ = conv_loff(csrc_, lane); (void)cst_; (void)cloff_; \
        _Pragma("unroll") for (int hv = 0; hv < 2; ++hv) { f32x16 pp = f32x16{}; \
            _Pragma("unroll") for (int d0 = 0; d0 < 4; ++d0) { const bf16x8 ka = *(LAS bf16x8*)(cur + kof(d0) + hv * 32 * 128); pp = __builtin_amdgcn_mfma_f32_32x32x16_bf16(ka, qf[d0], pp, 0, 0, 0); } \
            if (TICK_) conv_issue_one(cv.s[(SET_) ^ 1], csrc_, cloff_, cst_, 4 * hv + 0); \
            _Pragma("unroll") for (int r = 0; r < 16; ++r) { pp[r] = __builtin_amdgcn_exp2f(pp[r]); lsum += pp[r]; } \
            if (TICK_) conv_issue_one(cv.s[(SET_) ^ 1], csrc_, cloff_, cst_, 4 * hv + 1); \
            _Pragma("unroll") for (int k2 = 0; k2 < 2; ++k2) { const int o = 8 * k2; \
                v4u t4; t4.x = pk2(pp[o + 0], pp[o + 1]); t4.y = pk2(pp[o + 2], pp[o + 3]); t4.z = pk2(pp[o + 4], pp[o + 5]); t4.w = pk2(pp[o + 6], pp[o + 7]); \
                const bf16x8 pa = __builtin_bit_cast(bf16x8, t4); \
                _Pragma("unroll") for (int d0 = 0; d0 < 4; ++d0) { LAS unsigned char* va = cur + vof(d0) + (32 * hv + 16 * k2) * 256; \
                    const bf16x8 vf = cat8(trr(va), trr(va + 8 * 256)); \
                    O[d0] = __builtin_amdgcn_mfma_f32_32x32x16_bf16(vf, pa, O[d0], 0, 0, 0); } \
                if (TICK_) conv_issue_one(cv.s[(SET_) ^ 1], csrc_, cloff_, cst_, 4 * hv + 2 + k2); } } \
        if (TICK_) { if (conv_consume<12>(cv, cv.s[SET_], a, lds + AT_CV + w * 8448, NGW, lane)) asm volatile("s_waitcnt vmcnt(16) lgkmcnt(0)" ::: "memory"); \
            else asm volatile("s_waitcnt vmcnt(8) lgkmcnt(0)" ::: "memory"); } \
        else asm volatile("s_waitcnt vmcnt(0) lgkmcnt(0)" ::: "memory"); \
        __builtin_amdgcn_s_barrier(); asm volatile("" ::: "memory"); \
    } while (0)
    { const int slot = C.vcu & 3; int pa = 64, pb = 64;
      if ((slot >> 1) == uidx) { pa = 32 * (slot & 1); pb = pa + 32; }
      int t = 0;
      for (; t < pa; t += 2) { AT_ITER(t, 0, true); AT_ITER(t + 1, 1, true); }
      for (; t < pb; t += 2) { AT_ITER(t, 0, false); AT_ITER(t + 1, 1, false); }
      for (; t < S / 64; t += 2) { AT_ITER(t, 0, true); AT_ITER(t + 1, 1, true); } }
#undef AT_ITER
#undef AT_TILE_DMA
#undef kof
#undef vof
    lsum += __shfl_xor(lsum, 32);
    const float inv = 1.f / lsum;
    int le = C.tid & 63; asm volatile("" : "+v"(le));
    LAS float* ex = (LAS float*)lds + rg * 4096;
    if (mp == 1) {
#pragma unroll
        for (int d0 = 0; d0 < 4; ++d0)
#pragma unroll
            for (int r = 0; r < 16; ++r) ex[(d0 * 16 + r) * 64 + le] = O[d0][r] * inv; }
    asm volatile("s_waitcnt lgkmcnt(0)" ::: "memory"); __builtin_amdgcn_s_barrier(); asm volatile("" ::: "memory");
    if (mp == 0) {
        float ss = 0.f; int lb_ = lam_s; asm volatile("" : "+s"(lb_)); const float lamv = __int_as_float(lb_);
#pragma unroll
        for (int d0 = 0; d0 < 4; ++d0)
#pragma unroll
            for (int r = 0; r < 16; ++r) { const float o = O[d0][r] * inv - lamv * ex[(d0 * 16 + r) * 64 + le]; O[d0][r] = o; ss += o * o; }
        ss += __shfl_xor(ss, 32);
        const float rr = rsqrtf(ss * (1.f / 128.f) + EPS) * (1.f - LAM_INIT);
        const size_t tok = (size_t)b * S + qb * 128 + rg * 32 + (le & 31); const int he = le >> 5;
        bf16* odp = (bf16*)(a.ws + WS_OD) + tok * 1024 + hh * 128 + 4 * he;
#pragma unroll
        for (int dh = 0; dh < 2; ++dh) { f32x4 gn[8];
#pragma unroll
            for (int i = 0; i < 8; ++i) gn[i] = *(const f32x4*)(a.in[9] + 32 * (2 * dh + (i >> 2)) + 8 * (i & 3) + 4 * he);
            __builtin_amdgcn_sched_barrier(0);
#pragma unroll
            for (int i = 0; i < 8; ++i) { const int d0 = 2 * dh + (i >> 2), g4 = i & 3, dv0 = 32 * d0 + 8 * g4;
                v2u o; o.x = pk2(O[d0][4 * g4 + 0] * rr * gn[i].x, O[d0][4 * g4 + 1] * rr * gn[i].y); o.y = pk2(O[d0][4 * g4 + 2] * rr * gn[i].z, O[d0][4 * g4 + 3] * rr * gn[i].w);
                *(v2u*)(odp + dv0) = o; } }
    }
}

__device__ __forceinline__ void p8_router(const Ctx& C, const Args& a) {
    const float* x1 = a.out; const float* g2 = a.in[12]; const float* br = a.in[14];
    const bf16* WRH = (const bf16*)(a.ws + WS_WRH); const bf16* WRL = (const bf16*)(a.ws + WS_WRL);
    unsigned char* H2 = a.ws + WS_H2; int* cnt = (int*)(a.ws + WS_CTL) + CW_WGCNT;
    int* TOPE = (int*)(a.ws + WS_RT); int* SLOT = TOPE + T * 4; float* WTS = (float*)(SLOT + T * 4);
    const int lane = C.lane, w = C.wave, r32 = lane & 31, h = lane >> 5;
    constexpr int XP = 4112, XT_BYTES = 32 * XP;
    LAS unsigned char* XT = C.lds;
    LAS float* PLG = (LAS float*)C.lds;
    LAS float* SSQ = (LAS float*)(C.lds + XT_BYTES);
    LAS float* LG = (LAS float*)(C.lds + XT_BYTES + 1024);
    LAS float* RSTD = (LAS float*)(C.lds + XT_BYTES + 1024 + 32 * 33 * 4);
    LAS int* lcnt = (LAS int*)(C.lds + XT_BYTES + 1024 + 32 * 33 * 4 + 128);
    static_assert(XT_BYTES + 1024 + 32 * 33 * 4 + 256 <= MISC_OFF, "router LDS");
    if (C.tid < NE) lcnt[C.tid] = 0;
    for (int m0 = C.vcu * 32; m0 < T; m0 += C.G * 32) {
        __syncthreads();
        f32x16 acc = f32x16{}; float ssq = 0.f;
        const float* xrow = x1 + (size_t)(m0 + r32) * D + 256 * w + 4 * h;
        const bf16* whp = WRH + (size_t)(w * 16 * 64 + lane) * 8; const bf16* wlp = WRL + (size_t)(w * 16 * 64 + lane) * 8;
        LAS unsigned char* xt = XT + r32 * XP + (256 * w + 4 * h) * 2;
#pragma unroll
        for (int hb = 0; hb < 2; ++hb) {
            f32x4 xa[8], xb[8]; bf16x8 wh[8], wl[8];
#pragma unroll
            for (int s8 = 0; s8 < 8; ++s8) { const int s = 8 * hb + s8; xa[s8] = *(const f32x4*)(xrow + 16 * s); xb[s8] = *(const f32x4*)(xrow + 16 * s + 8);
                wh[s8] = *(const bf16x8*)(whp + 512 * s); wl[s8] = *(const bf16x8*)(wlp + 512 * s); }
            __builtin_amdgcn_sched_barrier(0);
#pragma unroll
            for (int s8 = 0; s8 < 8; ++s8) { const int s = 8 * hb + s8;
                ssq += (xa[s8].x * xa[s8].x + xa[s8].y * xa[s8].y) + (xa[s8].z * xa[s8].z + xa[s8].w * xa[s8].w) + (xb[s8].x * xb[s8].x + xb[s8].y * xb[s8].y) + (xb[s8].z * xb[s8].z + xb[s8].w * xb[s8].w);
                const float hv[8] = {xa[s8].x, xa[s8].y, xa[s8].z, xa[s8].w, xb[s8].x, xb[s8].y, xb[s8].z, xb[s8].w};
                v4u hi4, lo4;
#pragma unroll
                for (int i = 0; i < 4; ++i) { const unsigned hp = pk2(hv[2 * i], hv[2 * i + 1]); ((unsigned*)&hi4)[i] = hp; ((unsigned*)&lo4)[i] = pk2(hv[2 * i] - bflo(hp), hv[2 * i + 1] - bfhi(hp)); }
                { v2u t0; t0.x = hi4.x; t0.y = hi4.y; v2u t1; t1.x = hi4.z; t1.y = hi4.w; *(LAS v2u*)(xt + 32 * s) = t0; *(LAS v2u*)(xt + 32 * s + 16) = t1; }
                const bf16x8 hh = __builtin_bit_cast(bf16x8, hi4), hl = __builtin_bit_cast(bf16x8, lo4);
                acc = __builtin_amdgcn_mfma_f32_32x32x16_bf16(wh[s8], hh, acc, 0, 0, 0);
                acc = __builtin_amdgcn_mfma_f32_32x32x16_bf16(wh[s8], hl, acc, 0, 0, 0);
                acc = __builtin_amdgcn_mfma_f32_32x32x16_bf16(wl[s8], hh, acc, 0, 0, 0); }
            __builtin_amdgcn_sched_barrier(0);
        }
        ssq += __shfl_xor(ssq, 32);
        if (h == 0) SSQ[w * 32 + r32] = ssq;
        __syncthreads();
        if (C.tid < 32) { float s = 0.f;
#pragma unroll
            for (int ww = 0; ww < 8; ++ww) s += SSQ[ww * 32 + C.tid];
            RSTD[C.tid] = rsqrtf(s * (1.f / D) + EPS); }
        __syncthreads();
        f32x4 gq[8];
#pragma unroll
        for (int j = 0; j < 8; ++j) gq[j] = *((const f32x4*)g2 + lane + 64 * j);
#pragma unroll
        for (int it = 0; it < 4; ++it) { const int t = 4 * w + it, m = m0 + t; const float rs = RSTD[t];
#pragma unroll
            for (int j = 0; j < 8; ++j) { const v2u q = *(const LAS v2u*)(XT + t * XP + (lane + 64 * j) * 8);
                int o = 0; o = __builtin_amdgcn_cvt_pk_fp8_f32(bflo(q.x) * rs * gq[j].x, bfhi(q.x) * rs * gq[j].y, o, false); o = __builtin_amdgcn_cvt_pk_fp8_f32(bflo(q.y) * rs * gq[j].z, bfhi(q.y) * rs * gq[j].w, o, true);
                *((int*)(H2 + (size_t)m * D) + lane + 64 * j) = o; } }
        __syncthreads();
#pragma unroll
        for (int r = 0; r < 16; ++r) PLG[(w * 16 + r) * 64 + lane] = acc[r];
        __syncthreads();
#pragma unroll
        for (int q = 0; q < 2; ++q) { const int idx = C.tid + 512 * q, r = idx >> 6, l = idx & 63; float s = 0.f;
#pragma unroll
            for (int ww = 0; ww < 8; ++ww) s += PLG[(ww * 16 + r) * 64 + l];
            const int e = (r & 3) + 8 * (r >> 2) + 4 * (l >> 5), t = l & 31;
            LG[t * 33 + e] = s * RSTD[t] + br[e]; }
        __syncthreads();
#pragma unroll
        for (int ps = 0; ps < 2; ++ps) { const int t = 4 * w + 2 * ps + h, m = m0 + t; float v = LG[t * 33 + r32]; float tv[4]; int ti[4];
#pragma unroll
            for (int k = 0; k < 4; ++k) { float best = v;
#pragma unroll
                for (int o = 1; o < 32; o <<= 1) best = fmaxf(best, __shfl_xor(best, o));
                const unsigned long long bm = __ballot(v == best); const unsigned hm = h ? (unsigned)(bm >> 32) : (unsigned)bm; const int bi = __builtin_ctz(hm);
                tv[k] = best; ti[k] = bi; v = (r32 == bi) ? -INFINITY : v; }
            const float e1 = __expf(tv[1] - tv[0]), e2 = __expf(tv[2] - tv[0]), e3 = __expf(tv[3] - tv[0]); const float inv = 1.f / (1.f + e1 + e2 + e3);
            if (r32 < 4) { const int k = r32; const int tk = k == 0 ? ti[0] : k == 1 ? ti[1] : k == 2 ? ti[2] : ti[3]; const float wk = (k == 0 ? 1.f : k == 1 ? e1 : k == 2 ? e2 : e3) * inv;
                TOPE[m * 4 + k] = tk; SLOT[m * 4 + k] = __hip_atomic_fetch_add(lcnt + tk, 1, __ATOMIC_RELAXED, __HIP_MEMORY_SCOPE_WORKGROUP); WTS[m * 4 + k] = wk; } }
    }
    __syncthreads();
    if (C.tid < NE) cnt[C.vcu * NE + C.tid] = lcnt[C.tid];
}
__device__ __forceinline__ void p9_gather(const Ctx& C, const Args& a) {
    const unsigned char* H2 = a.ws + WS_H2; const int* wgcnt = (const int*)(a.ws + WS_CTL) + CW_WGCNT; int* cnt = (int*)(a.ws + WS_CTL) + CW_CNT;
    const int* TOPE = (const int*)(a.ws + WS_RT); const int* SLOT = TOPE + T * 4; int* DEST = (int*)(a.ws + WS_RT) + 3 * T * 4; unsigned char* XG = a.ws + WS_XG;
    const int gw = C.vcu * NWAVES + C.wave, NGW = C.G * NWAVES, lane = C.lane;
    int mycnt = 0, mybase = 0;
    if (C.G == 256) {
        LAS int* ps = (LAS int*)C.lds; int v[32], tot = 0, bas = 0;
#pragma unroll
        for (int i = 0; i < 32; ++i) v[i] = wgcnt[(32 * C.wave + i) * NE + (lane & 31)];
#pragma unroll
        for (int i = 0; i < 32; ++i) { tot += v[i]; bas += (32 * C.wave + i < C.vcu) ? v[i] : 0; }
        __syncthreads();
        if (lane < NE) { ps[(C.wave * 2 + 0) * 32 + lane] = tot; ps[(C.wave * 2 + 1) * 32 + lane] = bas; }
        __syncthreads();
#pragma unroll
        for (int w8 = 0; w8 < 8; ++w8) { mycnt += ps[(w8 * 2 + 0) * 32 + (lane & 31)]; mybase += ps[(w8 * 2 + 1) * 32 + (lane & 31)]; }
    } else {
#pragma unroll 8
    for (int w = 0; w < C.G; ++w) { const int v = wgcnt[w * NE + (lane & 31)]; mycnt += v; mybase += (w < C.vcu) ? v : 0; }
    }
    if (lane >= NE) { mycnt = 0; mybase = 0; }
    int tiles = (mycnt + PADM - 1) / PADM, inc = tiles;
#pragma unroll
    for (int o = 1; o < 32; o <<= 1) { const int t = __shfl_up(inc, o); if (lane >= o) inc += t; }
    const int startrow = (inc - tiles) * PADM;
    if (gw == 0 && lane < NE) cnt[lane] = mycnt;
    for (int m0 = C.vcu * 32; m0 < T; m0 += C.G * 32) {
        const int t0 = m0 + 4 * C.wave, qi = t0 * 4 + (lane & 15);
        const int te = TOPE[qi], ts = SLOT[qi];
        v4u s0[4], s1[4];
#pragma unroll
        for (int it = 0; it < 4; ++it) { const v4u* src = (const v4u*)(H2 + (size_t)(t0 + it) * D) + lane; s0[it] = src[0]; s1[it] = src[64]; }
        const int rowl = __shfl(startrow, te) + __shfl(mybase, te) + ts;
        if (lane < 16) DEST[qi] = rowl;
#pragma unroll
        for (int i = 0; i < 16; ++i) { const int row = __shfl(rowl, i); v4u* dst = (v4u*)(XG + (size_t)row * D) + lane; dst[0] = s0[i >> 2]; dst[64] = s1[i >> 2]; } }
    for (int p = gw; p < NE * PADM; p += NGW) { const int e = p / PADM, qq = p % PADM; const int c = __shfl(mycnt, e), st = __shfl(startrow, e), tl = __shfl(tiles, e);
        if (c + qq < tl * PADM) { v4u* dst = (v4u*)(XG + (size_t)(st + c + qq) * D) + lane; const v4u z = {0u, 0u, 0u, 0u}; dst[0] = z; dst[64] = z; } }
}
__device__ __forceinline__ void p12_combine(const Ctx& C, const Args& a) {
    const bf16* Y = (const bf16*)(a.ws + WS_Y); const float* WTS = (const float*)(a.ws + WS_RT) + 2 * T * 4; const int* DEST = (const int*)(a.ws + WS_RT) + 3 * T * 4; float* out = a.out;
    const int gw = C.vcu * NWAVES + C.wave, NGW = C.G * NWAVES, lane = C.lane;
    int dn[4]; float wn[4];
    if (gw < T) {
#pragma unroll
        for (int k = 0; k < 4; ++k) { dn[k] = DEST[gw * 4 + k]; wn[k] = WTS[gw * 4 + k]; } }
    for (int m = gw; m < T; m += NGW) { int d[4]; float wv[4];
#pragma unroll
        for (int k = 0; k < 4; ++k) { d[k] = dn[k]; wv[k] = wn[k]; }
        f32x4 o[8]; int y[4][8];
#pragma unroll
        for (int j = 0; j < 8; ++j) { o[j] = *((const f32x4*)(out + (size_t)m * D) + lane + 64 * j);
#pragma unroll
            for (int k = 0; k < 4; ++k) y[k][j] = *((const int*)((const unsigned char*)Y + (size_t)d[k] * D) + lane + 64 * j); }
        if (m + NGW < T) {
#pragma unroll
            for (int k = 0; k < 4; ++k) { dn[k] = DEST[(m + NGW) * 4 + k]; wn[k] = WTS[(m + NGW) * 4 + k]; } }
        __builtin_amdgcn_sched_barrier(0);
#pragma unroll
        for (int j = 0; j < 8; ++j) {
#pragma unroll
            for (int k = 0; k < 4; ++k) { const int yy = y[k][j];
                o[j].x += wv[k] * __builtin_amdgcn_cvt_f32_fp8(yy, 0); o[j].y += wv[k] * __builtin_amdgcn_cvt_f32_fp8(yy, 1); o[j].z += wv[k] * __builtin_amdgcn_cvt_f32_fp8(yy, 2); o[j].w += wv[k] * __builtin_amdgcn_cvt_f32_fp8(yy, 3); }
            *((f32x4*)(out + (size_t)m * D) + lane + 64 * j) = o[j]; }
        __builtin_amdgcn_sched_barrier(0);
    }
}

constexpr int N_PHASES = 14;
__global__ void __launch_bounds__(NTHR, 2) mega_fwd(Args args) {
    extern __shared__ __attribute__((aligned(16))) unsigned char lds_raw[];
    Ctx C; C.lds = (LAS unsigned char*)lds_raw; C.tid = threadIdx.x; C.lane = C.tid & 63; C.wave = __builtin_amdgcn_readfirstlane(C.tid >> 6);
    C.G = gridDim.x; { const int bx = blockIdx.x; C.vcu = (C.G % 8 == 0) ? (bx % 8) * (C.G / 8) + bx / 8 : bx; }
    volatile LAS unsigned* MISC = (volatile LAS unsigned*)(C.lds + MISC_OFF);
    if (C.tid < 32) MISC[C.tid] = 0u;
    __syncthreads();
    unsigned* ctl = (unsigned*)(args.ws + WS_CTL);
    XcdBarrier bar = xcd_barrier_post(ctl + CW_BAR, MISC + 8);
    const int lo = args.ph_lo, hi = args.ph_hi;
#ifndef ONLY_MASK
#define ONLY_MASK 0xFFFF
#endif
#define IN(k) (((ONLY_MASK >> (k)) & 1) && lo <= (k) && (k) < hi)
#ifndef DBL_MASK
#define DBL_MASK 0
#endif
#define REP(k) for (int rep_ = 0; rep_ < (((DBL_MASK >> (k)) & 1) ? 2 : 1); ++rep_, (((DBL_MASK >> (k)) & 1) && rep_ == 1 ? xcd_barrier(bar) : (void)0))
#define SEAM(k) do { if (IN(k) && IN((k) + 1)) xcd_barrier(bar); } while (0)
    if (IN(0)) REP(0) { p0_transposes(C, args); p0_rope(C, args); p0_router_w(C, args); p0_xn_gates(C, args); }
    SEAM(0);
    if (IN(1)) REP(1) { p2_mstats(C, args);
        { pg8::Gemm g{(const bf16*)(args.ws + WS_XN), (const bf16*)(args.ws + WS_WIN), T, 6144, D}; pg8::StaticOrder So; So.init(T, 6144, C.G, (int)blockIdx.x);
          EpiProj<false> E{(bf16*)(args.ws + WS_PROJ), nullptr}; pg8::gemm_phase<EpiProj<false>, pg8::StaticOrder, true, true>(C.lds, g, So, E); }
        __syncthreads();
        { pg8::Gemm g{(const bf16*)(args.ws + WS_XN8), (const bf16*)(args.ws + WS_WIN8), T, 4096, D / 2}; pg8::StaticOrder So; So.init(T, 4096, C.G, (int)blockIdx.x);
          EpiProj<true> E{(bf16*)(args.ws + WS_PROJ), args.ws + WS_G8}; pg8::gemm_phase<EpiProj<true>, pg8::StaticOrder, true, true, true>(C.lds, g, So, E); } }
    SEAM(1);
    if (IN(2)) REP(2) { p2_late_transposes(C, args); p2_qkprep(C, args); }
    if (!(IN(2) && IN(3))) SEAM(2);
    if (IN(3)) REP(3) { for (int u = C.vcu; u < 512; u += C.G) mlA_unit(C, u, args); }
    SEAM(3);
    if (IN(4)) REP(4) { mlB_scan(C, args); }
    SEAM(4);
    if (IN(5)) REP(5) { for (int u = C.vcu; u < 512; u += C.G) mlC_unit(C, u, args); }
    if (IN(6)) REP(6) {
        const float* lp = args.in[8]; const float sa = wave_sum(lp[C.lane] * lp[64 + C.lane]), sb = wave_sum(lp[128 + C.lane] * lp[192 + C.lane]);
        const float lam = __expf(sa) - __expf(sb) + LAM_INIT;
        Conv cv; conv_begin(cv, args, C.vcu * NWAVES + C.wave, C.G * NWAVES, C.lane);
        int lam_s = __builtin_amdgcn_readfirstlane(__float_as_int(lam)); asm volatile("" : "+s"(lam_s));
        { int uidx = 0; for (int u = C.vcu; u < 512; u += C.G, ++uidx) attn_unit(C, u, uidx, args, lam_s, cv); }
        asm volatile("s_waitcnt lgkmcnt(0)" ::: "memory"); __builtin_amdgcn_s_barrier(); asm volatile("" ::: "memory");
        while (cv.it < CV_NJ) { conv_issue_next(cv, cv.s[1], args, C.G * NWAVES, C.lane); (void)conv_consume<8>(cv, cv.s[0], args, C.lds + AT_CV + C.wave * 8448, C.G * NWAVES, C.lane);
            conv_issue_next(cv, cv.s[0], args, C.G * NWAVES, C.lane); (void)conv_consume<8>(cv, cv.s[1], args, C.lds + AT_CV + C.wave * 8448, C.G * NWAVES, C.lane); }
        asm volatile("s_waitcnt vmcnt(0)" ::: "memory");
    }
    SEAM(6);
    if (IN(7)) REP(7) { __syncthreads();
        pg8::StaticOrder So; So.init(T, D, C.G, (int)blockIdx.x);
        if (So.nwg % C.G == 0) {
            static_assert(WS_OD - WS_HM == (size_t)T * MLW * 2 && WS_WDA - WS_WML == (size_t)D * MLW * 2 && MLW == DAW, "pair stream: operands of the two products must be adjacent");
            pg8::Gemm g{(const bf16*)(args.ws + WS_HM), (const bf16*)(args.ws + WS_WML), 2 * T, D, MLW}; PairOrder Po{So};
            EpiGatePair E{(const bf16*)(args.ws + WS_G8), (bf16*)(args.ws + WS_T1), (bf16*)(args.ws + WS_MIX)}; pg8::gemm_phase<EpiGatePair, PairOrder, true, true>(C.lds, g, Po, E);
        } else {
        { pg8::Gemm g{(const bf16*)(args.ws + WS_HM), (const bf16*)(args.ws + WS_WML), T, D, MLW};
          EpiGate<0> E{(const bf16*)(args.ws + WS_G8), nullptr, (bf16*)(args.ws + WS_T1)}; pg8::gemm_phase<EpiGate<0>, pg8::StaticOrder, true, true>(C.lds, g, So, E); }
        __syncthreads();
        { pg8::Gemm g{(const bf16*)(args.ws + WS_OD), (const bf16*)(args.ws + WS_WDA), T, D, DAW};
          EpiGate<1> E{(const bf16*)(args.ws + WS_G8), (const bf16*)(args.ws + WS_T1), (bf16*)(args.ws + WS_MIX)}; pg8::gemm_phase<EpiGate<1>, pg8::StaticOrder, true, true>(C.lds, g, So, E); }
        }
    }
    SEAM(7);
    if (IN(8)) REP(8) { pg8::Gemm g{(const bf16*)(args.ws + WS_MIX), (const bf16*)(args.ws + WS_WO), T, D, D}; pg8::StaticOrder So; So.init(T, D, C.G, (int)blockIdx.x);
        EpiRes E{args.in[0], args.out}; pg8::gemm_phase<EpiRes, pg8::StaticOrder, true, true>(C.lds, g, So, E); }
    SEAM(8);
    if (IN(9)) REP(9) { p8_router(C, args); }
    SEAM(9);
    if (IN(10)) REP(10) { p9_gather(C, args); }
    SEAM(10);
    if (IN(11)) REP(11) { MoeSched Ms; Ms.init((const int*)(args.ws + WS_CTL) + CW_CNT, 16, C.G, (int)blockIdx.x, C.lane);
        pg8::Gemm g{(const bf16*)(args.ws + WS_XG), (const bf16*)(args.ws + WS_WGU), MAXROWS, 2 * DE, D / 2};
        EpiAct E{args.in[16], args.ws + WS_ACT}; pg8::gemm_phase<EpiAct, MoeSched, true, true, true>(C.lds, g, Ms, E); }
    SEAM(11);
    if (IN(12)) REP(12) { MoeSched Ms; Ms.init((const int*)(args.ws + WS_CTL) + CW_CNT, 8, C.G, (int)blockIdx.x, C.lane);
        pg8::Gemm g{(const bf16*)(args.ws + WS_ACT), (const bf16*)(args.ws + WS_WDN), MAXROWS, D, DE / 2};
        EpiY E{args.in[18], (bf16*)(args.ws + WS_Y)}; pg8::gemm_phase<EpiY, MoeSched, true, true, true>(C.lds, g, Ms, E); }
    SEAM(12);
    if (IN(13)) REP(13) { p12_combine(C, args); }
#undef IN
#undef SEAM
}
#ifdef DEV_NAIVE
constexpr size_t NV_XN32 = WS_NAIVE, NV_PROJ32 = NV_XN32 + 64 * MiB, NV_F = NV_PROJ32 + 322 * MiB, NV_HF = NV_F + 1 * MiB, NV_OD32 = NV_HF + 64 * MiB, NV_MIX32 = NV_OD32 + 32 * MiB, NV_END = NV_MIX32 + 64 * MiB;
__device__ __forceinline__ float ldf(const float* p) { return *p; }
__device__ __forceinline__ float ldf(const bf16* p) { return bf2f(*p); }
__global__ __launch_bounds__(256) void k_rmsnorm(const float* __restrict__ x, const float* __restrict__ g, float* __restrict__ y) {
    const int row = blockIdx.x * 4 + (threadIdx.x >> 6), lane = threadIdx.x & 63;
    const float* xr = x + (size_t)row * D; float v[32]; float s = 0.f;
#pragma unroll
    for (int j = 0; j < 32; ++j) { v[j] = xr[lane + 64 * j]; s += v[j] * v[j]; }
    s = wave_sum(s); const float r = rsqrtf(s * (1.f / D) + EPS);
#pragma unroll
    for (int j = 0; j < 32; ++j) y[(size_t)row * D + lane + 64 * j] = v[j] * r * g[lane + 64 * j];
}
struct GArgs { const void* A; const float* B; void* C; int M, N, K, lda, ldb, ldc; const void* aux0; const void* aux1; const int* cnt; };
template <int EPI, typename TA> __global__ __launch_bounds__(256) void k_gemm(GArgs g) {
    __shared__ float As[16][64 + 4], Bs[16][64 + 4];
    const int tx = threadIdx.x & 15, ty = threadIdx.x >> 4;
    int m0 = blockIdx.y * 64, n0 = blockIdx.x * 64;
    const TA* A = (const TA*)g.A; const float* Bp = g.B; int M = g.M; int rowbase = 0; int e = 0;
    if (EPI == 4 || EPI == 5) {
        e = blockIdx.z; int start = 0;
        for (int i = 0; i < e; ++i) start += (g.cnt[i] + PADM - 1) / PADM * PADM;
        const int c = g.cnt[e]; if (m0 >= c) return;
        M = (c + PADM - 1) / PADM * PADM; rowbase = start;
        A = (const TA*)g.A + (size_t)rowbase * g.lda; Bp = g.B + (size_t)e * g.K * g.ldb;
    }
    float acc[4][4] = {};
    for (int k0 = 0; k0 < g.K; k0 += 16) {
        for (int i = threadIdx.x; i < 64 * 16; i += 256) { const int mm = i >> 4, kk = i & 15; const int m = m0 + mm; As[kk][mm] = (m < M) ? ldf(A + (size_t)m * g.lda + k0 + kk) : 0.f; }
        for (int i = threadIdx.x; i < 16 * 64; i += 256) { const int kk = i >> 6, nn = i & 63; const int n = n0 + nn; Bs[kk][nn] = (n < g.N) ? Bp[(size_t)(k0 + kk) * g.ldb + n] : 0.f; }
        __syncthreads();
#pragma unroll
        for (int kk = 0; kk < 16; ++kk) {
            float a[4], b[4];
#pragma unroll
            for (int i = 0; i < 4; ++i) { a[i] = As[kk][ty * 4 + i]; b[i] = Bs[kk][tx * 4 + i]; }
#pragma unroll
            for (int i = 0; i < 4; ++i)
#pragma unroll
                for (int j = 0; j < 4; ++j) acc[i][j] += a[i] * b[j];
        }
        __syncthreads();
    }
#pragma unroll
    for (int i = 0; i < 4; ++i) {
        const int m = m0 + ty * 4 + i; if (m >= M) continue;
        if (EPI == 4) {
            const float* bias = (const float*)g.aux0 + (size_t)e * g.N;
#pragma unroll
            for (int j = 0; j < 4; j += 2) {
                const int n = n0 + tx * 4 + j;
                float glu = acc[i][j] + bias[n], lin = acc[i][j + 1] + bias[n + 1];
                glu = fminf(glu, 7.f); lin = fminf(fmaxf(lin, -7.f), 7.f);
                ((bf16*)g.C)[(size_t)(rowbase + m) * g.ldc + (n >> 1)] = f2bf(glu * sigmoidf_(1.702f * glu) * (lin + 1.f));
            }
        } else {
#pragma unroll
            for (int j = 0; j < 4; ++j) {
                const int n = n0 + tx * 4 + j; if (n >= g.N) continue;
                const float v = acc[i][j];
                if (EPI == 0) ((float*)g.C)[(size_t)m * g.ldc + n] = v;
                if (EPI == 1) ((float*)g.C)[(size_t)m * g.ldc + n] = bf2f(((const bf16*)g.aux0)[(size_t)m * NPJ + P_GM + n]) * v;
                if (EPI == 2) ((float*)g.C)[(size_t)m * g.ldc + n] += bf2f(((const bf16*)g.aux0)[(size_t)m * NPJ + P_GD + n]) * v;
                if (EPI == 3) ((float*)g.C)[(size_t)m * g.ldc + n] = ((const float*)g.aux0)[(size_t)m * g.ldc + n] + v;
                if (EPI == 5) ((bf16*)g.C)[(size_t)(rowbase + m) * g.ldc + n] = f2bf(v + ((const float*)g.aux0)[(size_t)e * g.N + n]);
            }
        }
    }
}
__global__ __launch_bounds__(256) void k_pack(const float* __restrict__ P32, const float* __restrict__ gbias, bf16* __restrict__ PROJ, float* __restrict__ MG) {
    const int t = blockIdx.x;
    for (int c = threadIdx.x; c < NPJ; c += 256) { const int src = c < G_OFF ? c : c + 16; float v = P32[(size_t)t * DIN + src];
        if (c >= P_MK && c < P_MV) v *= KSCALE;
        if ((c >= P_MO && c < P_DQ) || c >= P_GM) v = sigmoidf_(v);
        PROJ[(size_t)t * NPJ + c] = f2bf(v); }
    if (threadIdx.x < 16) MG[(size_t)t * 16 + threadIdx.x] = P32[(size_t)t * DIN + G_OFF + threadIdx.x] + gbias[threadIdx.x];
}
__global__ __launch_bounds__(256) void k_rope(float* __restrict__ ROPE) {
    const int g = blockIdx.x * 256 + threadIdx.x; const int pos = g >> 5, i = g & 31;
    const double inv = exp2(-(double)i * (13.287712379549449 / 32.0));
    const float ang = (float)pos * (float)inv;
    ROPE[2 * g] = cosf(ang); ROPE[2 * g + 1] = sinf(ang);
}
__global__ __launch_bounds__(256) void k_qkprep(const bf16* __restrict__ PROJ, const float* __restrict__ ROPE, const float* __restrict__ qg, const float* __restrict__ kg, bf16* __restrict__ QN, bf16* __restrict__ KN) {
    const int t = blockIdx.x * 4 + (threadIdx.x >> 6), lane = threadIdx.x & 63;
    const int pos = t % S, g = lane >> 2, sub = lane & 3;
    for (int which = 0; which < 2; ++which) {
        const bf16* src = PROJ + (size_t)t * NPJ + (which ? P_DK : P_DQ) + g * 64;
        const float* gn = which ? kg : qg; bf16* dst = (which ? KN : QN) + (size_t)t * 1024 + g * 64;
        float x1[8], x2[8]; float ss = 0.f;
#pragma unroll
        for (int i = 0; i < 8; ++i) { x1[i] = bf2f(src[sub * 8 + i]); x2[i] = bf2f(src[32 + sub * 8 + i]); ss += x1[i] * x1[i] + x2[i] * x2[i]; }
        ss += __shfl_xor(ss, 1); ss += __shfl_xor(ss, 2);
        const float r = rsqrtf(ss * (1.f / 64.f) + EPS) * (which ? 1.f : QSCALE);
#pragma unroll
        for (int i = 0; i < 8; ++i) {
            const int fi = sub * 8 + i; const float c = ROPE[((size_t)pos * 32 + fi) * 2], s = ROPE[((size_t)pos * 32 + fi) * 2 + 1];
            const float a = x1[i] * r * gn[fi], b = x2[i] * r * gn[32 + fi];
            dst[fi] = f2bf(a * c - b * s); dst[32 + fi] = f2bf(b * c + a * s);
        }
    }
}
__global__ void k_mlF(const float* __restrict__ MG, float* __restrict__ F) {
    const int chain = threadIdx.x; if (chain >= 16) return;
    const int dir = chain & 1, h = (chain >> 1) & 3, b = chain >> 3;
    const int col = (dir ? 12 : 4) + h; float acc = 0.f;
    if (!dir) { for (int p = 0; p < S; ++p) { acc += logsigf_(MG[(size_t)(b * S + p) * 16 + col]); F[chain * S + p] = acc; } }
    else      { for (int p = S - 1; p >= 0; --p) { acc += logsigf_(MG[(size_t)(b * S + p) * 16 + col]); F[chain * S + p] = acc; } }
}
__global__ __launch_bounds__(256) void k_mlquad(const bf16* __restrict__ PROJ, const float* __restrict__ MG, const float* __restrict__ F, float* __restrict__ HF) {
    __shared__ float qs[16][128 + 1], ks[64][128 + 1], sc[16][64 + 1], rs[16];
    const int chain = blockIdx.y, dir = chain & 1, h = (chain >> 1) & 3, b = chain >> 3;
    const int t0 = blockIdx.x * 16, tid = threadIdx.x; const int icol = (dir ? 8 : 0) + h;
    for (int i = tid; i < 16 * 128; i += 256) { const int tt = i >> 7, kk = i & 127; qs[tt][kk] = bf2f(PROJ[(size_t)(b * S + t0 + tt) * NPJ + P_MQ + h * 128 + kk]); }
    float acc[16];
#pragma unroll
    for (int i = 0; i < 16; ++i) acc[i] = 0.f;
    if (tid < 16) rs[tid] = 0.f;
    const int sbeg = dir ? (t0 / 64) * 64 : 0, send = dir ? S : (t0 + 16 + 63) / 64 * 64;
    for (int s0 = sbeg; s0 < send; s0 += 64) {
        __syncthreads();
        for (int i = tid; i < 64 * 128; i += 256) { const int ss = i >> 7, kk = i & 127; ks[ss][kk] = bf2f(PROJ[(size_t)(b * S + s0 + ss) * NPJ + P_MK + h * 128 + kk]); }
        __syncthreads();
        for (int i = tid; i < 1024; i += 256) {
            const int tt = i >> 6, ss = i & 63; const int t = t0 + tt, s = s0 + ss; float v = 0.f;
            const bool ok = dir ? (s >= t) : (s <= t);
            if (ok) { float d = 0.f; for (int kk = 0; kk < 128; ++kk) d += qs[tt][kk] * ks[ss][kk];
                v = d * __expf(F[chain * S + t] - F[chain * S + s] + MG[(size_t)(b * S + s) * 16 + icol]); }
            sc[tt][ss] = v;
        }
        __syncthreads();
        if (tid < 16) { float r = 0.f; for (int ss = 0; ss < 64; ++ss) r += sc[tid][ss]; rs[tid] += r; }
        for (int ss = 0; ss < 64; ++ss) { const float vv = bf2f(PROJ[(size_t)(b * S + s0 + ss) * NPJ + P_MV + h * 256 + tid]);
#pragma unroll
            for (int tt = 0; tt < 16; ++tt) acc[tt] += sc[tt][ss] * vv; }
    }
    __syncthreads();
#pragma unroll
    for (int tt = 0; tt < 16; ++tt) HF[((size_t)dir * T + (b * S + t0 + tt)) * 1024 + h * 256 + tid] = acc[tt] / fmaxf(fabsf(rs[tt]), 1.f);
}
__global__ __launch_bounds__(256) void k_mlpost(const float* __restrict__ HF, const bf16* __restrict__ PROJ, const float* __restrict__ g, bf16* __restrict__ HM) {
    const int w = blockIdx.x * 4 + (threadIdx.x >> 6), lane = threadIdx.x & 63; const int t = w >> 2, h = w & 3;
    float v[4]; float ss = 0.f;
#pragma unroll
    for (int j = 0; j < 4; ++j) { const int c = h * 256 + lane + 64 * j; v[j] = HF[(size_t)t * 1024 + c] + HF[((size_t)T + t) * 1024 + c]; ss += v[j] * v[j]; }
    ss = wave_sum(ss); const float r = rsqrtf(ss * (1.f / 256.f) + EPS);
#pragma unroll
    for (int j = 0; j < 4; ++j) { const int c = h * 256 + lane + 64 * j; HM[(size_t)t * 1024 + c] = f2bf(v[j] * r * g[lane + 64 * j] * bf2f(PROJ[(size_t)t * NPJ + P_MO + c])); }
}
__global__ __launch_bounds__(256) void k_attn(const bf16* __restrict__ QN, const bf16* __restrict__ KN, const bf16* __restrict__ PROJ, const float* __restrict__ lamp, float* __restrict__ OD32) {
    __shared__ float qs[2][16][64 + 1], ks[2][64][64 + 1], sc[2][16][64 + 1], ls[2][16];
    const int bh = blockIdx.y, b = bh >> 3, h = bh & 7, t0 = blockIdx.x * 16, tid = threadIdx.x;
    const int v = tid & 127, mp = tid >> 7;
    for (int i = tid; i < 2 * 16 * 64; i += 256) { const int m = i >> 10, tt = (i >> 6) & 15, dd = i & 63; qs[m][tt][dd] = bf2f(QN[(size_t)(b * S + t0 + tt) * 1024 + h * 128 + m * 64 + dd]); }
    if (tid < 32) ls[tid >> 4][tid & 15] = 0.f;
    float acc[16];
#pragma unroll
    for (int i = 0; i < 16; ++i) acc[i] = 0.f;
    for (int s0 = 0; s0 < S; s0 += 64) {
        __syncthreads();
        for (int i = tid; i < 2 * 64 * 64; i += 256) { const int m = i >> 12, ss = (i >> 6) & 63, dd = i & 63; ks[m][ss][dd] = bf2f(KN[(size_t)(b * S + s0 + ss) * 1024 + h * 128 + m * 64 + dd]); }
        __syncthreads();
        for (int i = tid; i < 2 * 16 * 64; i += 256) { const int m = i >> 10, tt = (i >> 6) & 15, ss = i & 63; float d = 0.f;
            for (int dd = 0; dd < 64; ++dd) d += qs[m][tt][dd] * ks[m][ss][dd];
            sc[m][tt][ss] = exp2f(d); }
        __syncthreads();
        if (tid < 32) { const int m = tid >> 4, tt = tid & 15; float r = 0.f; for (int ss = 0; ss < 64; ++ss) r += sc[m][tt][ss]; ls[m][tt] += r; }
        for (int ss = 0; ss < 64; ++ss) { const float vv = bf2f(PROJ[(size_t)(b * S + s0 + ss) * NPJ + P_DV + h * 128 + v]);
#pragma unroll
            for (int tt = 0; tt < 16; ++tt) acc[tt] += sc[mp][tt][ss] * vv; }
    }
    __syncthreads();
    float s01 = 0.f, s23 = 0.f;
    for (int i = 0; i < 64; ++i) { s01 += lamp[i] * lamp[64 + i]; s23 += lamp[128 + i] * lamp[192 + i]; }
    const float lam = __expf(s01) - __expf(s23) + LAM_INIT;
    float* ob = &ks[0][0][0];
    if (mp == 1) { for (int tt = 0; tt < 16; ++tt) ob[tt * 128 + v] = acc[tt] / ls[1][tt]; }
    __syncthreads();
    if (mp == 0) { for (int tt = 0; tt < 16; ++tt) OD32[(size_t)(b * S + t0 + tt) * 1024 + h * 128 + v] = acc[tt] / ls[0][tt] - lam * ob[tt * 128 + v]; }
}
__global__ __launch_bounds__(256) void k_dapost(const float* __restrict__ OD32, const float* __restrict__ g, bf16* __restrict__ OD) {
    const int w = blockIdx.x * 4 + (threadIdx.x >> 6), lane = threadIdx.x & 63; const int t = w >> 3, h = w & 7;
    float v[2]; float ss = 0.f;
#pragma unroll
    for (int j = 0; j < 2; ++j) { v[j] = OD32[(size_t)t * 1024 + h * 128 + lane + 64 * j]; ss += v[j] * v[j]; }
    ss = wave_sum(ss); const float r = rsqrtf(ss * (1.f / 128.f) + EPS);
#pragma unroll
    for (int j = 0; j < 2; ++j) OD[(size_t)t * 1024 + h * 128 + lane + 64 * j] = f2bf(v[j] * r * g[lane + 64 * j] * (1.f - LAM_INIT));
}
__global__ __launch_bounds__(256) void k_route1(const float* __restrict__ x1, const float* __restrict__ g2, const float* __restrict__ wr, const float* __restrict__ br,
                                                bf16* __restrict__ H2, int* __restrict__ cnt, int* __restrict__ TOPE, int* __restrict__ SLOT, float* __restrict__ WTS) {
    const int t = blockIdx.x * 4 + (threadIdx.x >> 6), lane = threadIdx.x & 63;
    const float* xr = x1 + (size_t)t * D; float v[32]; float s = 0.f;
#pragma unroll
    for (int j = 0; j < 32; ++j) { v[j] = xr[lane + 64 * j]; s += v[j] * v[j]; }
    s = wave_sum(s); const float r = rsqrtf(s * (1.f / D) + EPS);
#pragma unroll
    for (int j = 0; j < 32; ++j) { v[j] = v[j] * r * g2[lane + 64 * j]; H2[(size_t)t * D + lane + 64 * j] = f2bf(v[j]); }
    float mylogit = -INFINITY;
    for (int e = 0; e < NE; ++e) { float p = 0.f;
#pragma unroll
        for (int j = 0; j < 32; ++j) p += v[j] * wr[(size_t)(lane + 64 * j) * NE + e];
        p = wave_sum(p) + br[e]; if (lane == e) mylogit = p; }
    float tv[4]; int ti[4]; float cur = mylogit;
#pragma unroll
    for (int k = 0; k < 4; ++k) { const float m = wave_max(cur); const unsigned long long bal = __ballot(cur == m && lane < NE); const int idx = __ffsll((long long)bal) - 1; tv[k] = m; ti[k] = idx; if (lane == idx) cur = -INFINITY; }
    if (lane == 0) { const float e1 = __expf(tv[1] - tv[0]), e2 = __expf(tv[2] - tv[0]), e3 = __expf(tv[3] - tv[0]); const float inv = 1.f / (1.f + e1 + e2 + e3);
        const float w[4] = {inv, e1 * inv, e2 * inv, e3 * inv};
#pragma unroll
        for (int k = 0; k < 4; ++k) { TOPE[t * 4 + k] = ti[k]; SLOT[t * 4 + k] = atomicAdd(&cnt[ti[k]], 1); WTS[t * 4 + k] = w[k]; } }
}
__global__ __launch_bounds__(256) void k_route2(const bf16* __restrict__ H2, const int* __restrict__ cnt, const int* __restrict__ TOPE, const int* __restrict__ SLOT, int* __restrict__ DEST, bf16* __restrict__ XG) {
    const int a = blockIdx.x * 4 + (threadIdx.x >> 6), lane = threadIdx.x & 63;
    if (a < T * TOPK) { const int t = a >> 2, e = TOPE[a]; int start = 0;
        for (int i = 0; i < e; ++i) start += (cnt[i] + PADM - 1) / PADM * PADM;
        const int row = start + SLOT[a]; if (lane == 0) DEST[a] = row;
        for (int j = 0; j < 32; ++j) XG[(size_t)row * D + lane + 64 * j] = H2[(size_t)t * D + lane + 64 * j];
    } else { const int p = a - T * TOPK; if (p >= NE * PADM) return;
        const int e = p / PADM, q = p % PADM; int start = 0;
        for (int i = 0; i < e; ++i) start += (cnt[i] + PADM - 1) / PADM * PADM;
        const int c = cnt[e], padded = (c + PADM - 1) / PADM * PADM;
        if (c + q < padded) { const int row = start + c + q; for (int j = 0; j < 32; ++j) XG[(size_t)row * D + lane + 64 * j] = 0; } }
}
__global__ __launch_bounds__(256) void k_combine(float* __restrict__ out, const bf16* __restrict__ Y, const int* __restrict__ DEST, const float* __restrict__ WTS) {
    const int t = blockIdx.x * 4 + (threadIdx.x >> 6), lane = threadIdx.x & 63; int d[4]; float w[4];
#pragma unroll
    for (int k = 0; k < 4; ++k) { d[k] = DEST[t * 4 + k]; w[k] = WTS[t * 4 + k]; }
    for (int j = 0; j < 32; ++j) { const int c = lane + 64 * j; float a = out[(size_t)t * D + c];
#pragma unroll
        for (int k = 0; k < 4; ++k) a += w[k] * bf2f(Y[(size_t)d[k] * D + c]);
        out[(size_t)t * D + c] = a; }
}
#endif
#ifndef MEGA_MASK
#define MEGA_MASK 0xFF
#endif
static int g_grid = 0;
static void launch_mega(Args a, int lo, int hi, hipStream_t stream) {
    (void)hipMemsetAsync(a.ws + WS_CTL + CW_BAR * 4, 0, XCD_BAR_WORDS * 4, stream);
    a.ph_lo = lo; a.ph_hi = hi;
    hipLaunchKernelGGL(mega_fwd, dim3(g_grid), dim3(NTHR), LDS_BYTES, stream, a);
}
extern "C" void kernel_launch(void* const* d_in, const int* in_sizes, int n_in, void* d_out, int out_size, void* d_ws, size_t ws_size, hipStream_t stream) {
    if (g_grid == 0) {
        int dev = 0, cus = 0;
        if (n_in != 19 || out_size != T * D || hipGetDevice(&dev) != hipSuccess || hipDeviceGetAttribute(&cus, hipDeviceAttributeMultiprocessorCount, dev) != hipSuccess) { g_grid = -1; return; }
        if (hipFuncSetAttribute((const void*)mega_fwd, hipFuncAttributeMaxDynamicSharedMemorySize, LDS_BYTES) != hipSuccess) { g_grid = -1; return; }
        int per_cu = 0; (void)hipOccupancyMaxActiveBlocksPerMultiprocessor(&per_cu, (const void*)mega_fwd, NTHR, LDS_BYTES); (void)hipGetLastError();
        g_grid = cus;
    }
    if (g_grid < 0) return;
    Args a{};
    for (int i = 0; i < 19; ++i) a.in[i] = (const float*)d_in[i];
    a.out = (float*)d_out; a.ws = (unsigned char*)d_ws;
    (void)hipMemsetAsync(a.ws + WS_CTL, 0, 4096 * 4, stream);
#ifdef DEV_NAIVE
    unsigned char* ws = a.ws; const int mask = MEGA_MASK;
    bf16* PROJ = (bf16*)(ws + WS_PROJ); float* MG = (float*)(ws + WS_MG); float* ROPE = (float*)(ws + WS_ROPE);
    bf16* QN = (bf16*)(ws + WS_QN); bf16* KN = (bf16*)(ws + WS_KN); bf16* HM = (bf16*)(ws + WS_HM); bf16* OD = (bf16*)(ws + WS_OD);
    bf16* H2 = (bf16*)(ws + WS_H2); bf16* XG = (bf16*)(ws + WS_XG); bf16* ACT = (bf16*)(ws + WS_ACT); bf16* Y = (bf16*)(ws + WS_Y);
    int* cnt = (int*)(ws + WS_CTL) + CW_CNT; int* TOPE = (int*)(ws + WS_RT); int* SLOT = TOPE + T * 4; float* WTS = (float*)(SLOT + T * 4); int* DEST = (int*)(WTS + T * 4);
    float* XN32 = (float*)(ws + NV_XN32); float* PROJ32 = (float*)(ws + NV_PROJ32); float* F = (float*)(ws + NV_F); float* HF = (float*)(ws + NV_HF); float* OD32 = (float*)(ws + NV_OD32); float* MIX32 = (float*)(ws + NV_MIX32);
    const float* x = a.in[0]; float* out = a.out;
    static const int ranges[8][2] = {{0, 2}, {2, 3}, {3, 6}, {6, 7}, {7, 9}, {9, 11}, {11, 13}, {13, 14}};
    for (int s = 0; s < 8; ++s) {
        if (mask & (1 << s)) { int e = s; while (e + 1 < 8 && (mask & (1 << (e + 1)))) ++e; launch_mega(a, ranges[s][0], ranges[e][1], stream); s = e; continue; }
        switch (s) {
        case 0: { k_rmsnorm<<<T / 4, 256, 0, stream>>>(x, a.in[1], XN32);
            GArgs g{}; g.A = XN32; g.B = a.in[2]; g.C = PROJ32; g.M = T; g.N = DIN; g.K = D; g.lda = D; g.ldb = DIN; g.ldc = DIN;
            k_gemm<0, float><<<dim3((DIN + 63) / 64, T / 64), 256, 0, stream>>>(g);
            k_pack<<<T, 256, 0, stream>>>(PROJ32, a.in[3], PROJ, MG); k_rope<<<S * 32 / 256, 256, 0, stream>>>(ROPE); } break;
        case 1: k_qkprep<<<T / 4, 256, 0, stream>>>(PROJ, ROPE, a.in[6], a.in[7], QN, KN); break;
        case 2: k_mlF<<<1, 64, 0, stream>>>(MG, F); k_mlquad<<<dim3(S / 16, 16), 256, 0, stream>>>(PROJ, MG, F, HF); k_mlpost<<<T, 256, 0, stream>>>(HF, PROJ, a.in[4], HM); break;
        case 3: k_attn<<<dim3(S / 16, 16), 256, 0, stream>>>(QN, KN, PROJ, a.in[8], OD32); k_dapost<<<T * 2, 256, 0, stream>>>(OD32, a.in[9], OD); break;
        case 4: { GArgs g{}; g.A = HM; g.B = a.in[5]; g.C = MIX32; g.M = T; g.N = D; g.K = MLW; g.lda = MLW; g.ldb = D; g.ldc = D; g.aux0 = PROJ;
            k_gemm<1, bf16><<<dim3(D / 64, T / 64), 256, 0, stream>>>(g);
            g.A = OD; g.B = a.in[10]; g.K = DAW; g.lda = DAW; k_gemm<2, bf16><<<dim3(D / 64, T / 64), 256, 0, stream>>>(g);
            GArgs h{}; h.A = MIX32; h.B = a.in[11]; h.C = out; h.M = T; h.N = D; h.K = D; h.lda = D; h.ldb = D; h.ldc = D; h.aux0 = x;
            k_gemm<3, float><<<dim3(D / 64, T / 64), 256, 0, stream>>>(h); } break;
        case 5: k_route1<<<T / 4, 256, 0, stream>>>(out, a.in[12], a.in[13], a.in[14], H2, cnt, TOPE, SLOT, WTS);
            k_route2<<<(T * TOPK + NE * PADM) / 4, 256, 0, stream>>>(H2, cnt, TOPE, SLOT, DEST, XG); break;
        case 6: { GArgs g{}; g.A = XG; g.B = a.in[15]; g.C = ACT; g.N = 2 * DE; g.K = D; g.lda = D; g.ldb = 2 * DE; g.ldc = DE; g.aux0 = a.in[16]; g.cnt = cnt;
            k_gemm<4, bf16><<<dim3(2 * DE / 64, T / 64, NE), 256, 0, stream>>>(g);
            GArgs h{}; h.A = ACT; h.B = a.in[17]; h.C = Y; h.N = D; h.K = DE; h.lda = DE; h.ldb = D; h.ldc = D; h.aux0 = a.in[18]; h.cnt = cnt;
            k_gemm<5, bf16><<<dim3(D / 64, T / 64, NE), 256, 0, stream>>>(h); } break;
        case 7: k_combine<<<T / 4, 256, 0, stream>>>(out, Y, DEST, WTS); break;
        }
    }
#else
    launch_mega(a, 0, N_PHASES, stream);
#endif
}
```

```cpp
#include <hip/hip_runtime.h>
#include <cstdio>
#include <cstdint>
#include <math.h>

constexpr int D = 2048, NB = 2, S = 4096, T = NB * S;
constexpr int MLH = 4, MLDK = 128, MLDV = 256, MLW = 1024, NCH = 64;
constexpr int DAH = 8, DAD = 64, DADV = 128, DAW = 1024;
constexpr int NE = 32, TOPK = 4, DE = 2048;
constexpr int DIN = 10256, NPJ = 10240;
constexpr int G_OFF = 3072;
constexpr int P_MQ = 0, P_MK = 512, P_MV = 1024, P_MO = 2048, P_DQ = 3072, P_DK = 4096, P_DV = 5120, P_GM = 6144, P_GD = 8192;
constexpr float EPS = 1e-6f;
constexpr int PADM = 256;
constexpr int MAXROWS = T * TOPK + NE * PADM;
constexpr float LAM_INIT = 0.2f;
constexpr float QSCALE = 0.125f * 1.4426950408889634f;
constexpr float KSCALE = 0.08838834764831845f;

constexpr size_t MiB = 1ull << 20;
constexpr size_t WS_CTL = 0, CTL_ZERO_BYTES = 1 * MiB;
constexpr size_t WS_MSC = 1 * MiB;
constexpr size_t WS_RT = 2 * MiB;
constexpr size_t WS_ROPE = 3 * MiB;
constexpr size_t WS_MG = 4 * MiB;
constexpr size_t WS_NU = 5 * MiB;
constexpr size_t WS_NP = 6 * MiB;
constexpr size_t WS_WRH = 7 * MiB, WS_WRL = 7 * MiB + 256 * 1024;
constexpr size_t WS_WIN = 8 * MiB;
constexpr size_t WS_WIN8 = 32 * MiB;
constexpr size_t WS_WML = 48 * MiB;
constexpr size_t WS_WDA = 52 * MiB;
constexpr size_t WS_WO = 56 * MiB;
constexpr size_t WS_WGU = 64 * MiB;
constexpr size_t WS_WDN = 576 * MiB;
constexpr size_t WS_XN = 832 * MiB;
constexpr size_t WS_PROJ = 864 * MiB;
constexpr size_t WS_QN = 1024 * MiB;
constexpr size_t WS_KN = 1040 * MiB;
constexpr size_t WS_U = 1056 * MiB;
constexpr size_t WS_CP = 1184 * MiB;
constexpr size_t WS_HM = 1248 * MiB;
constexpr size_t WS_OD = 1264 * MiB;
constexpr size_t WS_XN8 = 1280 * MiB;
constexpr size_t WS_T1 = 1280 * MiB;
constexpr size_t WS_MIX = 1312 * MiB;
constexpr size_t WS_H2 = 1344 * MiB;
constexpr size_t WS_XG = 1376 * MiB;
constexpr size_t WS_ACT = 1536 * MiB;
constexpr size_t WS_Y = 1696 * MiB;
constexpr size_t WS_G8 = 1856 * MiB;
constexpr size_t WS_NAIVE = 1920 * MiB;
constexpr size_t WS_END = 2500 * MiB;
constexpr int CW_CNT = 64;
constexpr int CW_BAR = 4096;
constexpr int CW_WGCNT = 8192;

typedef unsigned short bf16;
typedef unsigned v4u __attribute__((ext_vector_type(4)));
typedef unsigned v2u __attribute__((ext_vector_type(2)));
typedef float f32x4 __attribute__((ext_vector_type(4)));
typedef float f32x2 __attribute__((ext_vector_type(2)));
typedef float f32x16 __attribute__((ext_vector_type(16)));
typedef short bf16x8 __attribute__((ext_vector_type(8)));
typedef short s16x4 __attribute__((ext_vector_type(4)));
typedef __bf16 bf16x2_t __attribute__((ext_vector_type(2)));
#define GAS __attribute__((address_space(1)))
#define LAS __attribute__((address_space(3)))

__device__ __forceinline__ float bf2f(unsigned v) { return __uint_as_float(v << 16); }
__device__ __forceinline__ float bflo(unsigned w) { return __uint_as_float(w << 16); }
__device__ __forceinline__ float bfhi(unsigned w) { return __uint_as_float(w & 0xffff0000u); }
__device__ __forceinline__ unsigned pk2(float lo, float hi) { f32x2 v = {lo, hi}; bf16x2_t b = __builtin_convertvector(v, bf16x2_t); return __builtin_bit_cast(unsigned, b); }
__device__ __forceinline__ bf16 f2bf(float f) { return (bf16)(pk2(f, 0.f) & 0xffffu); }
__device__ __forceinline__ float sigmoidf_(float x) { return __builtin_amdgcn_rcpf(1.f + __expf(-x)); }
__device__ __forceinline__ float logsigf_(float x) { return x >= 0.f ? -log1pf(__expf(-x)) : x - log1pf(__expf(x)); }
__device__ __forceinline__ float wave_sum(float v) {
#pragma unroll
    for (int o = 1; o < 64; o <<= 1) v += __shfl_xor(v, o);
    return v;
}
__device__ __forceinline__ float wave_max(float v) {
#pragma unroll
    for (int o = 1; o < 64; o <<= 1) v = fmaxf(v, __shfl_xor(v, o));
    return v;
}
namespace pg8 {
#define PG8_LAS __attribute__((address_space(3)))
typedef unsigned short bf16_t;
typedef short bf16x8 __attribute__((ext_vector_type(8)));
typedef float f32x4 __attribute__((ext_vector_type(4)));
typedef unsigned u32x4 __attribute__((ext_vector_type(4)));
constexpr int BM = 256, BK = 64, HALF = 128, HTB = HALF * BK * 2  , STAGE_BYTES = 8 * HTB, NXCD = 8, WGM = 8;

__host__ __device__ __forceinline__ int lds_byte(int r, int c) { const int st = (r >> 4) * 2 + (c >> 5), rr = r & 15, cc = c & 31, ob = rr * 64 + cc * 2; return st * 1024 + (ob ^ (((ob >> 9) & 1) << 5)); }
__host__ __device__ __forceinline__ void stage_rc(int b, int& R, int& C) { const int st = b / 1024, sb = b % 1024, swz = sb ^ (((sb >> 9) & 1) << 5); R = (st >> 1) * 16 + swz / 64; C = (st & 1) * 32 + (swz % 64) / 2; }
__host__ __device__ __forceinline__ int perm32(int rho) { const int n = rho >> 4, i = rho & 15; return 8 * (i >> 2) + 4 * n + (i & 3); }

struct Unit { int pm, pn, pb, half; };
struct Gemm { const bf16_t* A; const bf16_t* Bt; int M, N, K; };

struct StaticOrder {
    int nM, nN, nwg, G, c;
    __host__ __device__ void init(int M, int N, int G_, int c_) { nM = M / BM; nN = N / BM; nwg = nM * nN; G = G_; c = c_; }
    __host__ __device__ bool next(int i, Unit& u) const {
        const long L = (long)i * G + c; if (L >= nwg) return false;
        int wgid = (int)L; { const int q = nwg / NXCD, r = nwg % NXCD, xcd = wgid % NXCD, off = wgid / NXCD; wgid = (xcd < r ? xcd * (q + 1) : r * (q + 1) + (xcd - r) * q) + off; }
        const int nig = WGM * nN, gid = wgid / nig, fm = gid * WGM, gsz = (nM - fm) < WGM ? (nM - fm) : WGM;
        u.pm = fm + ((wgid % nig) % gsz); u.pn = (wgid % nig) / gsz; u.pb = u.pn; u.half = 0; return true;
    }
    __device__ __forceinline__ void a_ready(const Unit&) const {}
    __device__ __forceinline__ void done(const Unit&) const {}
    __device__ __forceinline__ int rot() const { return 0; }
};

__device__ __forceinline__ unsigned cvt_pk_bf16(float lo, float hi) { unsigned r; asm volatile("v_cvt_pk_bf16_f32 %0, %1, %2" : "=v"(r) : "v"(lo), "v"(hi)); return r; }
typedef float f32x2 __attribute__((ext_vector_type(2)));
typedef int v8i_t __attribute__((ext_vector_type(8)));
__device__ __forceinline__ const char* pg8_uni(const char* p) { const unsigned long long v = (unsigned long long)p; const unsigned lo = __builtin_amdgcn_readfirstlane((unsigned)v), hi = __builtin_amdgcn_readfirstlane((unsigned)(v >> 32)); return (const char*)(((unsigned long long)hi << 32) | lo); }
template <class Epi, class Sched, bool ALIGN_EPI = false, bool SP2 = false, bool FP8 = false, int BLK = 0, bool GATHER = false>
__device__ __forceinline__ void gemm_phase(PG8_LAS unsigned char* lds, const Gemm g, const Sched& S, const Epi& E, const unsigned* rmap = nullptr, int salt = 0) {
    const int tid = (int)threadIdx.x + salt, wid = __builtin_amdgcn_readfirstlane(tid >> 6), lane = tid & 63, wr = wid >> 2, wc = wid & 3, fr = lane & 15, fq = lane >> 4;
    const int K = g.K, nt = K / BK;
    unsigned voffA[2], voffB[2];
#pragma unroll
    for (int i = 0; i < 2; ++i) { int R, C; stage_rc(tid * 16 + i * 8192, R, C); const int Rb = Epi::PERM ? ((R & ~31) + perm32(R & 31)) : R;
        voffA[i] = (unsigned)(R * ((BLK & 1) ? BK : K) + C) * 2u; voffB[i] = (unsigned)(Rb * ((BLK & 2) ? BK : K) + C) * 2u; }
    const size_t kstepA = (BLK & 1) ? (size_t)(2 * HTB) : (size_t)(BK * 2), kstepB = (BLK & 2) ? (size_t)(2 * HTB) : (size_t)(BK * 2);
    const size_t hstepA = GATHER ? (size_t)0 : (BLK & 1) ? (size_t)HTB : (size_t)HALF * K * 2, hstepB = (BLK & 2) ? (size_t)HTB : (size_t)HALF * K * 2;
    const size_t tstep = (size_t)2 * HALF * K * 2;
    const size_t tstepA = GATHER ? (size_t)0 : tstep;
    unsigned gofs[2][2], gcb[2], gri[2]; (void)gofs; (void)gcb; (void)gri;
    if constexpr (GATHER) { _Pragma("unroll") for (int i = 0; i < 2; ++i) { int R, C; stage_rc(tid * 16 + i * 8192, R, C); gcb[i] = (unsigned)C * 2u; gri[i] = (unsigned)R * 4u; } }
    constexpr int GMAP_OFF = STAGE_BYTES;
    const unsigned ldsb_ = (unsigned)(uintptr_t)lds;
    const unsigned ldsw = (unsigned)wid * 1024u;
    const int aoff = lds_byte(wr * 64 + fr, fq * 8), boff = lds_byte(wc * 32 + fr, fq * 8);
#define PG8_SA(b, h) (((b) * 2 + (h)) * HTB)
#define PG8_SB(b, h) ((4 + (b) * 2 + (h)) * HTB)
#define PG8_STAGE(bufoff, gbase, voff) do { _Pragma("unroll") for (int _i = 0; _i < 2; ++_i) { unsigned keep_; \
        asm volatile("s_mov_b32 %0, m0\n\ts_mov_b32 m0, %3\n\ts_nop 0\n\tglobal_load_lds_dwordx4 %1, %2\n\ts_mov_b32 m0, %0" : "=&s"(keep_) : "v"((voff)[_i]), "s"(pg8_uni((const char*)(gbase))), \
            "s"((unsigned)__builtin_amdgcn_readfirstlane((int)(ldsb_ + (unsigned)(bufoff) + ldsw + (unsigned)(_i * 8192)))) : "memory"); } } while (0)
#define PG8_STAGE_A(bufoff, gbase, h) do { if constexpr (GATHER) PG8_STAGE(bufoff, gbase, gofs[h]); else PG8_STAGE(bufoff, gbase, voffA); } while (0)
#define PG8_CAT16(lo, hi) __builtin_bit_cast(v8i_t, __builtin_shufflevector(lo, hi, 0, 1, 2, 3, 4, 5, 6, 7, 8, 9, 10, 11, 12, 13, 14, 15))
#define PG8_LDA(dst, b, h) do { if constexpr (FP8) { _Pragma("unroll") for (int m = 0; m < 4; ++m) { const bf16x8 lo_ = *(const PG8_LAS bf16x8*)(lds + PG8_SA(b, h) + aoff + m * 2048), hi_ = *(const PG8_LAS bf16x8*)(lds + PG8_SA(b, h) + aoff + m * 2048 + 1024); dst##8[m] = PG8_CAT16(lo_, hi_); } } \
    else { _Pragma("unroll") for (int m = 0; m < 4; ++m) _Pragma("unroll") for (int k = 0; k < 2; ++k) dst[m][k] = *(const PG8_LAS bf16x8*)(lds + PG8_SA(b, h) + aoff + m * 2048 + k * 1024); } } while (0)
#define PG8_LDB(dst, b, h) do { if constexpr (FP8) { _Pragma("unroll") for (int n = 0; n < 2; ++n) { const bf16x8 lo_ = *(const PG8_LAS bf16x8*)(lds + PG8_SB(b, h) + boff + n * 2048), hi_ = *(const PG8_LAS bf16x8*)(lds + PG8_SB(b, h) + boff + n * 2048 + 1024); dst##8[n] = PG8_CAT16(lo_, hi_); } } \
    else { _Pragma("unroll") for (int n = 0; n < 2; ++n) _Pragma("unroll") for (int k = 0; k < 2; ++k) dst[n][k] = *(const PG8_LAS bf16x8*)(lds + PG8_SB(b, h) + boff + n * 2048 + k * 1024); } } while (0)
#define PG8_MMA(ai, bj, At, Bt) do { __builtin_amdgcn_s_setprio(1); \
    if constexpr (FP8) { _Pragma("unroll") for (int m = 0; m < 4; ++m) _Pragma("unroll") for (int n = 0; n < 2; ++n) \
        asm volatile("v_mfma_f32_16x16x128_f8f6f4 %0, %1, %2, %0" : "+v"(acc[ai][bj][m][n]) : "v"(Bt##8[n]), "v"(At##8[m])); } \
    else { _Pragma("unroll") for (int m = 0; m < 4; ++m) _Pragma("unroll") for (int n = 0; n < 2; ++n) _Pragma("unroll") for (int k = 0; k < 2; ++k) \
        acc[ai][bj][m][n] = __builtin_amdgcn_mfma_f32_16x16x32_bf16(Bt[n][k], At[m][k], acc[ai][bj][m][n], 0, 0, 0); } \
    __builtin_amdgcn_s_setprio(0); } while (0)
#define PG8_WAIT_V(n) asm volatile("s_waitcnt vmcnt(" #n ")" ::: "memory")
#define PG8_WAIT_L(n) asm volatile("s_waitcnt lgkmcnt(" #n ")" ::: "memory")
#define PG8_BAR __builtin_amdgcn_s_barrier()
#define PG8_SCHED __builtin_amdgcn_sched_barrier(0)
    Unit cur, nxt; int ui = 0;
    if (!S.next(0, cur)) return;
    f32x4 acc[2][2][4][2];
#pragma unroll
    for (int a = 0; a < 2; ++a)
#pragma unroll
        for (int b = 0; b < 2; ++b)
#pragma unroll
            for (int m = 0; m < 4; ++m)
#pragma unroll
                for (int n = 0; n < 2; ++n) acc[a][b][m][n] = (f32x4){0.f, 0.f, 0.f, 0.f};
    bf16x8 At[4][2], B0[2][2], B1[2][2]; v8i_t At8[4], B08[2], B18[2]; (void)At; (void)B0; (void)B1; (void)At8; (void)B08; (void)B18; int sc8_ = 0x7f7f7f7f; asm volatile("" : "+v"(sc8_)); (void)sc8_;
    const char* cA = (const char*)g.A + (size_t)cur.pm * tstepA; const char* cB = (const char*)g.Bt + (size_t)cur.pb * tstep;
    const int rot = S.rot();
#define PG8_KIX(t) ((size_t)(((t) + rot) & (nt - 1)))
    const size_t k0A = PG8_KIX(0) * kstepA, k1A = PG8_KIX(1) * kstepA, k0B = PG8_KIX(0) * kstepB, k1B = PG8_KIX(1) * kstepB;
    S.a_ready(cur);
    static_assert(!GATHER || SP2, "GATHER is implemented for the SP2 loop");
    if constexpr (GATHER) { _Pragma("unroll") for (int h = 0; h < 2; ++h) _Pragma("unroll") for (int i = 0; i < 2; ++i) gofs[h][i] = rmap[cur.pm * BM + h * HALF + (int)(gri[i] >> 2)] + gcb[i]; }
    if constexpr (SP2) {
        PG8_STAGE(PG8_SB(0, 0), cB + k0B, voffB); PG8_STAGE(PG8_SB(0, 1), cB + hstepB + k0B, voffB); PG8_STAGE_A(PG8_SA(0, 0), cA + k0A, 0); PG8_STAGE_A(PG8_SA(0, 1), cA + hstepA + k0A, 1);
        if (wr == 1) PG8_BAR;
        PG8_WAIT_V(2); PG8_BAR;
        PG8_STAGE(PG8_SB(1, 0), cB + k1B, voffB); PG8_STAGE_A(PG8_SA(1, 0), cA + k1A, 0); PG8_STAGE(PG8_SB(1, 1), cB + hstepB + k1B, voffB);
        PG8_WAIT_V(6); PG8_BAR;
    } else {
        PG8_STAGE(PG8_SB(0, 0), cB + k0B, voffB); PG8_STAGE_A(PG8_SA(0, 0), cA + k0A, 0); PG8_STAGE(PG8_SB(0, 1), cB + hstepB + k0B, voffB); PG8_STAGE_A(PG8_SA(0, 1), cA + hstepA + k0A, 1);
        if (wr == 1) PG8_BAR;
        PG8_WAIT_V(4); PG8_BAR;
        PG8_STAGE(PG8_SB(1, 0), cB + k1B, voffB); PG8_STAGE_A(PG8_SA(1, 0), cA + k1A, 0); PG8_STAGE(PG8_SB(1, 1), cB + hstepB + k1B, voffB);
        PG8_WAIT_V(6); PG8_BAR;
    }
    for (;;) {
        const bool has_next = S.next(ui + 1, nxt);
        const char* nA = has_next ? (const char*)g.A + (size_t)nxt.pm * tstepA : cA; const char* nB = has_next ? (const char*)g.Bt + (size_t)nxt.pb * tstep : cB;
        for (int t = 0; t < nt; t += 2) {
            const bool last = (t == nt - 2);
            const char* a1 = cA + PG8_KIX(t + 1) * kstepA;
            const size_t i2 = PG8_KIX(t + 2), i3 = PG8_KIX(t + 3);
            const char* a2 = (last ? nA : cA) + i2 * kstepA; const char* b2 = (last ? nB : cB) + i2 * kstepB;
            const char* a3 = (last ? nA : cA) + i3 * kstepA; const char* b3 = (last ? nB : cB) + i3 * kstepB;
            if (last && has_next) S.a_ready(nxt);
            if constexpr (SP2) {
            if constexpr (GATHER) { if (t == 0 && has_next) {
                _Pragma("unroll") for (int h = 0; h < 2; ++h) _Pragma("unroll") for (int i = 0; i < 2; ++i) { unsigned keep_;
                    asm volatile("s_mov_b32 %0, m0\n\ts_mov_b32 m0, %3\n\ts_nop 0\n\tglobal_load_lds_dword %1, %2\n\ts_mov_b32 m0, %0" : "=&s"(keep_) : "v"(gri[i]), "s"(pg8_uni((const char*)(rmap + nxt.pm * BM + h * HALF))),
                        "s"((unsigned)__builtin_amdgcn_readfirstlane((int)(ldsb_ + (unsigned)GMAP_OFF + ldsw + (unsigned)((h * 2 + i) * 256)))) : "memory"); } } }
            PG8_LDB(B0, 0, 0); PG8_LDB(B1, 0, 1); PG8_SCHED; PG8_LDA(At, 0, 0); PG8_STAGE_A(PG8_SA(1, 1), a1 + hstepA, 1);
            if constexpr (GATHER) { if (last && has_next) {
                _Pragma("unroll") for (int h = 0; h < 2; ++h) _Pragma("unroll") for (int i = 0; i < 2; ++i) gofs[h][i] = *(const PG8_LAS unsigned*)(lds + GMAP_OFF + ldsw + (h * 2 + i) * 256 + lane * 4) + gcb[i]; } }
            PG8_WAIT_V(8); PG8_WAIT_L(0); PG8_BAR; PG8_MMA(0, 0, At, B0); PG8_MMA(0, 1, At, B1); PG8_BAR; PG8_SCHED;
            PG8_LDA(At, 0, 1); PG8_STAGE(PG8_SB(0, 0), b2, voffB); PG8_STAGE(PG8_SB(0, 1), b2 + hstepB, voffB); PG8_STAGE_A(PG8_SA(0, 0), a2, 0);
            PG8_WAIT_V(8); PG8_WAIT_L(0); PG8_BAR; if (!cur.half) { PG8_MMA(1, 0, At, B0); PG8_MMA(1, 1, At, B1); } PG8_BAR; PG8_SCHED;
            PG8_LDB(B0, 1, 0); PG8_LDB(B1, 1, 1); PG8_SCHED; PG8_LDA(At, 1, 0); PG8_STAGE_A(PG8_SA(0, 1), a2 + hstepA, 1);
            PG8_WAIT_V(8); PG8_WAIT_L(0); PG8_BAR; PG8_MMA(0, 0, At, B0); PG8_MMA(0, 1, At, B1); PG8_BAR; PG8_SCHED;
            PG8_LDA(At, 1, 1); PG8_STAGE(PG8_SB(1, 0), b3, voffB); PG8_STAGE(PG8_SB(1, 1), b3 + hstepB, voffB); PG8_STAGE_A(PG8_SA(1, 0), a3, 0);
            PG8_WAIT_V(8); PG8_WAIT_L(0); PG8_BAR; if (!cur.half) { PG8_MMA(1, 0, At, B0); PG8_MMA(1, 1, At, B1); } PG8_BAR; PG8_SCHED;
            } else {
            PG8_LDB(B0, 0, 0); PG8_SCHED; PG8_LDA(At, 0, 0); PG8_STAGE_A(PG8_SA(1, 1), a1 + hstepA, 1);
            PG8_WAIT_L(8); PG8_BAR; PG8_WAIT_L(0); PG8_MMA(0, 0, At, B0); PG8_BAR; PG8_SCHED;
            PG8_LDB(B1, 0, 1); PG8_STAGE(PG8_SB(0, 0), b2, voffB);
            PG8_BAR; PG8_WAIT_L(0); PG8_MMA(0, 1, At, B1); PG8_BAR;
            PG8_LDA(At, 0, 1); PG8_STAGE_A(PG8_SA(0, 0), a2, 0);
            PG8_BAR; PG8_WAIT_L(0); if (!cur.half) PG8_MMA(1, 0, At, B0); PG8_BAR; PG8_SCHED;
            PG8_STAGE(PG8_SB(0, 1), b2 + hstepB, voffB);
            PG8_WAIT_V(6); PG8_BAR; if (!cur.half) PG8_MMA(1, 1, At, B1); PG8_BAR;
            PG8_LDB(B0, 1, 0); PG8_SCHED; PG8_LDA(At, 1, 0); PG8_STAGE_A(PG8_SA(0, 1), a2 + hstepA, 1);
            PG8_WAIT_L(8); PG8_BAR; PG8_WAIT_L(0); PG8_MMA(0, 0, At, B0); PG8_BAR; PG8_SCHED;
            PG8_LDB(B1, 1, 1); PG8_STAGE(PG8_SB(1, 0), b3, voffB);
            PG8_BAR; PG8_WAIT_L(0); PG8_MMA(0, 1, At, B1); PG8_BAR;
            PG8_LDA(At, 1, 1); PG8_STAGE_A(PG8_SA(1, 0), a3, 0);
            PG8_BAR; PG8_WAIT_L(0); if (!cur.half) PG8_MMA(1, 0, At, B0); PG8_BAR; PG8_SCHED;
            PG8_STAGE(PG8_SB(1, 1), b3 + hstepB, voffB);
            PG8_WAIT_V(6); PG8_BAR; if (!cur.half) PG8_MMA(1, 1, At, B1); PG8_BAR;
            }
        }
        if constexpr (ALIGN_EPI) { if (wr == 0) PG8_BAR; }
        if constexpr (FP8) asm volatile("s_nop 15\n\ts_nop 15" ::: "memory");
        if constexpr (!Epi::AFTER_DRAIN) { E(acc, cur, wr, wc, fr, fq); S.done(cur); }
        if (!has_next) break;
#pragma unroll
        for (int a = 0; a < 2; ++a)
#pragma unroll
            for (int b = 0; b < 2; ++b)
#pragma unroll
                for (int m = 0; m < 4; ++m)
#pragma unroll
                    for (int n = 0; n < 2; ++n) acc[a][b][m][n] = (f32x4){0.f, 0.f, 0.f, 0.f};
        cur = nxt; cA = nA; cB = nB; ++ui;
        if constexpr (ALIGN_EPI) { if (wr == 1) PG8_BAR; }
    }
    PG8_WAIT_V(0);
    if constexpr (!ALIGN_EPI) { if (wr == 0) PG8_BAR; }
    PG8_BAR;
    if constexpr (Epi::AFTER_DRAIN) { E.fused(acc, cur, wr, wc, fr, fq, lds, wid, lane); S.done(cur); }
#undef PG8_KIX
#undef PG8_SA
#undef PG8_SB
#undef PG8_STAGE
#undef PG8_LDA
#undef PG8_LDB
#undef PG8_MMA
#undef PG8_WAIT_V
#undef PG8_WAIT_L
#undef PG8_BAR
#undef PG8_SCHED
}
}
constexpr int NWAVES = 8, NTHR = 512;
constexpr int LDS_BYTES = 147456;
constexpr int MISC_OFF = LDS_BYTES - 128;
typedef GAS unsigned gu32;
#define RLX_AGENT __ATOMIC_RELAXED, __HIP_MEMORY_SCOPE_AGENT
#define LDS_WAIT() asm volatile("s_waitcnt lgkmcnt(0)" ::: "memory")
#define VM_WAIT() asm volatile("s_waitcnt vmcnt(0)" ::: "memory")
#define XB_TMO      128
#define XB_XCNT(j)  (256  + 64 * (j))
#define XB_XSUB(j)  (1280 + 64 * (j))
#define XB_XGEN(j)  (2304 + 64 * (j))
#define XB_TOP      3328
#define XB_TOPGEN   3392
#define XCD_BAR_WORDS 3456
#define XB_SPIN_CAP (1u << 18)

__device__ __forceinline__ unsigned xb_ld(unsigned* p)              { return __hip_atomic_load(p, __ATOMIC_RELAXED, __HIP_MEMORY_SCOPE_AGENT); }
__device__ __forceinline__ unsigned xb_add(unsigned* p, unsigned v) { return __hip_atomic_fetch_add(p, v, __ATOMIC_RELAXED, __HIP_MEMORY_SCOPE_AGENT); }
__device__ __forceinline__ unsigned xb_xcc_id() { return (unsigned)__builtin_amdgcn_s_getreg((3 << 11) | 20) & 0xFu; }
#define XB_SPIN(cond, bar) do { unsigned _sp = 0; while (cond) { __builtin_amdgcn_s_sleep(1); \
    if ((++_sp & 255u) == 0u) { if (xb_ld(&(bar)[XB_TMO])) break; if (_sp > XB_SPIN_CAP) { atomicAdd(&(bar)[XB_TMO], 1u); break; } } } } while (0)

struct XcdBarrier {
    unsigned* bar; unsigned x;
    volatile LAS unsigned* st;
};

__device__ __forceinline__ XcdBarrier xcd_barrier_post(unsigned* bar, volatile LAS unsigned* st) {
    XcdBarrier b; b.bar = bar; b.x = xb_xcc_id(); b.st = st;
    if (threadIdx.x == 0) (void)xb_add(&bar[XB_XCNT(b.x)], 1u);
    return b;
}
__device__ __forceinline__ void xcd_barrier_complete(unsigned* bar, unsigned x, unsigned& nloc, unsigned& nx) {
    const unsigned G = gridDim.x * gridDim.y * gridDim.z;
    unsigned sum, cnt, mine, sp = 0u;
    for (;;) {
        sum = 0u; cnt = 0u; mine = 0u;
#pragma unroll
        for (unsigned j = 0; j < 16; ++j) { const unsigned c = xb_ld(&bar[XB_XCNT(j)]); sum += c; cnt += (c > 0u) ? 1u : 0u; mine = (j == x) ? c : mine; }
        if (sum == G) break;
        __builtin_amdgcn_s_sleep(1);
        if ((++sp & 255u) == 0u) { if (xb_ld(&bar[XB_TMO])) break; if (sp > XB_SPIN_CAP) { atomicAdd(&bar[XB_TMO], 1u); break; } }
    }
    nloc = mine > 0u ? mine : 1u; nx = cnt > 0u ? cnt : 1u;
}

__device__ __forceinline__ void xcd_barrier(const XcdBarrier& b) {
    asm volatile("s_waitcnt vmcnt(0)" ::: "memory");
    __syncthreads();
    if (threadIdx.x == 0) {
        unsigned* bar = b.bar;
        __builtin_amdgcn_s_waitcnt(0);
        unsigned nloc = b.st[0], nx = b.st[1];
        if (nloc == 0u) { xcd_barrier_complete(bar, b.x, nloc, nx); b.st[0] = nloc; b.st[1] = nx; }
        const unsigned old = xb_add(&bar[XB_XSUB(b.x)], 1u);
        const unsigned gen = old / nloc;
        if (old + 1u == (gen + 1u) * nloc) {
            __builtin_amdgcn_fence(__ATOMIC_RELEASE, "agent");
            asm volatile("s_waitcnt vmcnt(0)" ::: "memory");
            const unsigned og = xb_add(&bar[XB_TOP], 1u);
            const unsigned tg = og / nx;
            if (og + 1u == (tg + 1u) * nx) xb_add(&bar[XB_TOPGEN], 1u);
            else XB_SPIN(xb_ld(&bar[XB_TOPGEN]) == tg, bar);
            __builtin_amdgcn_fence(__ATOMIC_ACQUIRE, "agent");
            xb_add(&bar[XB_XGEN(b.x)], 1u);
            asm volatile("s_waitcnt vmcnt(0)" ::: "memory");
        } else {
            XB_SPIN(xb_ld(&bar[XB_XGEN(b.x)]) == gen, bar);
            __builtin_amdgcn_fence(__ATOMIC_ACQUIRE, "agent");
            asm volatile("s_waitcnt vmcnt(0)" ::: "memory");
        }
    }
    __syncthreads();
}
struct Ctx { LAS unsigned char* lds; int tid, lane, wave, vcu, G; };
struct Args { const float* in[19]; float* out; unsigned char* ws; int ph_lo, ph_hi; };

typedef short v4i16_t __attribute__((ext_vector_type(4)));
__device__ __forceinline__ s16x4 trr(LAS unsigned char* p) { return __builtin_bit_cast(s16x4, __builtin_amdgcn_ds_read_tr16_b64_v4i16((LAS v4i16_t*)p)); }
__device__ __forceinline__ bf16x8 cat8(s16x4 lo, s16x4 hi) { return (bf16x8){lo[0], lo[1], lo[2], lo[3], hi[0], hi[1], hi[2], hi[3]}; }
__device__ __forceinline__ float incl_sum_up(float v, int lane) {
#pragma unroll
    for (int o = 1; o < 64; o <<= 1) { const float t = __shfl_up(v, o); if (lane >= o) v += t; }
    return v;
}
__device__ __forceinline__ float incl_max_up(float v, int lane) {
#pragma unroll
    for (int o = 1; o < 64; o <<= 1) { const float t = __shfl_up(v, o); if (lane >= o) v = fmaxf(v, t); }
    return v;
}
__device__ __forceinline__ float incl_max_down(float v, int lane) {
#pragma unroll
    for (int o = 1; o < 64; o <<= 1) { const float t = __shfl_down(v, o); if (lane + o < 64) v = fmaxf(v, t); }
    return v;
}
__device__ __forceinline__ v4u scale8(v4u q, float s) {
    v4u o; o.x = pk2(bflo(q.x) * s, bfhi(q.x) * s); o.y = pk2(bflo(q.y) * s, bfhi(q.y) * s); o.z = pk2(bflo(q.z) * s, bfhi(q.z) * s); o.w = pk2(bflo(q.w) * s, bfhi(q.w) * s); return o;
}

__device__ __forceinline__ float sat8(float x) { return fminf(fmaxf(x, -448.f), 448.f); }
__device__ __forceinline__ void tr_item(const float* __restrict__ W, int ldw, int K, bf16* __restrict__ WT, int n_src0, int n_dst0, int k0, LAS unsigned char* scr, int lane) {
    const int nq = lane & 15, kg = lane >> 4;
    const float* src = W + (size_t)(k0 + 4 * kg) * ldw + n_src0 + 4 * nq;
    f32x4 rr[4][4];
#pragma unroll
    for (int j = 0; j < 4; ++j)
#pragma unroll
        for (int q = 0; q < 4; ++q) rr[j][q] = __builtin_nontemporal_load((const f32x4*)(src + (size_t)(16 * j + q) * ldw));
    __builtin_amdgcn_sched_barrier(0);
#pragma unroll
    for (int j = 0; j < 4; ++j) {
#pragma unroll
        for (int c = 0; c < 4; ++c) { LAS unsigned* d = (LAS unsigned*)(scr + (4 * nq + c) * 132 + (16 * j + 4 * kg) * 2); d[0] = pk2(rr[j][0][c], rr[j][1][c]); d[1] = pk2(rr[j][2][c], rr[j][3][c]); }
    }
    const int row8 = lane >> 3, c8 = lane & 7;
#pragma unroll
    for (int jj = 0; jj < 8; ++jj) { const int row = row8 + 8 * jj; LAS unsigned char* rp = scr + row * 132 + 16 * c8;
        v4u o; o.x = *(LAS unsigned*)rp; o.y = *(LAS unsigned*)(rp + 4); o.z = *(LAS unsigned*)(rp + 8); o.w = *(LAS unsigned*)(rp + 12);
        *(v4u*)(WT + (size_t)(n_dst0 + row) * K + k0 + 8 * c8) = o; }
}
constexpr float W8SCALE = 64.f, W8INV = 1.f / 64.f;
__device__ __forceinline__ void tr8_item(const float* __restrict__ W, int ldw, int Kb, unsigned char* __restrict__ WT, int n0, int k0, LAS unsigned char* scr, int lane) {
    const int nq = lane & 15, kg = lane >> 4;
    const float* src = W + (size_t)(k0 + 4 * kg) * ldw + n0 + 4 * nq;
#pragma unroll
    for (int jh = 0; jh < 2; ++jh) {
        f32x4 rr[4][4];
#pragma unroll
        for (int j = 0; j < 4; ++j)
#pragma unroll
            for (int q = 0; q < 4; ++q) rr[j][q] = __builtin_nontemporal_load((const f32x4*)(src + (size_t)(16 * (4 * jh + j) + q) * ldw));
        __builtin_amdgcn_sched_barrier(0);
#pragma unroll
        for (int j = 0; j < 4; ++j)
#pragma unroll
            for (int c = 0; c < 4; ++c) { int w = 0; w = __builtin_amdgcn_cvt_pk_fp8_f32(rr[j][0][c] * W8SCALE, rr[j][1][c] * W8SCALE, w, false); w = __builtin_amdgcn_cvt_pk_fp8_f32(rr[j][2][c] * W8SCALE, rr[j][3][c] * W8SCALE, w, true);
                *(LAS int*)(scr + (4 * nq + c) * 132 + 16 * (4 * jh + j) + 4 * kg) = w; }
        __builtin_amdgcn_sched_barrier(0);
    }
    const int row8 = lane >> 3, c8 = lane & 7;
#pragma unroll
    for (int jj = 0; jj < 8; ++jj) { const int row = row8 + 8 * jj; LAS unsigned char* rp = scr + row * 132 + 16 * c8;
        v4u o; o.x = *(LAS unsigned*)rp; o.y = *(LAS unsigned*)(rp + 4); o.z = *(LAS unsigned*)(rp + 8); o.w = *(LAS unsigned*)(rp + 12);
        *(v4u*)(WT + (size_t)(n0 + row) * Kb + k0 + 16 * c8) = o; }
}
__device__ __forceinline__ void p0_transposes(const Ctx& C, const Args& a) {
    const float* w_in = a.in[2]; const float* w_ml = a.in[5]; const float* w_da = a.in[10]; const float* w_o = a.in[11]; const float* w_gu = a.in[15]; const float* w_dn = a.in[17];
    bf16* WIN = (bf16*)(a.ws + WS_WIN); bf16* WML = (bf16*)(a.ws + WS_WML); bf16* WDA = (bf16*)(a.ws + WS_WDA); bf16* WO = (bf16*)(a.ws + WS_WO);
    const int gw = C.vcu * NWAVES + C.wave, NGW = C.G * NWAVES;
    constexpr int I_IN = 32 * 96, I_IN8 = 16 * 64;
    constexpr int NIT = I_IN + I_IN8;
    LAS unsigned char* scr = C.lds + C.wave * 8448;
    for (int it = gw; it < NIT; it += NGW) {
        int r = it;
        if (r < I_IN) { const int kb = r / 96, nb = r % 96, nd = nb * 64; tr_item(w_in, DIN, D, WIN, nd < G_OFF ? nd : nd + 16, nd, kb * 64, scr, C.lane); continue; } r -= I_IN;
        { const int kb = r / 64, nb = r % 64; tr8_item(w_in + (P_GM + 16), DIN, D, (unsigned char*)(a.ws + WS_WIN8), nb * 64, kb * 128, scr, C.lane); }
    }
    (void)w_ml; (void)w_da; (void)w_o; (void)WML; (void)WDA; (void)WO;
    __syncthreads();
}
__device__ __forceinline__ void p2_late_transposes(const Ctx& C, const Args& a) {
    const float* w_ml = a.in[5]; const float* w_da = a.in[10]; const float* w_o = a.in[11];
    bf16* WML = (bf16*)(a.ws + WS_WML); bf16* WDA = (bf16*)(a.ws + WS_WDA); bf16* WO = (bf16*)(a.ws + WS_WO);
    const int gw = C.vcu * NWAVES + C.wave, NGW = C.G * NWAVES;
    constexpr int I_ML = 16 * 32, I_O = 32 * 32, NIT = 2 * I_ML + I_O;
    LAS unsigned char* scr = C.lds + C.wave * 8448;
    for (int it = gw; it < NIT; it += NGW) {
        int r = it;
        if (r < I_ML) { const int kb = r / 32, nb = r % 32; tr_item(w_ml, D, MLW, WML, nb * 64, nb * 64, kb * 64, scr, C.lane); continue; } r -= I_ML;
        if (r < I_ML) { const int kb = r / 32, nb = r % 32; tr_item(w_da, D, DAW, WDA, nb * 64, nb * 64, kb * 64, scr, C.lane); continue; } r -= I_ML;
        { const int kb = r / 32, nb = r % 32; tr_item(w_o, D, D, WO, nb * 64, nb * 64, kb * 64, scr, C.lane); }
    }
    __syncthreads();
}
constexpr int CV_J_GU = 16 * 64, CV_J_DN = 16 * 32, CV_NJ = NE * (CV_J_GU + CV_J_DN);
constexpr int CV_L6 = NE * CV_J_GU + 6144;
struct ConvSet { f32x4 r[8]; };
struct Conv { int it, step; ConvSet s[2]; };
struct ConvItem { const float* src; unsigned char* dst; int ldw, Kb; };
__device__ __forceinline__ ConvItem conv_item(const Args& a, int it) {
    const float* w_gu = a.in[15]; const float* w_dn = a.in[17]; ConvItem ci;
    if (it < NE * CV_J_GU) { const int e = it / CV_J_GU, q = it % CV_J_GU, kb = q / 64, nb = q % 64; ci.ldw = 2 * DE; ci.Kb = D;
        ci.src = w_gu + (size_t)e * D * 2 * DE + (size_t)(kb * 128) * (2 * DE) + nb * 64;
        ci.dst = a.ws + WS_WGU + (size_t)e * 2 * DE * D + (size_t)(nb * 64) * D + kb * 128; }
    else { const int r = it - NE * CV_J_GU, e = r / CV_J_DN, q = r % CV_J_DN, kb = q / 32, nb = q % 32; ci.ldw = D; ci.Kb = DE;
        ci.src = w_dn + (size_t)e * DE * D + (size_t)(kb * 128) * D + nb * 64;
        ci.dst = a.ws + WS_WDN + (size_t)e * D * DE + (size_t)(nb * 64) * DE + kb * 128; }
    return ci;
}
__device__ __forceinline__ const char* uni_ptr(const void* p) { const unsigned long long v = (unsigned long long)p; const unsigned lo = __builtin_amdgcn_readfirstlane((unsigned)v), hi = __builtin_amdgcn_readfirstlane((unsigned)(v >> 32)); return (const char*)(((unsigned long long)hi << 32) | lo); }
struct ConvSrc { const float* src; int ldw; };
template <int LIM = CV_NJ> __device__ __forceinline__ ConvSrc conv_src(const Args& a, int it) { const int itc = it < LIM ? it : LIM - 1; const ConvItem ci = conv_item(a, __builtin_amdgcn_readfirstlane(itc)); ConvSrc s; s.src = ci.src; s.ldw = ci.ldw; return s; }
__device__ __forceinline__ unsigned conv_loff(const ConvSrc& cs, int lane) { return ((unsigned)(4 * (lane >> 4)) * (unsigned)cs.ldw + 4u * (lane & 15)) * 4u; }
__device__ __forceinline__ void conv_issue_one(ConvSet& S, const ConvSrc& cs, unsigned loff, int st, int q) {
    const char* sb = (const char*)(cs.src + (size_t)(16 * (2 * st + (q >> 2)) + (q & 3)) * cs.ldw);
    asm volatile("global_load_dwordx4 %0, %1, %2 nt" : "=v"(S.r[q]) : "v"(loff), "s"(sb) : "memory");
}
template <int LIM = CV_NJ> __device__ __forceinline__ void conv_issue(ConvSet& S, const Args& a, int it, int st, int lane) {
    const ConvSrc cs = conv_src<LIM>(a, it); const unsigned loff = conv_loff(cs, lane);
#pragma unroll
    for (int q = 0; q < 8; ++q) conv_issue_one(S, cs, loff, st, q);
}
__device__ __forceinline__ void conv_next(int& it, int& st, int NGW) { if (st == 3) { st = 0; it += NGW; } else ++st; }
template <int LIM = CV_NJ> __device__ __forceinline__ void conv_begin(Conv& cv, const Args& a, int gw, int NGW, int lane) { cv.it = gw; cv.step = 0; conv_issue<LIM>(cv.s[0], a, cv.it, cv.step, lane); }
template <int LIM = CV_NJ> __device__ __forceinline__ void conv_issue_next(Conv& cv, ConvSet& S, const Args& a, int NGW, int lane) { int it1 = cv.it, st1 = cv.step; conv_next(it1, st1, NGW); conv_issue<LIM>(S, a, it1, st1, lane); }
template <int NW, int LIM = CV_NJ> __device__ __forceinline__ bool conv_consume(Conv& cv, ConvSet& S, const Args& a, LAS unsigned char* scr, int NGW, int lane) {
    if constexpr (NW == 24) asm volatile("s_waitcnt vmcnt(24)" : "+v"(S.r[0]), "+v"(S.r[1]), "+v"(S.r[2]), "+v"(S.r[3]), "+v"(S.r[4]), "+v"(S.r[5]), "+v"(S.r[6]), "+v"(S.r[7]) :: "memory");
    else if constexpr (NW == 12) asm volatile("s_waitcnt vmcnt(12)" : "+v"(S.r[0]), "+v"(S.r[1]), "+v"(S.r[2]), "+v"(S.r[3]), "+v"(S.r[4]), "+v"(S.r[5]), "+v"(S.r[6]), "+v"(S.r[7]) :: "memory");
    else if constexpr (NW == 8) asm volatile("s_waitcnt vmcnt(8)" : "+v"(S.r[0]), "+v"(S.r[1]), "+v"(S.r[2]), "+v"(S.r[3]), "+v"(S.r[4]), "+v"(S.r[5]), "+v"(S.r[6]), "+v"(S.r[7]) :: "memory");
    else asm volatile("s_waitcnt vmcnt(0)" : "+v"(S.r[0]), "+v"(S.r[1]), "+v"(S.r[2]), "+v"(S.r[3]), "+v"(S.r[4]), "+v"(S.r[5]), "+v"(S.r[6]), "+v"(S.r[7]) :: "memory");
    const int nq = lane & 15, kg = lane >> 4; const bool st = (cv.it < LIM) && cv.step == 3;
#pragma unroll
    for (int jj = 0; jj < 2; ++jj) { const int j = 2 * cv.step + jj;
#pragma unroll
        for (int c = 0; c < 4; ++c) { int w = 0; w = __builtin_amdgcn_cvt_pk_fp8_f32(S.r[4 * jj + 0][c] * W8SCALE, S.r[4 * jj + 1][c] * W8SCALE, w, false);
            w = __builtin_amdgcn_cvt_pk_fp8_f32(S.r[4 * jj + 2][c] * W8SCALE, S.r[4 * jj + 3][c] * W8SCALE, w, true);
            *(LAS int*)(scr + (4 * nq + c) * 132 + 16 * j + 4 * kg) = w; } }
    if (st) {
        const ConvItem ci = conv_item(a, __builtin_amdgcn_readfirstlane(cv.it));
        const int row8 = lane >> 3, c8 = lane & 7;
#pragma unroll 2
        for (int jj = 0; jj < 8; ++jj) { const int row = row8 + 8 * jj; LAS unsigned char* rp = scr + row * 132 + 16 * c8;
            v4u o; o.x = *(LAS unsigned*)rp; o.y = *(LAS unsigned*)(rp + 4); o.z = *(LAS unsigned*)(rp + 8); o.w = *(LAS unsigned*)(rp + 12);
            __builtin_nontemporal_store(o, (v4u*)(ci.dst + (size_t)row * ci.Kb + 16 * c8)); }
    }
    conv_next(cv.it, cv.step, NGW);
    return st;
}
__device__ __forceinline__ void conv_run(const Args& a, int it0, int NGW, LAS unsigned char* scr, int lane) {
    Conv cv; cv.it = it0; cv.step = 0; ConvSet x2, x3; int iit = it0, ist = 0;
    conv_issue(cv.s[0], a, iit, ist, lane); conv_next(iit, ist, NGW); conv_issue(cv.s[1], a, iit, ist, lane); conv_next(iit, ist, NGW); conv_issue(x2, a, iit, ist, lane); conv_next(iit, ist, NGW);
    while (cv.it < CV_NJ) {
        conv_issue(x3, a, iit, ist, lane); conv_next(iit, ist, NGW); (void)conv_consume<24>(cv, cv.s[0], a, scr, NGW, lane);
        conv_issue(cv.s[0], a, iit, ist, lane); conv_next(iit, ist, NGW); (void)conv_consume<24>(cv, cv.s[1], a, scr, NGW, lane);
        conv_issue(cv.s[1], a, iit, ist, lane); conv_next(iit, ist, NGW); (void)conv_consume<24>(cv, x2, a, scr, NGW, lane);
        conv_issue(x2, a, iit, ist, lane); conv_next(iit, ist, NGW); (void)conv_consume<24>(cv, x3, a, scr, NGW, lane); }
    asm volatile("s_waitcnt vmcnt(0)" ::: "memory");
}
__device__ __forceinline__ void p0_xn_gates(const Ctx& C, const Args& a) {
    const float* x = a.in[0]; const float* g1 = a.in[1]; const float* w_in = a.in[2]; const float* gbias = a.in[3];
    bf16* XN = (bf16*)(a.ws + WS_XN); float* MG = (float*)(a.ws + WS_MG);
    { f32x4 gwv[D * 4 / NTHR];
      static_assert(D * 4 % NTHR == 0, "gate weight staging");
#pragma unroll
      for (int i = 0; i < D * 4 / NTHR; ++i) { const int idx = (C.tid + i * NTHR + C.vcu * 32) & (D * 4 - 1), k = idx >> 2, c = idx & 3; gwv[i] = *(const f32x4*)(w_in + (size_t)k * DIN + G_OFF + 4 * c); }
      __builtin_amdgcn_sched_barrier(0);
#pragma unroll
      for (int i = 0; i < D * 4 / NTHR; ++i) { const int idx = (C.tid + i * NTHR + C.vcu * 32) & (D * 4 - 1), k = idx >> 2, c = idx & 3; const int r = (k & 3) * 512 + (k >> 2);
        *(LAS f32x4*)(C.lds + r * 64 + ((c ^ ((r >> 2) & 3)) * 16)) = gwv[i]; } }
    __syncthreads();
    const int gw = C.vcu * NWAVES + C.wave, NGW = C.G * NWAVES, lane = C.lane;
    f32x4 g1r[8];
#pragma unroll
    for (int j = 0; j < 8; ++j) g1r[j] = *((const f32x4*)g1 + lane + 64 * j);
    for (int m = gw; m < T; m += NGW) {
        const f32x4* xr = (const f32x4*)(x + (size_t)m * D) + lane; f32x4 v[8]; float ss = 0.f;
#pragma unroll
        for (int j = 0; j < 8; ++j) { v[j] = __builtin_nontemporal_load(xr + 64 * j); ss += (v[j].x * v[j].x + v[j].y * v[j].y) + (v[j].z * v[j].z + v[j].w * v[j].w); }
        const float rstd = rsqrtf(wave_sum(ss) * (1.f / D) + EPS);
        float acc[16];
#pragma unroll
        for (int i = 0; i < 16; ++i) acc[i] = 0.f;
        int lb = lane * 64; asm volatile("" : "+v"(lb));
        int lbase[4];
#pragma unroll
        for (int c = 0; c < 4; ++c) lbase[c] = lb + ((c ^ ((lane >> 2) & 3)) << 4);
#pragma unroll
        for (int j = 0; j < 8; ++j) {
            const f32x4 g = g1r[j];
            v[j].x *= rstd * g.x; v[j].y *= rstd * g.y; v[j].z *= rstd * g.z; v[j].w *= rstd * g.w;
            v2u o; o.x = pk2(v[j].x, v[j].y); o.y = pk2(v[j].z, v[j].w);
            *((v2u*)(XN + (size_t)m * D) + lane + 64 * j) = o;
            { int o8 = 0; o8 = __builtin_amdgcn_cvt_pk_fp8_f32(v[j].x, v[j].y, o8, false); o8 = __builtin_amdgcn_cvt_pk_fp8_f32(v[j].z, v[j].w, o8, true); *((int*)(a.ws + WS_XN8 + (size_t)m * D) + lane + 64 * j) = o8; }
#pragma unroll
            for (int i = 0; i < 4; ++i) {
                const float hv = v[j][i];
#pragma unroll
                for (int c = 0; c < 4; ++c) { const f32x4 w = *(const LAS f32x4*)(C.lds + lbase[c] + (i * 512 + 64 * j) * 64);
                    acc[4 * c + 0] += hv * w.x; acc[4 * c + 1] += hv * w.y; acc[4 * c + 2] += hv * w.z; acc[4 * c + 3] += hv * w.w; }
            }
        }
        float mine = 0.f;
#pragma unroll
        for (int i = 0; i < 16; ++i) { const float s = wave_sum(acc[i]); if (lane == i) mine = s; }
        if (lane < 16) MG[(size_t)m * 16 + lane] = mine + gbias[lane];
    }
}
__device__ __forceinline__ void p0_router_w(const Ctx& C, const Args& a) {
    const float* wr = a.in[13]; const float* g2 = a.in[12]; bf16* WRH = (bf16*)(a.ws + WS_WRH); bf16* WRL = (bf16*)(a.ws + WS_WRL);
    for (int g = C.vcu * NTHR + C.tid; g < D * NE; g += C.G * NTHR) { const int k = g >> 5, e = g & 31; const float w = wr[g] * g2[k];
        const int q = k & 15, idx = (((k >> 4) * 64) + ((q >> 2) & 1) * 32 + e) * 8 + (q >> 3) * 4 + (q & 3);
        const bf16 hi = f2bf(w); const bf16 lo = f2bf(w - bf2f(hi)); WRH[idx] = hi; WRL[idx] = lo; }
}
__device__ __forceinline__ void p0_rope(const Ctx& C, const Args& a) {
    float* ROPE = (float*)(a.ws + WS_ROPE);
    for (int g = C.vcu * NTHR + C.tid; g < S * 32; g += C.G * NTHR) {
        const int pos = g >> 5, i = g & 31;
        const double inv = exp2(-(double)i * (13.287712379549449 / 32.0));
        const double rev = (double)pos * inv * 0.15915494309189535;
        const double fr = rev - floor(rev + 0.5);
        const float ang = (float)(fr * 6.283185307179586);
        f32x2 cs; cs.x = cosf(ang); cs.y = sinf(ang);
        *(f32x2*)(ROPE + 2 * g) = cs;
    }
}

template <bool GATES8> struct EpiProj {
    static constexpr bool PERM = true, AFTER_DRAIN = false;
    bf16* O; unsigned char* G8;
    __device__ __forceinline__ void operator()(const pg8::f32x4 (&acc)[2][2][4][2], const pg8::Unit& u, int wr, int wc, int fr, int fq) const {
        const int pn = GATES8 ? u.pn + 24 : u.pn;
        const int row0 = u.pm * 256 + wr * 64 + fr, col0 = pn * 256 + wc * 32 + 8 * fq;
        const int mode = (pn == 2 || pn == 3) ? 1 : (((pn >= 8 && pn < 12) || pn >= 24) ? 2 : 0);
#pragma unroll
        for (int ai = 0; ai < 2; ++ai)
#pragma unroll
            for (int m = 0; m < 4; ++m) { bf16* rowp = O + (size_t)(row0 + ai * 128 + m * 16) * NPJ + col0;
#pragma unroll
                for (int bj = 0; bj < 2; ++bj) { pg8::f32x4 v0 = acc[ai][bj][m][0], v1 = acc[ai][bj][m][1];
                    if (GATES8) { v0 = v0 * W8INV; v1 = v1 * W8INV; }
                    if (mode == 1) { v0 = v0 * KSCALE; v1 = v1 * KSCALE; }
                    if (mode == 2) {
#pragma unroll
                        for (int i = 0; i < 4; ++i) { v0[i] = sigmoidf_(v0[i]); v1[i] = sigmoidf_(v1[i]); } }
                    if (GATES8) {
                        v2u w; w.x = 0u; w.y = 0u;
#pragma unroll
                        for (int i = 0; i < 4; ++i) { w.x = __builtin_amdgcn_cvt_pk_u8_f32(v0[i] * 255.f, i, w.x); w.y = __builtin_amdgcn_cvt_pk_u8_f32(v1[i] * 255.f, i, w.y); }
                        *(v2u*)(G8 + (size_t)(row0 + ai * 128 + m * 16) * 4096 + u.pn * 256 + wc * 32 + 8 * fq + bj * 128) = w;
                    } else {
                    v4u w; w.x = pk2(v0[0], v0[1]); w.y = pk2(v0[2], v0[3]); w.z = pk2(v1[0], v1[1]); w.w = pk2(v1[2], v1[3]);
                    *(v4u*)(rowp + bj * 128) = w; } } }
    }
};
__device__ __forceinline__ void gate8(const unsigned char* G8, size_t row, int gcol, float (&g)[8]) {
    const v2u w = *(const v2u*)(G8 + row * 4096 + gcol); const float s = 1.f / 255.f;
    g[0] = (float)(w.x & 0xff) * s; g[1] = (float)((w.x >> 8) & 0xff) * s; g[2] = (float)((w.x >> 16) & 0xff) * s; g[3] = (float)(w.x >> 24) * s;
    g[4] = (float)(w.y & 0xff) * s; g[5] = (float)((w.y >> 8) & 0xff) * s; g[6] = (float)((w.y >> 16) & 0xff) * s; g[7] = (float)(w.y >> 24) * s;
}
template <int MODE> struct EpiGate {
    static constexpr bool PERM = true, AFTER_DRAIN = false;
    const bf16* PROJ; const bf16* T1in; bf16* O;
    __device__ __forceinline__ void operator()(const pg8::f32x4 (&acc)[2][2][4][2], const pg8::Unit& u, int wr, int wc, int fr, int fq) const {
        const int row0 = u.pm * 256 + wr * 64 + fr, col0 = u.pn * 256 + wc * 32 + 8 * fq;
#pragma unroll
        for (int ai = 0; ai < 2; ++ai)
#pragma unroll
            for (int m = 0; m < 4; ++m) { const size_t row = (size_t)(row0 + ai * 128 + m * 16);
#pragma unroll
                for (int bj = 0; bj < 2; ++bj) { const int col = col0 + bj * 128; const pg8::f32x4 v0 = acc[ai][bj][m][0], v1 = acc[ai][bj][m][1];
                    float g[8]; gate8((const unsigned char*)PROJ, row, (MODE ? 2048 : 0) + col, g);
                    float o[8] = {g[0] * v0[0], g[1] * v0[1], g[2] * v0[2], g[3] * v0[3], g[4] * v1[0], g[5] * v1[1], g[6] * v1[2], g[7] * v1[3]};
                    if (MODE == 1) { const v4u t = *(const v4u*)(T1in + row * D + col);
                        o[0] += bflo(t.x); o[1] += bfhi(t.x); o[2] += bflo(t.y); o[3] += bfhi(t.y); o[4] += bflo(t.z); o[5] += bfhi(t.z); o[6] += bflo(t.w); o[7] += bfhi(t.w); }
                    v4u w; w.x = pk2(o[0], o[1]); w.y = pk2(o[2], o[3]); w.z = pk2(o[4], o[5]); w.w = pk2(o[6], o[7]);
                    *(v4u*)(O + row * D + col) = w; } }
    }
};
struct EpiGatePair {
    static constexpr bool PERM = true, AFTER_DRAIN = false;
    const bf16* PROJ; bf16* T1; bf16* MIX;
    __device__ __forceinline__ void operator()(const pg8::f32x4 (&acc)[2][2][4][2], const pg8::Unit& u, int wr, int wc, int fr, int fq) const {
        const bool second = u.pm >= T / 256; const int pmr = second ? u.pm - T / 256 : u.pm;
        const int row0 = pmr * 256 + wr * 64 + fr, col0 = u.pn * 256 + wc * 32 + 8 * fq; const int gcol = second ? 2048 : 0; bf16* O = second ? MIX : T1;
        const unsigned char* G8 = (const unsigned char*)PROJ;
#pragma unroll
        for (int ai = 0; ai < 2; ++ai) {
            v2u gw[4][2]; v4u tw[4][2];
#pragma unroll
            for (int m = 0; m < 4; ++m)
#pragma unroll
                for (int bj = 0; bj < 2; ++bj) { const size_t row = (size_t)(row0 + ai * 128 + m * 16); const int col = col0 + bj * 128;
                    gw[m][bj] = *(const v2u*)(G8 + row * 4096 + gcol + col); if (second) tw[m][bj] = *(const v4u*)(T1 + row * D + col); }
            __builtin_amdgcn_sched_barrier(0);
#pragma unroll
            for (int m = 0; m < 4; ++m) { const size_t row = (size_t)(row0 + ai * 128 + m * 16);
#pragma unroll
                for (int bj = 0; bj < 2; ++bj) { const int col = col0 + bj * 128; const pg8::f32x4 v0 = acc[ai][bj][m][0], v1 = acc[ai][bj][m][1];
                    const v2u w8 = gw[m][bj]; const float s = 1.f / 255.f;
                    const float g[8] = {(float)(w8.x & 0xff) * s, (float)((w8.x >> 8) & 0xff) * s, (float)((w8.x >> 16) & 0xff) * s, (float)(w8.x >> 24) * s,
                                        (float)(w8.y & 0xff) * s, (float)((w8.y >> 8) & 0xff) * s, (float)((w8.y >> 16) & 0xff) * s, (float)(w8.y >> 24) * s};
                    float o[8] = {g[0] * v0[0], g[1] * v0[1], g[2] * v0[2], g[3] * v0[3], g[4] * v1[0], g[5] * v1[1], g[6] * v1[2], g[7] * v1[3]};
                    if (second) { const v4u t = tw[m][bj];
                        o[0] += bflo(t.x); o[1] += bfhi(t.x); o[2] += bflo(t.y); o[3] += bfhi(t.y); o[4] += bflo(t.z); o[5] += bfhi(t.z); o[6] += bflo(t.w); o[7] += bfhi(t.w); }
                    v4u w; w.x = pk2(o[0], o[1]); w.y = pk2(o[2], o[3]); w.z = pk2(o[4], o[5]); w.w = pk2(o[6], o[7]);
                    *(v4u*)(O + row * D + col) = w; } }
            __builtin_amdgcn_sched_barrier(0);
        }
    }
};
struct PairOrder {
    pg8::StaticOrder so;
    __device__ __forceinline__ bool next(int i, pg8::Unit& u) const {
        const int per = so.nwg / so.G;
        if (i >= 2 * per) return false;
        const bool second = i >= per; if (!so.next(second ? i - per : i, u)) return false;
        if (second) { u.pm += T / 256; u.pb += D / 256; }
        return true;
    }
    __device__ __forceinline__ void a_ready(const pg8::Unit&) const {}
    __device__ __forceinline__ void done(const pg8::Unit&) const {}
    __device__ __forceinline__ int rot() const { return 0; }
};
struct EpiRes {
    static constexpr bool PERM = false, AFTER_DRAIN = false;
    const float* X; float* O;
    __device__ __forceinline__ void operator()(const pg8::f32x4 (&acc)[2][2][4][2], const pg8::Unit& u, int wr, int wc, int fr, int fq) const {
        const int row0 = u.pm * 256 + wr * 64 + fr, col0 = u.pn * 256 + wc * 32 + 4 * fq;
#pragma unroll
        for (int ai = 0; ai < 2; ++ai) { pg8::f32x4 xv[4][2][2];
#pragma unroll
            for (int m = 0; m < 4; ++m) { const size_t off = (size_t)(row0 + ai * 128 + m * 16) * D + col0;
#pragma unroll
                for (int bj = 0; bj < 2; ++bj)
#pragma unroll
                    for (int n = 0; n < 2; ++n) xv[m][bj][n] = __builtin_nontemporal_load((const pg8::f32x4*)(X + off + bj * 128 + n * 16)); }
            __builtin_amdgcn_sched_barrier(0);
#pragma unroll
            for (int m = 0; m < 4; ++m) { const size_t off = (size_t)(row0 + ai * 128 + m * 16) * D + col0;
#pragma unroll
                for (int bj = 0; bj < 2; ++bj)
#pragma unroll
                    for (int n = 0; n < 2; ++n) *(pg8::f32x4*)(O + off + bj * 128 + n * 16) = xv[m][bj][n] + acc[ai][bj][m][n]; }
            __builtin_amdgcn_sched_barrier(0); }
    }
};
struct EpiAct {
    static constexpr bool PERM = true, AFTER_DRAIN = false;
    const float* bias; unsigned char* O;
    __device__ __forceinline__ void operator()(const pg8::f32x4 (&acc)[2][2][4][2], const pg8::Unit& u, int wr, int wc, int fr, int fq) const {
        const int row0 = u.pm * 256 + wr * 64 + fr, col0 = u.pn * 256 + wc * 32 + 8 * fq, e = u.pb >> 4;
        pg8::f32x4 bv[2][2];
#pragma unroll
        for (int bj = 0; bj < 2; ++bj)
#pragma unroll
            for (int n = 0; n < 2; ++n) bv[bj][n] = *(const pg8::f32x4*)(bias + (size_t)e * 2 * DE + col0 + bj * 128 + 4 * n);
#pragma unroll
        for (int ai = 0; ai < 2; ++ai)
#pragma unroll
            for (int m = 0; m < 4; ++m) { const size_t row = (size_t)(row0 + ai * 128 + m * 16);
#pragma unroll
                for (int bj = 0; bj < 2; ++bj) { const pg8::f32x4 v0 = acc[ai][bj][m][0] * W8INV + bv[bj][0], v1 = acc[ai][bj][m][1] * W8INV + bv[bj][1];
                    const float gu[8] = {v0[0], v0[1], v0[2], v0[3], v1[0], v1[1], v1[2], v1[3]}; float o[4];
#pragma unroll
                    for (int p = 0; p < 4; ++p) { const float glu = fminf(gu[2 * p], 7.f), lin = fminf(fmaxf(gu[2 * p + 1], -7.f), 7.f); o[p] = glu * sigmoidf_(1.702f * glu) * (lin + 1.f); }
                    int w = 0; w = __builtin_amdgcn_cvt_pk_fp8_f32(o[0], o[1], w, false); w = __builtin_amdgcn_cvt_pk_fp8_f32(o[2], o[3], w, true);
                    *(int*)(O + row * DE + ((col0 + bj * 128) >> 1)) = w; } }
    }
};
struct EpiY {
    static constexpr bool PERM = true, AFTER_DRAIN = false;
    const float* bias; bf16* O;
    __device__ __forceinline__ void operator()(const pg8::f32x4 (&acc)[2][2][4][2], const pg8::Unit& u, int wr, int wc, int fr, int fq) const {
        const int row0 = u.pm * 256 + wr * 64 + fr, col0 = u.pn * 256 + wc * 32 + 8 * fq, e = u.pb >> 3;
        pg8::f32x4 bv[2][2];
#pragma unroll
        for (int bj = 0; bj < 2; ++bj)
#pragma unroll
            for (int n = 0; n < 2; ++n) bv[bj][n] = *(const pg8::f32x4*)(bias + (size_t)e * D + col0 + bj * 128 + 4 * n);
#pragma unroll
        for (int ai = 0; ai < 2; ++ai)
#pragma unroll
            for (int m = 0; m < 4; ++m) { const size_t row = (size_t)(row0 + ai * 128 + m * 16);
#pragma unroll
                for (int bj = 0; bj < 2; ++bj) { const pg8::f32x4 v0 = acc[ai][bj][m][0] * W8INV + bv[bj][0], v1 = acc[ai][bj][m][1] * W8INV + bv[bj][1];
                    int a0 = 0, a1 = 0; a0 = __builtin_amdgcn_cvt_pk_fp8_f32(sat8(v0[0]), sat8(v0[1]), a0, false); a0 = __builtin_amdgcn_cvt_pk_fp8_f32(sat8(v0[2]), sat8(v0[3]), a0, true);
                    a1 = __builtin_amdgcn_cvt_pk_fp8_f32(sat8(v1[0]), sat8(v1[1]), a1, false); a1 = __builtin_amdgcn_cvt_pk_fp8_f32(sat8(v1[2]), sat8(v1[3]), a1, true);
                    v2u w; w.x = (unsigned)a0; w.y = (unsigned)a1;
                    *(v2u*)((unsigned char*)O + row * D + col0 + bj * 128) = w; } }
    }
};
struct MoeSched {
    int tsl, fin, hin, fl, F, total, NT, G, c, WPX;
    __device__ __forceinline__ void init(const int* cnt, int NT_, int G_, int c_, int lane, int WPX_ = 32) { WPX = WPX_;
        const int cn = lane < NE ? cnt[lane] : 0, f = cn / PADM, r = cn - f * PADM;
        const int full = f + (r > PADM / 2 ? 1 : 0), half = (r > 0 && r <= PADM / 2) ? 1 : 0, tiles = full + half;
        int it = tiles, iff = full, ih = half;
#pragma unroll
        for (int o = 1; o < 32; o <<= 1) { const int t0 = __shfl_up(it, o), t1 = __shfl_up(iff, o), t2 = __shfl_up(ih, o); if (lane >= o) { it += t0; iff += t1; ih += t2; } }
        F = __shfl(iff, 31); total = F + __shfl(ih, 31);
        tsl = it - tiles; fl = full; fin = lane < NE ? iff : 0x7fffffff; hin = lane < NE ? ih : 0x7fffffff; NT = NT_; G = G_; c = c_;
    }
    __device__ __forceinline__ bool next(int i, pg8::Unit& u) const {
        int mo, pn;
        if (G == 256) { const int x = c & 7, q = i * WPX + (c >> 3), ii = q >> 5, jj = q & 31, NPB = NT >> 3, RPM = (8 / NPB) * 4;
            mo = ii * RPM + (x / NPB) * 4 + (jj & 3); pn = (x % NPB) * 8 + (jj >> 2); }
        else { const long L = (long)i * G + c; mo = (int)(L / NT); pn = (int)(L % NT); }
        if (mo >= total) return false;
        int e, mt, hf;
        if (mo < F) { e = __popcll(__ballot(fin <= mo)); mt = __shfl(tsl, e) + (mo - (__shfl(fin, e) - __shfl(fl, e))); hf = 0; }
        else { e = __popcll(__ballot(hin <= mo - F)); mt = __shfl(tsl, e) + __shfl(fl, e); hf = 1; }
        u.pm = mt; u.pn = pn; u.pb = e * NT + pn; u.half = __builtin_amdgcn_readfirstlane(hf); return true;
    }
    __device__ __forceinline__ void a_ready(const pg8::Unit&) const {}
    __device__ __forceinline__ void done(const pg8::Unit&) const {}
    __device__ __forceinline__ int rot() const { const int jj = c >> 3; return G == 256 ? ((jj >> 2) + (jj & 3)) & 15 : 0; }
};

__device__ __forceinline__ void p2_mstats(const Ctx& C, const Args& a) {
    const float* MG = (const float*)(a.ws + WS_MG); float* GA = (float*)(a.ws + WS_MSC);
    const int gw = C.vcu * NWAVES + C.wave, NGW = C.G * NWAVES, lane = C.lane;
    for (int q = gw; q < 16 * 64; q += NGW) {
        const int chain = q >> 6, c = q & 63, dir = chain & 1, hh = (chain >> 1) & 3, b = chain >> 3;
        const int p = b * S + 64 * c + (dir ? 63 - lane : lane);
        const float lf = logsigf_(MG[(size_t)p * 16 + (dir ? 12 : 4) + hh]), ig = MG[(size_t)p * 16 + (dir ? 8 : 0) + hh];
        const float bs = incl_sum_up(lf, lane), g = __shfl(bs, 63), amax = g + wave_max(ig - bs);
        if (lane == 0) { f32x2 o; o.x = g; o.y = amax; *(f32x2*)(GA + (size_t)q * 2) = o; }
    }
}
struct MScan { float mprev, mnew, dec; };
__device__ __forceinline__ float rdlane(float v, int l) { return __int_as_float(__builtin_amdgcn_readlane(__float_as_int(v), l)); }
__device__ __forceinline__ MScan mscan_ga(const f32x2 ga, int dir, int lane);
__device__ __forceinline__ MScan mscan(const float* GA, int chain, int lane) { return mscan_ga(*(const f32x2*)(GA + (size_t)(chain * 64 + lane) * 2), chain & 1, lane); }
__device__ __forceinline__ MScan mscan_ga(const f32x2 ga, int dir, int lane) {
    float G = ga.x, A = ga.y;
#pragma unroll
    for (int o = 1; o < 64; o <<= 1) { const float Gp = dir ? __shfl_down(G, o) : __shfl_up(G, o), Ap = dir ? __shfl_down(A, o) : __shfl_up(A, o);
        const bool ok = dir ? (lane + o < 64) : (lane >= o); if (ok) { A = fmaxf(Ap + G, A); G = Gp + G; } }
    MScan r; r.mnew = fmaxf(G, A);
    const float mp = dir ? __shfl_down(r.mnew, 1) : __shfl_up(r.mnew, 1); r.mprev = (dir ? lane == 63 : lane == 0) ? 0.f : mp;
    r.dec = __expf(ga.x + r.mprev - r.mnew);
    return r;
}
constexpr size_t WS_MSV = WS_MSC + 65536;
__device__ __forceinline__ MScan mscan_ld(const unsigned char* ws, int chain, int lane) { const f32x4 v = *(const f32x4*)(ws + WS_MSV + (size_t)(chain * 64 + lane) * 16); MScan r; r.mprev = v.x; r.mnew = v.y; r.dec = v.z; return r; }
__device__ __forceinline__ void p2_qkprep(const Ctx& C, const Args& a) {
    const bf16* PROJ = (const bf16*)(a.ws + WS_PROJ); const float* ROPE = (const float*)(a.ws + WS_ROPE);
    const float* qg = a.in[6]; const float* kg = a.in[7];
    bf16* QN = (bf16*)(a.ws + WS_QN); bf16* KN = (bf16*)(a.ws + WS_KN);
    const int gw = C.vcu * NWAVES + C.wave, NGW = C.G * NWAVES, lane = C.lane, g = lane >> 2, sub = lane & 3;
    float gq1[8], gq2[8], gk1[8], gk2[8];
#pragma unroll
    for (int i = 0; i < 8; ++i) { gq1[i] = qg[sub * 8 + i]; gq2[i] = qg[32 + sub * 8 + i]; gk1[i] = kg[sub * 8 + i]; gk2[i] = kg[32 + sub * 8 + i]; }
    for (int mb = gw; mb < T; mb += 4 * NGW) {
        f32x4 rp[4][4]; v4u qa1[4], qa2[4], ka1[4], ka2[4];
#pragma unroll
        for (int tt = 0; tt < 4; ++tt) { const int m = mb + tt * NGW < T ? mb + tt * NGW : mb, pos = m & (S - 1);
#pragma unroll
            for (int i = 0; i < 4; ++i) rp[tt][i] = *(const f32x4*)(ROPE + ((size_t)pos * 32 + sub * 8 + 2 * i) * 2);
            const bf16* sq = PROJ + (size_t)m * NPJ + P_DQ + g * 64 + sub * 8; const bf16* sk = PROJ + (size_t)m * NPJ + P_DK + g * 64 + sub * 8;
            qa1[tt] = __builtin_nontemporal_load((const v4u*)sq); qa2[tt] = __builtin_nontemporal_load((const v4u*)(sq + 32)); ka1[tt] = __builtin_nontemporal_load((const v4u*)sk); ka2[tt] = __builtin_nontemporal_load((const v4u*)(sk + 32)); }
        __builtin_amdgcn_sched_barrier(0);
#pragma unroll
        for (int tt = 0; tt < 4; ++tt) { const int m = mb + tt * NGW; if (m < T) {
            float cs[8], sn[8];
#pragma unroll
            for (int i = 0; i < 4; ++i) { const f32x4 t = rp[tt][i]; cs[2 * i] = t.x; sn[2 * i] = t.y; cs[2 * i + 1] = t.z; sn[2 * i + 1] = t.w; }
#pragma unroll
            for (int which = 0; which < 2; ++which) {
                const v4u a1 = which ? ka1[tt] : qa1[tt], a2 = which ? ka2[tt] : qa2[tt];
                float x1[8] = {bflo(a1.x), bfhi(a1.x), bflo(a1.y), bfhi(a1.y), bflo(a1.z), bfhi(a1.z), bflo(a1.w), bfhi(a1.w)};
                float x2[8] = {bflo(a2.x), bfhi(a2.x), bflo(a2.y), bfhi(a2.y), bflo(a2.z), bfhi(a2.z), bflo(a2.w), bfhi(a2.w)};
                float ss = 0.f;
#pragma unroll
                for (int i = 0; i < 8; ++i) ss += x1[i] * x1[i] + x2[i] * x2[i];
                ss += __shfl_xor(ss, 1); ss += __shfl_xor(ss, 2);
                const float r = rsqrtf(ss * (1.f / 64.f) + EPS) * (which ? 1.f : QSCALE);
                float o1[8], o2[8];
#pragma unroll
                for (int i = 0; i < 8; ++i) { const float u1 = x1[i] * r * (which ? gk1[i] : gq1[i]), u2 = x2[i] * r * (which ? gk2[i] : gq2[i]); o1[i] = u1 * cs[i] - u2 * sn[i]; o2[i] = u2 * cs[i] + u1 * sn[i]; }
                bf16* dst = (which ? KN : QN) + (size_t)m * 1024 + g * 64 + sub * 8;
                v4u w1, w2; w1.x = pk2(o1[0], o1[1]); w1.y = pk2(o1[2], o1[3]); w1.z = pk2(o1[4], o1[5]); w1.w = pk2(o1[6], o1[7]);
                w2.x = pk2(o2[0], o2[1]); w2.y = pk2(o2[2], o2[3]); w2.z = pk2(o2[4], o2[5]); w2.w = pk2(o2[6], o2[7]);
                *(v4u*)dst = w1; *(v4u*)(dst + 32) = w2;
            } } }
        __builtin_amdgcn_sched_barrier(0);
    }
}

__device__ __forceinline__ void mlA_unit(const Ctx& C, int u, const Args& a) {
    const bf16* PROJ = (const bf16*)(a.ws + WS_PROJ); const float* MG = (const float*)(a.ws + WS_MG); const float* MSC = (const float*)(a.ws + WS_MSC);
    bf16* U = (bf16*)(a.ws + WS_U); float* NU = (float*)(a.ws + WS_NU);
    const int b = u >> 8, hh = (u >> 6) & 3, j = u & 63, chain0 = (b * 4 + hh) * 2;
    const size_t row0 = (size_t)b * S + j * 64;
    const int tid = C.tid, lane = C.lane, w = C.wave;
    LAS unsigned char* lds = C.lds;
    constexpr int KI = 0, VI = 20480, WKF = 57344, WKB = 77824, WF = 98304;
    float fgv = 0.f, igv = 0.f; f32x2 ga; ga.x = 0.f; ga.y = 0.f;
    if (w < 2) { fgv = MG[(row0 + lane) * 16 + (w ? 12 : 4) + hh]; igv = MG[(row0 + lane) * 16 + (w ? 8 : 0) + hh]; ga = *(const f32x2*)(MSC + (size_t)((chain0 + w) * 64 + lane) * 2); }
    __syncthreads();
#pragma unroll
    for (int i = 0; i < 2; ++i) { const int p = tid + 512 * i, row = p >> 4, c = p & 15;
        *(LAS v4u*)(lds + KI + row * 320 + c * 16) = *(const v4u*)(PROJ + (row0 + row) * NPJ + P_MK + hh * 128 + c * 8); }
#pragma unroll
    for (int i = 0; i < 4; ++i) { const int p = tid + 512 * i, row = p >> 5, c = p & 31;
        *(LAS v4u*)(lds + VI + row * 576 + c * 16) = *(const v4u*)(PROJ + (row0 + row) * NPJ + P_MV + hh * 256 + c * 8); }
    if (w < 2) {
        const int dir = w, t = lane;
        const float lf = logsigf_(fgv), P = incl_sum_up(lf, lane), Gt = __shfl(P, 63);
        const float bcur = dir ? (Gt - P + lf) : P;
        const MScan ms = mscan_ga(ga, dir, lane);
        if (j == 0) { f32x4 o; o.x = ms.mprev; o.y = ms.mnew; o.z = ms.dec; o.w = 0.f; *(f32x4*)(a.ws + WS_MSV + (size_t)((chain0 + dir) * 64 + lane) * 16) = o; }
        const float av = Gt - bcur + igv, mnew = rdlane(ms.mnew, j);
        ((LAS float*)(lds + WF + dir * 256))[t] = __expf(av - mnew);
    }
    __syncthreads();
#pragma unroll
    for (int i = 0; i < 2; ++i) { const int p = tid + 512 * i, row = p >> 4, c = p & 15;
        const v4u kv = *(LAS v4u*)(lds + KI + row * 320 + c * 16);
        const float wf = ((LAS float*)(lds + WF))[row], wb = ((LAS float*)(lds + WF + 256))[row];
        *(LAS v4u*)(lds + WKF + row * 320 + c * 16) = scale8(kv, wf);
        *(LAS v4u*)(lds + WKB + row * 320 + c * 16) = scale8(kv, wb); }
    if (tid < 256) { const int dir = tid >> 7, k = tid & 127; float s = 0.f;
        for (int t = 0; t < 64; ++t) s += ((LAS float*)(lds + WF + dir * 256))[t] * bf2f(*(LAS bf16*)(lds + KI + t * 320 + k * 2));
        NU[(size_t)((chain0 + dir) * 64 + j) * 128 + k] = s; }
    __syncthreads();
    const int G_ = (lane >> 4) & 1, i16 = lane & 15, q_ = i16 >> 2, p_ = i16 & 3, h = lane >> 5, r32 = lane & 31;
    f32x16 acc[2][4];
#pragma unroll
    for (int d = 0; d < 2; ++d)
#pragma unroll
        for (int n = 0; n < 4; ++n) acc[d][n] = f32x16{};
#pragma unroll
    for (int s = 0; s < 4; ++s) {
        LAS unsigned char* va = lds + VI + (16 * s + 8 * h + q_) * 576 + (32 * w + 16 * G_ + 4 * p_) * 2;
        const bf16x8 af = cat8(trr(va), trr(va + 4 * 576));
#pragma unroll
        for (int d = 0; d < 2; ++d)
#pragma unroll
            for (int n = 0; n < 4; ++n) {
                LAS unsigned char* ba = lds + (d ? WKB : WKF) + (16 * s + 8 * h + q_) * 320 + (32 * n + 16 * G_ + 4 * p_) * 2;
                const bf16x8 bfr = cat8(trr(ba), trr(ba + 4 * 320));
                acc[d][n] = __builtin_amdgcn_mfma_f32_32x32x16_bf16(bfr, af, acc[d][n], 0, 0, 0);
            }
    }
    __syncthreads();
    LAS unsigned char* ut = lds + w * 4096;
#pragma unroll
    for (int d = 0; d < 2; ++d) {
#pragma unroll
        for (int n = 0; n < 4; ++n)
#pragma unroll
            for (int g4 = 0; g4 < 4; ++g4) { int o = 0; o = __builtin_amdgcn_cvt_pk_fp8_f32(sat8(acc[d][n][4 * g4 + 0]), sat8(acc[d][n][4 * g4 + 1]), o, false); o = __builtin_amdgcn_cvt_pk_fp8_f32(sat8(acc[d][n][4 * g4 + 2]), sat8(acc[d][n][4 * g4 + 3]), o, true);
                *(LAS int*)(ut + r32 * 128 + ((32 * n + 8 * g4 + 4 * h) ^ ((r32 & 7) << 4))) = o; }
        unsigned char* ub = (unsigned char*)U + ((size_t)((chain0 + d) * 64 + j) * 256 + 32 * w) * 128;
#pragma unroll
        for (int i = 0; i < 4; ++i) { const int row = 8 * i + (lane >> 3), ch = lane & 7;
            const v4u v = *(LAS v4u*)(ut + row * 128 + ((ch ^ (row & 7)) << 4));
            *(v4u*)(ub + (size_t)row * 128 + ch * 16) = v; }
    }
}
__device__ __forceinline__ void mlB_scan(const Ctx& C, const Args& a) {
    const bf16* __restrict__ U = (const bf16*)(a.ws + WS_U); bf16* __restrict__ CP = (bf16*)(a.ws + WS_CP); const float* MSC = (const float*)(a.ws + WS_MSC);
    const float* __restrict__ NU = (const float*)(a.ws + WS_NU); float* __restrict__ NP = (float*)(a.ws + WS_NP);
    for (int g = C.vcu * NTHR + C.tid; g < 16 * 8192; g += C.G * NTHR) {
        const int chain = __builtin_amdgcn_readfirstlane(g >> 13), e4 = g & 8191, dir = chain & 1;
        const MScan ms = mscan_ld(a.ws, chain, C.lane);
        const unsigned char* ub = (const unsigned char*)U + (size_t)chain * 64 * 32768 + 4 * e4; unsigned char* cb = (unsigned char*)CP + (size_t)chain * 64 * 32768 + 4 * e4;
        int ur[64];
#pragma unroll
        for (int ci = 0; ci < 64; ++ci) { const int c = dir ? 63 - ci : ci; ur[ci] = __builtin_nontemporal_load((const int*)(ub + (size_t)c * 32768)); }
        __builtin_amdgcn_sched_barrier(0);
        f32x4 st = {0.f, 0.f, 0.f, 0.f};
#pragma unroll
        for (int ci = 0; ci < 64; ++ci) { const int c = dir ? 63 - ci : ci; const float dec = rdlane(ms.dec, c);
            { int o = 0; o = __builtin_amdgcn_cvt_pk_fp8_f32(sat8(st.x), sat8(st.y), o, false); o = __builtin_amdgcn_cvt_pk_fp8_f32(sat8(st.z), sat8(st.w), o, true); *(int*)(cb + (size_t)c * 32768) = o; }
            const f32x4 uv = {__builtin_amdgcn_cvt_f32_fp8(ur[ci], 0), __builtin_amdgcn_cvt_f32_fp8(ur[ci], 1), __builtin_amdgcn_cvt_f32_fp8(ur[ci], 2), __builtin_amdgcn_cvt_f32_fp8(ur[ci], 3)}; st = st * dec + uv; }
    }
    const int g = C.vcu * NTHR + C.tid;
    if (g < 2048) { const int chain = __builtin_amdgcn_readfirstlane(g >> 7), k = g & 127, dir = chain & 1; const MScan ms = mscan_ld(a.ws, chain, C.lane);
        float nu[64];
#pragma unroll
        for (int ci = 0; ci < 64; ++ci) { const int c = dir ? 63 - ci : ci; nu[ci] = NU[(size_t)(chain * 64 + c) * 128 + k]; }
        __builtin_amdgcn_sched_barrier(0);
        float st = 0.f;
#pragma unroll
        for (int ci = 0; ci < 64; ++ci) { const int c = dir ? 63 - ci : ci; NP[(size_t)(chain * 64 + c) * 128 + k] = st; st = st * rdlane(ms.dec, c) + nu[ci]; } }
}
__device__ __forceinline__ void mlC_unit(const Ctx& C, int u, const Args& a) {
    const bf16* PROJ = (const bf16*)(a.ws + WS_PROJ); const float* MG = (const float*)(a.ws + WS_MG); const float* MSC = (const float*)(a.ws + WS_MSC);
    const bf16* CP = (const bf16*)(a.ws + WS_CP); const float* NP = (const float*)(a.ws + WS_NP); const float* mlg = a.in[4]; bf16* HM = (bf16*)(a.ws + WS_HM);
    const int b = u >> 8, hh = (u >> 6) & 3, j = u & 63, chain0 = (b * 4 + hh) * 2;
    const size_t row0 = (size_t)b * S + j * 64;
    const int tid = C.tid, lane = C.lane, w = C.wave;
    LAS unsigned char* lds = C.lds;
    constexpr int QI = 0, KI = 17408, VI = 34816, SI = 71680, PI = 89088, SC = 98304;
    constexpr int NQ = SC + 2048, NPL = SC + 6144, SSO = SC + 7168, RS = SC + 9216;
    float fgv = 0.f, igv = 0.f; MScan ms; ms.mprev = 0.f; ms.mnew = 0.f; ms.dec = 0.f;
    if (w < 2) { fgv = MG[(row0 + lane) * 16 + (w ? 12 : 4) + hh]; igv = MG[(row0 + lane) * 16 + (w ? 8 : 0) + hh]; ms = mscan_ld(a.ws, chain0 + w, lane); }
    __syncthreads();
#pragma unroll
    for (int i = 0; i < 2; ++i) { const int p = tid + 512 * i, row = p >> 4, c = p & 15;
        *(LAS v4u*)(lds + QI + row * 272 + c * 16) = *(const v4u*)(PROJ + (row0 + row) * NPJ + P_MQ + hh * 128 + c * 8);
        *(LAS v4u*)(lds + KI + row * 272 + c * 16) = *(const v4u*)(PROJ + (row0 + row) * NPJ + P_MK + hh * 128 + c * 8); }
#pragma unroll
    for (int i = 0; i < 4; ++i) { const int p = tid + 512 * i, row = p >> 5, c = p & 31;
        *(LAS v4u*)(lds + VI + row * 576 + c * 16) = *(const v4u*)(PROJ + (row0 + row) * NPJ + P_MV + hh * 256 + c * 8); }
    if (tid < 256) ((LAS float*)(lds + NPL))[tid] = NP[(size_t)((chain0 + (tid >> 7)) * 64 + j) * 128 + (tid & 127)];
    if (w < 2) {
        const int dir = w, t = lane;
        const float lf = logsigf_(fgv), P = incl_sum_up(lf, lane), Gt = __shfl(P, 63);
        const float bcur = dir ? (Gt - P + lf) : P, cv = igv - bcur;
        const float pm = dir ? incl_max_down(cv, lane) : incl_max_up(cv, lane);
        const float mprev = rdlane(ms.mprev, j);
        const float mt = bcur + fmaxf(mprev, pm), si = __expf(bcur + mprev - mt);
        LAS float* sc = (LAS float*)(lds + SC + dir * 1024);
        sc[t] = bcur; sc[64 + t] = cv; sc[128 + t] = mt; sc[192 + t] = si;
    }
    asm volatile("" ::: "memory");
    v2u cpr[2][8];
#pragma unroll
    for (int d = 0; d < 2; ++d) { const unsigned char* cp = (const unsigned char*)CP + ((size_t)((chain0 + d) * 64 + j) * 256 + 32 * w + (lane & 31)) * 128 + 8 * (lane >> 5);
#pragma unroll
        for (int ks = 0; ks < 8; ++ks) cpr[d][ks] = *(const v2u*)(cp + 16 * ks); }
    f32x4 gnr[4]; v2u smr[2][4];
#pragma unroll
    for (int g4 = 0; g4 < 4; ++g4) { const int v0 = 32 * w + 8 * g4 + 4 * (lane >> 5); gnr[g4] = *(const f32x4*)(mlg + v0);
#pragma unroll
        for (int th = 0; th < 2; ++th) smr[th][g4] = *(const v2u*)(PROJ + (row0 + 32 * th + (lane & 31)) * NPJ + P_MO + hh * 256 + v0); }
    __syncthreads();
    {
        const int fr = lane & 15, fq = lane >> 4;
#pragma unroll
        for (int tt = 0; tt < 2; ++tt) { const int tile = 2 * w + tt, ti = tile >> 2, si_ = tile & 3; f32x4 acc4 = {0.f, 0.f, 0.f, 0.f};
#pragma unroll
            for (int ks = 0; ks < 4; ++ks) {
                const bf16x8 aq = *(LAS bf16x8*)(lds + QI + (16 * ti + fr) * 272 + (32 * ks + 8 * fq) * 2);
                const bf16x8 bk = *(LAS bf16x8*)(lds + KI + (16 * si_ + fr) * 272 + (32 * ks + 8 * fq) * 2);
                acc4 = __builtin_amdgcn_mfma_f32_16x16x32_bf16(aq, bk, acc4, 0, 0, 0); }
#pragma unroll
            for (int i = 0; i < 4; ++i) ((LAS float*)(lds + SI))[(16 * ti + 4 * fq + i) * 68 + 16 * si_ + fr] = acc4[i]; }
        const int t = tid & 63, part = tid >> 6;
        const v4u q0 = *(LAS v4u*)(lds + QI + t * 272 + part * 32), q1 = *(LAS v4u*)(lds + QI + t * 272 + part * 32 + 16);
        const float qv[16] = {bflo(q0.x), bfhi(q0.x), bflo(q0.y), bfhi(q0.y), bflo(q0.z), bfhi(q0.z), bflo(q0.w), bfhi(q0.w), bflo(q1.x), bfhi(q1.x), bflo(q1.y), bfhi(q1.y), bflo(q1.z), bfhi(q1.z), bflo(q1.w), bfhi(q1.w)};
#pragma unroll
        for (int d = 0; d < 2; ++d) { float s = 0.f;
#pragma unroll
            for (int k = 0; k < 16; ++k) s += ((LAS float*)(lds + NPL))[d * 128 + part * 16 + k] * qv[k];
            ((LAS float*)(lds + NQ))[(d * 8 + part) * 64 + t] = s; }
    }
    __syncthreads();
    {
        const int t = tid >> 3, sg = tid & 7, s0 = 8 * sg;
        const f32x4 sa = *(LAS f32x4*)(lds + SI + (t * 68 + s0) * 4), sb = *(LAS f32x4*)(lds + SI + (t * 68 + s0 + 4) * 4);
        const float sv[8] = {sa.x, sa.y, sa.z, sa.w, sb.x, sb.y, sb.z, sb.w};
        float p[2][8], inv[2];
#pragma unroll
        for (int d = 0; d < 2; ++d) { LAS float* sc = (LAS float*)(lds + SC + d * 1024);
            const float Bt = sc[t], MTt = sc[128 + t], SIt = sc[192 + t]; float rs = 0.f;
#pragma unroll
            for (int e = 0; e < 8; ++e) { const int s = s0 + e; const bool ok = d ? (s >= t) : (s <= t);
                const float dv = ok ? __expf(Bt + sc[64 + s] - MTt) : 0.f; p[d][e] = dv * sv[e]; rs += p[d][e]; }
            float nq = ((LAS float*)(lds + NQ))[(d * 8 + sg) * 64 + t];
            rs += __shfl_xor(rs, 1); rs += __shfl_xor(rs, 2); rs += __shfl_xor(rs, 4);
            nq += __shfl_xor(nq, 1); nq += __shfl_xor(nq, 2); nq += __shfl_xor(nq, 4);
            const float den = fmaxf(fabsf(SIt * nq + rs), __expf(-MTt)); inv[d] = 1.f / den;
            if (sg == 0) ((LAS float*)(lds + RS))[d * 64 + t] = SIt * inv[d]; }
        float o[8];
#pragma unroll
        for (int e = 0; e < 8; ++e) o[e] = p[0][e] * inv[0] + p[1][e] * inv[1];
        v4u wv; wv.x = pk2(o[0], o[1]); wv.y = pk2(o[2], o[3]); wv.z = pk2(o[4], o[5]); wv.w = pk2(o[6], o[7]);
        *(LAS v4u*)(lds + PI + t * 144 + s0 * 2) = wv;
    }
    __syncthreads();
#pragma unroll
    for (int i = 0; i < 2; ++i) { const int p = tid + 512 * i, row = p >> 4, c = p & 15;
        const v4u qv = *(LAS v4u*)(lds + QI + row * 272 + c * 16);
        const float rf = ((LAS float*)(lds + RS))[row], rb = ((LAS float*)(lds + RS))[64 + row];
        *(LAS v4u*)(lds + QI + row * 272 + c * 16) = scale8(qv, rf);
        *(LAS v4u*)(lds + KI + row * 272 + c * 16) = scale8(qv, rb); }
    __syncthreads();
    const int G_ = (lane >> 4) & 1, i16 = lane & 15, q_ = i16 >> 2, p_ = i16 & 3, h = lane >> 5, r32 = lane & 31;
    f32x16 acc[2]; acc[0] = f32x16{}; acc[1] = f32x16{};
#pragma unroll
    for (int d = 0; d < 2; ++d) {
#pragma unroll
        for (int ks = 0; ks < 8; ++ks) { const v2u cr = cpr[d][ks]; v4u a4;
            a4.x = pk2(__builtin_amdgcn_cvt_f32_fp8((int)cr.x, 0), __builtin_amdgcn_cvt_f32_fp8((int)cr.x, 1)); a4.y = pk2(__builtin_amdgcn_cvt_f32_fp8((int)cr.x, 2), __builtin_amdgcn_cvt_f32_fp8((int)cr.x, 3));
            a4.z = pk2(__builtin_amdgcn_cvt_f32_fp8((int)cr.y, 0), __builtin_amdgcn_cvt_f32_fp8((int)cr.y, 1)); a4.w = pk2(__builtin_amdgcn_cvt_f32_fp8((int)cr.y, 2), __builtin_amdgcn_cvt_f32_fp8((int)cr.y, 3));
            const bf16x8 af = __builtin_bit_cast(bf16x8, a4);
#pragma unroll
            for (int th = 0; th < 2; ++th) { const bf16x8 bq = *(LAS bf16x8*)(lds + (d ? KI : QI) + (32 * th + r32) * 272 + (16 * ks + 8 * h) * 2);
                acc[th] = __builtin_amdgcn_mfma_f32_32x32x16_bf16(af, bq, acc[th], 0, 0, 0); } } }
#pragma unroll
    for (int ks = 0; ks < 4; ++ks) { LAS unsigned char* va = lds + VI + (16 * ks + 8 * h + q_) * 576 + (32 * w + 16 * G_ + 4 * p_) * 2;
        const bf16x8 af = cat8(trr(va), trr(va + 4 * 576));
#pragma unroll
        for (int th = 0; th < 2; ++th) { const bf16x8 bp = *(LAS bf16x8*)(lds + PI + (32 * th + r32) * 144 + (16 * ks + 8 * h) * 2);
            acc[th] = __builtin_amdgcn_mfma_f32_32x32x16_bf16(af, bp, acc[th], 0, 0, 0); } }
#pragma unroll
    for (int th = 0; th < 2; ++th) { float ss = 0.f;
#pragma unroll
        for (int r = 0; r < 16; ++r) ss += acc[th][r] * acc[th][r];
        ss += __shfl_xor(ss, 32);
        if (h == 0) ((LAS float*)(lds + SSO))[w * 64 + 32 * th + r32] = ss; }
    __syncthreads();
#pragma unroll
    for (int th = 0; th < 2; ++th) { float tot = 0.f;
#pragma unroll
        for (int ww = 0; ww < 8; ++ww) tot += ((LAS float*)(lds + SSO))[ww * 64 + 32 * th + r32];
        const float rr = rsqrtf(tot * (1.f / 256.f) + EPS); const size_t tok = row0 + 32 * th + r32;
#pragma unroll
        for (int g4 = 0; g4 < 4; ++g4) { const int v0 = 32 * w + 8 * g4 + 4 * h;
            const f32x4 gn = gnr[g4]; const v2u sm = smr[th][g4];
            v2u o; o.x = pk2(acc[th][4 * g4 + 0] * rr * gn.x * bflo(sm.x), acc[th][4 * g4 + 1] * rr * gn.y * bfhi(sm.x));
            o.y = pk2(acc[th][4 * g4 + 2] * rr * gn.z * bflo(sm.y), acc[th][4 * g4 + 3] * rr * gn.w * bfhi(sm.y));
            *(v2u*)(HM + tok * 1024 + hh * 256 + v0) = o; } }
}

constexpr int AT_BUF = 32768, AT_K2 = 8192, AT_V = 16384, AT_CV = 65536, AT_DUMMY = AT_CV + 8 * 8448;
__device__ __forceinline__ void at_dma(unsigned off, const char* base, unsigned ldsaddr) { unsigned keep;
    asm volatile("s_mov_b32 %0, m0\n\ts_mov_b32 m0, %3\n\ts_nop 0\n\tglobal_load_lds_dwordx4 %1, %2\n\ts_mov_b32 m0, %0" : "=&s"(keep) : "v"(off), "s"(base), "s"(ldsaddr) : "memory"); }
__device__ __forceinline__ void attn_unit(const Ctx& C, int u, int uidx, const Args& a, int lam_s, Conv& cv) {
    const bf16* QN = (const bf16*)(a.ws + WS_QN); const bf16* KN = (const bf16*)(a.ws + WS_KN); const bf16* PROJ = (const bf16*)(a.ws + WS_PROJ);
    const int b = u >> 8, hh = (u >> 5) & 7, qb = u & 31;
    const int lane = C.lane, w = C.wave, rg = w >> 1, mp = w & 1, r32 = lane & 31, h = lane >> 5;
    LAS unsigned char* lds = C.lds; const unsigned ldsb = (unsigned)(uintptr_t)lds;
    const size_t rowbase = (size_t)b * S; const int NGW = C.G * NWAVES;
    unsigned ko, vo0;
    { const int row = 8 * w + (lane >> 3), c = (lane & 7) ^ ((row >> 1) & 7); ko = (unsigned)((row * 1024 + c * 8) * 2); }
    { const int row = 8 * w + (lane >> 4), ch = (lane & 15) ^ ((row & 3) << 2); vo0 = (unsigned)((row * NPJ + ch * 8) * 2); }
    const char* kbase = (const char*)(KN + rowbase * 1024 + hh * 128); const char* vbase = (const char*)(PROJ + rowbase * NPJ + P_DV + hh * 128);
#define AT_TILE_DMA(t_, bufoff_) do { const char* kb__ = uni_ptr(kbase + (size_t)(t_) * 64 * 1024 * 2); const char* vb__ = uni_ptr(vbase + (size_t)(t_) * 64 * NPJ * 2); \
        const unsigned d__ = (unsigned)__builtin_amdgcn_readfirstlane((int)(ldsb + (bufoff_))); \
        at_dma(ko, kb__, d__ + w * 1024); at_dma(ko, kb__ + 128, d__ + AT_K2 + w * 1024); at_dma(vo0, vb__, d__ + AT_V + w * 2048); at_dma(vo0, vb__ + 4 * NPJ * 2, d__ + AT_V + w * 2048 + 1024); } while (0)
    bf16x8 qf[4];
    { const bf16* qsrc = QN + (rowbase + qb * 128 + rg * 32 + r32) * 1024 + hh * 128 + mp * 64 + h * 8;
#pragma unroll
      for (int d0 = 0; d0 < 4; ++d0) qf[d0] = *(const bf16x8*)(qsrc + 16 * d0); }
    f32x16 O[4];
#pragma unroll
    for (int d0 = 0; d0 < 4; ++d0) O[d0] = f32x16{};
    float lsum = 0.f;
    const int G_ = (lane >> 4) & 1, i16 = lane & 15, q_ = i16 >> 2, p_ = i16 & 3;
    const int kofb = mp * AT_K2 + r32 * 128 + ((h ^ ((r32 >> 1) & 1)) << 4) + (((r32 >> 2) & 3) << 5);
    const int vofb = AT_V + (4 * h + q_) * 256 + (q_ << 6) + 32 * G_ + 8 * p_;
#define kof(d0) (kofb ^ ((d0) << 5))
#define vof(d0) (vofb ^ ((d0) << 6))
    asm volatile("s_waitcnt lgkmcnt(0)" ::: "memory"); __builtin_amdgcn_s_barrier(); asm volatile("" ::: "memory");
    AT_TILE_DMA(0, 0);
    asm volatile("s_waitcnt vmcnt(0)" ::: "memory"); __builtin_amdgcn_s_barrier(); asm volatile("" ::: "memory");
#define AT_ITER(t_, SET_, TICK_) do { \
        LAS unsigned char* cur = lds + ((t_) & 1) * AT_BUF; \
        if ((t_) + 1 < S / 64) AT_TILE_DMA((t_) + 1, (((t_) + 1) & 1) * AT_BUF); \
        else { const unsigned d__ = (unsigned)__builtin_amdgcn_readfirstlane((int)(ldsb + AT_DUMMY)); const char* kb__ = uni_ptr(kbase); at_dma(ko, kb__, d__); at_dma(ko, kb__, d__); at_dma(ko, kb__, d__); at_dma(ko, kb__, d__); } \
        int cit_ = cv.it, cst_ = cv.step; conv_next(cit_, cst_, NGW); const ConvSrc csrc_ = conv_src<CV_L6>(a, cit_); const unsigned cloff_ = conv_loff(csrc_, lane); (void)cst_; (void)cloff_; \
        _Pragma("unroll") for (int hv = 0; hv < 2; ++hv) { f32x16 pp = f32x16{}; \
            _Pragma("unroll") for (int d0 = 0; d0 < 4; ++d0) { const bf16x8 ka = *(LAS bf16x8*)(cur + kof(d0) + hv * 32 * 128); pp = __builtin_amdgcn_mfma_f32_32x32x16_bf16(ka, qf[d0], pp, 0, 0, 0); } \
            if (TICK_) conv_issue_one(cv.s[(SET_) ^ 1], csrc_, cloff_, cst_, 4 * hv + 0); \
            _Pragma("unroll") for (int r = 0; r < 16; ++r) { pp[r] = __builtin_amdgcn_exp2f(pp[r]); lsum += pp[r]; } \
            if (TICK_) conv_issue_one(cv.s[(SET_) ^ 1], csrc_, cloff_, cst_, 4 * hv + 1); \
            _Pragma("unroll") for (int k2 = 0; k2 < 2; ++k2) { const int o = 8 * k2; \
                v4u t4; t4.x = pk2(pp[o + 0], pp[o + 1]); t4.y = pk2(pp[o + 2], pp[o + 3]); t4.z = pk2(pp[o + 4], pp[o + 5]); t4.w = pk2(pp[o + 6], pp[o + 7]); \
                const bf16x8 pa = __builtin_bit_cast(bf16x8, t4); \
                _Pragma("unroll") for (int d0 = 0; d0 < 4; ++d0) { LAS unsigned char* va = cur + vof(d0) + (32 * hv + 16 * k2) * 256; \
                    const bf16x8 vf = cat8(trr(va), trr(va + 8 * 256)); \
                    O[d0] = __builtin_amdgcn_mfma_f32_32x32x16_bf16(vf, pa, O[d0], 0, 0, 0); } \
                if (TICK_) conv_issue_one(cv.s[(SET_) ^ 1], csrc_, cloff_, cst_, 4 * hv + 2 + k2); } } \
        if (TICK_) { if (conv_consume<12, CV_L6>(cv, cv.s[SET_], a, lds + AT_CV + w * 8448, NGW, lane)) asm volatile("s_waitcnt vmcnt(16) lgkmcnt(0)" ::: "memory"); \
            else asm volatile("s_waitcnt vmcnt(8) lgkmcnt(0)" ::: "memory"); } \
        else asm volatile("s_waitcnt vmcnt(0) lgkmcnt(0)" ::: "memory"); \
        __builtin_amdgcn_s_barrier(); asm volatile("" ::: "memory"); \
    } while (0)
    { const int slot = C.vcu & 3; int pa = 64, pb = 64;
      if ((slot >> 1) == uidx) { pa = 12 * (slot & 1); pb = pa + 52; }
      int t = 0;
      for (; t < pa; t += 2) { AT_ITER(t, 0, true); AT_ITER(t + 1, 1, true); }
      for (; t < pb; t += 2) { AT_ITER(t, 0, false); AT_ITER(t + 1, 1, false); }
      for (; t < S / 64; t += 2) { AT_ITER(t, 0, true); AT_ITER(t + 1, 1, true); } }
#undef AT_ITER
#undef AT_TILE_DMA
#undef kof
#undef vof
    lsum += __shfl_xor(lsum, 32);
    const float inv = 1.f / lsum;
    int le = C.tid & 63; asm volatile("" : "+v"(le));
    LAS float* ex = (LAS float*)lds + rg * 4096;
    if (mp == 1) {
#pragma unroll
        for (int d0 = 0; d0 < 4; ++d0)
#pragma unroll
            for (int r = 0; r < 16; ++r) ex[(d0 * 16 + r) * 64 + le] = O[d0][r] * inv; }
    asm volatile("s_waitcnt lgkmcnt(0)" ::: "memory"); __builtin_amdgcn_s_barrier(); asm volatile("" ::: "memory");
    if (mp == 0) {
        float ss = 0.f; int lb_ = lam_s; asm volatile("" : "+s"(lb_)); const float lamv = __int_as_float(lb_);
#pragma unroll
        for (int d0 = 0; d0 < 4; ++d0)
#pragma unroll
            for (int r = 0; r < 16; ++r) { const float o = O[d0][r] * inv - lamv * ex[(d0 * 16 + r) * 64 + le]; O[d0][r] = o; ss += o * o; }
        ss += __shfl_xor(ss, 32);
        const float rr = rsqrtf(ss * (1.f / 128.f) + EPS) * (1.f - LAM_INIT);
        const size_t tok = (size_t)b * S + qb * 128 + rg * 32 + (le & 31); const int he = le >> 5;
        bf16* odp = (bf16*)(a.ws + WS_OD) + tok * 1024 + hh * 128 + 4 * he;
#pragma unroll
        for (int dh = 0; dh < 2; ++dh) { f32x4 gn[8];
#pragma unroll
            for (int i = 0; i < 8; ++i) gn[i] = *(const f32x4*)(a.in[9] + 32 * (2 * dh + (i >> 2)) + 8 * (i & 3) + 4 * he);
            __builtin_amdgcn_sched_barrier(0);
#pragma unroll
            for (int i = 0; i < 8; ++i) { const int d0 = 2 * dh + (i >> 2), g4 = i & 3, dv0 = 32 * d0 + 8 * g4;
                v2u o; o.x = pk2(O[d0][4 * g4 + 0] * rr * gn[i].x, O[d0][4 * g4 + 1] * rr * gn[i].y); o.y = pk2(O[d0][4 * g4 + 2] * rr * gn[i].z, O[d0][4 * g4 + 3] * rr * gn[i].w);
                *(v2u*)(odp + dv0) = o; } }
    }
}

__device__ __forceinline__ void p8_router(const Ctx& C, const Args& a) {
    const float* x1 = a.out; const float* g2 = a.in[12]; const float* br = a.in[14];
    const bf16* WRH = (const bf16*)(a.ws + WS_WRH); const bf16* WRL = (const bf16*)(a.ws + WS_WRL);
    unsigned char* H2 = a.ws + WS_H2; int* cnt = (int*)(a.ws + WS_CTL) + CW_WGCNT;
    int* TOPE = (int*)(a.ws + WS_RT); int* SLOT = TOPE + T * 4; float* WTS = (float*)(SLOT + T * 4);
    const int lane = C.lane, w = C.wave, r32 = lane & 31, h = lane >> 5;
    constexpr int XP = 4112, XT_BYTES = 32 * XP;
    LAS unsigned char* XT = C.lds;
    LAS float* PLG = (LAS float*)C.lds;
    LAS float* SSQ = (LAS float*)(C.lds + XT_BYTES);
    LAS float* LG = (LAS float*)(C.lds + XT_BYTES + 1024);
    LAS float* RSTD = (LAS float*)(C.lds + XT_BYTES + 1024 + 32 * 33 * 4);
    LAS int* lcnt = (LAS int*)(C.lds + XT_BYTES + 1024 + 32 * 33 * 4 + 128);
    static_assert(XT_BYTES + 1024 + 32 * 33 * 4 + 256 <= MISC_OFF, "router LDS");
    if (C.tid < NE) lcnt[C.tid] = 0;
    for (int m0 = C.vcu * 32; m0 < T; m0 += C.G * 32) {
        __syncthreads();
        f32x16 acc = f32x16{}; float ssq = 0.f;
        const float* xrow = x1 + (size_t)(m0 + r32) * D + 256 * w + 4 * h;
        const bf16* whp = WRH + (size_t)(w * 16 * 64 + lane) * 8; const bf16* wlp = WRL + (size_t)(w * 16 * 64 + lane) * 8;
        LAS unsigned char* xt = XT + r32 * XP + (256 * w + 4 * h) * 2;
#pragma unroll
        for (int hb = 0; hb < 2; ++hb) {
            f32x4 xa[8], xb[8]; bf16x8 wh[8], wl[8];
#pragma unroll
            for (int s8 = 0; s8 < 8; ++s8) { const int s = 8 * hb + s8; xa[s8] = *(const f32x4*)(xrow + 16 * s); xb[s8] = *(const f32x4*)(xrow + 16 * s + 8);
                wh[s8] = *(const bf16x8*)(whp + 512 * s); wl[s8] = *(const bf16x8*)(wlp + 512 * s); }
            __builtin_amdgcn_sched_barrier(0);
#pragma unroll
            for (int s8 = 0; s8 < 8; ++s8) { const int s = 8 * hb + s8;
                ssq += (xa[s8].x * xa[s8].x + xa[s8].y * xa[s8].y) + (xa[s8].z * xa[s8].z + xa[s8].w * xa[s8].w) + (xb[s8].x * xb[s8].x + xb[s8].y * xb[s8].y) + (xb[s8].z * xb[s8].z + xb[s8].w * xb[s8].w);
                const float hv[8] = {xa[s8].x, xa[s8].y, xa[s8].z, xa[s8].w, xb[s8].x, xb[s8].y, xb[s8].z, xb[s8].w};
                v4u hi4, lo4;
#pragma unroll
                for (int i = 0; i < 4; ++i) { const unsigned hp = pk2(hv[2 * i], hv[2 * i + 1]); ((unsigned*)&hi4)[i] = hp; ((unsigned*)&lo4)[i] = pk2(hv[2 * i] - bflo(hp), hv[2 * i + 1] - bfhi(hp)); }
                { v2u t0; t0.x = hi4.x; t0.y = hi4.y; v2u t1; t1.x = hi4.z; t1.y = hi4.w; *(LAS v2u*)(xt + 32 * s) = t0; *(LAS v2u*)(xt + 32 * s + 16) = t1; }
                const bf16x8 hh = __builtin_bit_cast(bf16x8, hi4), hl = __builtin_bit_cast(bf16x8, lo4);
                acc = __builtin_amdgcn_mfma_f32_32x32x16_bf16(wh[s8], hh, acc, 0, 0, 0);
                acc = __builtin_amdgcn_mfma_f32_32x32x16_bf16(wh[s8], hl, acc, 0, 0, 0);
                acc = __builtin_amdgcn_mfma_f32_32x32x16_bf16(wl[s8], hh, acc, 0, 0, 0); }
            __builtin_amdgcn_sched_barrier(0);
        }
        ssq += __shfl_xor(ssq, 32);
        if (h == 0) SSQ[w * 32 + r32] = ssq;
        __syncthreads();
        if (C.tid < 32) { float s = 0.f;
#pragma unroll
            for (int ww = 0; ww < 8; ++ww) s += SSQ[ww * 32 + C.tid];
            RSTD[C.tid] = rsqrtf(s * (1.f / D) + EPS); }
        __syncthreads();
        f32x4 gq[8];
#pragma unroll
        for (int j = 0; j < 8; ++j) gq[j] = *((const f32x4*)g2 + lane + 64 * j);
#pragma unroll
        for (int it = 0; it < 4; ++it) { const int t = 4 * w + it, m = m0 + t; const float rs = RSTD[t];
#pragma unroll
            for (int j = 0; j < 8; ++j) { const v2u q = *(const LAS v2u*)(XT + t * XP + (lane + 64 * j) * 8);
                int o = 0; o = __builtin_amdgcn_cvt_pk_fp8_f32(bflo(q.x) * rs * gq[j].x, bfhi(q.x) * rs * gq[j].y, o, false); o = __builtin_amdgcn_cvt_pk_fp8_f32(bflo(q.y) * rs * gq[j].z, bfhi(q.y) * rs * gq[j].w, o, true);
                *((int*)(H2 + (size_t)m * D) + lane + 64 * j) = o; } }
        __syncthreads();
#pragma unroll
        for (int r = 0; r < 16; ++r) PLG[(w * 16 + r) * 64 + lane] = acc[r];
        __syncthreads();
#pragma unroll
        for (int q = 0; q < 2; ++q) { const int idx = C.tid + 512 * q, r = idx >> 6, l = idx & 63; float s = 0.f;
#pragma unroll
            for (int ww = 0; ww < 8; ++ww) s += PLG[(ww * 16 + r) * 64 + l];
            const int e = (r & 3) + 8 * (r >> 2) + 4 * (l >> 5), t = l & 31;
            LG[t * 33 + e] = s * RSTD[t] + br[e]; }
        __syncthreads();
#pragma unroll
        for (int ps = 0; ps < 2; ++ps) { const int t = 4 * w + 2 * ps + h, m = m0 + t; float v = LG[t * 33 + r32]; float tv[4]; int ti[4];
#pragma unroll
            for (int k = 0; k < 4; ++k) { float best = v;
#pragma unroll
                for (int o = 1; o < 32; o <<= 1) best = fmaxf(best, __shfl_xor(best, o));
                const unsigned long long bm = __ballot(v == best); const unsigned hm = h ? (unsigned)(bm >> 32) : (unsigned)bm; const int bi = __builtin_ctz(hm);
                tv[k] = best; ti[k] = bi; v = (r32 == bi) ? -INFINITY : v; }
            const float e1 = __expf(tv[1] - tv[0]), e2 = __expf(tv[2] - tv[0]), e3 = __expf(tv[3] - tv[0]); const float inv = 1.f / (1.f + e1 + e2 + e3);
            if (r32 < 4) { const int k = r32; const int tk = k == 0 ? ti[0] : k == 1 ? ti[1] : k == 2 ? ti[2] : ti[3]; const float wk = (k == 0 ? 1.f : k == 1 ? e1 : k == 2 ? e2 : e3) * inv;
                TOPE[m * 4 + k] = tk; SLOT[m * 4 + k] = __hip_atomic_fetch_add(lcnt + tk, 1, __ATOMIC_RELAXED, __HIP_MEMORY_SCOPE_WORKGROUP); WTS[m * 4 + k] = wk; } }
    }
    __syncthreads();
    if (C.tid < NE) cnt[C.vcu * NE + C.tid] = lcnt[C.tid];
}
__device__ __forceinline__ void p9_gather(const Ctx& C, const Args& a) {
    const unsigned char* H2 = a.ws + WS_H2; const int* wgcnt = (const int*)(a.ws + WS_CTL) + CW_WGCNT; int* cnt = (int*)(a.ws + WS_CTL) + CW_CNT;
    const int* TOPE = (const int*)(a.ws + WS_RT); const int* SLOT = TOPE + T * 4; int* DEST = (int*)(a.ws + WS_RT) + 3 * T * 4; unsigned* RMAP = (unsigned*)(a.ws + WS_XG); (void)H2;
    const int gw = C.vcu * NWAVES + C.wave, NGW = C.G * NWAVES, lane = C.lane;
    int mycnt = 0, mybase = 0;
    if (C.G == 256) {
        LAS int* ps = (LAS int*)C.lds; int v[32], tot = 0, bas = 0;
#pragma unroll
        for (int i = 0; i < 32; ++i) v[i] = wgcnt[(32 * C.wave + i) * NE + (lane & 31)];
#pragma unroll
        for (int i = 0; i < 32; ++i) { tot += v[i]; bas += (32 * C.wave + i < C.vcu) ? v[i] : 0; }
        __syncthreads();
        if (lane < NE) { ps[(C.wave * 2 + 0) * 32 + lane] = tot; ps[(C.wave * 2 + 1) * 32 + lane] = bas; }
        __syncthreads();
#pragma unroll
        for (int w8 = 0; w8 < 8; ++w8) { mycnt += ps[(w8 * 2 + 0) * 32 + (lane & 31)]; mybase += ps[(w8 * 2 + 1) * 32 + (lane & 31)]; }
    } else {
#pragma unroll 8
    for (int w = 0; w < C.G; ++w) { const int v = wgcnt[w * NE + (lane & 31)]; mycnt += v; mybase += (w < C.vcu) ? v : 0; }
    }
    if (lane >= NE) { mycnt = 0; mybase = 0; }
    int tiles = (mycnt + PADM - 1) / PADM, inc = tiles;
#pragma unroll
    for (int o = 1; o < 32; o <<= 1) { const int t = __shfl_up(inc, o); if (lane >= o) inc += t; }
    const int startrow = (inc - tiles) * PADM;
    if (gw == 0 && lane < NE) cnt[lane] = mycnt;
    for (int m0 = C.vcu * 32; m0 < T; m0 += C.G * 32) {
        const int t0 = m0 + 4 * C.wave, qi = t0 * 4 + (lane & 15);
        const int te = TOPE[qi], ts = SLOT[qi];
        const int rowl = __shfl(startrow, te) + __shfl(mybase, te) + ts;
        if (lane < 16) { DEST[qi] = rowl; RMAP[rowl] = (unsigned)(t0 + (lane >> 2)) * (unsigned)D; } }
    for (int p = gw * 64 + lane; p < NE * PADM; p += NGW * 64) { const int e = p / PADM, qq = p % PADM; const int c = __shfl(mycnt, e), st = __shfl(startrow, e), tl = __shfl(tiles, e);
        if (c + qq < tl * PADM) RMAP[st + c + qq] = 0u; }
}
__device__ __forceinline__ void p12_combine(const Ctx& C, const Args& a) {
    const bf16* Y = (const bf16*)(a.ws + WS_Y); const float* WTS = (const float*)(a.ws + WS_RT) + 2 * T * 4; const int* DEST = (const int*)(a.ws + WS_RT) + 3 * T * 4; float* out = a.out;
    const int gw = C.vcu * NWAVES + C.wave, NGW = C.G * NWAVES, lane = C.lane;
    int dn[4]; float wn[4];
    if (gw < T) {
#pragma unroll
        for (int k = 0; k < 4; ++k) { dn[k] = DEST[gw * 4 + k]; wn[k] = WTS[gw * 4 + k]; } }
    for (int m = gw; m < T; m += NGW) { int d[4]; float wv[4];
#pragma unroll
        for (int k = 0; k < 4; ++k) { d[k] = dn[k]; wv[k] = wn[k]; }
        f32x4 o[8]; int y[4][8];
#pragma unroll
        for (int j = 0; j < 8; ++j) { o[j] = __builtin_nontemporal_load((const f32x4*)(out + (size_t)m * D) + lane + 64 * j);
#pragma unroll
            for (int k = 0; k < 4; ++k) y[k][j] = __builtin_nontemporal_load((const int*)((const unsigned char*)Y + (size_t)d[k] * D) + lane + 64 * j); }
        if (m + NGW < T) {
#pragma unroll
            for (int k = 0; k < 4; ++k) { dn[k] = DEST[(m + NGW) * 4 + k]; wn[k] = WTS[(m + NGW) * 4 + k]; } }
        __builtin_amdgcn_sched_barrier(0);
#pragma unroll
        for (int j = 0; j < 8; ++j) {
#pragma unroll
            for (int k = 0; k < 4; ++k) { const int yy = y[k][j];
                o[j].x += wv[k] * __builtin_amdgcn_cvt_f32_fp8(yy, 0); o[j].y += wv[k] * __builtin_amdgcn_cvt_f32_fp8(yy, 1); o[j].z += wv[k] * __builtin_amdgcn_cvt_f32_fp8(yy, 2); o[j].w += wv[k] * __builtin_amdgcn_cvt_f32_fp8(yy, 3); }
            *((f32x4*)(out + (size_t)m * D) + lane + 64 * j) = o[j]; }
        __builtin_amdgcn_sched_barrier(0);
    }
}

constexpr int N_PHASES = 14;
__global__ void __launch_bounds__(NTHR, 2) mega_fwd(Args args) {
    extern __shared__ __attribute__((aligned(16))) unsigned char lds_raw[];
    Ctx C; C.lds = (LAS unsigned char*)lds_raw; C.tid = threadIdx.x; C.lane = C.tid & 63; C.wave = __builtin_amdgcn_readfirstlane(C.tid >> 6);
    C.G = gridDim.x; { const int bx = blockIdx.x; C.vcu = (C.G % 8 == 0) ? (bx % 8) * (C.G / 8) + bx / 8 : bx; }
    volatile LAS unsigned* MISC = (volatile LAS unsigned*)(C.lds + MISC_OFF);
    if (C.tid < 32) MISC[C.tid] = 0u;
    __syncthreads();
    unsigned* ctl = (unsigned*)(args.ws + WS_CTL);
    XcdBarrier bar = xcd_barrier_post(ctl + CW_BAR, MISC + 8);
    const int lo = args.ph_lo, hi = args.ph_hi;
#ifndef ONLY_MASK
#define ONLY_MASK 0xFFFF
#endif
#define IN(k) (((ONLY_MASK >> (k)) & 1) && lo <= (k) && (k) < hi)
#ifndef DBL_MASK
#define DBL_MASK 0
#endif
#define REP(k) for (int rep_ = 0; rep_ < (((DBL_MASK >> (k)) & 1) ? 2 : 1); ++rep_, (((DBL_MASK >> (k)) & 1) && rep_ == 1 ? xcd_barrier(bar) : (void)0))
#define SEAM(k) do { if (IN(k) && IN((k) + 1)) xcd_barrier(bar); } while (0)
    if (IN(0)) REP(0) { p0_transposes(C, args); p0_rope(C, args); p0_router_w(C, args); p0_xn_gates(C, args); }
    SEAM(0);
    if (IN(1)) REP(1) { p2_mstats(C, args);
        { pg8::Gemm g{(const bf16*)(args.ws + WS_XN), (const bf16*)(args.ws + WS_WIN), T, 6144, D}; pg8::StaticOrder So; So.init(T, 6144, C.G, (int)blockIdx.x);
          EpiProj<false> E{(bf16*)(args.ws + WS_PROJ), nullptr}; pg8::gemm_phase<EpiProj<false>, pg8::StaticOrder, true, true>(C.lds, g, So, E); } }
    SEAM(1);
    if (IN(2)) REP(2) { p2_late_transposes(C, args); p2_qkprep(C, args); }
    if (!(IN(2) && IN(3))) SEAM(2);
    if (IN(3)) REP(3) { for (int u = C.vcu; u < 512; u += C.G) mlA_unit(C, u, args); }
    SEAM(3);
    if (IN(4)) REP(4) { mlB_scan(C, args); }
    SEAM(4);
    const bool gfirst_ = ((int)blockIdx.x & 1) != 0;
    if (IN(5) && (gfirst_ || !IN(6))) REP(5) { for (int u = C.vcu; u < 512; u += C.G) mlC_unit(C, u, args); }
    if (IN(6)) REP(6) {
        const bool gfirst = ((int)blockIdx.x & 1) != 0;
#define GATE_GEMM() do { __syncthreads(); \
            { pg8::Gemm g{(const bf16*)(args.ws + WS_XN8), (const bf16*)(args.ws + WS_WIN8), T, 4096, D / 2}; pg8::StaticOrder So; So.init(T, 4096, C.G, (int)blockIdx.x);     \
              EpiProj<true> E{(bf16*)(args.ws + WS_PROJ), args.ws + WS_G8}; int z_ = 0; asm volatile("" : "+v"(z_)); pg8::gemm_phase<EpiProj<true>, pg8::StaticOrder, true, true, true>(C.lds, g, So, E, nullptr, z_); } \
            __syncthreads(); } while (0)
        if (gfirst) GATE_GEMM();
        {
        const float* lp = args.in[8]; const float sa = wave_sum(lp[C.lane] * lp[64 + C.lane]), sb = wave_sum(lp[128 + C.lane] * lp[192 + C.lane]);
        const float lam = __expf(sa) - __expf(sb) + LAM_INIT;
        Conv cv; conv_begin<CV_L6>(cv, args, C.vcu * NWAVES + C.wave, C.G * NWAVES, C.lane);
        int lam_s = __builtin_amdgcn_readfirstlane(__float_as_int(lam)); asm volatile("" : "+s"(lam_s));
        { int uidx = 0; for (int u = C.vcu; u < 512; u += C.G, ++uidx) attn_unit(C, u, uidx, args, lam_s, cv); }
        asm volatile("s_waitcnt lgkmcnt(0)" ::: "memory"); __builtin_amdgcn_s_barrier(); asm volatile("" ::: "memory");
        while (cv.it < CV_L6) { conv_issue_next<CV_L6>(cv, cv.s[1], args, C.G * NWAVES, C.lane); (void)conv_consume<8, CV_L6>(cv, cv.s[0], args, C.lds + AT_CV + C.wave * 8448, C.G * NWAVES, C.lane);
            conv_issue_next<CV_L6>(cv, cv.s[0], args, C.G * NWAVES, C.lane); (void)conv_consume<8, CV_L6>(cv, cv.s[1], args, C.lds + AT_CV + C.wave * 8448, C.G * NWAVES, C.lane); }
        asm volatile("s_waitcnt vmcnt(0)" ::: "memory");
        }
        if (!gfirst) GATE_GEMM();
#undef GATE_GEMM
        if (IN(5) && !gfirst) { __syncthreads(); Ctx C2 = C; int z_ = 0; asm volatile("" : "+v"(z_)); C2.tid = C.tid + z_; C2.lane = C2.tid & 63;
            for (int u = C.vcu; u < 512; u += C.G) mlC_unit(C2, u, args); }
    }
    SEAM(6);
    if (IN(7)) REP(7) { __syncthreads();
        pg8::StaticOrder So; So.init(T, D, C.G, (int)blockIdx.x);
        if (So.nwg % C.G == 0) {
            static_assert(WS_OD - WS_HM == (size_t)T * MLW * 2 && WS_WDA - WS_WML == (size_t)D * MLW * 2 && MLW == DAW, "pair stream: operands of the two products must be adjacent");
            pg8::Gemm g{(const bf16*)(args.ws + WS_HM), (const bf16*)(args.ws + WS_WML), 2 * T, D, MLW}; PairOrder Po{So};
            EpiGatePair E{(const bf16*)(args.ws + WS_G8), (bf16*)(args.ws + WS_T1), (bf16*)(args.ws + WS_MIX)}; pg8::gemm_phase<EpiGatePair, PairOrder, true, true>(C.lds, g, Po, E);
        } else {
        { pg8::Gemm g{(const bf16*)(args.ws + WS_HM), (const bf16*)(args.ws + WS_WML), T, D, MLW};
          EpiGate<0> E{(const bf16*)(args.ws + WS_G8), nullptr, (bf16*)(args.ws + WS_T1)}; pg8::gemm_phase<EpiGate<0>, pg8::StaticOrder, true, true>(C.lds, g, So, E); }
        __syncthreads();
        { pg8::Gemm g{(const bf16*)(args.ws + WS_OD), (const bf16*)(args.ws + WS_WDA), T, D, DAW};
          EpiGate<1> E{(const bf16*)(args.ws + WS_G8), (const bf16*)(args.ws + WS_T1), (bf16*)(args.ws + WS_MIX)}; pg8::gemm_phase<EpiGate<1>, pg8::StaticOrder, true, true>(C.lds, g, So, E); }
        }
    }
    SEAM(7);
    if (IN(8)) REP(8) { pg8::Gemm g{(const bf16*)(args.ws + WS_MIX), (const bf16*)(args.ws + WS_WO), T, D, D}; pg8::StaticOrder So; So.init(T, D, C.G, (int)blockIdx.x);
        EpiRes E{args.in[0], args.out}; pg8::gemm_phase<EpiRes, pg8::StaticOrder, true, true>(C.lds, g, So, E); }
    SEAM(8);
    if (IN(9)) REP(9) { p8_router(C, args); }
    SEAM(9);
    if (IN(10)) REP(10) { p9_gather(C, args); }
    SEAM(10);
    if (IN(11)) REP(11) {
      const bool split = C.G == 256; const int bj = (int)blockIdx.x >> 3;
      if (!split || bj >= 28) conv_run(args, CV_L6 + (split ? (((int)blockIdx.x & 7) * 4 + (bj - 28)) : C.vcu) * NWAVES + C.wave, (split ? 32 : C.G) * NWAVES, C.lds + AT_CV + C.wave * 8448, C.lane);
      if (!split) __syncthreads();
      if (!split || bj < 28) {
        MoeSched Ms; Ms.init((const int*)(args.ws + WS_CTL) + CW_CNT, 16, C.G, (int)blockIdx.x, C.lane, split ? 28 : 32);
        pg8::Gemm g{(const bf16*)(args.ws + WS_H2), (const bf16*)(args.ws + WS_WGU), MAXROWS, 2 * DE, D / 2};
        EpiAct E{args.in[16], args.ws + WS_ACT}; pg8::gemm_phase<EpiAct, MoeSched, true, true, true, 0, true>(C.lds, g, Ms, E, (const unsigned*)(args.ws + WS_XG)); } }
    SEAM(11);
    if (IN(12)) REP(12) { MoeSched Ms; Ms.init((const int*)(args.ws + WS_CTL) + CW_CNT, 8, C.G, (int)blockIdx.x, C.lane);
        pg8::Gemm g{(const bf16*)(args.ws + WS_ACT), (const bf16*)(args.ws + WS_WDN), MAXROWS, D, DE / 2};
        EpiY E{args.in[18], (bf16*)(args.ws + WS_Y)}; pg8::gemm_phase<EpiY, MoeSched, true, true, true>(C.lds, g, Ms, E); }
    SEAM(12);
    if (IN(13)) REP(13) { p12_combine(C, args); }
#undef IN
#undef SEAM
}
#ifdef DEV_NAIVE
constexpr size_t NV_XN32 = WS_NAIVE, NV_PROJ32 = NV_XN32 + 64 * MiB, NV_F = NV_PROJ32 + 322 * MiB, NV_HF = NV_F + 1 * MiB, NV_OD32 = NV_HF + 64 * MiB, NV_MIX32 = NV_OD32 + 32 * MiB, NV_END = NV_MIX32 + 64 * MiB;
__device__ __forceinline__ float ldf(const float* p) { return *p; }
__device__ __forceinline__ float ldf(const bf16* p) { return bf2f(*p); }
__global__ __launch_bounds__(256) void k_rmsnorm(const float* __restrict__ x, const float* __restrict__ g, float* __restrict__ y) {
    const int row = blockIdx.x * 4 + (threadIdx.x >> 6), lane = threadIdx.x & 63;
    const float* xr = x + (size_t)row * D; float v[32]; float s = 0.f;
#pragma unroll
    for (int j = 0; j < 32; ++j) { v[j] = xr[lane + 64 * j]; s += v[j] * v[j]; }
    s = wave_sum(s); const float r = rsqrtf(s * (1.f / D) + EPS);
#pragma unroll
    for (int j = 0; j < 32; ++j) y[(size_t)row * D + lane + 64 * j] = v[j] * r * g[lane + 64 * j];
}
struct GArgs { const void* A; const float* B; void* C; int M, N, K, lda, ldb, ldc; const void* aux0; const void* aux1; const int* cnt; };
template <int EPI, typename TA> __global__ __launch_bounds__(256) void k_gemm(GArgs g) {
    __shared__ float As[16][64 + 4], Bs[16][64 + 4];
    const int tx = threadIdx.x & 15, ty = threadIdx.x >> 4;
    int m0 = blockIdx.y * 64, n0 = blockIdx.x * 64;
    const TA* A = (const TA*)g.A; const float* Bp = g.B; int M = g.M; int rowbase = 0; int e = 0;
    if (EPI == 4 || EPI == 5) {
        e = blockIdx.z; int start = 0;
        for (int i = 0; i < e; ++i) start += (g.cnt[i] + PADM - 1) / PADM * PADM;
        const int c = g.cnt[e]; if (m0 >= c) return;
        M = (c + PADM - 1) / PADM * PADM; rowbase = start;
        A = (const TA*)g.A + (size_t)rowbase * g.lda; Bp = g.B + (size_t)e * g.K * g.ldb;
    }
    float acc[4][4] = {};
    for (int k0 = 0; k0 < g.K; k0 += 16) {
        for (int i = threadIdx.x; i < 64 * 16; i += 256) { const int mm = i >> 4, kk = i & 15; const int m = m0 + mm; As[kk][mm] = (m < M) ? ldf(A + (size_t)m * g.lda + k0 + kk) : 0.f; }
        for (int i = threadIdx.x; i < 16 * 64; i += 256) { const int kk = i >> 6, nn = i & 63; const int n = n0 + nn; Bs[kk][nn] = (n < g.N) ? Bp[(size_t)(k0 + kk) * g.ldb + n] : 0.f; }
        __syncthreads();
#pragma unroll
        for (int kk = 0; kk < 16; ++kk) {
            float a[4], b[4];
#pragma unroll
            for (int i = 0; i < 4; ++i) { a[i] = As[kk][ty * 4 + i]; b[i] = Bs[kk][tx * 4 + i]; }
#pragma unroll
            for (int i = 0; i < 4; ++i)
#pragma unroll
                for (int j = 0; j < 4; ++j) acc[i][j] += a[i] * b[j];
        }
        __syncthreads();
    }
#pragma unroll
    for (int i = 0; i < 4; ++i) {
        const int m = m0 + ty * 4 + i; if (m >= M) continue;
        if (EPI == 4) {
            const float* bias = (const float*)g.aux0 + (size_t)e * g.N;
#pragma unroll
            for (int j = 0; j < 4; j += 2) {
                const int n = n0 + tx * 4 + j;
                float glu = acc[i][j] + bias[n], lin = acc[i][j + 1] + bias[n + 1];
                glu = fminf(glu, 7.f); lin = fminf(fmaxf(lin, -7.f), 7.f);
                ((bf16*)g.C)[(size_t)(rowbase + m) * g.ldc + (n >> 1)] = f2bf(glu * sigmoidf_(1.702f * glu) * (lin + 1.f));
            }
        } else {
#pragma unroll
            for (int j = 0; j < 4; ++j) {
                const int n = n0 + tx * 4 + j; if (n >= g.N) continue;
                const float v = acc[i][j];
                if (EPI == 0) ((float*)g.C)[(size_t)m * g.ldc + n] = v;
                if (EPI == 1) ((float*)g.C)[(size_t)m * g.ldc + n] = bf2f(((const bf16*)g.aux0)[(size_t)m * NPJ + P_GM + n]) * v;
                if (EPI == 2) ((float*)g.C)[(size_t)m * g.ldc + n] += bf2f(((const bf16*)g.aux0)[(size_t)m * NPJ + P_GD + n]) * v;
                if (EPI == 3) ((float*)g.C)[(size_t)m * g.ldc + n] = ((const float*)g.aux0)[(size_t)m * g.ldc + n] + v;
                if (EPI == 5) ((bf16*)g.C)[(size_t)(rowbase + m) * g.ldc + n] = f2bf(v + ((const float*)g.aux0)[(size_t)e * g.N + n]);
            }
        }
    }
}
__global__ __launch_bounds__(256) void k_pack(const float* __restrict__ P32, const float* __restrict__ gbias, bf16* __restrict__ PROJ, float* __restrict__ MG) {
    const int t = blockIdx.x;
    for (int c = threadIdx.x; c < NPJ; c += 256) { const int src = c < G_OFF ? c : c + 16; float v = P32[(size_t)t * DIN + src];
        if (c >= P_MK && c < P_MV) v *= KSCALE;
        if ((c >= P_MO && c < P_DQ) || c >= P_GM) v = sigmoidf_(v);
        PROJ[(size_t)t * NPJ + c] = f2bf(v); }
    if (threadIdx.x < 16) MG[(size_t)t * 16 + threadIdx.x] = P32[(size_t)t * DIN + G_OFF + threadIdx.x] + gbias[threadIdx.x];
}
__global__ __launch_bounds__(256) void k_rope(float* __restrict__ ROPE) {
    const int g = blockIdx.x * 256 + threadIdx.x; const int pos = g >> 5, i = g & 31;
    const double inv = exp2(-(double)i * (13.287712379549449 / 32.0));
    const float ang = (float)pos * (float)inv;
    ROPE[2 * g] = cosf(ang); ROPE[2 * g + 1] = sinf(ang);
}
__global__ __launch_bounds__(256) void k_qkprep(const bf16* __restrict__ PROJ, const float* __restrict__ ROPE, const float* __restrict__ qg, const float* __restrict__ kg, bf16* __restrict__ QN, bf16* __restrict__ KN) {
    const int t = blockIdx.x * 4 + (threadIdx.x >> 6), lane = threadIdx.x & 63;
    const int pos = t % S, g = lane >> 2, sub = lane & 3;
    for (int which = 0; which < 2; ++which) {
        const bf16* src = PROJ + (size_t)t * NPJ + (which ? P_DK : P_DQ) + g * 64;
        const float* gn = which ? kg : qg; bf16* dst = (which ? KN : QN) + (size_t)t * 1024 + g * 64;
        float x1[8], x2[8]; float ss = 0.f;
#pragma unroll
        for (int i = 0; i < 8; ++i) { x1[i] = bf2f(src[sub * 8 + i]); x2[i] = bf2f(src[32 + sub * 8 + i]); ss += x1[i] * x1[i] + x2[i] * x2[i]; }
        ss += __shfl_xor(ss, 1); ss += __shfl_xor(ss, 2);
        const float r = rsqrtf(ss * (1.f / 64.f) + EPS) * (which ? 1.f : QSCALE);
#pragma unroll
        for (int i = 0; i < 8; ++i) {
            const int fi = sub * 8 + i; const float c = ROPE[((size_t)pos * 32 + fi) * 2], s = ROPE[((size_t)pos * 32 + fi) * 2 + 1];
            const float a = x1[i] * r * gn[fi], b = x2[i] * r * gn[32 + fi];
            dst[fi] = f2bf(a * c - b * s); dst[32 + fi] = f2bf(b * c + a * s);
        }
    }
}
__global__ void k_mlF(const float* __restrict__ MG, float* __restrict__ F) {
    const int chain = threadIdx.x; if (chain >= 16) return;
    const int dir = chain & 1, h = (chain >> 1) & 3, b = chain >> 3;
    const int col = (dir ? 12 : 4) + h; float acc = 0.f;
    if (!dir) { for (int p = 0; p < S; ++p) { acc += logsigf_(MG[(size_t)(b * S + p) * 16 + col]); F[chain * S + p] = acc; } }
    else      { for (int p = S - 1; p >= 0; --p) { acc += logsigf_(MG[(size_t)(b * S + p) * 16 + col]); F[chain * S + p] = acc; } }
}
__global__ __launch_bounds__(256) void k_mlquad(const bf16* __restrict__ PROJ, const float* __restrict__ MG, const float* __restrict__ F, float* __restrict__ HF) {
    __shared__ float qs[16][128 + 1], ks[64][128 + 1], sc[16][64 + 1], rs[16];
    const int chain = blockIdx.y, dir = chain & 1, h = (chain >> 1) & 3, b = chain >> 3;
    const int t0 = blockIdx.x * 16, tid = threadIdx.x; const int icol = (dir ? 8 : 0) + h;
    for (int i = tid; i < 16 * 128; i += 256) { const int tt = i >> 7, kk = i & 127; qs[tt][kk] = bf2f(PROJ[(size_t)(b * S + t0 + tt) * NPJ + P_MQ + h * 128 + kk]); }
    float acc[16];
#pragma unroll
    for (int i = 0; i < 16; ++i) acc[i] = 0.f;
    if (tid < 16) rs[tid] = 0.f;
    const int sbeg = dir ? (t0 / 64) * 64 : 0, send = dir ? S : (t0 + 16 + 63) / 64 * 64;
    for (int s0 = sbeg; s0 < send; s0 += 64) {
        __syncthreads();
        for (int i = tid; i < 64 * 128; i += 256) { const int ss = i >> 7, kk = i & 127; ks[ss][kk] = bf2f(PROJ[(size_t)(b * S + s0 + ss) * NPJ + P_MK + h * 128 + kk]); }
        __syncthreads();
        for (int i = tid; i < 1024; i += 256) {
            const int tt = i >> 6, ss = i & 63; const int t = t0 + tt, s = s0 + ss; float v = 0.f;
            const bool ok = dir ? (s >= t) : (s <= t);
            if (ok) { float d = 0.f; for (int kk = 0; kk < 128; ++kk) d += qs[tt][kk] * ks[ss][kk];
                v = d * __expf(F[chain * S + t] - F[chain * S + s] + MG[(size_t)(b * S + s) * 16 + icol]); }
            sc[tt][ss] = v;
        }
        __syncthreads();
        if (tid < 16) { float r = 0.f; for (int ss = 0; ss < 64; ++ss) r += sc[tid][ss]; rs[tid] += r; }
        for (int ss = 0; ss < 64; ++ss) { const float vv = bf2f(PROJ[(size_t)(b * S + s0 + ss) * NPJ + P_MV + h * 256 + tid]);
#pragma unroll
            for (int tt = 0; tt < 16; ++tt) acc[tt] += sc[tt][ss] * vv; }
    }
    __syncthreads();
#pragma unroll
    for (int tt = 0; tt < 16; ++tt) HF[((size_t)dir * T + (b * S + t0 + tt)) * 1024 + h * 256 + tid] = acc[tt] / fmaxf(fabsf(rs[tt]), 1.f);
}
__global__ __launch_bounds__(256) void k_mlpost(const float* __restrict__ HF, const bf16* __restrict__ PROJ, const float* __restrict__ g, bf16* __restrict__ HM) {
    const int w = blockIdx.x * 4 + (threadIdx.x >> 6), lane = threadIdx.x & 63; const int t = w >> 2, h = w & 3;
    float v[4]; float ss = 0.f;
#pragma unroll
    for (int j = 0; j < 4; ++j) { const int c = h * 256 + lane + 64 * j; v[j] = HF[(size_t)t * 1024 + c] + HF[((size_t)T + t) * 1024 + c]; ss += v[j] * v[j]; }
    ss = wave_sum(ss); const float r = rsqrtf(ss * (1.f / 256.f) + EPS);
#pragma unroll
    for (int j = 0; j < 4; ++j) { const int c = h * 256 + lane + 64 * j; HM[(size_t)t * 1024 + c] = f2bf(v[j] * r * g[lane + 64 * j] * bf2f(PROJ[(size_t)t * NPJ + P_MO + c])); }
}
__global__ __launch_bounds__(256) void k_attn(const bf16* __restrict__ QN, const bf16* __restrict__ KN, const bf16* __restrict__ PROJ, const float* __restrict__ lamp, float* __restrict__ OD32) {
    __shared__ float qs[2][16][64 + 1], ks[2][64][64 + 1], sc[2][16][64 + 1], ls[2][16];
    const int bh = blockIdx.y, b = bh >> 3, h = bh & 7, t0 = blockIdx.x * 16, tid = threadIdx.x;
    const int v = tid & 127, mp = tid >> 7;
    for (int i = tid; i < 2 * 16 * 64; i += 256) { const int m = i >> 10, tt = (i >> 6) & 15, dd = i & 63; qs[m][tt][dd] = bf2f(QN[(size_t)(b * S + t0 + tt) * 1024 + h * 128 + m * 64 + dd]); }
    if (tid < 32) ls[tid >> 4][tid & 15] = 0.f;
    float acc[16];
#pragma unroll
    for (int i = 0; i < 16; ++i) acc[i] = 0.f;
    for (int s0 = 0; s0 < S; s0 += 64) {
        __syncthreads();
        for (int i = tid; i < 2 * 64 * 64; i += 256) { const int m = i >> 12, ss = (i >> 6) & 63, dd = i & 63; ks[m][ss][dd] = bf2f(KN[(size_t)(b * S + s0 + ss) * 1024 + h * 128 + m * 64 + dd]); }
        __syncthreads();
        for (int i = tid; i < 2 * 16 * 64; i += 256) { const int m = i >> 10, tt = (i >> 6) & 15, ss = i & 63; float d = 0.f;
            for (int dd = 0; dd < 64; ++dd) d += qs[m][tt][dd] * ks[m][ss][dd];
            sc[m][tt][ss] = exp2f(d); }
        __syncthreads();
        if (tid < 32) { const int m = tid >> 4, tt = tid & 15; float r = 0.f; for (int ss = 0; ss < 64; ++ss) r += sc[m][tt][ss]; ls[m][tt] += r; }
        for (int ss = 0; ss < 64; ++ss) { const float vv = bf2f(PROJ[(size_t)(b * S + s0 + ss) * NPJ + P_DV + h * 128 + v]);
#pragma unroll
            for (int tt = 0; tt < 16; ++tt) acc[tt] += sc[mp][tt][ss] * vv; }
    }
    __syncthreads();
    float s01 = 0.f, s23 = 0.f;
    for (int i = 0; i < 64; ++i) { s01 += lamp[i] * lamp[64 + i]; s23 += lamp[128 + i] * lamp[192 + i]; }
    const float lam = __expf(s01) - __expf(s23) + LAM_INIT;
    float* ob = &ks[0][0][0];
    if (mp == 1) { for (int tt = 0; tt < 16; ++tt) ob[tt * 128 + v] = acc[tt] / ls[1][tt]; }
    __syncthreads();
    if (mp == 0) { for (int tt = 0; tt < 16; ++tt) OD32[(size_t)(b * S + t0 + tt) * 1024 + h * 128 + v] = acc[tt] / ls[0][tt] - lam * ob[tt * 128 + v]; }
}
__global__ __launch_bounds__(256) void k_dapost(const float* __restrict__ OD32, const float* __restrict__ g, bf16* __restrict__ OD) {
    const int w = blockIdx.x * 4 + (threadIdx.x >> 6), lane = threadIdx.x & 63; const int t = w >> 3, h = w & 7;
    float v[2]; float ss = 0.f;
#pragma unroll
    for (int j = 0; j < 2; ++j) { v[j] = OD32[(size_t)t * 1024 + h * 128 + lane + 64 * j]; ss += v[j] * v[j]; }
    ss = wave_sum(ss); const float r = rsqrtf(ss * (1.f / 128.f) + EPS);
#pragma unroll
    for (int j = 0; j < 2; ++j) OD[(size_t)t * 1024 + h * 128 + lane + 64 * j] = f2bf(v[j] * r * g[lane + 64 * j] * (1.f - LAM_INIT));
}
__global__ __launch_bounds__(256) void k_route1(const float* __restrict__ x1, const float* __restrict__ g2, const float* __restrict__ wr, const float* __restrict__ br,
                                                bf16* __restrict__ H2, int* __restrict__ cnt, int* __restrict__ TOPE, int* __restrict__ SLOT, float* __restrict__ WTS) {
    const int t = blockIdx.x * 4 + (threadIdx.x >> 6), lane = threadIdx.x & 63;
    const float* xr = x1 + (size_t)t * D; float v[32]; float s = 0.f;
#pragma unroll
    for (int j = 0; j < 32; ++j) { v[j] = xr[lane + 64 * j]; s += v[j] * v[j]; }
    s = wave_sum(s); const float r = rsqrtf(s * (1.f / D) + EPS);
#pragma unroll
    for (int j = 0; j < 32; ++j) { v[j] = v[j] * r * g2[lane + 64 * j]; H2[(size_t)t * D + lane + 64 * j] = f2bf(v[j]); }
    float mylogit = -INFINITY;
    for (int e = 0; e < NE; ++e) { float p = 0.f;
#pragma unroll
        for (int j = 0; j < 32; ++j) p += v[j] * wr[(size_t)(lane + 64 * j) * NE + e];
        p = wave_sum(p) + br[e]; if (lane == e) mylogit = p; }
    float tv[4]; int ti[4]; float cur = mylogit;
#pragma unroll
    for (int k = 0; k < 4; ++k) { const float m = wave_max(cur); const unsigned long long bal = __ballot(cur == m && lane < NE); const int idx = __ffsll((long long)bal) - 1; tv[k] = m; ti[k] = idx; if (lane == idx) cur = -INFINITY; }
    if (lane == 0) { const float e1 = __expf(tv[1] - tv[0]), e2 = __expf(tv[2] - tv[0]), e3 = __expf(tv[3] - tv[0]); const float inv = 1.f / (1.f + e1 + e2 + e3);
        const float w[4] = {inv, e1 * inv, e2 * inv, e3 * inv};
#pragma unroll
        for (int k = 0; k < 4; ++k) { TOPE[t * 4 + k] = ti[k]; SLOT[t * 4 + k] = atomicAdd(&cnt[ti[k]], 1); WTS[t * 4 + k] = w[k]; } }
}
__global__ __launch_bounds__(256) void k_route2(const bf16* __restrict__ H2, const int* __restrict__ cnt, const int* __restrict__ TOPE, const int* __restrict__ SLOT, int* __restrict__ DEST, bf16* __restrict__ XG) {
    const int a = blockIdx.x * 4 + (threadIdx.x >> 6), lane = threadIdx.x & 63;
    if (a < T * TOPK) { const int t = a >> 2, e = TOPE[a]; int start = 0;
        for (int i = 0; i < e; ++i) start += (cnt[i] + PADM - 1) / PADM * PADM;
        const int row = start + SLOT[a]; if (lane == 0) DEST[a] = row;
        for (int j = 0; j < 32; ++j) XG[(size_t)row * D + lane + 64 * j] = H2[(size_t)t * D + lane + 64 * j];
    } else { const int p = a - T * TOPK; if (p >= NE * PADM) return;
        const int e = p / PADM, q = p % PADM; int start = 0;
        for (int i = 0; i < e; ++i) start += (cnt[i] + PADM - 1) / PADM * PADM;
        const int c = cnt[e], padded = (c + PADM - 1) / PADM * PADM;
        if (c + q < padded) { const int row = start + c + q; for (int j = 0; j < 32; ++j) XG[(size_t)row * D + lane + 64 * j] = 0; } }
}
__global__ __launch_bounds__(256) void k_combine(float* __restrict__ out, const bf16* __restrict__ Y, const int* __restrict__ DEST, const float* __restrict__ WTS) {
    const int t = blockIdx.x * 4 + (threadIdx.x >> 6), lane = threadIdx.x & 63; int d[4]; float w[4];
#pragma unroll
    for (int k = 0; k < 4; ++k) { d[k] = DEST[t * 4 + k]; w[k] = WTS[t * 4 + k]; }
    for (int j = 0; j < 32; ++j) { const int c = lane + 64 * j; float a = out[(size_t)t * D + c];
#pragma unroll
        for (int k = 0; k < 4; ++k) a += w[k] * bf2f(Y[(size_t)d[k] * D + c]);
        out[(size_t)t * D + c] = a; }
}
#endif
#ifndef MEGA_MASK
#define MEGA_MASK 0xFF
#endif
static int g_grid = 0;
static void launch_mega(Args a, int lo, int hi, hipStream_t stream) {
    (void)hipMemsetAsync(a.ws + WS_CTL + CW_BAR * 4, 0, XCD_BAR_WORDS * 4, stream);
    a.ph_lo = lo; a.ph_hi = hi;
    hipLaunchKernelGGL(mega_fwd, dim3(g_grid), dim3(NTHR), LDS_BYTES, stream, a);
}
extern "C" void kernel_launch(void* const* d_in, const int* in_sizes, int n_in, void* d_out, int out_size, void* d_ws, size_t ws_size, hipStream_t stream) {
    if (g_grid == 0) {
        int dev = 0, cus = 0;
        if (n_in != 19 || out_size != T * D || hipGetDevice(&dev) != hipSuccess || hipDeviceGetAttribute(&cus, hipDeviceAttributeMultiprocessorCount, dev) != hipSuccess) { g_grid = -1; return; }
        if (hipFuncSetAttribute((const void*)mega_fwd, hipFuncAttributeMaxDynamicSharedMemorySize, LDS_BYTES) != hipSuccess) { g_grid = -1; return; }
        int per_cu = 0; (void)hipOccupancyMaxActiveBlocksPerMultiprocessor(&per_cu, (const void*)mega_fwd, NTHR, LDS_BYTES); (void)hipGetLastError();
        g_grid = cus;
    }
    if (g_grid < 0) return;
    Args a{};
    for (int i = 0; i < 19; ++i) a.in[i] = (const float*)d_in[i];
    a.out = (float*)d_out; a.ws = (unsigned char*)d_ws;
    (void)hipMemsetAsync(a.ws + WS_CTL, 0, 4096 * 4, stream);
#ifdef DEV_NAIVE
    unsigned char* ws = a.ws; const int mask = MEGA_MASK;
    bf16* PROJ = (bf16*)(ws + WS_PROJ); float* MG = (float*)(ws + WS_MG); float* ROPE = (float*)(ws + WS_ROPE);
    bf16* QN = (bf16*)(ws + WS_QN); bf16* KN = (bf16*)(ws + WS_KN); bf16* HM = (bf16*)(ws + WS_HM); bf16* OD = (bf16*)(ws + WS_OD);
    bf16* H2 = (bf16*)(ws + WS_H2); bf16* XG = (bf16*)(ws + WS_XG); bf16* ACT = (bf16*)(ws + WS_ACT); bf16* Y = (bf16*)(ws + WS_Y);
    int* cnt = (int*)(ws + WS_CTL) + CW_CNT; int* TOPE = (int*)(ws + WS_RT); int* SLOT = TOPE + T * 4; float* WTS = (float*)(SLOT + T * 4); int* DEST = (int*)(WTS + T * 4);
    float* XN32 = (float*)(ws + NV_XN32); float* PROJ32 = (float*)(ws + NV_PROJ32); float* F = (float*)(ws + NV_F); float* HF = (float*)(ws + NV_HF); float* OD32 = (float*)(ws + NV_OD32); float* MIX32 = (float*)(ws + NV_MIX32);
    const float* x = a.in[0]; float* out = a.out;
    static const int ranges[8][2] = {{0, 2}, {2, 3}, {3, 6}, {6, 7}, {7, 9}, {9, 11}, {11, 13}, {13, 14}};
    for (int s = 0; s < 8; ++s) {
        if (mask & (1 << s)) { int e = s; while (e + 1 < 8 && (mask & (1 << (e + 1)))) ++e; launch_mega(a, ranges[s][0], ranges[e][1], stream); s = e; continue; }
        switch (s) {
        case 0: { k_rmsnorm<<<T / 4, 256, 0, stream>>>(x, a.in[1], XN32);
            GArgs g{}; g.A = XN32; g.B = a.in[2]; g.C = PROJ32; g.M = T; g.N = DIN; g.K = D; g.lda = D; g.ldb = DIN; g.ldc = DIN;
            k_gemm<0, float><<<dim3((DIN + 63) / 64, T / 64), 256, 0, stream>>>(g);
            k_pack<<<T, 256, 0, stream>>>(PROJ32, a.in[3], PROJ, MG); k_rope<<<S * 32 / 256, 256, 0, stream>>>(ROPE); } break;
        case 1: k_qkprep<<<T / 4, 256, 0, stream>>>(PROJ, ROPE, a.in[6], a.in[7], QN, KN); break;
        case 2: k_mlF<<<1, 64, 0, stream>>>(MG, F); k_mlquad<<<dim3(S / 16, 16), 256, 0, stream>>>(PROJ, MG, F, HF); k_mlpost<<<T, 256, 0, stream>>>(HF, PROJ, a.in[4], HM); break;
        case 3: k_attn<<<dim3(S / 16, 16), 256, 0, stream>>>(QN, KN, PROJ, a.in[8], OD32); k_dapost<<<T * 2, 256, 0, stream>>>(OD32, a.in[9], OD); break;
        case 4: { GArgs g{}; g.A = HM; g.B = a.in[5]; g.C = MIX32; g.M = T; g.N = D; g.K = MLW; g.lda = MLW; g.ldb = D; g.ldc = D; g.aux0 = PROJ;
            k_gemm<1, bf16><<<dim3(D / 64, T / 64), 256, 0, stream>>>(g);
            g.A = OD; g.B = a.in[10]; g.K = DAW; g.lda = DAW; k_gemm<2, bf16><<<dim3(D / 64, T / 64), 256, 0, stream>>>(g);
            GArgs h{}; h.A = MIX32; h.B = a.in[11]; h.C = out; h.M = T; h.N = D; h.K = D; h.lda = D; h.ldb = D; h.ldc = D; h.aux0 = x;
            k_gemm<3, float><<<dim3(D / 64, T / 64), 256, 0, stream>>>(h); } break;
        case 5: k_route1<<<T / 4, 256, 0, stream>>>(out, a.in[12], a.in[13], a.in[14], H2, cnt, TOPE, SLOT, WTS);
            k_route2<<<(T * TOPK + NE * PADM) / 4, 256, 0, stream>>>(H2, cnt, TOPE, SLOT, DEST, XG); break;
        case 6: { GArgs g{}; g.A = XG; g.B = a.in[15]; g.C = ACT; g.N = 2 * DE; g.K = D; g.lda = D; g.ldb = 2 * DE; g.ldc = DE; g.aux0 = a.in[16]; g.cnt = cnt;
            k_gemm<4, bf16><<<dim3(2 * DE / 64, T / 64, NE), 256, 0, stream>>>(g);
            GArgs h{}; h.A = ACT; h.B = a.in[17]; h.C = Y; h.N = D; h.K = DE; h.lda = DE; h.ldb = D; h.ldc = D; h.aux0 = a.in[18]; h.cnt = cnt;
            k_gemm<5, bf16><<<dim3(D / 64, T / 64, NE), 256, 0, stream>>>(h); } break;
        case 7: k_combine<<<T / 4, 256, 0, stream>>>(out, Y, DEST, WTS); break;
        }
    }
#else
    launch_mega(a, 0, N_PHASES, stream);
#endif
}
```
